# Optimizing an MI355X kernel written in HIP

```python
import math
import jax, jax.numpy as jnp
from jax import lax
import numpy as np

D_MODEL = 1024
BATCH = 4
SEQ = 8192
DEPTH = 1

D_MIX = D_MODEL
N_DIFF_HEADS = 8
DIFF_HEAD_DIM = 32
DIFF_V_DIM = 2 * DIFF_HEAD_DIM
D_ATTN = N_DIFF_HEADS * DIFF_V_DIM
D_SSM = D_MIX - D_ATTN
SSM_GROUP = 16
N_SSM_GROUPS = D_SSM // SSM_GROUP
SSM_STATE = 64
D_IN_PROJ = 3 * D_ATTN + D_SSM
N_EXPERTS = 32
TOP_K = 4
D_FF = D_MODEL
SWIGLU_LIMIT = 7.0
SWIGLU_ALPHA = 1.702
PLE_DIM = 256
Q_BLOCK = 128
MOE_BLOCK = 128
LN_EPS = 1e-5
RMS_EPS = 1e-5
DEEPNORM_ALPHA = (2.0 * DEPTH) ** 0.25
DEEPNORM_BETA = (8.0 * DEPTH) ** -0.25

kernel_name = "hymba_diffattn_s5_moe_deepnorm"


def layer_norm(x, g, b):
    xf = x.astype(jnp.float32)
    mu = jnp.mean(xf, axis=-1, keepdims=True)
    var = jnp.mean(jnp.square(xf - mu), axis=-1, keepdims=True)
    return ((xf - mu) * lax.rsqrt(var + LN_EPS) * g + b).astype(x.dtype)


def rms_norm(x, g):
    xf = x.astype(jnp.float32)
    return (xf * lax.rsqrt(jnp.mean(jnp.square(xf), axis=-1, keepdims=True) + RMS_EPS) * g).astype(x.dtype)


def alibi_slopes(n_heads):
    return jnp.exp2(-(jnp.arange(n_heads, dtype=jnp.float32) + 1.0) * (8.0 / n_heads))


def diff_attention(q, k, v, lam, subln_g, lambda_init):
    Bsz, H, L, _ = v.shape
    nb = L // Q_BLOCK
    scale = DIFF_HEAD_DIM ** -0.5
    slopes = alibi_slopes(H)
    kpos = jnp.arange(L, dtype=jnp.int32)
    qb = q.reshape(Bsz, H, nb, Q_BLOCK, 2, DIFF_HEAD_DIM).transpose(2, 0, 1, 3, 4, 5)

    def block(args):
        i, qi = args
        qpos = i * Q_BLOCK + jnp.arange(Q_BLOCK, dtype=jnp.int32)
        s = jnp.einsum('bhqmd,bhkmd->bhmqk', qi, k,
                       preferred_element_type=jnp.float32) * scale
        dist = (qpos[:, None] - kpos[None, :]).astype(jnp.float32)
        bias = jnp.where(dist >= 0, -slopes[:, None, None] * dist, -jnp.inf)
        probs = jax.nn.softmax(s + bias[None, :, None], axis=-1)
        w = probs[:, :, 0] - lam * probs[:, :, 1]
        return jnp.einsum('bhqk,bhkd->bhqd', w.astype(v.dtype), v)

    o = lax.map(block, (jnp.arange(nb, dtype=jnp.int32), qb))
    o = o.transpose(1, 2, 0, 3, 4).reshape(Bsz, H, L, DIFF_V_DIM)
    o = rms_norm(o, subln_g) * (1.0 - lambda_init)
    return o.transpose(0, 2, 1, 3).reshape(Bsz, L, H * DIFF_V_DIM)


def _ssm_combine(e1, e2):
    a1, b1 = e1
    a2, b2 = e2
    return (a2 * a1, a2 * b1 + b2)


def s5_ssm(u, a_re, a_im, log_dt, b_re, b_im, c_re, c_im, d_skip):
    Bsz, L, _ = u.shape
    f32 = jnp.float32
    A = lax.complex(a_re.astype(f32), a_im.astype(f32))
    dt = jnp.exp(log_dt.astype(f32))[:, None]
    A_bar = jnp.exp(A * dt)
    Bm = lax.complex(b_re.astype(f32), b_im.astype(f32))
    B_bar = ((A_bar - 1.0) / A)[..., None] * Bm
    Cm = lax.complex(c_re.astype(f32), c_im.astype(f32))
    uf = u.astype(f32)
    ug = uf.reshape(Bsz, L, N_SSM_GROUPS, SSM_GROUP)

    def one(u_b):
        bu = jnp.einsum('lgc,gpc->lgp', u_b, B_bar)
        a = jnp.broadcast_to(A_bar, bu.shape)
        _, states = lax.associative_scan(_ssm_combine, (a, bu), axis=0)
        return jnp.einsum('lgp,gcp->lgc', states, Cm).real

    y = lax.map(one, ug).reshape(Bsz, L, D_SSM)
    y = y + d_skip.astype(f32) * uf
    return y.astype(u.dtype)


def moe(x, w_router, b_router, w_gate_up, b_gate_up, w_down, b_down):
    Bsz, L, D = x.shape
    T = Bsz * L
    xf = x.reshape(T, D)
    logits = (xf @ w_router + b_router).astype(jnp.float32)
    top_vals, top_idx = lax.top_k(logits, TOP_K)
    gates = jax.nn.softmax(top_vals, axis=-1)
    n_assign = T * TOP_K
    flat_e = top_idx.reshape(-1).astype(jnp.int32)
    flat_tok = jnp.arange(n_assign, dtype=jnp.int32) // TOP_K
    flat_gate = gates.reshape(-1)
    order = jnp.argsort(flat_e)
    sorted_e = flat_e[order]
    counts = jnp.bincount(flat_e, length=N_EXPERTS).astype(jnp.int32)
    padded = ((counts + MOE_BLOCK - 1) // MOE_BLOCK) * MOE_BLOCK
    pad_end = jnp.cumsum(padded)
    pad_start = pad_end - padded
    start = jnp.cumsum(counts) - counts
    rank = jnp.arange(n_assign, dtype=jnp.int32) - start[sorted_e]
    dest = pad_start[sorted_e] + rank
    n_pad = n_assign + N_EXPERTS * MOE_BLOCK
    n_blocks = n_pad // MOE_BLOCK
    slot_tok = jnp.zeros((n_pad,), jnp.int32).at[dest].set(flat_tok[order])
    slot_gate = jnp.zeros((n_pad,), jnp.float32).at[dest].set(flat_gate[order])
    block_e = jnp.minimum(
        jnp.searchsorted(pad_end, jnp.arange(n_blocks, dtype=jnp.int32) * MOE_BLOCK, side='right'),
        N_EXPERTS - 1).astype(jnp.int32)

    def expert_block(args):
        e, tok = args
        xb = xf[tok]
        h = xb @ w_gate_up[e] + b_gate_up[e]
        x_glu = jnp.minimum(h[:, ::2], SWIGLU_LIMIT)
        x_lin = jnp.clip(h[:, 1::2], -SWIGLU_LIMIT, SWIGLU_LIMIT)
        act = x_glu * jax.nn.sigmoid(SWIGLU_ALPHA * x_glu) * (x_lin + 1.0)
        return act @ w_down[e] + b_down[e]

    out = lax.map(expert_block, (block_e, slot_tok.reshape(n_blocks, MOE_BLOCK)))
    out = out.reshape(n_pad, D) * slot_gate[:, None].astype(x.dtype)
    y = jnp.zeros_like(xf).at[slot_tok].add(out)
    return y.reshape(Bsz, L, D)


def setup_inputs(seed: int = 0) -> dict:
    key = jax.random.key(seed)
    ks = jax.random.split(key, 40)
    f32 = jnp.float32

    def nrm(k, shape, s):
        return s * jax.random.normal(k, shape, f32)

    n_idx = jnp.arange(SSM_STATE, dtype=f32)
    return {
        "x": nrm(ks[0], (BATCH, SEQ, D_MODEL), 1.0),
        "p": nrm(ks[1], (DEPTH, BATCH, SEQ, PLE_DIM), 1.0),
        "w_in": nrm(ks[2], (DEPTH, D_MODEL, D_IN_PROJ), D_MODEL ** -0.5),
        "lambda_q1": nrm(ks[3], (DEPTH, DIFF_HEAD_DIM), 0.1),
        "lambda_k1": nrm(ks[4], (DEPTH, DIFF_HEAD_DIM), 0.1),
        "lambda_q2": nrm(ks[5], (DEPTH, DIFF_HEAD_DIM), 0.1),
        "lambda_k2": nrm(ks[6], (DEPTH, DIFF_HEAD_DIM), 0.1),
        "subln_g": 1.0 + nrm(ks[7], (DEPTH, DIFF_V_DIM), 0.02),
        "ssm_a_re": -0.5 + nrm(ks[8], (DEPTH, N_SSM_GROUPS, SSM_STATE), 0.01),
        "ssm_a_im": jnp.pi * n_idx[None, None, :] + nrm(ks[9], (DEPTH, N_SSM_GROUPS, SSM_STATE), 0.01),
        "ssm_log_dt": jax.random.uniform(ks[10], (DEPTH, N_SSM_GROUPS), f32,
                                         math.log(1e-3), math.log(1e-1)),
        "ssm_b_re": nrm(ks[11], (DEPTH, N_SSM_GROUPS, SSM_STATE, SSM_GROUP), (0.5 / SSM_GROUP) ** 0.5),
        "ssm_b_im": nrm(ks[12], (DEPTH, N_SSM_GROUPS, SSM_STATE, SSM_GROUP), (0.5 / SSM_GROUP) ** 0.5),
        "ssm_c_re": nrm(ks[13], (DEPTH, N_SSM_GROUPS, SSM_GROUP, SSM_STATE), (0.5 / SSM_STATE) ** 0.5),
        "ssm_c_im": nrm(ks[14], (DEPTH, N_SSM_GROUPS, SSM_GROUP, SSM_STATE), (0.5 / SSM_STATE) ** 0.5),
        "ssm_d": nrm(ks[15], (DEPTH, D_SSM), 1.0),
        "w_glu": nrm(ks[16], (DEPTH, D_SSM, 2 * D_SSM), D_SSM ** -0.5),
        "ssm_norm_g": 1.0 + nrm(ks[17], (DEPTH, D_SSM), 0.02),
        "w_out": nrm(ks[18], (DEPTH, D_MIX, D_MODEL), D_MIX ** -0.5 * DEEPNORM_BETA),
        "ln1_g": 1.0 + nrm(ks[19], (DEPTH, D_MODEL), 0.02),
        "ln1_b": nrm(ks[20], (DEPTH, D_MODEL), 0.01),
        "w_router": nrm(ks[21], (DEPTH, D_MODEL, N_EXPERTS), D_MODEL ** -0.5),
        "b_router": nrm(ks[22], (DEPTH, N_EXPERTS), 0.01),
        "w_gate_up": nrm(ks[23], (DEPTH, N_EXPERTS, D_MODEL, 2 * D_FF), D_MODEL ** -0.5),
        "b_gate_up": nrm(ks[24], (DEPTH, N_EXPERTS, 2 * D_FF), 0.01),
        "w_down": nrm(ks[25], (DEPTH, N_EXPERTS, D_FF, D_MODEL), D_FF ** -0.5 * DEEPNORM_BETA),
        "b_down": nrm(ks[26], (DEPTH, N_EXPERTS, D_MODEL), 0.01),
        "w_ple_gate": nrm(ks[27], (DEPTH, D_MODEL, D_MODEL), D_MODEL ** -0.5),
        "w_ple_proj": nrm(ks[28], (DEPTH, PLE_DIM, D_MODEL), PLE_DIM ** -0.5 * DEEPNORM_BETA),
        "ln2_g": 1.0 + nrm(ks[29], (DEPTH, D_MODEL), 0.02),
        "ln2_b": nrm(ks[30], (DEPTH, D_MODEL), 0.01),
    }


def reference(x, p, w_in, lambda_q1, lambda_k1, lambda_q2, lambda_k2, subln_g,
              ssm_a_re, ssm_a_im, ssm_log_dt, ssm_b_re, ssm_b_im, ssm_c_re, ssm_c_im,
              ssm_d, w_glu, ssm_norm_g, w_out, ln1_g, ln1_b,
              w_router, b_router, w_gate_up, b_gate_up, w_down, b_down,
              w_ple_gate, w_ple_proj, ln2_g, ln2_b):
    Bsz, L, _ = x.shape
    for i in range(DEPTH):
        lambda_init = 0.8 - 0.6 * math.exp(-0.3 * i)
        h = x @ w_in[i]
        q, k, v, u = jnp.split(h, [D_ATTN, 2 * D_ATTN, 3 * D_ATTN], axis=-1)
        q = q.reshape(Bsz, L, N_DIFF_HEADS, 2, DIFF_HEAD_DIM).transpose(0, 2, 1, 3, 4)
        k = k.reshape(Bsz, L, N_DIFF_HEADS, 2, DIFF_HEAD_DIM).transpose(0, 2, 1, 3, 4)
        v = v.reshape(Bsz, L, N_DIFF_HEADS, DIFF_V_DIM).transpose(0, 2, 1, 3)
        lam = (jnp.exp(jnp.sum(lambda_q1[i].astype(jnp.float32) * lambda_k1[i].astype(jnp.float32)))
               - jnp.exp(jnp.sum(lambda_q2[i].astype(jnp.float32) * lambda_k2[i].astype(jnp.float32)))
               + lambda_init)
        attn_out = diff_attention(q, k, v, lam, subln_g[i], lambda_init)
        y = s5_ssm(u, ssm_a_re[i], ssm_a_im[i], ssm_log_dt[i], ssm_b_re[i], ssm_b_im[i],
                   ssm_c_re[i], ssm_c_im[i], ssm_d[i])
        y = jax.nn.gelu(y)
        g = y @ w_glu[i]
        y = g[..., :D_SSM] * jax.nn.sigmoid(g[..., D_SSM:])
        ssm_out = rms_norm(y, ssm_norm_g[i])
        mix = jnp.concatenate([attn_out, ssm_out], axis=-1) @ w_out[i]
        x = layer_norm(DEEPNORM_ALPHA * x + mix, ln1_g[i], ln1_b[i])
        r = DEEPNORM_ALPHA * x + moe(x, w_router[i], b_router[i], w_gate_up[i], b_gate_up[i],
                                     w_down[i], b_down[i])
        gate = jax.nn.sigmoid(r @ w_ple_gate[i])
        x = layer_norm(r + gate * (p[i] @ w_ple_proj[i]), ln2_g[i], ln2_b[i])
    return x
```

```cpp
#include <hip/hip_runtime.h>
#include <cstdio>
#include <cstdint>

#ifndef PROBE_MASK
#define PROBE_MASK 0
#endif
#ifndef PROBE_SEL
#define PROBE_SEL 0
#endif
#ifndef PROBE_DUP
#define PROBE_DUP -1
#endif
#ifndef MK_N_LAUNCHES
#define MK_N_LAUNCHES 1
#endif

namespace {
constexpr int BATCH = 4, SEQ = 8192, DM = 1024, T = BATCH * SEQ;
constexpr int NH = 8, NG = 32, NS = 64, DIN = 2048;
constexpr int NE = 32, PLE = 256;
constexpr int ECAP = T;
constexpr float LN_EPS = 1e-5f, RMS_EPS = 1e-5f;
constexpr float ALPHA = 1.189207115002721f;
constexpr float QSCALE = 0.17677669529663687f * 1.4426950408889634f;
constexpr float LOG2E = 1.4426950408889634f;
constexpr int NPHASE = 11;
constexpr int NWAVES = 8, NTHREADS = 512;

typedef _Float16 f16;
typedef f16 h8 __attribute__((ext_vector_type(8)));
typedef f16 h4 __attribute__((ext_vector_type(4)));
typedef f16 h2 __attribute__((ext_vector_type(2)));
typedef float f32x4 __attribute__((ext_vector_type(4)));
typedef float f32x16 __attribute__((ext_vector_type(16)));
typedef int i32x4 __attribute__((ext_vector_type(4)));
typedef int i32x8 __attribute__((ext_vector_type(8)));
#define LAS __attribute__((address_space(3)))
#define GAS __attribute__((address_space(1)))
typedef GAS unsigned gu32;
#define RLX_AGENT __ATOMIC_RELAXED, __HIP_MEMORY_SCOPE_AGENT

constexpr size_t MiB = 1u << 20;
constexpr size_t WS_CTL = 0, CTL_ZERO_BYTES = 1 * MiB;
constexpr size_t WS_STATS = 3 * MiB;
constexpr size_t WS_GATES = 5 * MiB;
constexpr size_t WS_LIST = 6 * MiB;
constexpr size_t WS_WIN = 16 * MiB;
constexpr size_t WS_WGLU = 20 * MiB;
constexpr size_t WS_WOUT = 21 * MiB;
constexpr size_t WS_WPG = 23 * MiB;
constexpr size_t WS_WPP = 25 * MiB;
constexpr size_t WS_WGU = 32 * MiB;
constexpr size_t WS_WDN = 160 * MiB;
constexpr size_t WS_PE = 224 * MiB;
constexpr size_t WS_V1 = 288 * MiB;
constexpr size_t WS_A = 416 * MiB;
constexpr size_t WS_XH = WS_A;
constexpr size_t WS_PH = WS_A + 64 * MiB;
constexpr size_t WS_QH = WS_A + 80 * MiB;
constexpr size_t WS_KT = WS_A + 112 * MiB;
constexpr size_t WS_VT = WS_A + 144 * MiB;
constexpr size_t WS_UG = WS_A + 176 * MiB;
constexpr size_t WS_ACT = WS_A;
constexpr size_t WS_X1Q = WS_A + 128 * MiB;
constexpr size_t WS_R = WS_A;
constexpr size_t WS_RH = WS_A + 128 * MiB;
constexpr size_t WS_B = 672 * MiB;
constexpr size_t WS_YH = WS_B;
constexpr size_t WS_MIX = WS_B + 32 * MiB;
constexpr size_t WS_X1H = 940 * MiB;
constexpr size_t WS_SLAB = WS_B;
constexpr size_t WS_SSMOP = 928 * MiB;
constexpr size_t WS_A16 = 936 * MiB;
constexpr size_t WS_GATEH = WS_V1;
constexpr size_t WS_MIXO = WS_XH;
constexpr size_t WS_END = 1004 * MiB;

constexpr int CW_BAR = 4096;
constexpr int CW_CNT = 8192;
constexpr int CW_QUEUE = 12288;
constexpr int CW_KMAX = 16384;

constexpr int LDS_BYTES = 147456;
constexpr int LDS_BARST = LDS_BYTES - 64;

__device__ __forceinline__ float wave_sum(float v) {
#pragma unroll
    for (int o = 1; o < 64; o <<= 1) v += __shfl_xor(v, o);
    return v;
}
__device__ __forceinline__ float sigmoidf_(float x) { return __builtin_amdgcn_rcpf(1.0f + __builtin_amdgcn_exp2f(-LOG2E * x)); }
__device__ __forceinline__ float gelu_tanh(float x) {
    const float z = 0.7978845608028654f * (x + 0.044715f * x * x * x);
    const float e = __builtin_amdgcn_exp2f(fminf(2.0f * LOG2E * z, 80.0f));
    const float t = 1.0f - 2.0f * __builtin_amdgcn_rcpf(e + 1.0f);
    return 0.5f * x * (1.0f + t);
}
__device__ __forceinline__ int crow(int r, int hi) { return (r & 3) + 8 * (r >> 2) + 4 * hi; }
__device__ __forceinline__ float swap_add(float v) { return v + __shfl_xor(v, 32); }
__device__ __forceinline__ float swap_max(float v) { return fmaxf(v, __shfl_xor(v, 32)); }

#define XB_TMO      128
#define XB_XCNT(j)  (256  + 64 * (j))
#define XB_XSUB(j)  (1280 + 64 * (j))
#define XB_XGEN(j)  (2304 + 64 * (j))
#define XB_TOP      3328
#define XB_TOPGEN   3392
#define XCD_BAR_WORDS 3456
#define XB_SPIN_CAP (1u << 20)
__device__ __forceinline__ unsigned xb_ld(unsigned* p)              { return __hip_atomic_load(p, __ATOMIC_RELAXED, __HIP_MEMORY_SCOPE_AGENT); }
__device__ __forceinline__ unsigned xb_add(unsigned* p, unsigned v) { return __hip_atomic_fetch_add(p, v, __ATOMIC_RELAXED, __HIP_MEMORY_SCOPE_AGENT); }
__device__ __forceinline__ unsigned xb_xcc_id() { return (unsigned)__builtin_amdgcn_s_getreg((3 << 11) | 20) & 0xFu; }
#define XB_SPIN(cond, bar) do { unsigned _sp = 0; while (cond) { __builtin_amdgcn_s_sleep(1); \
    if ((++_sp & 255u) == 0u) { if (xb_ld(&(bar)[XB_TMO])) break; if (_sp > XB_SPIN_CAP) { atomicAdd(&(bar)[XB_TMO], 1u); break; } } } } while (0)
struct XcdBarrier { unsigned* bar; unsigned x; volatile LAS unsigned* st; };
__device__ __forceinline__ XcdBarrier xcd_barrier_post(unsigned* bar, volatile LAS unsigned* st) {
    XcdBarrier b; b.bar = bar; b.x = xb_xcc_id(); b.st = st;
    if (threadIdx.x == 0) (void)xb_add(&bar[XB_XCNT(b.x)], 1u);
    return b;
}
__device__ __forceinline__ void xcd_barrier_complete(unsigned* bar, unsigned x, unsigned& nloc, unsigned& nx) {
    const unsigned G = gridDim.x * gridDim.y * gridDim.z;
    unsigned sum, cnt, mine, sp = 0u;
    for (;;) {
        sum = 0u; cnt = 0u; mine = 0u;
#pragma unroll
        for (unsigned j = 0; j < 16; ++j) { const unsigned c = xb_ld(&bar[XB_XCNT(j)]); sum += c; cnt += (c > 0u) ? 1u : 0u; mine = (j == x) ? c : mine; }
        if (sum == G) break;
        __builtin_amdgcn_s_sleep(1);
        if ((++sp & 255u) == 0u) { if (xb_ld(&bar[XB_TMO])) break; if (sp > XB_SPIN_CAP) { atomicAdd(&bar[XB_TMO], 1u); break; } }
    }
    nloc = mine > 0u ? mine : 1u; nx = cnt > 0u ? cnt : 1u;
}
__device__ __forceinline__ void xcd_barrier(const XcdBarrier& b) {
    asm volatile("s_waitcnt vmcnt(0)" ::: "memory");
    __syncthreads();
    if (threadIdx.x == 0) {
        unsigned* bar = b.bar;
        __builtin_amdgcn_s_waitcnt(0);
        unsigned nloc = b.st[0], nx = b.st[1];
        if (nloc == 0u) { xcd_barrier_complete(bar, b.x, nloc, nx); b.st[0] = nloc; b.st[1] = nx; }
        const unsigned old = xb_add(&bar[XB_XSUB(b.x)], 1u);
        const unsigned gen = old / nloc;
        if (old + 1u == (gen + 1u) * nloc) {
            __builtin_amdgcn_fence(__ATOMIC_RELEASE, "agent");
            asm volatile("s_waitcnt vmcnt(0)" ::: "memory");
            const unsigned og = xb_add(&bar[XB_TOP], 1u);
            const unsigned tg = og / nx;
            if (og + 1u == (tg + 1u) * nx) xb_add(&bar[XB_TOPGEN], 1u);
            else XB_SPIN(xb_ld(&bar[XB_TOPGEN]) == tg, bar);
            __builtin_amdgcn_fence(__ATOMIC_ACQUIRE, "agent");
            xb_add(&bar[XB_XGEN(b.x)], 1u);
            asm volatile("s_waitcnt vmcnt(0)" ::: "memory");
        } else {
            XB_SPIN(xb_ld(&bar[XB_XGEN(b.x)]) == gen, bar);
            __builtin_amdgcn_fence(__ATOMIC_ACQUIRE, "agent");
            asm volatile("s_waitcnt vmcnt(0)" ::: "memory");
        }
    }
    __syncthreads();
}

struct Args { const float* in[31]; float* out; unsigned char* ws; int ph_lo, ph_hi, pass, pad; };
enum { I_X = 0, I_P, I_WIN, I_LQ1, I_LK1, I_LQ2, I_LK2, I_SUBLN, I_ARE, I_AIM, I_LOGDT, I_BRE, I_BIM, I_CRE, I_CIM, I_SSMD, I_WGLU, I_SSMG, I_WOUT,
       I_LN1G, I_LN1B, I_WR, I_BR, I_WGU, I_BGU, I_WDN, I_BDN, I_WPG, I_WPP, I_LN2G, I_LN2B };

struct Frame {
    LAS unsigned char* lds;
    const Args* a;
    unsigned char* ws;
    gu32* ctl;
    int tid, lane, wave, gw, NGW, G, vcu;
};

namespace pg8 {
constexpr int BM = 256, BK = 64, HALF = 128, HTB = HALF * BK * 2, STAGE_BYTES = 8 * HTB, NXCD = 8, WGM = 8;
__device__ __forceinline__ int lds_byte(int r, int c) { const int st = (r >> 4) * 2 + (c >> 5), rr = r & 15, cc = c & 31, ob = rr * 64 + cc * 2; return st * 1024 + (ob ^ (((ob >> 9) & 1) << 5)); }
__device__ __forceinline__ void stage_rc(int b, int& R, int& C) { const int st = b / 1024, sb = b % 1024, swz = sb ^ (((sb >> 9) & 1) << 5); R = (st >> 1) * 16 + swz / 64; C = (st & 1) * 32 + (swz % 64) / 2; }
struct Unit { int pm, pn, e, cnt; };
struct DenseOrder {
    int nM, nN, nwg, G, c;
    __device__ __forceinline__ void init(int M, int N, int G_, int c_) { nM = M / BM; nN = N / BM; nwg = nM * nN; G = G_; c = c_; }
    __device__ __forceinline__ bool next(int i, Unit& u) const {
        const long L = (long)i * G + c; if (L >= nwg) return false;
        int wgid = (int)L; { const int q = nwg / NXCD, r = nwg % NXCD, xcd = wgid % NXCD, off = wgid / NXCD; wgid = (xcd < r ? xcd * (q + 1) : r * (q + 1) + (xcd - r) * q) + off; }
        const int nig = WGM * nN, gid = wgid / nig, fm = gid * WGM, gsz = (nM - fm) < WGM ? (nM - fm) : WGM;
        u.pm = fm + ((wgid % nig) % gsz); u.pn = (wgid % nig) / gsz; u.e = 0; u.cnt = 0; return true;
    }
};
struct OneOrder { Unit u; __device__ __forceinline__ bool next(int i, Unit& o) const { if (i != 0) return false; o = u; return true; } };
struct MoeOrder {
    const LAS int* tab; int ntn, G, c;
    __device__ __forceinline__ bool next(int i, Unit& u) const {
        const int L = i * G + c; if (L >= tab[64] * ntn) return false;
        int e = 0;
#pragma unroll 1
        for (int q = 1; q < 32; ++q) if (L >= tab[32 + q] * ntn) e = q;
        const int cnt = tab[e], lu = L - tab[32 + e] * ntn;
        u.e = e; u.cnt = cnt; u.pn = lu % ntn; u.pm = lu / ntn; return true;
    }
};

template <class P, class Sched>
__device__ __forceinline__ void gemm_phase(LAS unsigned char* lds, const P& p, const Sched& S) {
    const int tid = threadIdx.x, wid = __builtin_amdgcn_readfirstlane(tid >> 6), lane = tid & 63, wr = wid >> 2, wc = wid & 3, fr = lane & 15, fq = lane >> 4;
    constexpr int K = P::K, PB = P::FP8 ? K : 2 * K  , nt = PB / 128;
    int RA[2]; unsigned CB[2], voffB[2];
#pragma unroll
    for (int i = 0; i < 2; ++i) { int R, C; stage_rc(tid * 16 + i * 8192, R, C); RA[i] = R; CB[i] = (unsigned)C * 2u; voffB[i] = (unsigned)(R * PB + C * 2); }
    constexpr size_t kstep = 128, hstep = (size_t)HALF * PB, tstep = 2 * hstep;
    const unsigned ldsw = (unsigned)wid * 1024u;
    const int aoff = lds_byte(wr * 64 + fr, fq * 8), boff = lds_byte(wc * 32 + fr, fq * 8);
    LAS float* rsl = (LAS float*)(lds + STAGE_BYTES);
    const char* abase = p.abase();
#define PG8_SA(b, h) (((b) * 2 + (h)) * HTB)
#define PG8_SB(b, h) ((4 + (b) * 2 + (h)) * HTB)
#define PG8_STAGE(bufoff, gbase, voff) do { _Pragma("unroll") for (int _i = 0; _i < 2; ++_i) \
        __builtin_amdgcn_global_load_lds((const unsigned*)((const char*)(gbase) + (voff)[_i]), (LAS unsigned*)(lds + (bufoff) + ldsw + _i * 8192), 16, 0, 0); } while (0)
#define PG8_LDA(dst, b, h) do { _Pragma("unroll") for (int m = 0; m < 4; ++m) { \
        if constexpr (P::FP8) { const i32x4 lo_ = *(const LAS i32x4*)(lds + PG8_SA(b, h) + aoff + m * 2048), hi_ = *(const LAS i32x4*)(lds + PG8_SA(b, h) + aoff + m * 2048 + 1024); dst##8[m] = __builtin_shufflevector(lo_, hi_, 0, 1, 2, 3, 4, 5, 6, 7); } \
        else { _Pragma("unroll") for (int k = 0; k < 2; ++k) dst[m][k] = *(const LAS h8*)(lds + PG8_SA(b, h) + aoff + m * 2048 + k * 1024); } } } while (0)
#define PG8_LDB(dst, b, h) do { _Pragma("unroll") for (int n = 0; n < 2; ++n) { \
        if constexpr (P::FP8) { const i32x4 lo_ = *(const LAS i32x4*)(lds + PG8_SB(b, h) + boff + n * 2048), hi_ = *(const LAS i32x4*)(lds + PG8_SB(b, h) + boff + n * 2048 + 1024); dst##8[n] = __builtin_shufflevector(lo_, hi_, 0, 1, 2, 3, 4, 5, 6, 7); } \
        else { _Pragma("unroll") for (int k = 0; k < 2; ++k) dst[n][k] = *(const LAS h8*)(lds + PG8_SB(b, h) + boff + n * 2048 + k * 1024); } } } while (0)
#define PG8_MMA(ai, bj, At, Bt) do { __builtin_amdgcn_s_setprio(1); _Pragma("unroll") for (int m = 0; m < 4; ++m) _Pragma("unroll") for (int n = 0; n < 2; ++n) { \
        if constexpr (P::FP8) asm volatile("v_mfma_scale_f32_16x16x128_f8f6f4 %0, %1, %2, %0, %3, %3 op_sel_hi:[0,0,0]" : "+v"(acc[ai][bj][m][n]) : "v"(Bt##8[n]), "v"(At##8[m]), "v"(one_scale)); \
        else { _Pragma("unroll") for (int k = 0; k < 2; ++k) acc[ai][bj][m][n] = __builtin_amdgcn_mfma_f32_16x16x32_f16(Bt[n][k], At[m][k], acc[ai][bj][m][n], 0, 0, 0); } } \
        __builtin_amdgcn_s_setprio(0); } while (0)
#define PG8_WAIT_V(n) asm volatile("s_waitcnt vmcnt(" #n ")" ::: "memory")
#define PG8_WAIT_L(n) asm volatile("s_waitcnt lgkmcnt(" #n ")" ::: "memory")
#define PG8_BAR __builtin_amdgcn_s_barrier()
#define PG8_SCHED __builtin_amdgcn_sched_barrier(0)
    Unit cur, nxt; int ui = 0;
    if (!S.next(0, cur)) return;
    f32x4 acc[2][2][4][2];
#pragma unroll
    for (int a = 0; a < 2; ++a)
#pragma unroll
        for (int b = 0; b < 2; ++b)
#pragma unroll
            for (int m = 0; m < 4; ++m)
#pragma unroll
                for (int n = 0; n < 2; ++n) acc[a][b][m][n] = (f32x4){0.f, 0.f, 0.f, 0.f};
    h8 At[4][2], B0[2][2], B1[2][2]; i32x8 At8[4], B08[2], B18[2];
    int one_scale = 0x7f7f7f7f; asm volatile("" : "+v"(one_scale));
    LAS int* ginfo = (LAS int*)(lds + STAGE_BYTES + 4096);
    unsigned voffA[2];
    const char* cA = abase; const char* nA = abase;
#pragma unroll
    for (int i = 0; i < 2; ++i) voffA[i] = P::GATHER ? CB[i] : (unsigned)(RA[i] * PB) + CB[i];
    if constexpr (P::GATHER) {
        if (tid < 256) p.fill_rows(cur, ginfo, tid);
        asm volatile("s_waitcnt lgkmcnt(0)" ::: "memory"); PG8_BAR; asm volatile("" ::: "memory");
    } else cA = abase + (size_t)cur.pm * tstep;
    constexpr size_t hA = P::GATHER ? 0 : hstep;
#define PG8_STAGE_A(bufoff, gbase, par, half) do { if constexpr (P::GATHER) { _Pragma("unroll") for (int _i = 0; _i < 2; ++_i) { \
            const unsigned ro_ = p.rowbytes(ginfo[(par) * 512 + (half) * 128 + RA[_i]] & 0x7fffffff) + voffA[_i]; \
            __builtin_amdgcn_global_load_lds((const unsigned*)((const char*)(gbase) + ro_), (LAS unsigned*)(lds + (bufoff) + ldsw + _i * 8192), 16, 0, 0); } } \
        else PG8_STAGE(bufoff, (const char*)(gbase) + (half) * hA, voffA); } while (0)
    const char* cB = p.bptr(cur);
    if constexpr (P::MID) p.mid_prepare(cur, rsl, tid);
    PG8_STAGE(PG8_SB(0, 0), cB, voffB); PG8_STAGE(PG8_SB(0, 1), cB + hstep, voffB); PG8_STAGE_A(PG8_SA(0, 0), cA, 0, 0); PG8_STAGE_A(PG8_SA(0, 1), cA, 0, 1);
    if (wr == 1) PG8_BAR;
    PG8_WAIT_V(2); PG8_BAR;
    PG8_STAGE(PG8_SB(1, 0), cB + kstep, voffB); PG8_STAGE_A(PG8_SA(1, 0), cA + kstep, 0, 0); PG8_STAGE(PG8_SB(1, 1), cB + hstep + kstep, voffB);
    PG8_WAIT_V(6); PG8_BAR;
    for (;;) {
        const bool has_next = S.next(ui + 1, nxt);
        const char* nB = cB; nA = cA;
        const int cpar = ui & 1; int npar = cpar;
        if (has_next) {
            nB = p.bptr(nxt); npar = cpar ^ 1;
            if constexpr (P::GATHER) { if (tid < 256) p.fill_rows(nxt, ginfo + npar * 512, tid); }
            else nA = abase + (size_t)nxt.pm * tstep;
            if constexpr (P::MID) p.mid_prepare(nxt, rsl + 256 * ((ui + 1) & 1), tid);
        }
#pragma unroll 1
        for (int t = 0; t < nt; t += 2) {
            const bool last = (t == nt - 2);
            if constexpr (P::MID) {
                if (t == nt / 2) {
                    const LAS float* rs = rsl + 256 * (ui & 1);
#pragma unroll
                    for (int a = 0; a < 2; ++a)
#pragma unroll
                        for (int m = 0; m < 4; ++m) { const float sc = rs[a * 128 + wr * 64 + m * 16 + fr];
#pragma unroll
                            for (int b = 0; b < 2; ++b)
#pragma unroll
                                for (int n = 0; n < 2; ++n) acc[a][b][m][n] *= sc; }
                }
            }
            const char* a1 = cA + (size_t)(t + 1) * kstep;
            const char* a2 = last ? nA : cA + (size_t)(t + 2) * kstep; const char* b2 = last ? nB : cB + (size_t)(t + 2) * kstep;
            const char* a3 = a2 + kstep; const char* b3 = b2 + kstep;
            const int par2 = last ? npar : cpar;
            PG8_LDB(B0, 0, 0); PG8_LDB(B1, 0, 1); PG8_SCHED; PG8_LDA(At, 0, 0); PG8_STAGE_A(PG8_SA(1, 1), a1, cpar, 1);
            PG8_WAIT_V(8); PG8_WAIT_L(0); PG8_BAR; PG8_MMA(0, 0, At, B0); PG8_MMA(0, 1, At, B1); PG8_BAR; PG8_SCHED;
            PG8_LDA(At, 0, 1); PG8_STAGE(PG8_SB(0, 0), b2, voffB); PG8_STAGE(PG8_SB(0, 1), b2 + hstep, voffB); PG8_STAGE_A(PG8_SA(0, 0), a2, par2, 0);
            PG8_WAIT_V(8); PG8_WAIT_L(0); PG8_BAR; PG8_MMA(1, 0, At, B0); PG8_MMA(1, 1, At, B1); PG8_BAR; PG8_SCHED;
            PG8_LDB(B0, 1, 0); PG8_LDB(B1, 1, 1); PG8_SCHED; PG8_LDA(At, 1, 0); PG8_STAGE_A(PG8_SA(0, 1), a2, par2, 1);
            PG8_WAIT_V(8); PG8_WAIT_L(0); PG8_BAR; PG8_MMA(0, 0, At, B0); PG8_MMA(0, 1, At, B1); PG8_BAR; PG8_SCHED;
            PG8_LDA(At, 1, 1); PG8_STAGE(PG8_SB(1, 0), b3, voffB); PG8_STAGE(PG8_SB(1, 1), b3 + hstep, voffB); PG8_STAGE_A(PG8_SA(1, 0), a3, par2, 0);
            PG8_WAIT_V(8); PG8_WAIT_L(0); PG8_BAR; PG8_MMA(1, 0, At, B0); PG8_MMA(1, 1, At, B1); PG8_BAR; PG8_SCHED;
        }
        if (wr == 0) PG8_BAR;
        if constexpr (P::FP8) asm volatile("s_nop 15\n\ts_nop 7" ::: "memory");
        {
            const int cb = wc * 32 + fq * 8;
#define PG8_EPI_LOOP(RI, CALL) do { const auto pre = p.pre(cur, cb); (void)pre; \
                _Pragma("unroll") for (int a = 0; a < 2; ++a) { \
                    int lrow = a * 128 + wr * 64 + fr; decltype(RI) ris[4]; \
                    _Pragma("unroll") for (int m = 0; m < 4; ++m) { lrow = a * 128 + wr * 64 + m * 16 + fr; ris[m] = RI; } \
                    _Pragma("unroll") for (int m = 0; m < 4; ++m) { lrow = a * 128 + wr * 64 + m * 16 + fr; const auto ri = ris[m]; CALL; } } } while (0)
            if constexpr (P::KINDS) {
                const int kd = __builtin_amdgcn_readfirstlane(p.kind(cur));
                if (kd == 1) p.knorm(cur, acc, wc, lane);
                if (kd == 0) PG8_EPI_LOOP(p.template rowpart<0>(cur, lrow), p.template epik<0>(cur, ri, cb, acc[a][0][m][0], acc[a][0][m][1], acc[a][1][m][0], acc[a][1][m][1]));
                else if (kd == 1) PG8_EPI_LOOP(p.template rowpart<1>(cur, lrow), p.template epik<1>(cur, ri, cb, acc[a][0][m][0], acc[a][0][m][1], acc[a][1][m][0], acc[a][1][m][1]));
                else if (kd == 2) PG8_EPI_LOOP(p.template rowpart<2>(cur, lrow), p.template epik<2>(cur, ri, cb, acc[a][0][m][0], acc[a][0][m][1], acc[a][1][m][0], acc[a][1][m][1]));
                else PG8_EPI_LOOP(p.template rowpart<3>(cur, lrow), p.template epik<3>(cur, ri, cb, acc[a][0][m][0], acc[a][0][m][1], acc[a][1][m][0], acc[a][1][m][1]));
            } else {
                if constexpr (P::GATHER) { const LAS int* gi_ = ginfo + (ui & 1) * 512; PG8_EPI_LOOP(p.rowinfo_lds(gi_, lrow), p.epi(cur, pre, ri, lrow, cb, acc[a][0][m][0], acc[a][0][m][1], acc[a][1][m][0], acc[a][1][m][1])); }
                else PG8_EPI_LOOP(p.rowinfo(cur, lrow), p.epi(cur, pre, ri, lrow, cb, acc[a][0][m][0], acc[a][0][m][1], acc[a][1][m][0], acc[a][1][m][1]));
            }
#undef PG8_EPI_LOOP
        }
        if (!has_next) break;
#pragma unroll
        for (int a = 0; a < 2; ++a)
#pragma unroll
            for (int b = 0; b < 2; ++b)
#pragma unroll
                for (int m = 0; m < 4; ++m)
#pragma unroll
                    for (int n = 0; n < 2; ++n) acc[a][b][m][n] = (f32x4){0.f, 0.f, 0.f, 0.f};
        cur = nxt; cB = nB; cA = nA; ++ui;
        if (wr == 1) PG8_BAR;
    }
    PG8_WAIT_V(0);
    PG8_BAR;
#undef PG8_SA
#undef PG8_SB
#undef PG8_STAGE
#undef PG8_STAGE_A
#undef PG8_LDA
#undef PG8_LDB
#undef PG8_MMA
#undef PG8_WAIT_V
#undef PG8_WAIT_L
#undef PG8_BAR
#undef PG8_SCHED
}
}

struct NoPre {};
__device__ __forceinline__ int pack_fp8x4(float a, float b, float c, float d) { int w = 0; w = __builtin_amdgcn_cvt_pk_fp8_f32(a, b, w, false); w = __builtin_amdgcn_cvt_pk_fp8_f32(c, d, w, true); return w; }
constexpr float WGU_SCALE = 32.0f, WDN_SCALE = 64.0f, ACT_SCALE = 4.0f, SLAB_SCALE = 16.0f;
__device__ __forceinline__ h8 pack8(f32x4 lo, f32x4 hi) { h8 o; o[0] = (f16)lo[0]; o[1] = (f16)lo[1]; o[2] = (f16)lo[2]; o[3] = (f16)lo[3]; o[4] = (f16)hi[0]; o[5] = (f16)hi[1]; o[6] = (f16)hi[2]; o[7] = (f16)hi[3]; return o; }
struct ProbInproj {
    static constexpr int K = 1024; static constexpr bool KINDS = true; static constexpr bool GATHER = false; static constexpr bool FP8 = false; static constexpr bool MID = false;
    const char* xh; const char* win; f16 *qh, *kt, *vt, *ug; gu32* kmax;
    __device__ __forceinline__ const char* abase() const { return xh; }
    __device__ __forceinline__ unsigned rowoff(const pg8::Unit& u, int r) const { return (unsigned)(u.pm * 256 + r) * (unsigned)(K * 2); }
    __device__ __forceinline__ const char* bptr(const pg8::Unit& u) const { return win + (size_t)u.pn * 256 * K * 2; }
    __device__ __forceinline__ NoPre pre(const pg8::Unit&, int) const { return NoPre{}; }
    __device__ __forceinline__ int kind(const pg8::Unit& u) const { return u.pn >> 1; }
    __device__ __forceinline__ void knorm(const pg8::Unit& u, const f32x4 (&acc)[2][2][4][2], int wc, int lane) const {
#pragma unroll
        for (int b = 0; b < 2; ++b) {
            float mx = 0.f;
#pragma unroll
            for (int a = 0; a < 2; ++a)
#pragma unroll
                for (int m = 0; m < 4; ++m) { const f32x4 x = acc[a][b][m][0], y = acc[a][b][m][1];
                    float q = (x[0] * x[0] + x[1] * x[1]) + (x[2] * x[2] + x[3] * x[3]) + (y[0] * y[0] + y[1] * y[1]) + (y[2] * y[2] + y[3] * y[3]);
                    q += __shfl_xor(q, 16); q += __shfl_xor(q, 32); mx = fmaxf(mx, q); }
            mx = fmaxf(mx, __shfl_xor(mx, 1)); mx = fmaxf(mx, __shfl_xor(mx, 2)); mx = fmaxf(mx, __shfl_xor(mx, 4)); mx = fmaxf(mx, __shfl_xor(mx, 8));
            if (lane == 0) { const int bt = (u.pm * 256) >> 13, hd = (u.pn & 1) * 4 + 2 * b + (wc >> 1), mp = wc & 1;
                __hip_atomic_fetch_max(kmax + (bt * 8 + hd) * 2 + mp, __float_as_uint(sqrtf(mx)), RLX_AGENT); }
        }
    }
    template <int KIND> __device__ __forceinline__ unsigned rowpart(const pg8::Unit& u, int lr) const {
        const int row = u.pm * 256 + lr, b = row >> 13, tt = row & 8191, tile = tt >> 6, key = tt & 63;
        if (KIND == 0) return (unsigned)row * 512u;
        if (KIND == 1) return (unsigned)((b * 8 * 128 + tile) * 4096 + key * 8);
        if (KIND == 2) { const int sx = key >> 4, w = key & 15, hh = (w >> 2) & 1, j = (w & 3) + 4 * (w >> 3); return (unsigned)((b * 8 * 128 + tile) * 4096 + (2 * sx + hh) * 512 + j); }
        return (unsigned)((b * 32 * 8192 + tt) * 16);
    }
    template <int KIND> __device__ __forceinline__ void epik(const pg8::Unit& u, unsigned rp, int cb, f32x4 v00, f32x4 v01, f32x4 v10, f32x4 v11) const {
#pragma unroll
        for (int b = 0; b < 2; ++b) {
            const int col = (u.pn & 1) * 256 + b * 128 + cb; const f32x4 lo = b ? v10 : v00, hi = b ? v11 : v01;
            if (KIND == 0) { *(h8*)(qh + rp + col) = pack8(lo * QSCALE, hi * QSCALE); }
            else if (KIND == 1) { const int hd = col >> 6, d = col & 63; *(h8*)(kt + rp + (unsigned)(hd * 128 * 4096 + (d >> 3) * 512)) = pack8(lo, hi); }
            else if (KIND == 2) { const int hd = col >> 6, dv = col & 63; f16* q = vt + rp + (unsigned)(hd * 128 * 4096 + dv * 8);
                q[0] = (f16)lo[0]; q[8] = (f16)lo[1]; q[16] = (f16)lo[2]; q[24] = (f16)lo[3]; q[32] = (f16)hi[0]; q[40] = (f16)hi[1]; q[48] = (f16)hi[2]; q[56] = (f16)hi[3]; }
            else { const int g = col >> 4, c0 = col & 15; *(h8*)(ug + rp + (unsigned)(g * 8192 * 16 + c0)) = pack8(lo, hi); }
        }
    }
};
struct ProbPleProj {
    static constexpr int K = 256; static constexpr bool KINDS = false; static constexpr bool GATHER = false; static constexpr bool FP8 = false; static constexpr bool MID = false;
    const char* ph; const char* wpp; f16* pe;
    __device__ __forceinline__ const char* abase() const { return ph; }
    __device__ __forceinline__ unsigned rowoff(const pg8::Unit& u, int r) const { return (unsigned)(u.pm * 256 + r) * (unsigned)(K * 2); }
    __device__ __forceinline__ const char* bptr(const pg8::Unit& u) const { return wpp + (size_t)u.pn * 256 * K * 2; }
    __device__ __forceinline__ NoPre pre(const pg8::Unit&, int) const { return NoPre{}; }
    __device__ __forceinline__ int rowinfo(const pg8::Unit&, int) const { return 0; }
    __device__ __forceinline__ void epi(const pg8::Unit& u, NoPre, int, int lr, int cb, f32x4 v00, f32x4 v01, f32x4 v10, f32x4 v11) const {
        f16* o = pe + (size_t)(u.pm * 256 + lr) * 1024 + u.pn * 256 + cb; *(h8*)o = pack8(v00, v01); *(h8*)(o + 128) = pack8(v10, v11); }
};
struct ProbGlu {
    static constexpr int K = 512; static constexpr bool KINDS = false; static constexpr bool GATHER = false; static constexpr bool FP8 = false; static constexpr bool MID = false;
    const char* yh; const char* wg; f16* mix;
    __device__ __forceinline__ const char* abase() const { return yh; }
    __device__ __forceinline__ unsigned rowoff(const pg8::Unit& u, int r) const { return (unsigned)(u.pm * 256 + r) * (unsigned)(K * 2); }
    __device__ __forceinline__ const char* bptr(const pg8::Unit& u) const { return wg + (size_t)u.pn * 256 * K * 2; }
    __device__ __forceinline__ NoPre pre(const pg8::Unit&, int) const { return NoPre{}; }
    __device__ __forceinline__ int rowinfo(const pg8::Unit&, int) const { return 0; }
    __device__ __forceinline__ void epi(const pg8::Unit& u, NoPre, int, int lr, int cb, f32x4 v00, f32x4 v01, f32x4 v10, f32x4 v11) const {
        h8 o;
#pragma unroll
        for (int e = 0; e < 4; ++e) { o[e] = (f16)(v00[e] * sigmoidf_(v10[e])); o[4 + e] = (f16)(v01[e] * sigmoidf_(v11[e])); }
        *(h8*)(mix + (size_t)(u.pm * 256 + lr) * 1024 + u.pn * 128 + cb) = o; }
};
struct ProbOut {
    static constexpr int K = 1024; static constexpr bool KINDS = false; static constexpr bool GATHER = false; static constexpr bool FP8 = false; static constexpr bool MID = true;
    const char* mixb; const char* wo; f16* mixo;
    __device__ __forceinline__ const char* abase() const { return mixb; }
    __device__ __forceinline__ unsigned rowoff(const pg8::Unit& u, int r) const { return (unsigned)(u.pm * 256 + r) * (unsigned)(K * 2); }
    __device__ __forceinline__ const char* bptr(const pg8::Unit& u) const { return wo + (size_t)u.pn * 256 * K * 2; }
    __device__ __forceinline__ NoPre pre(const pg8::Unit&, int) const { return NoPre{}; }
    __device__ __forceinline__ int rowinfo(const pg8::Unit&, int) const { return 0; }
    __device__ __forceinline__ void mid_prepare(const pg8::Unit& u, LAS float* slot, int tid) const {
        const int row = tid >> 1; const h8* q = (const h8*)(mixb + (size_t)(u.pm * 256 + row) * 2048 + (tid & 1) * 512); float sacc = 0.f;
#pragma unroll 4
        for (int j = 0; j < 32; ++j) { const h8 v = q[j];
#pragma unroll
            for (int e = 0; e < 8; ++e) { const float f = (float)v[e]; sacc += f * f; } }
        sacc += __shfl_xor(sacc, 1);
        if (!(tid & 1)) slot[row] = rsqrtf(sacc * (1.0f / 512.0f) + RMS_EPS);
    }
    __device__ __forceinline__ void epi(const pg8::Unit& u, NoPre, int, int lr, int cb, f32x4 v00, f32x4 v01, f32x4 v10, f32x4 v11) const {
        f16* o = mixo + (size_t)(u.pm * 256 + lr) * 1024 + u.pn * 256 + cb; *(h8*)o = pack8(v00, v01); *(h8*)(o + 128) = pack8(v10, v11); }
};
struct Pre16 { f32x4 a, b, c, d; };
struct ProbMoeUp {
    static constexpr int K = 1024; static constexpr bool KINDS = false; static constexpr bool GATHER = true; static constexpr bool FP8 = true; static constexpr bool MID = false;
    const char* x1q; const char* wgu; const int* list; const float* bias; unsigned char* act;
    __device__ __forceinline__ const char* abase() const { return x1q; }
    __device__ __forceinline__ unsigned rowoff(const pg8::Unit&, int) const { return 0u; }
    __device__ __forceinline__ void fill_rows(const pg8::Unit& u, LAS int* tabp, int r) const { const int i = u.pm * 256 + r; const bool ok = i < u.cnt; const int a = list[(size_t)u.e * ECAP + (ok ? i : 0)]; tabp[r] = ok ? a : (a | (int)0x80000000); }
    __device__ __forceinline__ unsigned rowbytes(int a) const { return (unsigned)(a >> 2) * (unsigned)K; }
    __device__ __forceinline__ int rowinfo_lds(const LAS int* tabp, int lr) const { return tabp[lr]; }
    __device__ __forceinline__ const char* bptr(const pg8::Unit& u) const { return wgu + ((size_t)u.e * 2048 + (size_t)u.pn * 256) * K; }
    __device__ __forceinline__ Pre16 pre(const pg8::Unit& u, int cb) const {
        const float* bp = bias + u.e * 2048 + 2 * (u.pn * 128 + cb); Pre16 r; r.a = *(const f32x4*)bp; r.b = *(const f32x4*)(bp + 4); r.c = *(const f32x4*)(bp + 8); r.d = *(const f32x4*)(bp + 12); return r; }
    __device__ __forceinline__ int rowinfo(const pg8::Unit& u, int lr) const { const int i = u.pm * 256 + lr; return i < u.cnt ? list[(size_t)u.e * ECAP + i] : -1; }
    __device__ __forceinline__ void epi(const pg8::Unit& u, const Pre16& pb, int a, int, int cb, f32x4 v00, f32x4 v01, f32x4 v10, f32x4 v11) const {
        if (a < 0) return;
        const float bg[8] = {pb.a[0], pb.a[2], pb.b[0], pb.b[2], pb.c[0], pb.c[2], pb.d[0], pb.d[2]}, bl[8] = {pb.a[1], pb.a[3], pb.b[1], pb.b[3], pb.c[1], pb.c[3], pb.d[1], pb.d[3]};
        float o[8];
#pragma unroll
        for (int e = 0; e < 8; ++e) { const float g = fminf((e < 4 ? v00[e] : v01[e - 4]) * (1.0f / WGU_SCALE) + bg[e], 7.0f), l = fminf(fmaxf((e < 4 ? v10[e] : v11[e - 4]) * (1.0f / WGU_SCALE) + bl[e], -7.0f), 7.0f);
            o[e] = g * sigmoidf_(1.702f * g) * (l + 1.0f) * ACT_SCALE; }
        int w0 = pack_fp8x4(o[0], o[1], o[2], o[3]), w1 = pack_fp8x4(o[4], o[5], o[6], o[7]);
        typedef int i32x2 __attribute__((ext_vector_type(2))); i32x2 ww = {w0, w1};
        *(i32x2*)(act + (size_t)a * 1024 + u.pn * 128 + cb) = ww; }
};
struct RowAG { int a; float g; };
struct ProbMoeDn {
    static constexpr int K = 1024; static constexpr bool KINDS = false; static constexpr bool GATHER = true; static constexpr bool FP8 = true; static constexpr bool MID = false;
    const char* actb; const char* wdn; const int* list; const float* bias; const float* gates; unsigned char* slab;
    __device__ __forceinline__ const char* abase() const { return actb; }
    __device__ __forceinline__ unsigned rowoff(const pg8::Unit&, int) const { return 0u; }
    __device__ __forceinline__ void fill_rows(const pg8::Unit& u, LAS int* tabp, int r) const { const int i = u.pm * 256 + r; const bool ok = i < u.cnt; const int a = list[(size_t)u.e * ECAP + (ok ? i : 0)];
        tabp[r] = ok ? a : (a | (int)0x80000000); tabp[256 + r] = __float_as_int(ok ? gates[a] : 0.f); }
    __device__ __forceinline__ unsigned rowbytes(int a) const { return (unsigned)a * (unsigned)K; }
    __device__ __forceinline__ RowAG rowinfo_lds(const LAS int* tabp, int lr) const { RowAG r; r.a = tabp[lr]; r.g = __int_as_float(tabp[256 + lr]); return r; }
    __device__ __forceinline__ const char* bptr(const pg8::Unit& u) const { return wdn + ((size_t)u.e * 1024 + (size_t)u.pn * 256) * K; }
    __device__ __forceinline__ Pre16 pre(const pg8::Unit& u, int cb) const {
        const float* bp = bias + u.e * 1024 + u.pn * 256 + cb; Pre16 r; r.a = *(const f32x4*)bp; r.b = *(const f32x4*)(bp + 4); r.c = *(const f32x4*)(bp + 128); r.d = *(const f32x4*)(bp + 132); return r; }
    __device__ __forceinline__ RowAG rowinfo(const pg8::Unit& u, int lr) const { const int i = u.pm * 256 + lr; RowAG r; r.a = i < u.cnt ? list[(size_t)u.e * ECAP + i] : -1; r.g = r.a >= 0 ? gates[r.a] : 0.f; return r; }
    __device__ __forceinline__ void epi(const pg8::Unit& u, const Pre16& pb, const RowAG& ri, int, int cb, f32x4 v00, f32x4 v01, f32x4 v10, f32x4 v11) const {
        if (ri.a < 0) return;
        constexpr float S = 1.0f / (WDN_SCALE * ACT_SCALE);
        typedef int i32x2 __attribute__((ext_vector_type(2)));
        unsigned char* o = slab + (size_t)ri.a * 1024 + u.pn * 256 + cb; const float g = ri.g * SLAB_SCALE;
        f32x4 a = (v00 * S + pb.a) * g, b = (v01 * S + pb.b) * g, c = (v10 * S + pb.c) * g, d = (v11 * S + pb.d) * g;
#pragma unroll
        for (int e = 0; e < 4; ++e) { a[e] = fminf(fmaxf(a[e], -448.f), 448.f); b[e] = fminf(fmaxf(b[e], -448.f), 448.f); c[e] = fminf(fmaxf(c[e], -448.f), 448.f); d[e] = fminf(fmaxf(d[e], -448.f), 448.f); }
        i32x2 w0 = {pack_fp8x4(a[0], a[1], a[2], a[3]), pack_fp8x4(b[0], b[1], b[2], b[3])}, w1 = {pack_fp8x4(c[0], c[1], c[2], c[3]), pack_fp8x4(d[0], d[1], d[2], d[3])};
        *(i32x2*)o = w0; *(i32x2*)(o + 128) = w1; }
};
struct ProbPleGate {
    static constexpr int K = 1024; static constexpr bool KINDS = false; static constexpr bool GATHER = false; static constexpr bool FP8 = false; static constexpr bool MID = false;
    const char* rh; const char* wpg; f16* gateh;
    __device__ __forceinline__ const char* abase() const { return rh; }
    __device__ __forceinline__ unsigned rowoff(const pg8::Unit& u, int r) const { return (unsigned)(u.pm * 256 + r) * (unsigned)(K * 2); }
    __device__ __forceinline__ const char* bptr(const pg8::Unit& u) const { return wpg + (size_t)u.pn * 256 * K * 2; }
    __device__ __forceinline__ NoPre pre(const pg8::Unit&, int) const { return NoPre{}; }
    __device__ __forceinline__ int rowinfo(const pg8::Unit&, int) const { return 0; }
    __device__ __forceinline__ void epi(const pg8::Unit& u, NoPre, int, int lr, int cb, f32x4 v00, f32x4 v01, f32x4 v10, f32x4 v11) const {
        f16* o = gateh + (size_t)(u.pm * 256 + lr) * 1024 + u.pn * 256 + cb;
        f32x4 a, b, c, d;
#pragma unroll
        for (int e = 0; e < 4; ++e) { a[e] = sigmoidf_(v00[e]); b[e] = sigmoidf_(v01[e]); c[e] = sigmoidf_(v10[e]); d[e] = sigmoidf_(v11[e]); }
        *(h8*)o = pack8(a, b); *(h8*)(o + 128) = pack8(c, d); }
};

__device__ __forceinline__ int invperm32(int c) { return 16 * ((c >> 2) & 1) + 4 * (c >> 3) + (c & 3); }
__device__ __forceinline__ void tr_item(const float* W, int K, int N, f16* WT, int item, int mode, const float* gsc, LAS float* scr, int lane) {
    const int nblk = N / 32, kb = item / nblk, nb = item % nblk, k0 = 64 * kb, n0 = 32 * nb;
#pragma unroll 8
    for (int i = 0; i < 32; ++i) {
        const int kk = 2 * i + (lane >> 5);
        float v = W[(size_t)(k0 + kk) * N + n0 + (lane & 31)];
        if (mode == 2 && k0 + kk >= 512) v *= gsc[k0 + kk - 512];
        scr[kk * 33 + (lane & 31)] = v;
    }
    asm volatile("s_waitcnt lgkmcnt(0)" ::: "memory");
    const int c = lane & 7;
#pragma unroll
    for (int j = 0; j < 4; ++j) {
        const int n = (lane >> 3) + 8 * j; const LAS float* s = scr + (8 * c) * 33 + n;
        const int ns = n0 + n; int nd;
        if (mode == 1 || mode == 3) { const int ja = mode == 1 ? (ns & 511) : (ns >> 1), bj = mode == 1 ? (ns >> 9) : (ns & 1), jl = ja & 127;
            nd = 256 * (ja >> 7) + 128 * bj + (jl & ~31) + invperm32(jl & 31); }
        else nd = (ns & ~31) + invperm32(ns & 31);
        int kd = k0 + 8 * c; if (mode == 2) kd = (kd + 512) & 1023;
        if (mode >= 3) {
            const float sc = mode == 3 ? WGU_SCALE : WDN_SCALE;
            typedef int i32x2 __attribute__((ext_vector_type(2)));
            i32x2 o; o[0] = pack_fp8x4(s[0] * sc, s[33] * sc, s[66] * sc, s[99] * sc); o[1] = pack_fp8x4(s[132] * sc, s[165] * sc, s[198] * sc, s[231] * sc);
            *(i32x2*)((unsigned char*)WT + (size_t)nd * K + kd) = o;
        } else {
            h8 o; o[0] = (f16)s[0]; o[1] = (f16)s[33]; o[2] = (f16)s[66]; o[3] = (f16)s[99]; o[4] = (f16)s[132]; o[5] = (f16)s[165]; o[6] = (f16)s[198]; o[7] = (f16)s[231];
            *(h8*)(WT + (size_t)nd * K + kd) = o;
        }
    }
    asm volatile("s_waitcnt lgkmcnt(0)" ::: "memory");
}

__device__ __forceinline__ void ssm_precompute(Frame& F, int g) {
    const Args& A = *F.a; const int tid = F.tid;
    LAS float* pwr = (LAS float*)F.lds;
    LAS float* pwi = pwr + 17 * 64;
    LAS float* Bbr = pwi + 17 * 64;
    LAS float* Bbi = Bbr + 1024;
    LAS float* Cr = Bbi + 1024;
    LAS float* Ci = Cr + 1024;
    LAS float* Kd = Ci + 1024;
    if (tid < 64) {
        const int p = tid;
        const float are = A.in[I_ARE][g * 64 + p], aim = A.in[I_AIM][g * 64 + p], dt = __expf(A.in[I_LOGDT][g]);
        for (int d = 0; d <= 16; ++d) { const float mag = __expf(are * dt * (float)d); float sn, cs; sincosf(aim * dt * (float)d, &sn, &cs); pwr[d * 64 + p] = mag * cs; pwi[d * 64 + p] = mag * sn; }
        const float abr = pwr[64 + p], abi = pwi[64 + p];
        const float nr = abr - 1.0f, ni = abi, den = 1.0f / (are * are + aim * aim);
        const float fr_ = (nr * are + ni * aim) * den, fi_ = (ni * are - nr * aim) * den;
        for (int c = 0; c < 16; ++c) { const float br = A.in[I_BRE][(g * 64 + p) * 16 + c], bi = A.in[I_BIM][(g * 64 + p) * 16 + c]; Bbr[p * 16 + c] = fr_ * br - fi_ * bi; Bbi[p * 16 + c] = fr_ * bi + fi_ * br; }
        float* a16 = (float*)(F.ws + WS_A16) + (g * 64 + p) * 2; a16[0] = pwr[16 * 64 + p]; a16[1] = pwi[16 * 64 + p];
    }
    for (int i = tid; i < 1024; i += NTHREADS) { Cr[i] = A.in[I_CRE][g * 1024 + i]; Ci[i] = A.in[I_CIM][g * 1024 + i]; }
    __syncthreads();
    for (int q = 0; q < 8; ++q) {
        const int idx = tid * 8 + q, d = idx >> 8, cp = (idx >> 4) & 15, c = idx & 15; float acc = 0.f;
        for (int p = 0; p < 64; ++p) { const float cr = Cr[cp * 64 + p], ci = Ci[cp * 64 + p], pr = pwr[d * 64 + p], pi = pwi[d * 64 + p];
            const float zr = cr * pr - ci * pi, zi = cr * pi + ci * pr; acc += zr * Bbr[p * 16 + c] - zi * Bbi[p * 16 + c]; }
        Kd[idx] = acc;
    }
    __syncthreads();
    f16* ops = (f16*)(F.ws + WS_SSMOP) + (size_t)g * 131072;
    f16* Top = ops; f16* We = ops + 65536; f16* Wc = ops + 65536 + 32768;
    for (int v = tid; v < 8192; v += NTHREADS) {
        const int row = v >> 5, kv = v & 31, j = kv >> 1, half = kv & 1, i = row >> 4, cp = row & 15; h8 o;
#pragma unroll
        for (int e = 0; e < 8; ++e) o[e] = (j <= i) ? (f16)Kd[((i - j) * 16 + cp) * 16 + 8 * half + e] : (f16)0.f;
        *(h8*)(Top + row * 256 + kv * 8) = o;
    }
    for (int v = tid; v < 4096; v += NTHREADS) {
        const int sx = v >> 5, kv = v & 31, j = kv >> 1, half = kv & 1, p = sx & 63; const float pr = pwr[(15 - j) * 64 + p], pi = pwi[(15 - j) * 64 + p]; h8 o;
#pragma unroll
        for (int e = 0; e < 8; ++e) { const float br = Bbr[p * 16 + 8 * half + e], bi = Bbi[p * 16 + 8 * half + e]; o[e] = (f16)(sx < 64 ? pr * br - pi * bi : pr * bi + pi * br); }
        *(h8*)(We + sx * 256 + kv * 8) = o;
    }
    for (int v = tid; v < 4096; v += NTHREADS) {
        const int row = v >> 4, kv = v & 15, i = row >> 4, cp = row & 15; h8 o;
#pragma unroll
        for (int e = 0; e < 8; ++e) { const int sx = 8 * kv + e, p = sx & 63; const float cr = Cr[cp * 64 + p], ci = Ci[cp * 64 + p], pr = pwr[(i + 1) * 64 + p], pi = pwi[(i + 1) * 64 + p];
            o[e] = (f16)(sx < 64 ? cr * pr - ci * pi : -(cr * pi + ci * pr)); }
        *(h8*)(Wc + row * 128 + kv * 8) = o;
    }
    __syncthreads();
}

__device__ __forceinline__ void p0_prologue(Frame& F) {
    const Args& A = *F.a;
    if (blockIdx.x < NG) ssm_precompute(F, (int)blockIdx.x);
    LAS float* scr = (LAS float*)(F.lds + F.wave * 16384);
    constexpr int I0 = 16 * 64, I1 = 8 * 32, I2 = 16 * 32, I3 = 16 * 32, I4 = 4 * 32, I5 = NE * 16 * 64, I6 = NE * 16 * 32;
    constexpr int NIT = I0 + I1 + I2 + I3 + I4 + I5;
    for (int it = F.gw; it < NIT; it += F.NGW) {
        int r = it;
        if (r < I0) { tr_item(A.in[I_WIN], 1024, 2048, (f16*)(F.ws + WS_WIN), r, 0, nullptr, scr, F.lane); continue; } r -= I0;
        if (r < I1) { tr_item(A.in[I_WGLU], 512, 1024, (f16*)(F.ws + WS_WGLU), r, 1, nullptr, scr, F.lane); continue; } r -= I1;
        if (r < I2) { tr_item(A.in[I_WOUT], 1024, 1024, (f16*)(F.ws + WS_WOUT), r, 2, A.in[I_SSMG], scr, F.lane); continue; } r -= I2;
        if (r < I3) { tr_item(A.in[I_WPG], 1024, 1024, (f16*)(F.ws + WS_WPG), r, 0, nullptr, scr, F.lane); continue; } r -= I3;
        if (r < I4) { tr_item(A.in[I_WPP], 256, 1024, (f16*)(F.ws + WS_WPP), r, 0, nullptr, scr, F.lane); continue; } r -= I4;
        if (r < I5) { const int e = r / (16 * 64), ii = r % (16 * 64);
            tr_item(A.in[I_WGU] + (size_t)e * 1024 * 2048, 1024, 2048, (f16*)(F.ws + WS_WGU + (size_t)e * 2048 * 1024), ii, 3, nullptr, scr, F.lane); continue; }
    }
    const size_t gt = (size_t)blockIdx.x * NTHREADS + F.tid, NT = (size_t)F.G * NTHREADS;
    { const f32x4* s = (const f32x4*)A.in[I_X]; h8* d = (h8*)(F.ws + WS_XH);
      for (size_t i = gt; i < (size_t)T * DM / 8; i += NT) { const f32x4 a = s[2 * i], b = s[2 * i + 1]; h8 o; o[0] = (f16)a[0]; o[1] = (f16)a[1]; o[2] = (f16)a[2]; o[3] = (f16)a[3]; o[4] = (f16)b[0]; o[5] = (f16)b[1]; o[6] = (f16)b[2]; o[7] = (f16)b[3]; d[i] = o; } }
    { const f32x4* s = (const f32x4*)A.in[I_P]; h8* d = (h8*)(F.ws + WS_PH);
      for (size_t i = gt; i < (size_t)T * PLE / 8; i += NT) { const f32x4 a = s[2 * i], b = s[2 * i + 1]; h8 o; o[0] = (f16)a[0]; o[1] = (f16)a[1]; o[2] = (f16)a[2]; o[3] = (f16)a[3]; o[4] = (f16)b[0]; o[5] = (f16)b[1]; o[6] = (f16)b[2]; o[7] = (f16)b[3]; d[i] = o; } }
}

__device__ __forceinline__ void p1_inproj(Frame& F) {
    { ProbInproj P{(const char*)(F.ws + WS_XH), (const char*)(F.ws + WS_WIN), (f16*)(F.ws + WS_QH), (f16*)(F.ws + WS_KT), (f16*)(F.ws + WS_VT), (f16*)(F.ws + WS_UG), F.ctl + CW_KMAX};
      pg8::DenseOrder S; S.init(T, DIN, F.G, (int)blockIdx.x); pg8::gemm_phase(F.lds, P, S); }
}

constexpr int ATT_SLOT = 32768, ATT_FLAGS = 3 * ATT_SLOT;
constexpr float ATT_SKIP = -40.0f;
__device__ __forceinline__ void attn_unit(Frame& F, int b, int hd, int qb, float lam) {
    const int lane = F.lane, wave = F.wave, r32 = lane & 31, hi = lane >> 5;
    LAS unsigned char* lds = F.lds;
    const f16* qh = (const f16*)(F.ws + WS_QH);
    const f16* ktb = (const f16*)(F.ws + WS_KT) + (size_t)((b * 8 + hd) * 128) * 4096;
    const f16* vtb = (const f16*)(F.ws + WS_VT) + (size_t)((b * 8 + hd) * 128) * 4096;
    f16* mix = (f16*)(F.ws + WS_MIX);
    const int q0 = qb * 256, q0w = q0 + 32 * wave, NT = 4 * (qb + 1), NI = NT / 2; const size_t rowbase = (size_t)b * SEQ;
    volatile LAS int* flags = (volatile LAS int*)(lds + ATT_FLAGS);
#define ATT_ISSUE(ii) do { const int t0_ = NT - 1 - 2 * (ii); const unsigned so_ = (unsigned)(((ii) % 3) * ATT_SLOT + wave * 1024); \
        __builtin_amdgcn_global_load_lds((const unsigned*)(ktb + (size_t)t0_ * 4096 + wave * 512 + lane * 8), (LAS unsigned*)(lds + so_), 16, 0, 0); \
        __builtin_amdgcn_global_load_lds((const unsigned*)(vtb + (size_t)t0_ * 4096 + wave * 512 + lane * 8), (LAS unsigned*)(lds + so_ + 8192), 16, 0, 0); \
        __builtin_amdgcn_global_load_lds((const unsigned*)(ktb + (size_t)(t0_ - 1) * 4096 + wave * 512 + lane * 8), (LAS unsigned*)(lds + so_ + 16384), 16, 0, 0); \
        __builtin_amdgcn_global_load_lds((const unsigned*)(vtb + (size_t)(t0_ - 1) * 4096 + wave * 512 + lane * 8), (LAS unsigned*)(lds + so_ + 24576), 16, 0, 0); } while (0)
    ATT_ISSUE(0); ATT_ISSUE(1);
    if (lane == 0) { flags[wave] = 1; flags[8 + wave] = 1; }
    h8 qf[2][2];
#pragma unroll
    for (int mp = 0; mp < 2; ++mp)
#pragma unroll
        for (int kk = 0; kk < 2; ++kk) qf[mp][kk] = *(const h8*)(qh + (rowbase + q0w + r32) * 512 + hd * 64 + mp * 32 + kk * 16 + hi * 8);
    float sb1, sb2;
    { float n1 = 0.f, n2 = 0.f;
#pragma unroll
      for (int kk = 0; kk < 2; ++kk)
#pragma unroll
          for (int e = 0; e < 8; ++e) { const float a = (float)qf[0][kk][e], c = (float)qf[1][kk][e]; n1 += a * a; n2 += c * c; }
      n1 = swap_add(n1); n2 = swap_add(n2);
      const float k1 = __uint_as_float(__hip_atomic_load(F.ctl + CW_KMAX + (b * 8 + hd) * 2, RLX_AGENT)), k2 = __uint_as_float(__hip_atomic_load(F.ctl + CW_KMAX + (b * 8 + hd) * 2 + 1, RLX_AGENT));
      sb1 = sqrtf(n1) * k1 * 1.01f; sb2 = sqrtf(n2) * k2 * 1.01f; }
    const float slope2 = exp2f(-(float)(hd + 1)) * LOG2E;
    const int td = q0w >> 6, wo = q0w & 63;
    const f16 s_hi = (f16)slope2, s_lo = (f16)(slope2 - (float)s_hi);
    float mr1 = 0.f, mr2 = 0.f, l1 = 0.f, l2 = 0.f;
    h8 qx1, qx2;
    { h8 z; z[0] = (f16)(64.0f * (float)s_hi); z[1] = s_hi; z[2] = (f16)(64.0f * (float)s_lo); z[3] = s_lo; z[4] = (f16)0.f; z[5] = (f16)0.f; z[6] = (f16)0.f; z[7] = (f16)0.f;
      if (hi) { z[0] = (f16)0.f; z[1] = (f16)0.f; z[2] = (f16)0.f; z[3] = (f16)0.f; }
      qx1 = z; qx2 = z; }
    f32x16 o1[2], o2[2];
#pragma unroll
    for (int i = 0; i < 2; ++i) { o1[i] = (f32x16){}; o2[i] = (f32x16){}; }
    bool wdone = false, started = false;
    h2 ones; ones[0] = (f16)1.f; ones[1] = (f16)1.f;
#pragma unroll 1
    for (int ii = 0; ii < NI; ++ii) {
        if (ii + 1 < NI) asm volatile("s_waitcnt vmcnt(4) lgkmcnt(0)" ::: "memory"); else asm volatile("s_waitcnt vmcnt(0) lgkmcnt(0)" ::: "memory");
        __builtin_amdgcn_s_barrier();
        asm volatile("" ::: "memory");
        { const volatile LAS int* fl = flags + 8 * (ii & 1); const int any = fl[0] | fl[1] | fl[2] | fl[3] | fl[4] | fl[5] | fl[6] | fl[7];
          if (__builtin_amdgcn_readfirstlane(any) == 0) break; }
        if (ii + 2 < NI) ATT_ISSUE(ii + 2);
        bool need = !wdone;
        const int T0 = NT - 1 - 2 * ii, T1 = T0 - 1;
        if (T1 <= td && !wdone) {
            const bool first = !started; started = true;
            const LAS unsigned char* kp = lds + (ii % 3) * ATT_SLOT;
            const LAS unsigned char* kbase = kp + (hi * 512 + r32 * 8) * 2;
            const LAS unsigned char* vbase = kp + 8192 + (hi * 512 + r32 * 8) * 2;
            const float bmax = slope2 * (float)(64 * (T0 - td) + 63 - wo);
            const bool gen = first || T0 >= td || (__any(fmaxf(sb1 - mr1, sb2 - mr2) + bmax > 12.0f) != 0);
            const bool tlo = T0 > td;
            f32x16 s0[2], s1[2]; h8 kfr[4], vfr[6], pf[4], kxa, kxb; float ls;
#define ATT_SB __builtin_amdgcn_sched_barrier(0)
#define ATT_KX(tl) do { const f16 tr_ = (f16)(float)(T0 - (tl) - td); const f16 wa_ = (f16)(float)(r32 - wo), wb_ = (f16)(float)(32 + r32 - wo); h8 za, zb; \
                za[0] = tr_; za[1] = wa_; za[2] = tr_; za[3] = wa_; za[4] = (f16)1.f; za[5] = (f16)0.f; za[6] = (f16)0.f; za[7] = (f16)0.f; \
                zb[0] = tr_; zb[1] = wb_; zb[2] = tr_; zb[3] = wb_; zb[4] = (f16)1.f; zb[5] = (f16)0.f; zb[6] = (f16)0.f; zb[7] = (f16)0.f; \
                if (hi) { za[0] = (f16)0.f; za[1] = (f16)0.f; za[2] = (f16)0.f; za[3] = (f16)0.f; za[4] = (f16)0.f; zb[0] = (f16)0.f; zb[1] = (f16)0.f; zb[2] = (f16)0.f; zb[3] = (f16)0.f; zb[4] = (f16)0.f; } \
                kxa = za; kxb = zb; } while (0)
#define ATT_KLD(mp, tl) do { _Pragma("unroll") for (int kb = 0; kb < 2; ++kb) _Pragma("unroll") for (int j = 0; j < 2; ++j) \
                kfr[kb * 2 + j] = *(const LAS h8*)(kbase + (tl) * 16384 + ((mp) * 4 + j * 2) * 1024 + kb * 512); } while (0)
#define ATT_VLD(d, tl, sx, dh) vfr[d] = *(const LAS h8*)(vbase + (tl) * 16384 + (sx) * 2048 + (dh) * 512)
#define ATT_QKM(sn, mpn, qxn, j) do { if ((j) == 0) sn[0] = __builtin_amdgcn_mfma_f32_32x32x16_f16(kxa, qxn, (f32x16){}, 0, 0, 0); \
                else if ((j) == 1) sn[1] = __builtin_amdgcn_mfma_f32_32x32x16_f16(kxb, qxn, (f32x16){}, 0, 0, 0); \
                else if ((j) == 2) sn[0] = __builtin_amdgcn_mfma_f32_32x32x16_f16(kfr[0], qf[mpn][0], sn[0], 0, 0, 0); \
                else if ((j) == 3) sn[1] = __builtin_amdgcn_mfma_f32_32x32x16_f16(kfr[2], qf[mpn][0], sn[1], 0, 0, 0); \
                else if ((j) == 4) sn[0] = __builtin_amdgcn_mfma_f32_32x32x16_f16(kfr[1], qf[mpn][1], sn[0], 0, 0, 0); \
                else sn[1] = __builtin_amdgcn_mfma_f32_32x32x16_f16(kfr[3], qf[mpn][1], sn[1], 0, 0, 0); } while (0)
#define ATT_EXPQ(sc, hq) do { const float a0_ = __builtin_amdgcn_exp2f(sc[(hq) >> 2][4 * ((hq) & 3)]), a1_ = __builtin_amdgcn_exp2f(sc[(hq) >> 2][4 * ((hq) & 3) + 1]), \
                    a2_ = __builtin_amdgcn_exp2f(sc[(hq) >> 2][4 * ((hq) & 3) + 2]), a3_ = __builtin_amdgcn_exp2f(sc[(hq) >> 2][4 * ((hq) & 3) + 3]); \
                h2 p01_, p23_; p01_[0] = (f16)a0_; p01_[1] = (f16)a1_; p23_[0] = (f16)a2_; p23_[1] = (f16)a3_; \
                pf[(hq) >> 1][4 * ((hq) & 1)] = p01_[0]; pf[(hq) >> 1][4 * ((hq) & 1) + 1] = p01_[1]; pf[(hq) >> 1][4 * ((hq) & 1) + 2] = p23_[0]; pf[(hq) >> 1][4 * ((hq) & 1) + 3] = p23_[1]; \
                { const h2 hs_ = p01_ + p23_; asm volatile("v_dot2c_f32_f16 %0, %1, %2" : "+v"(ls) : "v"(hs_), "v"(ones)); } } while (0)
#define ATT_PLAINQK(sn, mpn, qxn) do { ATT_QKM(sn, mpn, qxn, 0); ATT_QKM(sn, mpn, qxn, 1); ATT_QKM(sn, mpn, qxn, 2); ATT_QKM(sn, mpn, qxn, 3); ATT_QKM(sn, mpn, qxn, 4); ATT_QKM(sn, mpn, qxn, 5); } while (0)
#define ATT_GENI(sc, mr, l, o, qx, tile, FIRST) do { \
                if ((tile) >= td) { _Pragma("unroll") for (int kb = 0; kb < 2; ++kb) _Pragma("unroll") for (int r = 0; r < 16; ++r) { const int kpos = 64 * (tile) + 32 * kb + crow(r, hi); if (kpos > q0w + r32) sc[kb][r] = -1e30f; } } \
                float rm = sc[0][0]; \
                _Pragma("unroll") for (int kb = 0; kb < 2; ++kb) _Pragma("unroll") for (int r = 0; r < 16; ++r) rm = fmaxf(rm, sc[kb][r]); \
                rm = swap_max(rm); \
                if ((FIRST) || __any(rm > 4.0f) != 0) { const float d = (FIRST) ? rm : fmaxf(rm, 0.f); const float f = __builtin_amdgcn_exp2f(-d); \
                    _Pragma("unroll") for (int kb = 0; kb < 2; ++kb) _Pragma("unroll") for (int r = 0; r < 16; ++r) sc[kb][r] -= d; \
                    mr += d; l *= f; o[0] *= f; o[1] *= f; if (!hi) qx[4] = (f16)(-mr); } } while (0)
#define ATT_BLOCK(sc, l, o, tlc, HASN, sn, mpn, qxn, NKLD) do { ls = 0.f; \
                if (HASN) ATT_QKM(sn, mpn, qxn, 0); ATT_EXPQ(sc, 0); ATT_SB; \
                if (HASN) ATT_QKM(sn, mpn, qxn, 1); ATT_EXPQ(sc, 1); ATT_SB; \
                if (HASN) ATT_QKM(sn, mpn, qxn, 2); ATT_EXPQ(sc, 2); ATT_VLD(0, tlc, 0, 0); ATT_VLD(1, tlc, 0, 1); ATT_SB; \
                if (HASN) ATT_QKM(sn, mpn, qxn, 3); ATT_EXPQ(sc, 3); ATT_VLD(2, tlc, 1, 0); ATT_VLD(3, tlc, 1, 1); ATT_SB; \
                if (HASN) ATT_QKM(sn, mpn, qxn, 4); ATT_EXPQ(sc, 4); ATT_VLD(4, tlc, 2, 0); ATT_VLD(5, tlc, 2, 1); ATT_SB; \
                if (HASN) ATT_QKM(sn, mpn, qxn, 5); ATT_EXPQ(sc, 5); ATT_SB; \
                o[0] = __builtin_amdgcn_mfma_f32_32x32x16_f16(vfr[0], pf[0], o[0], 0, 0, 0); ATT_EXPQ(sc, 6); ATT_SB; \
                o[1] = __builtin_amdgcn_mfma_f32_32x32x16_f16(vfr[1], pf[0], o[1], 0, 0, 0); ATT_EXPQ(sc, 7); NKLD; ATT_SB; \
                o[0] = __builtin_amdgcn_mfma_f32_32x32x16_f16(vfr[2], pf[1], o[0], 0, 0, 0); ATT_VLD(0, tlc, 3, 0); ATT_VLD(1, tlc, 3, 1); ATT_SB; \
                o[1] = __builtin_amdgcn_mfma_f32_32x32x16_f16(vfr[3], pf[1], o[1], 0, 0, 0); ATT_SB; \
                o[0] = __builtin_amdgcn_mfma_f32_32x32x16_f16(vfr[4], pf[2], o[0], 0, 0, 0); ATT_SB; \
                o[1] = __builtin_amdgcn_mfma_f32_32x32x16_f16(vfr[5], pf[2], o[1], 0, 0, 0); ATT_SB; \
                o[0] = __builtin_amdgcn_mfma_f32_32x32x16_f16(vfr[0], pf[3], o[0], 0, 0, 0); ATT_SB; \
                o[1] = __builtin_amdgcn_mfma_f32_32x32x16_f16(vfr[1], pf[3], o[1], 0, 0, 0); ATT_SB; \
                l += ls; } while (0)
            if (!tlo) {
                ATT_KX(0); ATT_KLD(0, 0); ATT_PLAINQK(s0, 0, qx1); ATT_SB; ATT_KLD(1, 0); ATT_SB;
                if (gen) ATT_GENI(s0, mr1, l1, o1, qx1, T0, first);
                ATT_BLOCK(s0, l1, o1, 0, true, s1, 1, qx2, ATT_KLD(0, 1));
                ATT_KX(1);
                if (gen) ATT_GENI(s1, mr2, l2, o2, qx2, T0, first);
                ATT_BLOCK(s1, l2, o2, 0, true, s0, 0, qx1, ATT_KLD(1, 1));
            } else {
                ATT_KX(1); ATT_KLD(0, 1); ATT_PLAINQK(s0, 0, qx1); ATT_SB; ATT_KLD(1, 1); ATT_SB;
            }
            { const bool f2 = first && tlo;
              if (gen) ATT_GENI(s0, mr1, l1, o1, qx1, T1, f2);
              ATT_BLOCK(s0, l1, o1, 1, true, s1, 1, qx2, (void)0);
              if (gen) ATT_GENI(s1, mr2, l2, o2, qx2, T1, f2);
              ATT_BLOCK(s1, l2, o2, 1, false, s0, 0, qx1, (void)0); }
#undef ATT_SB
#undef ATT_KX
#undef ATT_KLD
#undef ATT_VLD
#undef ATT_QKM
#undef ATT_EXPQ
#undef ATT_PLAINQK
#undef ATT_GENI
#undef ATT_BLOCK
            const float far = fmaxf(sb1 - mr1, sb2 - mr2) + slope2 * (float)(64 * T1 - 1 - q0w);
            need = (T1 >= 1) && (__any(far >= ATT_SKIP) != 0);
            if (!need) wdone = true;
        }
        if (lane == 0) flags[8 * ((ii + 1) & 1) + wave] = need ? 1 : 0;
    }
    asm volatile("s_waitcnt vmcnt(0) lgkmcnt(0)" ::: "memory");
    __builtin_amdgcn_s_barrier();
    asm volatile("" ::: "memory");
#undef ATT_ISSUE
    l1 = swap_add(l1); l2 = swap_add(l2);
    const float i1 = 1.0f / l1, i2 = lam / l2;
    float ss = 0.f;
#pragma unroll
    for (int dh = 0; dh < 2; ++dh)
#pragma unroll
        for (int r = 0; r < 16; ++r) { const float v = o1[dh][r] * i1 - o2[dh][r] * i2; o1[dh][r] = v; ss += v * v; }
    ss = swap_add(ss);
    const float rs = rsqrtf(ss * (1.0f / 64.0f) + RMS_EPS) * 0.8f;
    const float* sg = F.a->in[I_SUBLN];
    f16* orow = mix + (rowbase + q0w + r32) * 1024 + 512 + hd * 64;
#pragma unroll
    for (int dh = 0; dh < 2; ++dh)
#pragma unroll
        for (int gq = 0; gq < 4; ++gq) {
            const int dv = 32 * dh + 8 * gq + 4 * hi; const f32x4 gg = *(const f32x4*)(sg + dv);
            h4 o; o[0] = (f16)(o1[dh][4 * gq] * rs * gg[0]); o[1] = (f16)(o1[dh][4 * gq + 1] * rs * gg[1]); o[2] = (f16)(o1[dh][4 * gq + 2] * rs * gg[2]); o[3] = (f16)(o1[dh][4 * gq + 3] * rs * gg[3]);
            *(h4*)(orow + dv) = o;
        }
}

constexpr int SSM_UROW = 528, SSM_EROW = 528, SSM_XROW = 272;
constexpr int SSM_U0 = 0, SSM_U1 = 64 * SSM_UROW, SSM_E = 2 * 64 * SSM_UROW, SSM_XP = SSM_E + 64 * SSM_EROW;
typedef float f32x4_t __attribute__((ext_vector_type(4)));
__device__ __forceinline__ void ssm_unit(Frame& F, int b, int g) {
    const Args& A = *F.a; const int tid = F.tid, wave = F.wave, lane = F.lane, fr = lane & 15, fq = lane >> 4;
    const f16* ops = (const f16*)(F.ws + WS_SSMOP) + (size_t)g * 131072;
    const f16* Top = ops; const f16* We = ops + 65536; const f16* Wc = ops + 65536 + 32768;
    const char* ugb = (const char*)((const f16*)(F.ws + WS_UG) + (size_t)((b * 32 + g) * 8192) * 16);
    f16* yh = (f16*)(F.ws + WS_YH) + (size_t)b * SEQ * 512 + g * 16;
    LAS unsigned char* lds = F.lds;
    h8 BY[2][12];
#pragma unroll
    for (int n2 = 0; n2 < 2; ++n2) {
        const int nrow = 16 * (2 * wave + n2) + fr;
#pragma unroll
        for (int kk = 0; kk < 8; ++kk) BY[n2][kk] = *(const h8*)(Top + nrow * 256 + 32 * kk + 8 * fq);
#pragma unroll
        for (int kk = 0; kk < 4; ++kk) BY[n2][8 + kk] = *(const h8*)(Wc + nrow * 128 + 32 * kk + 8 * fq);
    }
    const float* a16 = (const float*)(F.ws + WS_A16) + (g * 64 + lane) * 2;
    const float a16r = a16[0], a16i = a16[1];
    const f32x4 dsk = *(const f32x4*)(A.in[I_SSMD] + g * 16 + 4 * fq);
    float xr = 0.f, xi = 0.f;
#pragma unroll
    for (int q = 0; q < 4; ++q) { const int o = (q * NTHREADS + tid) * 16; const h8 v = *(const h8*)(ugb + o); *(LAS h8*)(lds + SSM_U0 + (o >> 9) * SSM_UROW + (o & 511)) = v; }
    __syncthreads();
#pragma unroll 1
    for (int seg = 0; seg < 8; ++seg) {
        LAS unsigned char* Uc = lds + ((seg & 1) ? SSM_U1 : SSM_U0);
        LAS unsigned char* Un = lds + ((seg & 1) ? SSM_U0 : SSM_U1);
        {
            f32x4 ea[4]; h8 BE[8];
#pragma unroll
            for (int kk = 0; kk < 8; ++kk) BE[kk] = *(const h8*)(We + (16 * wave + fr) * 256 + 32 * kk + 8 * fq);
#pragma unroll
            for (int mt = 0; mt < 4; ++mt) ea[mt] = (f32x4){0.f, 0.f, 0.f, 0.f};
#pragma unroll
            for (int kk = 0; kk < 8; ++kk)
#pragma unroll
                for (int mt = 0; mt < 4; ++mt) { const h8 a = *(const LAS h8*)(Uc + (16 * mt + fr) * SSM_UROW + (32 * kk + 8 * fq) * 2); ea[mt] = __builtin_amdgcn_mfma_f32_16x16x32_f16(BE[kk], a, ea[mt], 0, 0, 0); }
#pragma unroll
            for (int mt = 0; mt < 4; ++mt) *(LAS f32x4*)(lds + SSM_E + (16 * mt + fr) * SSM_EROW + (16 * wave + 4 * fq) * 4) = ea[mt];
        }
        __syncthreads();
        if (wave == 0) {
#pragma unroll 8
            for (int n = 0; n < 64; ++n) {
                const float er = *(const LAS float*)(lds + SSM_E + n * SSM_EROW + lane * 4), ei = *(const LAS float*)(lds + SSM_E + n * SSM_EROW + (64 + lane) * 4);
                *(LAS f16*)(lds + SSM_XP + n * SSM_XROW + lane * 2) = (f16)xr; *(LAS f16*)(lds + SSM_XP + n * SSM_XROW + (64 + lane) * 2) = (f16)xi;
                const float nr = a16r * xr - a16i * xi + er, ni = a16r * xi + a16i * xr + ei; xr = nr; xi = ni;
            }
        } else if (seg < 7) {
            const char* src = ugb + (size_t)(seg + 1) * 32768;
            for (int v = tid - 64; v < 2048; v += NTHREADS - 64) { const int o = v * 16; const h8 x = *(const h8*)(src + o); *(LAS h8*)(Un + (o >> 9) * SSM_UROW + (o & 511)) = x; }
        }
        __syncthreads();
        {
            f32x4 ya[4][2];
#pragma unroll
            for (int mt = 0; mt < 4; ++mt) { ya[mt][0] = (f32x4){0.f, 0.f, 0.f, 0.f}; ya[mt][1] = (f32x4){0.f, 0.f, 0.f, 0.f}; }
#pragma unroll
            for (int kk = 0; kk < 12; ++kk)
#pragma unroll
                for (int mt = 0; mt < 4; ++mt) {
                    const h8 a = kk < 8 ? *(const LAS h8*)(Uc + (16 * mt + fr) * SSM_UROW + (32 * kk + 8 * fq) * 2) : *(const LAS h8*)(lds + SSM_XP + (16 * mt + fr) * SSM_XROW + (32 * (kk - 8) + 8 * fq) * 2);
                    ya[mt][0] = __builtin_amdgcn_mfma_f32_16x16x32_f16(BY[0][kk], a, ya[mt][0], 0, 0, 0);
                    ya[mt][1] = __builtin_amdgcn_mfma_f32_16x16x32_f16(BY[1][kk], a, ya[mt][1], 0, 0, 0);
                }
#pragma unroll
            for (int mt = 0; mt < 4; ++mt)
#pragma unroll
                for (int n2 = 0; n2 < 2; ++n2) {
                    const int ch = 16 * mt + fr, ti = 2 * wave + n2; const size_t tok = (size_t)(seg * 64 + ch) * 16 + ti;
                    const h4 u4 = *(const LAS h4*)(Uc + ch * SSM_UROW + (ti * 16 + 4 * fq) * 2);
                    h4 o;
#pragma unroll
                    for (int e = 0; e < 4; ++e) o[e] = (f16)gelu_tanh(ya[mt][n2][e] + dsk[e] * (float)u4[e]);
                    *(h4*)(yh + tok * 512 + 4 * fq) = o;
                }
        }
    }
    __syncthreads();
}

__device__ __forceinline__ void p2_mixers(Frame& F, int pass) {
    const Args& A = *F.a;
    gu32* qctr = F.ctl + CW_QUEUE + 128 * pass;
    constexpr int NSSM = BATCH * NG, NATT = BATCH * NH * 32;
    volatile LAS int* slot = (volatile LAS int*)(F.lds + LDS_BARST + 16);
    for (;;) {
        if (F.tid == 0) slot[0] = (int)__hip_atomic_fetch_add(qctr, 1u, RLX_AGENT);
        __syncthreads();
        const int it = __builtin_amdgcn_readfirstlane(slot[0]);
        __syncthreads();
        if (it >= NSSM) break;
        if (pass == 1 && PROBE_SEL != 0 && PROBE_SEL != 1) continue;
        ssm_unit(F, it / NG, it % NG);
    }
    asm volatile("" ::: "memory");
    float lam;
    { float d1 = 0.f, d2 = 0.f;
#pragma unroll 1
      for (int i = 0; i < 32; ++i) { d1 += A.in[I_LQ1][i] * A.in[I_LK1][i]; d2 += A.in[I_LQ2][i] * A.in[I_LK2][i]; }
      lam = __expf(d1) - __expf(d2) + 0.2f; }
    asm volatile("" : "+v"(lam));
    for (;;) {
        if (F.tid == 0) slot[0] = (int)__hip_atomic_fetch_add(qctr + 64, 1u, RLX_AGENT);
        __syncthreads();
        const int it = __builtin_amdgcn_readfirstlane(slot[0]);
        __syncthreads();
        if (it >= NATT) break;
        const int qb = 31 - it / 32, bh = it % 32;
        if (pass == 1 && PROBE_SEL != 0) { const int hd_ = bh & 7; const bool sel = PROBE_SEL == 2 ? hd_ >= 6 : PROBE_SEL == 3 ? hd_ <= 3 : PROBE_SEL == 4 ? (hd_ == 7 && qb == 31) : PROBE_SEL == 5 ? (hd_ == 4 || hd_ == 5) : false; if (!sel) continue; }
        attn_unit(F, bh >> 3, bh & 7, qb, lam);
    }
    constexpr int NPLE = (T / 256) * 4, WDN_ITEMS = NE * 16 * 32, WDN_CHUNK = 32, NWDN = WDN_ITEMS / WDN_CHUNK;
    gu32* fctr = F.ctl + CW_QUEUE + 256 + 64 * pass;
    for (;;) {
        if (F.tid == 0) slot[0] = (int)__hip_atomic_fetch_add(fctr, 1u, RLX_AGENT);
        __syncthreads();
        const int it = __builtin_amdgcn_readfirstlane(slot[0]);
        __syncthreads();
        if (it >= NPLE + NWDN) break;
        if (it < NPLE) {
            ProbPleProj P{(const char*)(F.ws + WS_PH), (const char*)(F.ws + WS_WPP), (f16*)(F.ws + WS_PE)};
            pg8::OneOrder S; S.u.pm = it >> 2; S.u.pn = it & 3; S.u.e = 0; S.u.cnt = 0; pg8::gemm_phase(F.lds, P, S);
        } else {
            LAS float* scr = (LAS float*)(F.lds + F.wave * 16384);
#pragma unroll 1
            for (int j = 0; j < WDN_CHUNK / 8; ++j) { const int r = (it - NPLE) * WDN_CHUNK + j * 8 + F.wave; const int e = r / (16 * 32), ii = r % (16 * 32);
                tr_item(A.in[I_WDN] + (size_t)e * 1024 * 1024, 1024, 1024, (f16*)(F.ws + WS_WDN + (size_t)e * 1024 * 1024), ii, 4, nullptr, scr, F.lane); }
        }
        __syncthreads();
    }
}

__device__ __forceinline__ void p3_glu(Frame& F) {
    ProbGlu P{(const char*)(F.ws + WS_YH), (const char*)(F.ws + WS_WGLU), (f16*)(F.ws + WS_MIX)};
    pg8::DenseOrder S; S.init(T, 1024, F.G, (int)blockIdx.x); pg8::gemm_phase(F.lds, P, S);
}

__device__ __forceinline__ void p4_outproj(Frame& F) {
    ProbOut P{(const char*)(F.ws + WS_MIX), (const char*)(F.ws + WS_WOUT), (f16*)(F.ws + WS_MIXO)};
    pg8::DenseOrder S; S.init(T, DM, F.G, (int)blockIdx.x); pg8::gemm_phase(F.lds, P, S);
}

constexpr int RT_XROW = 2064;
constexpr int RT_XHI = 0, RT_XLO = 32 * RT_XROW;
constexpr int RT_PART = 0;
constexpr int RT_FIN = 2 * 32 * RT_XROW;
constexpr int RT_CNT = RT_FIN + 32 * 33 * 4;
__device__ __forceinline__ void p5_router(Frame& F, int pass) {
    const Args& A = *F.a; const int tid = F.tid, lane = F.lane, wave = F.wave, r32 = lane & 31, hi = lane >> 5;
    LAS unsigned char* lds = F.lds;
    LAS unsigned* lcnt = (LAS unsigned*)(lds + RT_CNT); LAS unsigned* lbase = lcnt + 32; LAS unsigned* asg = lcnt + 64;
    if (tid < 32) lcnt[tid] = 0u;
    const float* xin = A.in[I_X]; const f16* mixo = (const f16*)(F.ws + WS_MIXO); f16* x1h = (f16*)(F.ws + WS_X1H); unsigned char* x1q = (unsigned char*)(F.ws + WS_X1Q); float* gates = (float*)(F.ws + WS_GATES);
    h8 whi[8], wlo[8];
#pragma unroll
    for (int kk = 0; kk < 8; ++kk)
#pragma unroll
        for (int e = 0; e < 8; ++e) { const float w = A.in[I_WR][(128 * wave + 16 * kk + 8 * hi + e) * 32 + r32]; const f16 h = (f16)w; whi[kk][e] = h; wlo[kk][e] = (f16)(w - (float)h); }
    f32x4 gv[4], bv[4];
#pragma unroll
    for (int jx = 0; jx < 4; ++jx) { gv[jx] = *(const f32x4*)(A.in[I_LN1G] + 256 * jx + 4 * lane); bv[jx] = *(const f32x4*)(A.in[I_LN1B] + 256 * jx + 4 * lane); }
    const int rows_per_blk = T / F.G;
#pragma unroll 1
    for (int bt = 0; bt < rows_per_blk / 32; ++bt) {
        const int row0 = blockIdx.x * rows_per_blk + bt * 32;
#pragma unroll 1
        for (int rr = 0; rr < 4; ++rr) {
            const int lr = wave * 4 + rr; const size_t ro = (size_t)(row0 + lr) * 1024;
            f32x4 v[4]; float s1 = 0.f, s2 = 0.f;
#pragma unroll
            for (int jx = 0; jx < 4; ++jx) { const f32x4 xv = *(const f32x4*)(xin + ro + 256 * jx + 4 * lane); const h4 mv = *(const h4*)(mixo + ro + 256 * jx + 4 * lane);
#pragma unroll
                for (int e = 0; e < 4; ++e) { const float t = ALPHA * xv[e] + (float)mv[e]; v[jx][e] = t; s1 += t; } }
            const float mean = wave_sum(s1) * (1.0f / 1024.0f);
#pragma unroll
            for (int jx = 0; jx < 4; ++jx) { v[jx] = v[jx] - mean; s2 += (v[jx][0] * v[jx][0] + v[jx][1] * v[jx][1]) + (v[jx][2] * v[jx][2] + v[jx][3] * v[jx][3]); }
            const float rstd = rsqrtf(wave_sum(s2) * (1.0f / 1024.0f) + LN_EPS);
#pragma unroll
            for (int jx = 0; jx < 4; ++jx) {
                const f32x4 y = v[jx] * rstd * gv[jx] + bv[jx];
                h4 yh_, yl_;
#pragma unroll
                for (int e = 0; e < 4; ++e) { const f16 h = (f16)y[e]; yh_[e] = h; yl_[e] = (f16)(y[e] - (float)h); }
                *(h4*)(x1h + ro + 256 * jx + 4 * lane) = yh_;
                *(int*)(x1q + ro + 256 * jx + 4 * lane) = pack_fp8x4(y[0], y[1], y[2], y[3]);
                *(LAS h4*)(lds + RT_XHI + lr * RT_XROW + (256 * jx + 4 * lane) * 2) = yh_;
                *(LAS h4*)(lds + RT_XLO + lr * RT_XROW + (256 * jx + 4 * lane) * 2) = yl_;
            }
        }
        __syncthreads();
        f32x16 acc = {};
#pragma unroll
        for (int kk = 0; kk < 8; ++kk) {
            const int ko = (128 * wave + 16 * kk + 8 * hi) * 2;
            const h8 xh_ = *(const LAS h8*)(lds + RT_XHI + r32 * RT_XROW + ko), xl_ = *(const LAS h8*)(lds + RT_XLO + r32 * RT_XROW + ko);
            acc = __builtin_amdgcn_mfma_f32_32x32x16_f16(whi[kk], xh_, acc, 0, 0, 0);
            acc = __builtin_amdgcn_mfma_f32_32x32x16_f16(wlo[kk], xh_, acc, 0, 0, 0);
            acc = __builtin_amdgcn_mfma_f32_32x32x16_f16(whi[kk], xl_, acc, 0, 0, 0);
        }
        __syncthreads();
#pragma unroll
        for (int g = 0; g < 4; ++g) { f32x4 o; o[0] = acc[4 * g]; o[1] = acc[4 * g + 1]; o[2] = acc[4 * g + 2]; o[3] = acc[4 * g + 3];
            *(LAS f32x4*)(lds + RT_PART + (((wave * 32 + r32) * 32) + 8 * g + 4 * hi) * 4) = o; }
        __syncthreads();
        { const int row = tid >> 4, e0 = 2 * (tid & 15); float a0 = A.in[I_BR][e0], a1 = A.in[I_BR][e0 + 1];
#pragma unroll
          for (int w = 0; w < 8; ++w) { a0 += *(const LAS float*)(lds + RT_PART + (((w * 32 + row) * 32) + e0) * 4); a1 += *(const LAS float*)(lds + RT_PART + (((w * 32 + row) * 32) + e0 + 1) * 4); }
          *(LAS float*)(lds + RT_FIN + (row * 33 + e0) * 4) = a0; *(LAS float*)(lds + RT_FIN + (row * 33 + e0 + 1) * 4) = a1; }
        __syncthreads();
        if (tid < 32) {
            const LAS float* lg = (const LAS float*)(lds + RT_FIN + tid * 33 * 4);
            float tv[4]; int te[4];
#pragma unroll
            for (int k = 0; k < 4; ++k) { tv[k] = -INFINITY; te[k] = 0; }
#pragma unroll 1
            for (int e = 0; e < 32; ++e) { const float x = lg[e];
                if (x > tv[3]) {
                    if (x > tv[0]) { tv[3] = tv[2]; te[3] = te[2]; tv[2] = tv[1]; te[2] = te[1]; tv[1] = tv[0]; te[1] = te[0]; tv[0] = x; te[0] = e; }
                    else if (x > tv[1]) { tv[3] = tv[2]; te[3] = te[2]; tv[2] = tv[1]; te[2] = te[1]; tv[1] = x; te[1] = e; }
                    else if (x > tv[2]) { tv[3] = tv[2]; te[3] = te[2]; tv[2] = x; te[2] = e; }
                    else { tv[3] = x; te[3] = e; } } }
            const float e1 = __expf(tv[1] - tv[0]), e2 = __expf(tv[2] - tv[0]), e3 = __expf(tv[3] - tv[0]); const float inv = 1.0f / (1.0f + e1 + e2 + e3);
            const int row = row0 + tid; f32x4 gk; gk[0] = inv; gk[1] = e1 * inv; gk[2] = e2 * inv; gk[3] = e3 * inv;
            *(f32x4*)(gates + (size_t)row * 4) = gk;
#pragma unroll
            for (int k = 0; k < 4; ++k) { const unsigned rk = atomicAdd((unsigned*)&lcnt[te[k]], 1u); asg[(bt * 32 + tid) * 4 + k] = (unsigned)te[k] | (rk << 8); }
        }
        __syncthreads();
    }
    if (F.tid < 32) lbase[F.tid] = __hip_atomic_fetch_add(F.ctl + CW_CNT + 2048 * pass + 64 * F.tid, lcnt[F.tid], RLX_AGENT);
    __syncthreads();
    int* list = (int*)(F.ws + WS_LIST + (size_t)pass * 4 * MiB);
    { const unsigned a = asg[F.tid]; const int e = a & 255, rk = a >> 8; const int row = blockIdx.x * rows_per_blk + (F.tid >> 2);
      list[(size_t)e * ECAP + lbase[e] + rk] = row * 4 + (F.tid & 3); }
    __syncthreads();
}

template <int WHICH> __device__ __forceinline__ void p67_moe(Frame& F) {
    const Args& A = *F.a;
    LAS int* tab = (LAS int*)(F.lds + pg8::STAGE_BYTES + 2048);
    if (F.tid < 32) tab[F.tid] = (int)__hip_atomic_load(F.ctl + CW_CNT + 64 * F.tid, RLX_AGENT);
    __syncthreads();
    if (F.tid == 0) { int sacc = 0; for (int e = 0; e < 32; ++e) { tab[32 + e] = sacc; sacc += (tab[e] + 255) >> 8; } tab[64] = sacc; }
    __syncthreads();
    const int* list = (const int*)(F.ws + WS_LIST);
    if (WHICH == 0) {
        ProbMoeUp P{(const char*)(F.ws + WS_X1Q), (const char*)(F.ws + WS_WGU), list, A.in[I_BGU], (unsigned char*)(F.ws + WS_ACT)};
        pg8::MoeOrder S{tab, 8, F.G, F.vcu}; pg8::gemm_phase(F.lds, P, S);
    } else {
        ProbMoeDn P{(const char*)(F.ws + WS_ACT), (const char*)(F.ws + WS_WDN), list, A.in[I_BDN], (const float*)(F.ws + WS_GATES), (unsigned char*)(F.ws + WS_SLAB)};
        pg8::MoeOrder S{tab, 4, F.G, F.vcu}; pg8::gemm_phase(F.lds, P, S);
    }
    __syncthreads();
}

__device__ __forceinline__ void p8_combine(Frame& F) {
    const int lane = F.lane;
    typedef int i32x2 __attribute__((ext_vector_type(2))); typedef float f32x2 __attribute__((ext_vector_type(2)));
    const f16* x1h = (const f16*)(F.ws + WS_X1H); const unsigned char* slab = (const unsigned char*)(F.ws + WS_SLAB); f16* rh = (f16*)(F.ws + WS_RH);
    for (int row = F.gw; row < T; row += F.NGW) {
#pragma unroll
        for (int j = 0; j < 2; ++j) {
            const size_t o = (size_t)row * 1024 + 512 * j + 8 * lane;
            const h8 xv = *(const h8*)(x1h + o); float v[8], acc[8];
#pragma unroll
            for (int e = 0; e < 8; ++e) { v[e] = ALPHA * (float)xv[e]; acc[e] = 0.f; }
#pragma unroll
            for (int k = 0; k < 4; ++k) { const i32x2 sv = *(const i32x2*)(slab + ((size_t)row * 4 + k) * 1024 + 512 * j + 8 * lane);
#pragma unroll
                for (int q = 0; q < 2; ++q) { const f32x2 lo = __builtin_amdgcn_cvt_pk_f32_fp8(sv[q], false), hi = __builtin_amdgcn_cvt_pk_f32_fp8(sv[q], true);
                    acc[4 * q] += lo[0]; acc[4 * q + 1] += lo[1]; acc[4 * q + 2] += hi[0]; acc[4 * q + 3] += hi[1]; } }
            h8 hh;
#pragma unroll
            for (int e = 0; e < 8; ++e) hh[e] = (f16)(v[e] + acc[e] * (1.0f / SLAB_SCALE));
            *(h8*)(rh + o) = hh;
        }
    }
}

__device__ __forceinline__ void p9_ple(Frame& F) {
    ProbPleGate P{(const char*)(F.ws + WS_RH), (const char*)(F.ws + WS_WPG), (f16*)(F.ws + WS_GATEH)};
    pg8::DenseOrder S; S.init(T, DM, F.G, (int)blockIdx.x); pg8::gemm_phase(F.lds, P, S);
}

__device__ __forceinline__ void p10_ln2(Frame& F) {
    const Args& A = *F.a; const int lane = F.lane; float* out = A.out; const f16* rh = (const f16*)(F.ws + WS_RH); const f16* gateh = (const f16*)(F.ws + WS_GATEH); const f16* pe = (const f16*)(F.ws + WS_PE);
    f32x4 gv[4], bv[4];
#pragma unroll
    for (int j = 0; j < 2; ++j)
#pragma unroll
        for (int q = 0; q < 2; ++q) { gv[2 * j + q] = *(const f32x4*)(A.in[I_LN2G] + 512 * j + 8 * lane + 4 * q); bv[2 * j + q] = *(const f32x4*)(A.in[I_LN2B] + 512 * j + 8 * lane + 4 * q); }
    for (int row = F.gw; row < T; row += F.NGW) {
        f32x4 v[4]; float s = 0.f;
#pragma unroll
        for (int j = 0; j < 2; ++j) { const size_t o_ = (size_t)row * 1024 + 512 * j + 8 * lane; const h8 r8 = *(const h8*)(rh + o_), g8 = *(const h8*)(gateh + o_), p8 = *(const h8*)(pe + o_);
#pragma unroll
            for (int q = 0; q < 2; ++q) { f32x4 t;
#pragma unroll
                for (int e = 0; e < 4; ++e) t[e] = (float)r8[4 * q + e] + (float)g8[4 * q + e] * (float)p8[4 * q + e];
                v[2 * j + q] = t; s += (t[0] + t[1]) + (t[2] + t[3]); } }
        const float mean = wave_sum(s) * (1.0f / 1024.0f); float s2 = 0.f;
#pragma unroll
        for (int j = 0; j < 4; ++j) { v[j] = v[j] - mean; s2 += (v[j][0] * v[j][0] + v[j][1] * v[j][1]) + (v[j][2] * v[j][2] + v[j][3] * v[j][3]); }
        const float rstd = rsqrtf(wave_sum(s2) * (1.0f / 1024.0f) + LN_EPS);
#pragma unroll
        for (int j = 0; j < 2; ++j)
#pragma unroll
            for (int q = 0; q < 2; ++q) *(f32x4*)(out + (size_t)row * 1024 + 512 * j + 8 * lane + 4 * q) = v[2 * j + q] * rstd * gv[2 * j + q] + bv[2 * j + q];
    }
}

__global__ void __launch_bounds__(NTHREADS, 2) fwd_kernel(Args args) {
    extern __shared__ __attribute__((aligned(16))) unsigned char lds_raw[];
    Frame F;
    F.lds = (LAS unsigned char*)lds_raw; F.a = &args; F.ws = args.ws; F.ctl = (gu32*)(args.ws + WS_CTL);
    F.tid = threadIdx.x; F.lane = F.tid & 63; F.wave = __builtin_amdgcn_readfirstlane(F.tid >> 6);
    F.G = gridDim.x; F.gw = blockIdx.x * NWAVES + F.wave; F.NGW = F.G * NWAVES;
    { const int bx = blockIdx.x; F.vcu = (F.G % 8 == 0) ? (bx % 8) * (F.G / 8) + bx / 8 : bx; }
    volatile LAS unsigned* barst = (volatile LAS unsigned*)(F.lds + LDS_BARST);
    if (F.tid < 16) barst[F.tid] = 0u;
    __syncthreads();
    XcdBarrier bar; bar.bar = (unsigned*)(F.ctl + CW_BAR); bar.x = 0; bar.st = nullptr;
    if (MK_N_LAUNCHES == 1) bar = xcd_barrier_post((unsigned*)(F.ctl + CW_BAR), barst);
    const int lo = args.ph_lo, hi = args.ph_hi;
#define IN(k) (lo <= (k) && (k) < hi)
#define SEAM(k) do { if (IN(k) && IN((k) + 1)) xcd_barrier(bar); } while (0)
#define REP(k, body) do { if (IN(k)) { body; if ((PROBE_MASK >> (k)) & 1) { xcd_barrier(bar); body; } } } while (0)
    REP(0, p0_prologue(F)); SEAM(0);
    REP(1, p1_inproj(F)); SEAM(1);
    if (IN(2)) { p2_mixers(F, args.pass); if ((PROBE_MASK >> 2) & 1) { xcd_barrier(bar); p2_mixers(F, 1); } } SEAM(2);
    REP(3, p3_glu(F)); SEAM(3);
    REP(4, p4_outproj(F)); SEAM(4);
    if (IN(5)) { p5_router(F, args.pass); } SEAM(5);
    REP(6, p67_moe<0>(F)); SEAM(6);
    REP(7, p67_moe<1>(F)); SEAM(7);
    REP(8, p8_combine(F)); SEAM(8);
    REP(9, p9_ple(F)); SEAM(9);
    if (IN(10)) { p10_ln2(F); }
#undef REP
#undef IN
#undef SEAM
}
}

extern "C" void kernel_launch(void* const* d_in, const int* in_sizes, int n_in, void* d_out, int out_size, void* d_ws, size_t ws_size, hipStream_t stream) {
    static int grid = 0;
    if (grid == 0) {
        if (n_in != 31 || out_size != T * DM || ws_size < WS_END) { fprintf(stderr, "kernel_launch: unexpected problem (n_in %d, out %d, ws %zu)\n", n_in, out_size, ws_size); grid = -1; return; }
        int dev = 0, cus = 0;
        if (hipGetDevice(&dev) != hipSuccess || hipDeviceGetAttribute(&cus, hipDeviceAttributeMultiprocessorCount, dev) != hipSuccess) { grid = -1; return; }
        if (hipFuncSetAttribute((const void*)fwd_kernel, hipFuncAttributeMaxDynamicSharedMemorySize, LDS_BYTES) != hipSuccess) { fprintf(stderr, "kernel_launch: hipFuncSetAttribute failed\n"); grid = -1; return; }
        int per_cu = 0;
        if (hipOccupancyMaxActiveBlocksPerMultiprocessor(&per_cu, (const void*)fwd_kernel, NTHREADS, LDS_BYTES) != hipSuccess || per_cu < 1) { fprintf(stderr, "kernel_launch: occupancy query says %d\n", per_cu); }
        (void)hipGetLastError();
        grid = cus;
    }
    if (grid < 0) return;
    (void)hipMemsetAsync((char*)d_ws + WS_CTL, 0, CTL_ZERO_BYTES, stream);
    Args a{};
    for (int i = 0; i < 31; ++i) a.in[i] = (const float*)d_in[i];
    a.out = (float*)d_out; a.ws = (unsigned char*)d_ws;
    if (MK_N_LAUNCHES == 1) { a.ph_lo = 0; a.ph_hi = NPHASE; hipLaunchKernelGGL(fwd_kernel, dim3(grid), dim3(NTHREADS), LDS_BYTES, stream, a); }
    else { for (int p = 0; p < NPHASE; ++p) { a.ph_lo = p; a.ph_hi = p + 1; a.pass = 0; hipLaunchKernelGGL(fwd_kernel, dim3(grid), dim3(NTHREADS), LDS_BYTES, stream, a);
             if (p == PROBE_DUP) { a.pass = 1; hipLaunchKernelGGL(fwd_kernel, dim3(grid), dim3(NTHREADS), LDS_BYTES, stream, a); } } }
}
```

```cpp
#include <hip/hip_runtime.h>
#include <cstdio>
#include <cstdint>

#ifndef PROBE_MASK
#define PROBE_MASK 0
#endif
#ifndef PROBE_SEL
#define PROBE_SEL 0
#endif
#ifndef PROBE_DUP
#define PROBE_DUP -1
#endif
#ifndef MK_N_LAUNCHES
#define MK_N_LAUNCHES 1
#endif

namespace {
constexpr int BATCH = 4, SEQ = 8192, DM = 1024, T = BATCH * SEQ;
constexpr int NH = 8, NG = 32, NS = 64, DIN = 2048;
constexpr int NE = 32, PLE = 256;
constexpr int ECAP = T;
constexpr float LN_EPS = 1e-5f, RMS_EPS = 1e-5f;
constexpr float ALPHA = 1.189207115002721f;
constexpr float QSCALE = 0.17677669529663687f * 1.4426950408889634f;
constexpr float LOG2E = 1.4426950408889634f;
constexpr int NPHASE = 11;
constexpr int NWAVES = 8, NTHREADS = 512;

typedef _Float16 f16;
typedef f16 h8 __attribute__((ext_vector_type(8)));
typedef f16 h4 __attribute__((ext_vector_type(4)));
typedef f16 h2 __attribute__((ext_vector_type(2)));
typedef float f32x4 __attribute__((ext_vector_type(4)));
typedef float f32x16 __attribute__((ext_vector_type(16)));
typedef int i32x4 __attribute__((ext_vector_type(4)));
typedef int i32x8 __attribute__((ext_vector_type(8)));
#define LAS __attribute__((address_space(3)))
#define GAS __attribute__((address_space(1)))
typedef GAS unsigned gu32;
#define RLX_AGENT __ATOMIC_RELAXED, __HIP_MEMORY_SCOPE_AGENT

constexpr size_t MiB = 1u << 20;
constexpr size_t WS_CTL = 0, CTL_ZERO_BYTES = 1 * MiB;
constexpr size_t WS_STATS = 3 * MiB;
constexpr size_t WS_GATES = 5 * MiB;
constexpr size_t WS_LIST = 6 * MiB;
constexpr size_t WS_WIN = 16 * MiB;
constexpr size_t WS_WGLU = 20 * MiB;
constexpr size_t WS_WOUT = 21 * MiB;
constexpr size_t WS_WPG = 23 * MiB;
constexpr size_t WS_WPP = 25 * MiB;
constexpr size_t WS_WGU = 32 * MiB;
constexpr size_t WS_WDN = 160 * MiB;
constexpr size_t WS_PE = 224 * MiB;
constexpr size_t WS_V1 = 288 * MiB;
constexpr size_t WS_A = 416 * MiB;
constexpr size_t WS_XH = WS_A;
constexpr size_t WS_PH = WS_A + 64 * MiB;
constexpr size_t WS_QH = WS_A + 80 * MiB;
constexpr size_t WS_KT = WS_A + 112 * MiB;
constexpr size_t WS_VT = WS_A + 144 * MiB;
constexpr size_t WS_UG = WS_A + 176 * MiB;
constexpr size_t WS_ACT = WS_A;
constexpr size_t WS_X1Q = WS_A + 128 * MiB;
constexpr size_t WS_R = WS_A;
constexpr size_t WS_RH = WS_A + 128 * MiB;
constexpr size_t WS_B = 672 * MiB;
constexpr size_t WS_YH = WS_B;
constexpr size_t WS_MIX = WS_B + 32 * MiB;
constexpr size_t WS_X1H = 940 * MiB;
constexpr size_t WS_SLAB = WS_B;
constexpr size_t WS_SSMOP = 928 * MiB;
constexpr size_t WS_A16 = 936 * MiB;
constexpr size_t WS_GATEH = WS_V1;
constexpr size_t WS_MIXO = WS_XH;
constexpr size_t WS_END = 1004 * MiB;

constexpr int CW_BAR = 4096;
constexpr int CW_CNT = 8192;
constexpr int CW_QUEUE = 12288;
constexpr int CW_KMAX = 16384;

constexpr int LDS_BYTES = 147456;
constexpr int LDS_BARST = LDS_BYTES - 64;

__device__ __forceinline__ float wave_sum(float v) {
#pragma unroll
    for (int o = 1; o < 64; o <<= 1) v += __shfl_xor(v, o);
    return v;
}
__device__ __forceinline__ float sigmoidf_(float x) { return __builtin_amdgcn_rcpf(1.0f + __builtin_amdgcn_exp2f(-LOG2E * x)); }
__device__ __forceinline__ float gelu_tanh(float x) {
    const float z = 0.7978845608028654f * (x + 0.044715f * x * x * x);
    const float e = __builtin_amdgcn_exp2f(fminf(2.0f * LOG2E * z, 80.0f));
    const float t = 1.0f - 2.0f * __builtin_amdgcn_rcpf(e + 1.0f);
    return 0.5f * x * (1.0f + t);
}
__device__ __forceinline__ int crow(int r, int hi) { return (r & 3) + 8 * (r >> 2) + 4 * hi; }
__device__ __forceinline__ float swap_add(float v) { return v + __shfl_xor(v, 32); }
__device__ __forceinline__ float swap_max(float v) { return fmaxf(v, __shfl_xor(v, 32)); }

#define XB_TMO      128
#define XB_XCNT(j)  (256  + 64 * (j))
#define XB_XSUB(j)  (1280 + 64 * (j))
#define XB_XGEN(j)  (2304 + 64 * (j))
#define XB_TOP      3328
#define XB_TOPGEN   3392
#define XCD_BAR_WORDS 3456
#define XB_SPIN_CAP (1u << 20)
__device__ __forceinline__ unsigned xb_ld(unsigned* p)              { return __hip_atomic_load(p, __ATOMIC_RELAXED, __HIP_MEMORY_SCOPE_AGENT); }
__device__ __forceinline__ unsigned xb_add(unsigned* p, unsigned v) { return __hip_atomic_fetch_add(p, v, __ATOMIC_RELAXED, __HIP_MEMORY_SCOPE_AGENT); }
__device__ __forceinline__ unsigned xb_xcc_id() { return (unsigned)__builtin_amdgcn_s_getreg((3 << 11) | 20) & 0xFu; }
#define XB_SPIN(cond, bar) do { unsigned _sp = 0; while (cond) { __builtin_amdgcn_s_sleep(1); \
    if ((++_sp & 255u) == 0u) { if (xb_ld(&(bar)[XB_TMO])) break; if (_sp > XB_SPIN_CAP) { atomicAdd(&(bar)[XB_TMO], 1u); break; } } } } while (0)
struct XcdBarrier { unsigned* bar; unsigned x; volatile LAS unsigned* st; };
__device__ __forceinline__ XcdBarrier xcd_barrier_post(unsigned* bar, volatile LAS unsigned* st) {
    XcdBarrier b; b.bar = bar; b.x = xb_xcc_id(); b.st = st;
    if (threadIdx.x == 0) (void)xb_add(&bar[XB_XCNT(b.x)], 1u);
    return b;
}
__device__ __forceinline__ void xcd_barrier_complete(unsigned* bar, unsigned x, unsigned& nloc, unsigned& nx) {
    const unsigned G = gridDim.x * gridDim.y * gridDim.z;
    unsigned sum, cnt, mine, sp = 0u;
    for (;;) {
        sum = 0u; cnt = 0u; mine = 0u;
#pragma unroll
        for (unsigned j = 0; j < 16; ++j) { const unsigned c = xb_ld(&bar[XB_XCNT(j)]); sum += c; cnt += (c > 0u) ? 1u : 0u; mine = (j == x) ? c : mine; }
        if (sum == G) break;
        __builtin_amdgcn_s_sleep(1);
        if ((++sp & 255u) == 0u) { if (xb_ld(&bar[XB_TMO])) break; if (sp > XB_SPIN_CAP) { atomicAdd(&bar[XB_TMO], 1u); break; } }
    }
    nloc = mine > 0u ? mine : 1u; nx = cnt > 0u ? cnt : 1u;
}
__device__ __forceinline__ void xcd_barrier(const XcdBarrier& b) {
    asm volatile("s_waitcnt vmcnt(0)" ::: "memory");
    __syncthreads();
    if (threadIdx.x == 0) {
        unsigned* bar = b.bar;
        __builtin_amdgcn_s_waitcnt(0);
        unsigned nloc = b.st[0], nx = b.st[1];
        if (nloc == 0u) { xcd_barrier_complete(bar, b.x, nloc, nx); b.st[0] = nloc; b.st[1] = nx; }
        const unsigned old = xb_add(&bar[XB_XSUB(b.x)], 1u);
        const unsigned gen = old / nloc;
        if (old + 1u == (gen + 1u) * nloc) {
            __builtin_amdgcn_fence(__ATOMIC_RELEASE, "agent");
            asm volatile("s_waitcnt vmcnt(0)" ::: "memory");
            const unsigned og = xb_add(&bar[XB_TOP], 1u);
            const unsigned tg = og / nx;
            if (og + 1u == (tg + 1u) * nx) xb_add(&bar[XB_TOPGEN], 1u);
            else XB_SPIN(xb_ld(&bar[XB_TOPGEN]) == tg, bar);
            __builtin_amdgcn_fence(__ATOMIC_ACQUIRE, "agent");
            xb_add(&bar[XB_XGEN(b.x)], 1u);
            asm volatile("s_waitcnt vmcnt(0)" ::: "memory");
        } else {
            XB_SPIN(xb_ld(&bar[XB_XGEN(b.x)]) == gen, bar);
            __builtin_amdgcn_fence(__ATOMIC_ACQUIRE, "agent");
            asm volatile("s_waitcnt vmcnt(0)" ::: "memory");
        }
    }
    __syncthreads();
}

struct Args { const float* in[31]; float* out; unsigned char* ws; int ph_lo, ph_hi, pass, pad; };
enum { I_X = 0, I_P, I_WIN, I_LQ1, I_LK1, I_LQ2, I_LK2, I_SUBLN, I_ARE, I_AIM, I_LOGDT, I_BRE, I_BIM, I_CRE, I_CIM, I_SSMD, I_WGLU, I_SSMG, I_WOUT,
       I_LN1G, I_LN1B, I_WR, I_BR, I_WGU, I_BGU, I_WDN, I_BDN, I_WPG, I_WPP, I_LN2G, I_LN2B };

struct Frame {
    LAS unsigned char* lds;
    const Args* a;
    unsigned char* ws;
    gu32* ctl;
    int tid, lane, wave, gw, NGW, G, vcu;
};

namespace pg8 {
constexpr int BM = 256, BK = 64, HALF = 128, HTB = HALF * BK * 2, STAGE_BYTES = 8 * HTB, NXCD = 8, WGM = 8;
__device__ __forceinline__ int lds_byte(int r, int c) { const int st = (r >> 4) * 2 + (c >> 5), rr = r & 15, cc = c & 31, ob = rr * 64 + cc * 2; return st * 1024 + (ob ^ (((ob >> 9) & 1) << 5)); }
__device__ __forceinline__ void stage_rc(int b, int& R, int& C) { const int st = b / 1024, sb = b % 1024, swz = sb ^ (((sb >> 9) & 1) << 5); R = (st >> 1) * 16 + swz / 64; C = (st & 1) * 32 + (swz % 64) / 2; }
struct Unit { int pm, pn, e, cnt; };
struct DenseOrder {
    int nM, nN, nwg, G, c;
    __device__ __forceinline__ void init(int M, int N, int G_, int c_) { nM = M / BM; nN = N / BM; nwg = nM * nN; G = G_; c = c_; }
    __device__ __forceinline__ bool next(int i, Unit& u) const {
        const long L = (long)i * G + c; if (L >= nwg) return false;
        int wgid = (int)L; { const int q = nwg / NXCD, r = nwg % NXCD, xcd = wgid % NXCD, off = wgid / NXCD; wgid = (xcd < r ? xcd * (q + 1) : r * (q + 1) + (xcd - r) * q) + off; }
        const int nig = WGM * nN, gid = wgid / nig, fm = gid * WGM, gsz = (nM - fm) < WGM ? (nM - fm) : WGM;
        u.pm = fm + ((wgid % nig) % gsz); u.pn = (wgid % nig) / gsz; u.e = 0; u.cnt = 0; return true;
    }
};
struct OneOrder { Unit u; __device__ __forceinline__ bool next(int i, Unit& o) const { if (i != 0) return false; o = u; return true; } };
struct MoeOrder {
    const LAS int* tab; int ntn, G, c;
    __device__ __forceinline__ bool next(int i, Unit& u) const {
        const int L = i * G + c; if (L >= tab[64] * ntn) return false;
        int e = 0;
#pragma unroll 1
        for (int q = 1; q < 32; ++q) if (L >= tab[32 + q] * ntn) e = q;
        const int cnt = tab[e], lu = L - tab[32 + e] * ntn;
        u.e = e; u.cnt = cnt; u.pn = lu % ntn; u.pm = lu / ntn; return true;
    }
};

template <class P, class Sched>
__device__ __forceinline__ void gemm_phase(LAS unsigned char* lds, const P& p, const Sched& S) {
    const int tid = threadIdx.x, wid = __builtin_amdgcn_readfirstlane(tid >> 6), lane = tid & 63, wr = wid >> 2, wc = wid & 3, fr = lane & 15, fq = lane >> 4;
    constexpr int K = P::K, PB = P::FP8 ? K : 2 * K  , nt = PB / 128;
    int RA[2]; unsigned CB[2], voffB[2];
#pragma unroll
    for (int i = 0; i < 2; ++i) { int R, C; stage_rc(tid * 16 + i * 8192, R, C); RA[i] = R; CB[i] = (unsigned)C * 2u; voffB[i] = (unsigned)(R * PB + C * 2); }
    constexpr size_t kstep = 128, hstep = (size_t)HALF * PB, tstep = 2 * hstep;
    const unsigned ldsw = (unsigned)wid * 1024u;
    const int aoff = lds_byte(wr * 64 + fr, fq * 8), boff = lds_byte(wc * 32 + fr, fq * 8);
    LAS float* rsl = (LAS float*)(lds + STAGE_BYTES);
    const char* abase = p.abase();
#define PG8_SA(b, h) (((b) * 2 + (h)) * HTB)
#define PG8_SB(b, h) ((4 + (b) * 2 + (h)) * HTB)
#define PG8_STAGE(bufoff, gbase, voff) do { _Pragma("unroll") for (int _i = 0; _i < 2; ++_i) \
        __builtin_amdgcn_global_load_lds((const unsigned*)((const char*)(gbase) + (voff)[_i]), (LAS unsigned*)(lds + (bufoff) + ldsw + _i * 8192), 16, 0, 0); } while (0)
#define PG8_LDA(dst, b, h) do { _Pragma("unroll") for (int m = 0; m < 4; ++m) { \
        if constexpr (P::FP8) { const i32x4 lo_ = *(const LAS i32x4*)(lds + PG8_SA(b, h) + aoff + m * 2048), hi_ = *(const LAS i32x4*)(lds + PG8_SA(b, h) + aoff + m * 2048 + 1024); dst##8[m] = __builtin_shufflevector(lo_, hi_, 0, 1, 2, 3, 4, 5, 6, 7); } \
        else { _Pragma("unroll") for (int k = 0; k < 2; ++k) dst[m][k] = *(const LAS h8*)(lds + PG8_SA(b, h) + aoff + m * 2048 + k * 1024); } } } while (0)
#define PG8_LDB(dst, b, h) do { _Pragma("unroll") for (int n = 0; n < 2; ++n) { \
        if constexpr (P::FP8) { const i32x4 lo_ = *(const LAS i32x4*)(lds + PG8_SB(b, h) + boff + n * 2048), hi_ = *(const LAS i32x4*)(lds + PG8_SB(b, h) + boff + n * 2048 + 1024); dst##8[n] = __builtin_shufflevector(lo_, hi_, 0, 1, 2, 3, 4, 5, 6, 7); } \
        else { _Pragma("unroll") for (int k = 0; k < 2; ++k) dst[n][k] = *(const LAS h8*)(lds + PG8_SB(b, h) + boff + n * 2048 + k * 1024); } } } while (0)
#define PG8_MMA(ai, bj, At, Bt) do { __builtin_amdgcn_s_setprio(1); _Pragma("unroll") for (int m = 0; m < 4; ++m) _Pragma("unroll") for (int n = 0; n < 2; ++n) { \
        if constexpr (P::FP8) asm volatile("v_mfma_scale_f32_16x16x128_f8f6f4 %0, %1, %2, %0, %3, %3 op_sel_hi:[0,0,0]" : "+v"(acc[ai][bj][m][n]) : "v"(Bt##8[n]), "v"(At##8[m]), "v"(one_scale)); \
        else { _Pragma("unroll") for (int k = 0; k < 2; ++k) acc[ai][bj][m][n] = __builtin_amdgcn_mfma_f32_16x16x32_f16(Bt[n][k], At[m][k], acc[ai][bj][m][n], 0, 0, 0); } } \
        __builtin_amdgcn_s_setprio(0); } while (0)
#define PG8_WAIT_V(n) asm volatile("s_waitcnt vmcnt(" #n ")" ::: "memory")
#define PG8_WAIT_L(n) asm volatile("s_waitcnt lgkmcnt(" #n ")" ::: "memory")
#define PG8_BAR __builtin_amdgcn_s_barrier()
#define PG8_SCHED __builtin_amdgcn_sched_barrier(0)
    Unit cur, nxt; int ui = 0;
    if (!S.next(0, cur)) return;
    f32x4 acc[2][2][4][2];
#pragma unroll
    for (int a = 0; a < 2; ++a)
#pragma unroll
        for (int b = 0; b < 2; ++b)
#pragma unroll
            for (int m = 0; m < 4; ++m)
#pragma unroll
                for (int n = 0; n < 2; ++n) acc[a][b][m][n] = (f32x4){0.f, 0.f, 0.f, 0.f};
    h8 At[4][2], B0[2][2], B1[2][2]; i32x8 At8[4], B08[2], B18[2];
    int one_scale = 0x7f7f7f7f; asm volatile("" : "+v"(one_scale));
    LAS int* ginfo = (LAS int*)(lds + STAGE_BYTES + 4096);
    unsigned voffA[2];
    const char* cA = abase; const char* nA = abase;
#pragma unroll
    for (int i = 0; i < 2; ++i) voffA[i] = P::GATHER ? CB[i] : (unsigned)(RA[i] * PB) + CB[i];
    if constexpr (P::GATHER) {
        if (tid < 256) p.fill_rows(cur, ginfo, tid);
        asm volatile("s_waitcnt lgkmcnt(0)" ::: "memory"); PG8_BAR; asm volatile("" ::: "memory");
    } else cA = abase + (size_t)cur.pm * tstep;
    constexpr size_t hA = P::GATHER ? 0 : hstep;
#define PG8_STAGE_A(bufoff, gbase, par, half) do { if constexpr (P::GATHER) { _Pragma("unroll") for (int _i = 0; _i < 2; ++_i) { \
            const unsigned ro_ = p.rowbytes(ginfo[(par) * 512 + (half) * 128 + RA[_i]] & 0x7fffffff) + voffA[_i]; \
            __builtin_amdgcn_global_load_lds((const unsigned*)((const char*)(gbase) + ro_), (LAS unsigned*)(lds + (bufoff) + ldsw + _i * 8192), 16, 0, 0); } } \
        else PG8_STAGE(bufoff, (const char*)(gbase) + (half) * hA, voffA); } while (0)
    const char* cB = p.bptr(cur);
    if constexpr (P::MID) p.mid_prepare(cur, rsl, tid);
    PG8_STAGE(PG8_SB(0, 0), cB, voffB); PG8_STAGE(PG8_SB(0, 1), cB + hstep, voffB); PG8_STAGE_A(PG8_SA(0, 0), cA, 0, 0); PG8_STAGE_A(PG8_SA(0, 1), cA, 0, 1);
    if (wr == 1) PG8_BAR;
    PG8_WAIT_V(2); PG8_BAR;
    PG8_STAGE(PG8_SB(1, 0), cB + kstep, voffB); PG8_STAGE_A(PG8_SA(1, 0), cA + kstep, 0, 0); PG8_STAGE(PG8_SB(1, 1), cB + hstep + kstep, voffB);
    PG8_WAIT_V(6); PG8_BAR;
    for (;;) {
        const bool has_next = S.next(ui + 1, nxt);
        const char* nB = cB; nA = cA;
        const int cpar = ui & 1; int npar = cpar;
        if (has_next) {
            nB = p.bptr(nxt); npar = cpar ^ 1;
            if constexpr (P::GATHER) { if (tid < 256) p.fill_rows(nxt, ginfo + npar * 512, tid); }
            else nA = abase + (size_t)nxt.pm * tstep;
            if constexpr (P::MID) p.mid_prepare(nxt, rsl + 256 * ((ui + 1) & 1), tid);
        }
#pragma unroll 1
        for (int t = 0; t < nt; t += 2) {
            const bool last = (t == nt - 2);
            if constexpr (P::MID) {
                if (t == nt / 2) {
                    const LAS float* rs = rsl + 256 * (ui & 1);
#pragma unroll
                    for (int a = 0; a < 2; ++a)
#pragma unroll
                        for (int m = 0; m < 4; ++m) { const float sc = rs[a * 128 + wr * 64 + m * 16 + fr];
#pragma unroll
                            for (int b = 0; b < 2; ++b)
#pragma unroll
                                for (int n = 0; n < 2; ++n) acc[a][b][m][n] *= sc; }
                }
            }
            const char* a1 = cA + (size_t)(t + 1) * kstep;
            const char* a2 = last ? nA : cA + (size_t)(t + 2) * kstep; const char* b2 = last ? nB : cB + (size_t)(t + 2) * kstep;
            const char* a3 = a2 + kstep; const char* b3 = b2 + kstep;
            const int par2 = last ? npar : cpar;
            PG8_LDB(B0, 0, 0); PG8_LDB(B1, 0, 1); PG8_SCHED; PG8_LDA(At, 0, 0); PG8_STAGE_A(PG8_SA(1, 1), a1, cpar, 1);
            PG8_WAIT_V(8); PG8_WAIT_L(0); PG8_BAR; PG8_MMA(0, 0, At, B0); PG8_MMA(0, 1, At, B1); PG8_BAR; PG8_SCHED;
            PG8_LDA(At, 0, 1); PG8_STAGE(PG8_SB(0, 0), b2, voffB); PG8_STAGE(PG8_SB(0, 1), b2 + hstep, voffB); PG8_STAGE_A(PG8_SA(0, 0), a2, par2, 0);
            PG8_WAIT_V(8); PG8_WAIT_L(0); PG8_BAR; PG8_MMA(1, 0, At, B0); PG8_MMA(1, 1, At, B1); PG8_BAR; PG8_SCHED;
            PG8_LDB(B0, 1, 0); PG8_LDB(B1, 1, 1); PG8_SCHED; PG8_LDA(At, 1, 0); PG8_STAGE_A(PG8_SA(0, 1), a2, par2, 1);
            PG8_WAIT_V(8); PG8_WAIT_L(0); PG8_BAR; PG8_MMA(0, 0, At, B0); PG8_MMA(0, 1, At, B1); PG8_BAR; PG8_SCHED;
            PG8_LDA(At, 1, 1); PG8_STAGE(PG8_SB(1, 0), b3, voffB); PG8_STAGE(PG8_SB(1, 1), b3 + hstep, voffB); PG8_STAGE_A(PG8_SA(1, 0), a3, par2, 0);
            PG8_WAIT_V(8); PG8_WAIT_L(0); PG8_BAR; PG8_MMA(1, 0, At, B0); PG8_MMA(1, 1, At, B1); PG8_BAR; PG8_SCHED;
        }
        if (wr == 0) PG8_BAR;
        if constexpr (P::FP8) asm volatile("s_nop 15\n\ts_nop 7" ::: "memory");
        {
            const int cb = wc * 32 + fq * 8;
#define PG8_EPI_LOOP(RI, CALL) do { const auto pre = p.pre(cur, cb); (void)pre; \
                _Pragma("unroll") for (int a = 0; a < 2; ++a) { \
                    int lrow = a * 128 + wr * 64 + fr; decltype(RI) ris[4]; \
                    _Pragma("unroll") for (int m = 0; m < 4; ++m) { lrow = a * 128 + wr * 64 + m * 16 + fr; ris[m] = RI; } \
                    _Pragma("unroll") for (int m = 0; m < 4; ++m) { lrow = a * 128 + wr * 64 + m * 16 + fr; const auto ri = ris[m]; CALL; } } } while (0)
            if constexpr (P::KINDS) {
                const int kd = __builtin_amdgcn_readfirstlane(p.kind(cur));
                if (kd == 1) p.knorm(cur, acc, wc, lane);
                if (kd == 0) PG8_EPI_LOOP(p.template rowpart<0>(cur, lrow), p.template epik<0>(cur, ri, cb, acc[a][0][m][0], acc[a][0][m][1], acc[a][1][m][0], acc[a][1][m][1]));
                else if (kd == 1) PG8_EPI_LOOP(p.template rowpart<1>(cur, lrow), p.template epik<1>(cur, ri, cb, acc[a][0][m][0], acc[a][0][m][1], acc[a][1][m][0], acc[a][1][m][1]));
                else if (kd == 2) PG8_EPI_LOOP(p.template rowpart<2>(cur, lrow), p.template epik<2>(cur, ri, cb, acc[a][0][m][0], acc[a][0][m][1], acc[a][1][m][0], acc[a][1][m][1]));
                else PG8_EPI_LOOP(p.template rowpart<3>(cur, lrow), p.template epik<3>(cur, ri, cb, acc[a][0][m][0], acc[a][0][m][1], acc[a][1][m][0], acc[a][1][m][1]));
            } else {
                if constexpr (P::GATHER) { const LAS int* gi_ = ginfo + (ui & 1) * 512; PG8_EPI_LOOP(p.rowinfo_lds(gi_, lrow), p.epi(cur, pre, ri, lrow, cb, acc[a][0][m][0], acc[a][0][m][1], acc[a][1][m][0], acc[a][1][m][1])); }
                else PG8_EPI_LOOP(p.rowinfo(cur, lrow), p.epi(cur, pre, ri, lrow, cb, acc[a][0][m][0], acc[a][0][m][1], acc[a][1][m][0], acc[a][1][m][1]));
            }
#undef PG8_EPI_LOOP
        }
        if (!has_next) break;
#pragma unroll
        for (int a = 0; a < 2; ++a)
#pragma unroll
            for (int b = 0; b < 2; ++b)
#pragma unroll
                for (int m = 0; m < 4; ++m)
#pragma unroll
                    for (int n = 0; n < 2; ++n) acc[a][b][m][n] = (f32x4){0.f, 0.f, 0.f, 0.f};
        cur = nxt; cB = nB; cA = nA; ++ui;
        if (wr == 1) PG8_BAR;
    }
    PG8_WAIT_V(0);
    PG8_BAR;
#undef PG8_SA
#undef PG8_SB
#undef PG8_STAGE
#undef PG8_STAGE_A
#undef PG8_LDA
#undef PG8_LDB
#undef PG8_MMA
#undef PG8_WAIT_V
#undef PG8_WAIT_L
#undef PG8_BAR
#undef PG8_SCHED
}
}

struct NoPre {};
__device__ __forceinline__ int pack_fp8x4(float a, float b, float c, float d) { int w = 0; w = __builtin_amdgcn_cvt_pk_fp8_f32(a, b, w, false); w = __builtin_amdgcn_cvt_pk_fp8_f32(c, d, w, true); return w; }
constexpr float WGU_SCALE = 32.0f, WDN_SCALE = 64.0f, ACT_SCALE = 4.0f, SLAB_SCALE = 16.0f;
__device__ __forceinline__ h8 pack8(f32x4 lo, f32x4 hi) { h8 o; o[0] = (f16)lo[0]; o[1] = (f16)lo[1]; o[2] = (f16)lo[2]; o[3] = (f16)lo[3]; o[4] = (f16)hi[0]; o[5] = (f16)hi[1]; o[6] = (f16)hi[2]; o[7] = (f16)hi[3]; return o; }
struct ProbInproj {
    static constexpr int K = 1024; static constexpr bool KINDS = true; static constexpr bool GATHER = false; static constexpr bool FP8 = false; static constexpr bool MID = false;
    const char* xh; const char* win; f16 *qh, *kt, *vt, *ug; gu32* kmax;
    __device__ __forceinline__ const char* abase() const { return xh; }
    __device__ __forceinline__ unsigned rowoff(const pg8::Unit& u, int r) const { return (unsigned)(u.pm * 256 + r) * (unsigned)(K * 2); }
    __device__ __forceinline__ const char* bptr(const pg8::Unit& u) const { return win + (size_t)u.pn * 256 * K * 2; }
    __device__ __forceinline__ NoPre pre(const pg8::Unit&, int) const { return NoPre{}; }
    __device__ __forceinline__ int kind(const pg8::Unit& u) const { return u.pn >> 1; }
    __device__ __forceinline__ void knorm(const pg8::Unit& u, const f32x4 (&acc)[2][2][4][2], int wc, int lane) const {
#pragma unroll
        for (int b = 0; b < 2; ++b) {
            float mx = 0.f;
#pragma unroll
            for (int a = 0; a < 2; ++a)
#pragma unroll
                for (int m = 0; m < 4; ++m) { const f32x4 x = acc[a][b][m][0], y = acc[a][b][m][1];
                    float q = (x[0] * x[0] + x[1] * x[1]) + (x[2] * x[2] + x[3] * x[3]) + (y[0] * y[0] + y[1] * y[1]) + (y[2] * y[2] + y[3] * y[3]);
                    q += __shfl_xor(q, 16); q += __shfl_xor(q, 32); mx = fmaxf(mx, q); }
            mx = fmaxf(mx, __shfl_xor(mx, 1)); mx = fmaxf(mx, __shfl_xor(mx, 2)); mx = fmaxf(mx, __shfl_xor(mx, 4)); mx = fmaxf(mx, __shfl_xor(mx, 8));
            if (lane == 0) { const int bt = (u.pm * 256) >> 13, hd = (u.pn & 1) * 4 + 2 * b + (wc >> 1), mp = wc & 1;
                __hip_atomic_fetch_max(kmax + (bt * 8 + hd) * 2 + mp, __float_as_uint(sqrtf(mx)), RLX_AGENT); }
        }
    }
    template <int KIND> __device__ __forceinline__ unsigned rowpart(const pg8::Unit& u, int lr) const {
        const int row = u.pm * 256 + lr, b = row >> 13, tt = row & 8191, tile = tt >> 6, key = tt & 63;
        if (KIND == 0) return (unsigned)row * 512u;
        if (KIND == 1) return (unsigned)((b * 8 * 128 + tile) * 4096 + key * 8);
        if (KIND == 2) { const int sx = key >> 4, w = key & 15, hh = (w >> 2) & 1, j = (w & 3) + 4 * (w >> 3); return (unsigned)((b * 8 * 128 + tile) * 4096 + (2 * sx + hh) * 512 + j); }
        return (unsigned)((b * 32 * 8192 + tt) * 16);
    }
    template <int KIND> __device__ __forceinline__ void epik(const pg8::Unit& u, unsigned rp, int cb, f32x4 v00, f32x4 v01, f32x4 v10, f32x4 v11) const {
#pragma unroll
        for (int b = 0; b < 2; ++b) {
            const int col = (u.pn & 1) * 256 + b * 128 + cb; const f32x4 lo = b ? v10 : v00, hi = b ? v11 : v01;
            if (KIND == 0) { *(h8*)(qh + rp + col) = pack8(lo * QSCALE, hi * QSCALE); }
            else if (KIND == 1) { const int hd = col >> 6, d = col & 63; *(h8*)(kt + rp + (unsigned)(hd * 128 * 4096 + (d >> 3) * 512)) = pack8(lo, hi); }
            else if (KIND == 2) { const int hd = col >> 6, dv = col & 63; f16* q = vt + rp + (unsigned)(hd * 128 * 4096 + dv * 8);
                q[0] = (f16)lo[0]; q[8] = (f16)lo[1]; q[16] = (f16)lo[2]; q[24] = (f16)lo[3]; q[32] = (f16)hi[0]; q[40] = (f16)hi[1]; q[48] = (f16)hi[2]; q[56] = (f16)hi[3]; }
            else { const int g = col >> 4, c0 = col & 15; *(h8*)(ug + rp + (unsigned)(g * 8192 * 16 + c0)) = pack8(lo, hi); }
        }
    }
};
struct ProbPleProj {
    static constexpr int K = 256; static constexpr bool KINDS = false; static constexpr bool GATHER = false; static constexpr bool FP8 = false; static constexpr bool MID = false;
    const char* ph; const char* wpp; f16* pe;
    __device__ __forceinline__ const char* abase() const { return ph; }
    __device__ __forceinline__ unsigned rowoff(const pg8::Unit& u, int r) const { return (unsigned)(u.pm * 256 + r) * (unsigned)(K * 2); }
    __device__ __forceinline__ const char* bptr(const pg8::Unit& u) const { return wpp + (size_t)u.pn * 256 * K * 2; }
    __device__ __forceinline__ NoPre pre(const pg8::Unit&, int) const { return NoPre{}; }
    __device__ __forceinline__ int rowinfo(const pg8::Unit&, int) const { return 0; }
    __device__ __forceinline__ void epi(const pg8::Unit& u, NoPre, int, int lr, int cb, f32x4 v00, f32x4 v01, f32x4 v10, f32x4 v11) const {
        f16* o = pe + (size_t)(u.pm * 256 + lr) * 1024 + u.pn * 256 + cb; *(h8*)o = pack8(v00, v01); *(h8*)(o + 128) = pack8(v10, v11); }
};
struct ProbGlu {
    static constexpr int K = 512; static constexpr bool KINDS = false; static constexpr bool GATHER = false; static constexpr bool FP8 = false; static constexpr bool MID = false;
    const char* yh; const char* wg; f16* mix;
    __device__ __forceinline__ const char* abase() const { return yh; }
    __device__ __forceinline__ unsigned rowoff(const pg8::Unit& u, int r) const { return (unsigned)(u.pm * 256 + r) * (unsigned)(K * 2); }
    __device__ __forceinline__ const char* bptr(const pg8::Unit& u) const { return wg + (size_t)u.pn * 256 * K * 2; }
    __device__ __forceinline__ NoPre pre(const pg8::Unit&, int) const { return NoPre{}; }
    __device__ __forceinline__ int rowinfo(const pg8::Unit&, int) const { return 0; }
    __device__ __forceinline__ void epi(const pg8::Unit& u, NoPre, int, int lr, int cb, f32x4 v00, f32x4 v01, f32x4 v10, f32x4 v11) const {
        h8 o;
#pragma unroll
        for (int e = 0; e < 4; ++e) { o[e] = (f16)(v00[e] * sigmoidf_(v10[e])); o[4 + e] = (f16)(v01[e] * sigmoidf_(v11[e])); }
        *(h8*)(mix + (size_t)(u.pm * 256 + lr) * 1024 + u.pn * 128 + cb) = o; }
};
struct ProbOut {
    static constexpr int K = 1024; static constexpr bool KINDS = false; static constexpr bool GATHER = false; static constexpr bool FP8 = false; static constexpr bool MID = true;
    const char* mixb; const char* wo; f16* mixo;
    __device__ __forceinline__ const char* abase() const { return mixb; }
    __device__ __forceinline__ unsigned rowoff(const pg8::Unit& u, int r) const { return (unsigned)(u.pm * 256 + r) * (unsigned)(K * 2); }
    __device__ __forceinline__ const char* bptr(const pg8::Unit& u) const { return wo + (size_t)u.pn * 256 * K * 2; }
    __device__ __forceinline__ NoPre pre(const pg8::Unit&, int) const { return NoPre{}; }
    __device__ __forceinline__ int rowinfo(const pg8::Unit&, int) const { return 0; }
    __device__ __forceinline__ void mid_prepare(const pg8::Unit& u, LAS float* slot, int tid) const {
        const int row = tid >> 1; const h8* q = (const h8*)(mixb + (size_t)(u.pm * 256 + row) * 2048 + (tid & 1) * 512); float sacc = 0.f;
#pragma unroll 4
        for (int j = 0; j < 32; ++j) { const h8 v = q[j];
#pragma unroll
            for (int e = 0; e < 8; ++e) { const float f = (float)v[e]; sacc += f * f; } }
        sacc += __shfl_xor(sacc, 1);
        if (!(tid & 1)) slot[row] = rsqrtf(sacc * (1.0f / 512.0f) + RMS_EPS);
    }
    __device__ __forceinline__ void epi(const pg8::Unit& u, NoPre, int, int lr, int cb, f32x4 v00, f32x4 v01, f32x4 v10, f32x4 v11) const {
        f16* o = mixo + (size_t)(u.pm * 256 + lr) * 1024 + u.pn * 256 + cb; *(h8*)o = pack8(v00, v01); *(h8*)(o + 128) = pack8(v10, v11); }
};
struct Pre16 { f32x4 a, b, c, d; };
struct ProbMoeUp {
    static constexpr int K = 1024; static constexpr bool KINDS = false; static constexpr bool GATHER = true; static constexpr bool FP8 = true; static constexpr bool MID = false;
    const char* x1q; const char* wgu; const int* list; const float* bias; unsigned char* act;
    __device__ __forceinline__ const char* abase() const { return x1q; }
    __device__ __forceinline__ unsigned rowoff(const pg8::Unit&, int) const { return 0u; }
    __device__ __forceinline__ void fill_rows(const pg8::Unit& u, LAS int* tabp, int r) const { const int i = u.pm * 256 + r; const bool ok = i < u.cnt; const int a = list[(size_t)u.e * ECAP + (ok ? i : 0)]; tabp[r] = ok ? a : (a | (int)0x80000000); }
    __device__ __forceinline__ unsigned rowbytes(int a) const { return (unsigned)(a >> 2) * (unsigned)K; }
    __device__ __forceinline__ int rowinfo_lds(const LAS int* tabp, int lr) const { return tabp[lr]; }
    __device__ __forceinline__ const char* bptr(const pg8::Unit& u) const { return wgu + ((size_t)u.e * 2048 + (size_t)u.pn * 256) * K; }
    __device__ __forceinline__ Pre16 pre(const pg8::Unit& u, int cb) const {
        const float* bp = bias + u.e * 2048 + 2 * (u.pn * 128 + cb); Pre16 r; r.a = *(const f32x4*)bp; r.b = *(const f32x4*)(bp + 4); r.c = *(const f32x4*)(bp + 8); r.d = *(const f32x4*)(bp + 12); return r; }
    __device__ __forceinline__ int rowinfo(const pg8::Unit& u, int lr) const { const int i = u.pm * 256 + lr; return i < u.cnt ? list[(size_t)u.e * ECAP + i] : -1; }
    __device__ __forceinline__ void epi(const pg8::Unit& u, const Pre16& pb, int a, int, int cb, f32x4 v00, f32x4 v01, f32x4 v10, f32x4 v11) const {
        if (a < 0) return;
        const float bg[8] = {pb.a[0], pb.a[2], pb.b[0], pb.b[2], pb.c[0], pb.c[2], pb.d[0], pb.d[2]}, bl[8] = {pb.a[1], pb.a[3], pb.b[1], pb.b[3], pb.c[1], pb.c[3], pb.d[1], pb.d[3]};
        float o[8];
#pragma unroll
        for (int e = 0; e < 8; ++e) { const float g = fminf((e < 4 ? v00[e] : v01[e - 4]) * (1.0f / WGU_SCALE) + bg[e], 7.0f), l = fminf(fmaxf((e < 4 ? v10[e] : v11[e - 4]) * (1.0f / WGU_SCALE) + bl[e], -7.0f), 7.0f);
            o[e] = g * sigmoidf_(1.702f * g) * (l + 1.0f) * ACT_SCALE; }
        int w0 = pack_fp8x4(o[0], o[1], o[2], o[3]), w1 = pack_fp8x4(o[4], o[5], o[6], o[7]);
        typedef int i32x2 __attribute__((ext_vector_type(2))); i32x2 ww = {w0, w1};
        *(i32x2*)(act + (size_t)a * 1024 + u.pn * 128 + cb) = ww; }
};
struct RowAG { int a; float g; };
struct ProbMoeDn {
    static constexpr int K = 1024; static constexpr bool KINDS = false; static constexpr bool GATHER = true; static constexpr bool FP8 = true; static constexpr bool MID = false;
    const char* actb; const char* wdn; const int* list; const float* bias; const float* gates; unsigned char* slab;
    __device__ __forceinline__ const char* abase() const { return actb; }
    __device__ __forceinline__ unsigned rowoff(const pg8::Unit&, int) const { return 0u; }
    __device__ __forceinline__ void fill_rows(const pg8::Unit& u, LAS int* tabp, int r) const { const int i = u.pm * 256 + r; const bool ok = i < u.cnt; const int a = list[(size_t)u.e * ECAP + (ok ? i : 0)];
        tabp[r] = ok ? a : (a | (int)0x80000000); tabp[256 + r] = __float_as_int(ok ? gates[a] : 0.f); }
    __device__ __forceinline__ unsigned rowbytes(int a) const { return (unsigned)a * (unsigned)K; }
    __device__ __forceinline__ RowAG rowinfo_lds(const LAS int* tabp, int lr) const { RowAG r; r.a = tabp[lr]; r.g = __int_as_float(tabp[256 + lr]); return r; }
    __device__ __forceinline__ const char* bptr(const pg8::Unit& u) const { return wdn + ((size_t)u.e * 1024 + (size_t)u.pn * 256) * K; }
    __device__ __forceinline__ Pre16 pre(const pg8::Unit& u, int cb) const {
        const float* bp = bias + u.e * 1024 + u.pn * 256 + cb; Pre16 r; r.a = *(const f32x4*)bp; r.b = *(const f32x4*)(bp + 4); r.c = *(const f32x4*)(bp + 128); r.d = *(const f32x4*)(bp + 132); return r; }
    __device__ __forceinline__ RowAG rowinfo(const pg8::Unit& u, int lr) const { const int i = u.pm * 256 + lr; RowAG r; r.a = i < u.cnt ? list[(size_t)u.e * ECAP + i] : -1; r.g = r.a >= 0 ? gates[r.a] : 0.f; return r; }
    __device__ __forceinline__ void epi(const pg8::Unit& u, const Pre16& pb, const RowAG& ri, int, int cb, f32x4 v00, f32x4 v01, f32x4 v10, f32x4 v11) const {
        if (ri.a < 0) return;
        constexpr float S = 1.0f / (WDN_SCALE * ACT_SCALE);
        typedef int i32x2 __attribute__((ext_vector_type(2)));
        unsigned char* o = slab + (size_t)ri.a * 1024 + u.pn * 256 + cb; const float g = ri.g * SLAB_SCALE;
        f32x4 a = (v00 * S + pb.a) * g, b = (v01 * S + pb.b) * g, c = (v10 * S + pb.c) * g, d = (v11 * S + pb.d) * g;
#pragma unroll
        for (int e = 0; e < 4; ++e) { a[e] = fminf(fmaxf(a[e], -448.f), 448.f); b[e] = fminf(fmaxf(b[e], -448.f), 448.f); c[e] = fminf(fmaxf(c[e], -448.f), 448.f); d[e] = fminf(fmaxf(d[e], -448.f), 448.f); }
        i32x2 w0 = {pack_fp8x4(a[0], a[1], a[2], a[3]), pack_fp8x4(b[0], b[1], b[2], b[3])}, w1 = {pack_fp8x4(c[0], c[1], c[2], c[3]), pack_fp8x4(d[0], d[1], d[2], d[3])};
        *(i32x2*)o = w0; *(i32x2*)(o + 128) = w1; }
};
struct ProbPleGate {
    static constexpr int K = 1024; static constexpr bool KINDS = false; static constexpr bool GATHER = false; static constexpr bool FP8 = false; static constexpr bool MID = false;
    const char* rh; const char* wpg; f16* gateh;
    __device__ __forceinline__ const char* abase() const { return rh; }
    __device__ __forceinline__ unsigned rowoff(const pg8::Unit& u, int r) const { return (unsigned)(u.pm * 256 + r) * (unsigned)(K * 2); }
    __device__ __forceinline__ const char* bptr(const pg8::Unit& u) const { return wpg + (size_t)u.pn * 256 * K * 2; }
    __device__ __forceinline__ NoPre pre(const pg8::Unit&, int) const { return NoPre{}; }
    __device__ __forceinline__ int rowinfo(const pg8::Unit&, int) const { return 0; }
    __device__ __forceinline__ void epi(const pg8::Unit& u, NoPre, int, int lr, int cb, f32x4 v00, f32x4 v01, f32x4 v10, f32x4 v11) const {
        f16* o = gateh + (size_t)(u.pm * 256 + lr) * 1024 + u.pn * 256 + cb;
        f32x4 a, b, c, d;
#pragma unroll
        for (int e = 0; e < 4; ++e) { a[e] = sigmoidf_(v00[e]); b[e] = sigmoidf_(v01[e]); c[e] = sigmoidf_(v10[e]); d[e] = sigmoidf_(v11[e]); }
        *(h8*)o = pack8(a, b); *(h8*)(o + 128) = pack8(c, d); }
};

__device__ __forceinline__ int invperm32(int c) { return 16 * ((c >> 2) & 1) + 4 * (c >> 3) + (c & 3); }
__device__ __forceinline__ void tr_item(const float* W, int K, int N, f16* WT, int item, int mode, const float* gsc, LAS float* scr, int lane) {
    const int nblk = N / 32, kb = item / nblk, nb = item % nblk, k0 = 64 * kb, n0 = 32 * nb;
#pragma unroll 8
    for (int i = 0; i < 32; ++i) {
        const int kk = 2 * i + (lane >> 5);
        float v = W[(size_t)(k0 + kk) * N + n0 + (lane & 31)];
        if (mode == 2 && k0 + kk >= 512) v *= gsc[k0 + kk - 512];
        scr[kk * 33 + (lane & 31)] = v;
    }
    asm volatile("s_waitcnt lgkmcnt(0)" ::: "memory");
    const int c = lane & 7;
#pragma unroll
    for (int j = 0; j < 4; ++j) {
        const int n = (lane >> 3) + 8 * j; const LAS float* s = scr + (8 * c) * 33 + n;
        const int ns = n0 + n; int nd;
        if (mode == 1 || mode == 3) { const int ja = mode == 1 ? (ns & 511) : (ns >> 1), bj = mode == 1 ? (ns >> 9) : (ns & 1), jl = ja & 127;
            nd = 256 * (ja >> 7) + 128 * bj + (jl & ~31) + invperm32(jl & 31); }
        else nd = (ns & ~31) + invperm32(ns & 31);
        int kd = k0 + 8 * c; if (mode == 2) kd = (kd + 512) & 1023;
        if (mode >= 3) {
            const float sc = mode == 3 ? WGU_SCALE : WDN_SCALE;
            typedef int i32x2 __attribute__((ext_vector_type(2)));
            i32x2 o; o[0] = pack_fp8x4(s[0] * sc, s[33] * sc, s[66] * sc, s[99] * sc); o[1] = pack_fp8x4(s[132] * sc, s[165] * sc, s[198] * sc, s[231] * sc);
            *(i32x2*)((unsigned char*)WT + (size_t)nd * K + kd) = o;
        } else {
            h8 o; o[0] = (f16)s[0]; o[1] = (f16)s[33]; o[2] = (f16)s[66]; o[3] = (f16)s[99]; o[4] = (f16)s[132]; o[5] = (f16)s[165]; o[6] = (f16)s[198]; o[7] = (f16)s[231];
            *(h8*)(WT + (size_t)nd * K + kd) = o;
        }
    }
    asm volatile("s_waitcnt lgkmcnt(0)" ::: "memory");
}

__device__ __forceinline__ void ssm_precompute(Frame& F, int g) {
    const Args& A = *F.a; const int tid = F.tid;
    LAS float* pwr = (LAS float*)F.lds;
    LAS float* pwi = pwr + 17 * 64;
    LAS float* Bbr = pwi + 17 * 64;
    LAS float* Bbi = Bbr + 1024;
    LAS float* Cr = Bbi + 1024;
    LAS float* Ci = Cr + 1024;
    LAS float* Kd = Ci + 1024;
    if (tid < 64) {
        const int p = tid;
        const float are = A.in[I_ARE][g * 64 + p], aim = A.in[I_AIM][g * 64 + p], dt = __expf(A.in[I_LOGDT][g]);
        for (int d = 0; d <= 16; ++d) { const float mag = __expf(are * dt * (float)d); float sn, cs; sincosf(aim * dt * (float)d, &sn, &cs); pwr[d * 64 + p] = mag * cs; pwi[d * 64 + p] = mag * sn; }
        const float abr = pwr[64 + p], abi = pwi[64 + p];
        const float nr = abr - 1.0f, ni = abi, den = 1.0f / (are * are + aim * aim);
        const float fr_ = (nr * are + ni * aim) * den, fi_ = (ni * are - nr * aim) * den;
        for (int c = 0; c < 16; ++c) { const float br = A.in[I_BRE][(g * 64 + p) * 16 + c], bi = A.in[I_BIM][(g * 64 + p) * 16 + c]; Bbr[p * 16 + c] = fr_ * br - fi_ * bi; Bbi[p * 16 + c] = fr_ * bi + fi_ * br; }
        float* a16 = (float*)(F.ws + WS_A16) + (g * 64 + p) * 2; a16[0] = pwr[16 * 64 + p]; a16[1] = pwi[16 * 64 + p];
    }
    for (int i = tid; i < 1024; i += NTHREADS) { Cr[i] = A.in[I_CRE][g * 1024 + i]; Ci[i] = A.in[I_CIM][g * 1024 + i]; }
    __syncthreads();
    for (int q = 0; q < 8; ++q) {
        const int idx = tid * 8 + q, d = idx >> 8, cp = (idx >> 4) & 15, c = idx & 15; float acc = 0.f;
        for (int p = 0; p < 64; ++p) { const float cr = Cr[cp * 64 + p], ci = Ci[cp * 64 + p], pr = pwr[d * 64 + p], pi = pwi[d * 64 + p];
            const float zr = cr * pr - ci * pi, zi = cr * pi + ci * pr; acc += zr * Bbr[p * 16 + c] - zi * Bbi[p * 16 + c]; }
        Kd[idx] = acc;
    }
    __syncthreads();
    f16* ops = (f16*)(F.ws + WS_SSMOP) + (size_t)g * 131072;
    f16* Top = ops; f16* We = ops + 65536; f16* Wc = ops + 65536 + 32768;
    for (int v = tid; v < 8192; v += NTHREADS) {
        const int row = v >> 5, kv = v & 31, j = kv >> 1, half = kv & 1, i = row >> 4, cp = row & 15; h8 o;
#pragma unroll
        for (int e = 0; e < 8; ++e) o[e] = (j <= i) ? (f16)Kd[((i - j) * 16 + cp) * 16 + 8 * half + e] : (f16)0.f;
        *(h8*)(Top + row * 256 + kv * 8) = o;
    }
    for (int v = tid; v < 4096; v += NTHREADS) {
        const int sx = v >> 5, kv = v & 31, j = kv >> 1, half = kv & 1, p = sx & 63; const float pr = pwr[(15 - j) * 64 + p], pi = pwi[(15 - j) * 64 + p]; h8 o;
#pragma unroll
        for (int e = 0; e < 8; ++e) { const float br = Bbr[p * 16 + 8 * half + e], bi = Bbi[p * 16 + 8 * half + e]; o[e] = (f16)(sx < 64 ? pr * br - pi * bi : pr * bi + pi * br); }
        *(h8*)(We + sx * 256 + kv * 8) = o;
    }
    for (int v = tid; v < 4096; v += NTHREADS) {
        const int row = v >> 4, kv = v & 15, i = row >> 4, cp = row & 15; h8 o;
#pragma unroll
        for (int e = 0; e < 8; ++e) { const int sx = 8 * kv + e, p = sx & 63; const float cr = Cr[cp * 64 + p], ci = Ci[cp * 64 + p], pr = pwr[(i + 1) * 64 + p], pi = pwi[(i + 1) * 64 + p];
            o[e] = (f16)(sx < 64 ? cr * pr - ci * pi : -(cr * pi + ci * pr)); }
        *(h8*)(Wc + row * 128 + kv * 8) = o;
    }
    __syncthreads();
}

__device__ __forceinline__ void p0_prologue(Frame& F) {
    const Args& A = *F.a;
    if (blockIdx.x < NG) ssm_precompute(F, (int)blockIdx.x);
    LAS float* scr = (LAS float*)(F.lds + F.wave * 16384);
    constexpr int I0 = 16 * 64, I1 = 8 * 32, I2 = 16 * 32, I3 = 16 * 32, I4 = 4 * 32, I5 = NE * 16 * 64, I6 = NE * 16 * 32;
    constexpr int NIT = I0 + I1 + I2 + I3 + I4 + I5;
    for (int it = F.gw; it < NIT; it += F.NGW) {
        int r = it;
        if (r < I0) { tr_item(A.in[I_WIN], 1024, 2048, (f16*)(F.ws + WS_WIN), r, 0, nullptr, scr, F.lane); continue; } r -= I0;
        if (r < I1) { tr_item(A.in[I_WGLU], 512, 1024, (f16*)(F.ws + WS_WGLU), r, 1, nullptr, scr, F.lane); continue; } r -= I1;
        if (r < I2) { tr_item(A.in[I_WOUT], 1024, 1024, (f16*)(F.ws + WS_WOUT), r, 2, A.in[I_SSMG], scr, F.lane); continue; } r -= I2;
        if (r < I3) { tr_item(A.in[I_WPG], 1024, 1024, (f16*)(F.ws + WS_WPG), r, 0, nullptr, scr, F.lane); continue; } r -= I3;
        if (r < I4) { tr_item(A.in[I_WPP], 256, 1024, (f16*)(F.ws + WS_WPP), r, 0, nullptr, scr, F.lane); continue; } r -= I4;
        if (r < I5) { const int e = r / (16 * 64), ii = r % (16 * 64);
            tr_item(A.in[I_WGU] + (size_t)e * 1024 * 2048, 1024, 2048, (f16*)(F.ws + WS_WGU + (size_t)e * 2048 * 1024), ii, 3, nullptr, scr, F.lane); continue; }
    }
    const size_t gt = (size_t)blockIdx.x * NTHREADS + F.tid, NT = (size_t)F.G * NTHREADS;
    { const f32x4* s = (const f32x4*)A.in[I_X]; h8* d = (h8*)(F.ws + WS_XH);
      for (size_t i = gt; i < (size_t)T * DM / 8; i += NT) { const f32x4 a = s[2 * i], b = s[2 * i + 1]; h8 o; o[0] = (f16)a[0]; o[1] = (f16)a[1]; o[2] = (f16)a[2]; o[3] = (f16)a[3]; o[4] = (f16)b[0]; o[5] = (f16)b[1]; o[6] = (f16)b[2]; o[7] = (f16)b[3]; d[i] = o; } }
    { const f32x4* s = (const f32x4*)A.in[I_P]; h8* d = (h8*)(F.ws + WS_PH);
      for (size_t i = gt; i < (size_t)T * PLE / 8; i += NT) { const f32x4 a = s[2 * i], b = s[2 * i + 1]; h8 o; o[0] = (f16)a[0]; o[1] = (f16)a[1]; o[2] = (f16)a[2]; o[3] = (f16)a[3]; o[4] = (f16)b[0]; o[5] = (f16)b[1]; o[6] = (f16)b[2]; o[7] = (f16)b[3]; d[i] = o; } }
}

__device__ __forceinline__ void p1_inproj(Frame& F) {
    { ProbInproj P{(const char*)(F.ws + WS_XH), (const char*)(F.ws + WS_WIN), (f16*)(F.ws + WS_QH), (f16*)(F.ws + WS_KT), (f16*)(F.ws + WS_VT), (f16*)(F.ws + WS_UG), F.ctl + CW_KMAX};
      pg8::DenseOrder S; S.init(T, DIN, F.G, (int)blockIdx.x); pg8::gemm_phase(F.lds, P, S); }
}

constexpr int ATT_SLOT = 32768, ATT_FLAGS = 3 * ATT_SLOT;
constexpr float ATT_SKIP = -40.0f;
__device__ __forceinline__ void attn_unit(Frame& F, int b, int hd, int qb, float lam) {
    const int lane = F.lane, wave = F.wave, r32 = lane & 31, hi = lane >> 5;
    LAS unsigned char* lds = F.lds;
    const f16* qh = (const f16*)(F.ws + WS_QH);
    const f16* ktb = (const f16*)(F.ws + WS_KT) + (size_t)((b * 8 + hd) * 128) * 4096;
    const f16* vtb = (const f16*)(F.ws + WS_VT) + (size_t)((b * 8 + hd) * 128) * 4096;
    f16* mix = (f16*)(F.ws + WS_MIX);
    const int q0 = qb * 256, q0w = q0 + 32 * wave, NT = 4 * (qb + 1), NI = NT / 2; const size_t rowbase = (size_t)b * SEQ;
    volatile LAS int* flags = (volatile LAS int*)(lds + ATT_FLAGS);
#define ATT_ISSUE(ii) do { const int t0_ = NT - 1 - 2 * (ii); const unsigned so_ = (unsigned)(((ii) % 3) * ATT_SLOT + wave * 1024); \
        __builtin_amdgcn_global_load_lds((const unsigned*)(ktb + (size_t)t0_ * 4096 + wave * 512 + lane * 8), (LAS unsigned*)(lds + so_), 16, 0, 0); \
        __builtin_amdgcn_global_load_lds((const unsigned*)(vtb + (size_t)t0_ * 4096 + wave * 512 + lane * 8), (LAS unsigned*)(lds + so_ + 8192), 16, 0, 0); \
        __builtin_amdgcn_global_load_lds((const unsigned*)(ktb + (size_t)(t0_ - 1) * 4096 + wave * 512 + lane * 8), (LAS unsigned*)(lds + so_ + 16384), 16, 0, 0); \
        __builtin_amdgcn_global_load_lds((const unsigned*)(vtb + (size_t)(t0_ - 1) * 4096 + wave * 512 + lane * 8), (LAS unsigned*)(lds + so_ + 24576), 16, 0, 0); } while (0)
    ATT_ISSUE(0); ATT_ISSUE(1);
    if (lane == 0) { flags[wave] = 1; flags[8 + wave] = 1; }
    h8 qf[2][2];
#pragma unroll
    for (int mp = 0; mp < 2; ++mp)
#pragma unroll
        for (int kk = 0; kk < 2; ++kk) qf[mp][kk] = *(const h8*)(qh + (rowbase + q0w + r32) * 512 + hd * 64 + mp * 32 + kk * 16 + hi * 8);
    float sb1, sb2;
    { float n1 = 0.f, n2 = 0.f;
#pragma unroll
      for (int kk = 0; kk < 2; ++kk)
#pragma unroll
          for (int e = 0; e < 8; ++e) { const float a = (float)qf[0][kk][e], c = (float)qf[1][kk][e]; n1 += a * a; n2 += c * c; }
      n1 = swap_add(n1); n2 = swap_add(n2);
      const float k1 = __uint_as_float(__hip_atomic_load(F.ctl + CW_KMAX + (b * 8 + hd) * 2, RLX_AGENT)), k2 = __uint_as_float(__hip_atomic_load(F.ctl + CW_KMAX + (b * 8 + hd) * 2 + 1, RLX_AGENT));
      sb1 = sqrtf(n1) * k1 * 1.01f; sb2 = sqrtf(n2) * k2 * 1.01f; }
    const float slope2 = exp2f(-(float)(hd + 1)) * LOG2E;
    const int td = q0w >> 6, wo = q0w & 63;
    const f16 s_hi = (f16)slope2, s_lo = (f16)(slope2 - (float)s_hi);
    float mr1 = 0.f, mr2 = 0.f, l1 = 0.f, l2 = 0.f;
    h8 qx1, qx2;
    { h8 z; z[0] = (f16)(64.0f * (float)s_hi); z[1] = s_hi; z[2] = (f16)(64.0f * (float)s_lo); z[3] = s_lo; z[4] = (f16)0.f; z[5] = (f16)0.f; z[6] = (f16)0.f; z[7] = (f16)0.f;
      if (hi) { z[0] = (f16)0.f; z[1] = (f16)0.f; z[2] = (f16)0.f; z[3] = (f16)0.f; }
      qx1 = z; qx2 = z; }
    f32x16 o1[2], o2[2];
#pragma unroll
    for (int i = 0; i < 2; ++i) { o1[i] = (f32x16){}; o2[i] = (f32x16){}; }
    bool wdone = false, started = false;
    h2 ones; ones[0] = (f16)1.f; ones[1] = (f16)1.f;
#pragma unroll 1
    for (int ii = 0; ii < NI; ++ii) {
        if (ii + 1 < NI) asm volatile("s_waitcnt vmcnt(4) lgkmcnt(0)" ::: "memory"); else asm volatile("s_waitcnt vmcnt(0) lgkmcnt(0)" ::: "memory");
        __builtin_amdgcn_s_barrier();
        asm volatile("" ::: "memory");
        { const volatile LAS int* fl = flags + 8 * (ii & 1); const int any = fl[0] | fl[1] | fl[2] | fl[3] | fl[4] | fl[5] | fl[6] | fl[7];
          if (__builtin_amdgcn_readfirstlane(any) == 0) break; }
        if (ii + 2 < NI) ATT_ISSUE(ii + 2);
        bool need = !wdone;
        const int T0 = NT - 1 - 2 * ii, T1 = T0 - 1;
        if (T1 <= td && !wdone) {
            const bool first = !started; started = true;
            const LAS unsigned char* kp = lds + (ii % 3) * ATT_SLOT;
            const LAS unsigned char* kbase = kp + (hi * 512 + r32 * 8) * 2;
            const LAS unsigned char* vbase = kp + 8192 + (hi * 512 + r32 * 8) * 2;
            const float bmax = slope2 * (float)(64 * (T0 - td) + 63 - wo);
            const bool gen = first || T0 >= td || (__any(fmaxf(sb1 - mr1, sb2 - mr2) + bmax > 12.0f) != 0);
            const bool tlo = T0 > td;
            f32x16 s0[2], s1[2]; h8 kfr[4], vfr[6], pf[4], kxa, kxb; float ls;
#define ATT_SB __builtin_amdgcn_sched_barrier(0)
#define ATT_KX(tl) do { const f16 tr_ = (f16)(float)(T0 - (tl) - td); const f16 wa_ = (f16)(float)(r32 - wo), wb_ = (f16)(float)(32 + r32 - wo); h8 za, zb; \
                za[0] = tr_; za[1] = wa_; za[2] = tr_; za[3] = wa_; za[4] = (f16)1.f; za[5] = (f16)0.f; za[6] = (f16)0.f; za[7] = (f16)0.f; \
                zb[0] = tr_; zb[1] = wb_; zb[2] = tr_; zb[3] = wb_; zb[4] = (f16)1.f; zb[5] = (f16)0.f; zb[6] = (f16)0.f; zb[7] = (f16)0.f; \
                if (hi) { za[0] = (f16)0.f; za[1] = (f16)0.f; za[2] = (f16)0.f; za[3] = (f16)0.f; za[4] = (f16)0.f; zb[0] = (f16)0.f; zb[1] = (f16)0.f; zb[2] = (f16)0.f; zb[3] = (f16)0.f; zb[4] = (f16)0.f; } \
                kxa = za; kxb = zb; } while (0)
#define ATT_KLD(mp, tl) do { _Pragma("unroll") for (int kb = 0; kb < 2; ++kb) _Pragma("unroll") for (int j = 0; j < 2; ++j) \
                kfr[kb * 2 + j] = *(const LAS h8*)(kbase + (tl) * 16384 + ((mp) * 4 + j * 2) * 1024 + kb * 512); } while (0)
#define ATT_VLD(d, tl, sx, dh) vfr[d] = *(const LAS h8*)(vbase + (tl) * 16384 + (sx) * 2048 + (dh) * 512)
#define ATT_QKM(sn, mpn, qxn, j) do { if ((j) == 0) sn[0] = __builtin_amdgcn_mfma_f32_32x32x16_f16(kxa, qxn, (f32x16){}, 0, 0, 0); \
                else if ((j) == 1) sn[1] = __builtin_amdgcn_mfma_f32_32x32x16_f16(kxb, qxn, (f32x16){}, 0, 0, 0); \
                else if ((j) == 2) sn[0] = __builtin_amdgcn_mfma_f32_32x32x16_f16(kfr[0], qf[mpn][0], sn[0], 0, 0, 0); \
                else if ((j) == 3) sn[1] = __builtin_amdgcn_mfma_f32_32x32x16_f16(kfr[2], qf[mpn][0], sn[1], 0, 0, 0); \
                else if ((j) == 4) sn[0] = __builtin_amdgcn_mfma_f32_32x32x16_f16(kfr[1], qf[mpn][1], sn[0], 0, 0, 0); \
                else sn[1] = __builtin_amdgcn_mfma_f32_32x32x16_f16(kfr[3], qf[mpn][1], sn[1], 0, 0, 0); } while (0)
#define ATT_EXPH(sc, h) do { const float a0_ = __builtin_amdgcn_exp2f(sc[(h) >> 3][2 * ((h) & 7)]), a1_ = __builtin_amdgcn_exp2f(sc[(h) >> 3][2 * ((h) & 7) + 1]); \
                h2 p_; p_[0] = (f16)a0_; p_[1] = (f16)a1_; pf[(h) >> 2][2 * ((h) & 3)] = p_[0]; pf[(h) >> 2][2 * ((h) & 3) + 1] = p_[1]; \
                if (((h) & 1) == 0) hacc = p_; else { hacc = hacc + p_; asm volatile("v_dot2c_f32_f16 %0, %1, %2" : "+v"(ls) : "v"(hacc), "v"(ones)); } } while (0)
#define ATT_PLAINQK(sn, mpn, qxn) do { ATT_QKM(sn, mpn, qxn, 0); ATT_QKM(sn, mpn, qxn, 1); ATT_QKM(sn, mpn, qxn, 2); ATT_QKM(sn, mpn, qxn, 3); ATT_QKM(sn, mpn, qxn, 4); ATT_QKM(sn, mpn, qxn, 5); } while (0)
#define ATT_GENI(sc, mr, l, o, qx, tile, FIRST) do { \
                if ((tile) >= td) { _Pragma("unroll") for (int kb = 0; kb < 2; ++kb) _Pragma("unroll") for (int r = 0; r < 16; ++r) { const int kpos = 64 * (tile) + 32 * kb + crow(r, hi); if (kpos > q0w + r32) sc[kb][r] = -1e30f; } } \
                float rm = sc[0][0]; \
                _Pragma("unroll") for (int kb = 0; kb < 2; ++kb) _Pragma("unroll") for (int r = 0; r < 16; ++r) rm = fmaxf(rm, sc[kb][r]); \
                rm = swap_max(rm); \
                if ((FIRST) || __any(rm > 4.0f) != 0) { const float d = (FIRST) ? rm : fmaxf(rm, 0.f); const float f = __builtin_amdgcn_exp2f(-d); \
                    _Pragma("unroll") for (int kb = 0; kb < 2; ++kb) _Pragma("unroll") for (int r = 0; r < 16; ++r) sc[kb][r] -= d; \
                    mr += d; l *= f; o[0] *= f; o[1] *= f; if (!hi) qx[4] = (f16)(-mr); } } while (0)
#define ATT_BLOCK(sc, l, o, tlc, HASN, sn, mpn, qxn, NKLD) do { ls = 0.f; h2 hacc; \
                if (HASN) ATT_QKM(sn, mpn, qxn, 0); ATT_EXPH(sc, 0); ATT_SB; \
                if (HASN) ATT_QKM(sn, mpn, qxn, 1); ATT_EXPH(sc, 1); ATT_SB; \
                if (HASN) ATT_QKM(sn, mpn, qxn, 2); ATT_EXPH(sc, 2); ATT_VLD(0, tlc, 0, 0); ATT_VLD(1, tlc, 0, 1); ATT_SB; \
                if (HASN) ATT_QKM(sn, mpn, qxn, 3); ATT_EXPH(sc, 3); ATT_VLD(2, tlc, 1, 0); ATT_VLD(3, tlc, 1, 1); ATT_SB; \
                if (HASN) ATT_QKM(sn, mpn, qxn, 4); ATT_EXPH(sc, 4); ATT_VLD(4, tlc, 2, 0); ATT_VLD(5, tlc, 2, 1); ATT_SB; \
                if (HASN) ATT_QKM(sn, mpn, qxn, 5); ATT_EXPH(sc, 5); ATT_SB; \
                o[0] = __builtin_amdgcn_mfma_f32_32x32x16_f16(vfr[0], pf[0], o[0], 0, 0, 0); ATT_EXPH(sc, 6); ATT_EXPH(sc, 7); ATT_SB; \
                o[1] = __builtin_amdgcn_mfma_f32_32x32x16_f16(vfr[1], pf[0], o[1], 0, 0, 0); ATT_EXPH(sc, 8); NKLD; ATT_SB; \
                o[0] = __builtin_amdgcn_mfma_f32_32x32x16_f16(vfr[2], pf[1], o[0], 0, 0, 0); ATT_EXPH(sc, 9); ATT_EXPH(sc, 10); ATT_VLD(0, tlc, 3, 0); ATT_VLD(1, tlc, 3, 1); ATT_SB; \
                o[1] = __builtin_amdgcn_mfma_f32_32x32x16_f16(vfr[3], pf[1], o[1], 0, 0, 0); ATT_EXPH(sc, 11); ATT_SB; \
                o[0] = __builtin_amdgcn_mfma_f32_32x32x16_f16(vfr[4], pf[2], o[0], 0, 0, 0); ATT_EXPH(sc, 12); ATT_EXPH(sc, 13); ATT_SB; \
                o[1] = __builtin_amdgcn_mfma_f32_32x32x16_f16(vfr[5], pf[2], o[1], 0, 0, 0); ATT_EXPH(sc, 14); ATT_EXPH(sc, 15); ATT_SB; \
                o[0] = __builtin_amdgcn_mfma_f32_32x32x16_f16(vfr[0], pf[3], o[0], 0, 0, 0); ATT_SB; \
                o[1] = __builtin_amdgcn_mfma_f32_32x32x16_f16(vfr[1], pf[3], o[1], 0, 0, 0); ATT_SB; \
                l += ls; } while (0)
            if (!tlo) {
                ATT_KX(0); ATT_KLD(0, 0); ATT_PLAINQK(s0, 0, qx1); ATT_SB; ATT_KLD(1, 0); ATT_SB;
                if (gen) ATT_GENI(s0, mr1, l1, o1, qx1, T0, first);
                ATT_BLOCK(s0, l1, o1, 0, true, s1, 1, qx2, ATT_KLD(0, 1));
                ATT_KX(1);
                if (gen) ATT_GENI(s1, mr2, l2, o2, qx2, T0, first);
                ATT_BLOCK(s1, l2, o2, 0, true, s0, 0, qx1, ATT_KLD(1, 1));
            } else {
                ATT_KX(1); ATT_KLD(0, 1); ATT_PLAINQK(s0, 0, qx1); ATT_SB; ATT_KLD(1, 1); ATT_SB;
            }
            { const bool f2 = first && tlo;
              if (gen) ATT_GENI(s0, mr1, l1, o1, qx1, T1, f2);
              ATT_BLOCK(s0, l1, o1, 1, true, s1, 1, qx2, (void)0);
              if (gen) ATT_GENI(s1, mr2, l2, o2, qx2, T1, f2);
              ATT_BLOCK(s1, l2, o2, 1, false, s0, 0, qx1, (void)0); }
#undef ATT_SB
#undef ATT_KX
#undef ATT_KLD
#undef ATT_VLD
#undef ATT_QKM
#undef ATT_EXPH
#undef ATT_PLAINQK
#undef ATT_GENI
#undef ATT_BLOCK
            const float far = fmaxf(sb1 - mr1, sb2 - mr2) + slope2 * (float)(64 * T1 - 1 - q0w);
            need = (T1 >= 1) && (__any(far >= ATT_SKIP) != 0);
            if (!need) wdone = true;
        }
        if (lane == 0) flags[8 * ((ii + 1) & 1) + wave] = need ? 1 : 0;
    }
    asm volatile("s_waitcnt vmcnt(0) lgkmcnt(0)" ::: "memory");
    __builtin_amdgcn_s_barrier();
    asm volatile("" ::: "memory");
#undef ATT_ISSUE
    l1 = swap_add(l1); l2 = swap_add(l2);
    const float i1 = 1.0f / l1, i2 = lam / l2;
    float ss = 0.f;
#pragma unroll
    for (int dh = 0; dh < 2; ++dh)
#pragma unroll
        for (int r = 0; r < 16; ++r) { const float v = o1[dh][r] * i1 - o2[dh][r] * i2; o1[dh][r] = v; ss += v * v; }
    ss = swap_add(ss);
    const float rs = rsqrtf(ss * (1.0f / 64.0f) + RMS_EPS) * 0.8f;
    const float* sg = F.a->in[I_SUBLN];
    f16* orow = mix + (rowbase + q0w + r32) * 1024 + 512 + hd * 64;
#pragma unroll
    for (int dh = 0; dh < 2; ++dh)
#pragma unroll
        for (int gq = 0; gq < 4; ++gq) {
            const int dv = 32 * dh + 8 * gq + 4 * hi; const f32x4 gg = *(const f32x4*)(sg + dv);
            h4 o; o[0] = (f16)(o1[dh][4 * gq] * rs * gg[0]); o[1] = (f16)(o1[dh][4 * gq + 1] * rs * gg[1]); o[2] = (f16)(o1[dh][4 * gq + 2] * rs * gg[2]); o[3] = (f16)(o1[dh][4 * gq + 3] * rs * gg[3]);
            *(h4*)(orow + dv) = o;
        }
}

constexpr int SSM_UROW = 528, SSM_EROW = 528, SSM_XROW = 272;
constexpr int SSM_U0 = 0, SSM_U1 = 64 * SSM_UROW, SSM_E = 2 * 64 * SSM_UROW, SSM_XP = SSM_E + 64 * SSM_EROW;
typedef float f32x4_t __attribute__((ext_vector_type(4)));
__device__ __forceinline__ void ssm_unit(Frame& F, int b, int g) {
    const Args& A = *F.a; const int tid = F.tid, wave = F.wave, lane = F.lane, fr = lane & 15, fq = lane >> 4;
    const f16* ops = (const f16*)(F.ws + WS_SSMOP) + (size_t)g * 131072;
    const f16* Top = ops; const f16* We = ops + 65536; const f16* Wc = ops + 65536 + 32768;
    const char* ugb = (const char*)((const f16*)(F.ws + WS_UG) + (size_t)((b * 32 + g) * 8192) * 16);
    f16* yh = (f16*)(F.ws + WS_YH) + (size_t)b * SEQ * 512 + g * 16;
    LAS unsigned char* lds = F.lds;
    h8 BY[2][12];
#pragma unroll
    for (int n2 = 0; n2 < 2; ++n2) {
        const int nrow = 16 * (2 * wave + n2) + fr;
#pragma unroll
        for (int kk = 0; kk < 8; ++kk) BY[n2][kk] = *(const h8*)(Top + nrow * 256 + 32 * kk + 8 * fq);
#pragma unroll
        for (int kk = 0; kk < 4; ++kk) BY[n2][8 + kk] = *(const h8*)(Wc + nrow * 128 + 32 * kk + 8 * fq);
    }
    const float* a16 = (const float*)(F.ws + WS_A16) + (g * 64 + lane) * 2;
    const float a16r = a16[0], a16i = a16[1];
    const f32x4 dsk = *(const f32x4*)(A.in[I_SSMD] + g * 16 + 4 * fq);
    float xr = 0.f, xi = 0.f;
#pragma unroll
    for (int q = 0; q < 4; ++q) { const int o = (q * NTHREADS + tid) * 16; const h8 v = *(const h8*)(ugb + o); *(LAS h8*)(lds + SSM_U0 + (o >> 9) * SSM_UROW + (o & 511)) = v; }
    __syncthreads();
#pragma unroll 1
    for (int seg = 0; seg < 8; ++seg) {
        LAS unsigned char* Uc = lds + ((seg & 1) ? SSM_U1 : SSM_U0);
        LAS unsigned char* Un = lds + ((seg & 1) ? SSM_U0 : SSM_U1);
        {
            f32x4 ea[4]; h8 BE[8];
#pragma unroll
            for (int kk = 0; kk < 8; ++kk) BE[kk] = *(const h8*)(We + (16 * wave + fr) * 256 + 32 * kk + 8 * fq);
#pragma unroll
            for (int mt = 0; mt < 4; ++mt) ea[mt] = (f32x4){0.f, 0.f, 0.f, 0.f};
#pragma unroll
            for (int kk = 0; kk < 8; ++kk)
#pragma unroll
                for (int mt = 0; mt < 4; ++mt) { const h8 a = *(const LAS h8*)(Uc + (16 * mt + fr) * SSM_UROW + (32 * kk + 8 * fq) * 2); ea[mt] = __builtin_amdgcn_mfma_f32_16x16x32_f16(BE[kk], a, ea[mt], 0, 0, 0); }
#pragma unroll
            for (int mt = 0; mt < 4; ++mt) *(LAS f32x4*)(lds + SSM_E + (16 * mt + fr) * SSM_EROW + (16 * wave + 4 * fq) * 4) = ea[mt];
        }
        __syncthreads();
        if (wave == 0) {
#pragma unroll 8
            for (int n = 0; n < 64; ++n) {
                const float er = *(const LAS float*)(lds + SSM_E + n * SSM_EROW + lane * 4), ei = *(const LAS float*)(lds + SSM_E + n * SSM_EROW + (64 + lane) * 4);
                *(LAS f16*)(lds + SSM_XP + n * SSM_XROW + lane * 2) = (f16)xr; *(LAS f16*)(lds + SSM_XP + n * SSM_XROW + (64 + lane) * 2) = (f16)xi;
                const float nr = a16r * xr - a16i * xi + er, ni = a16r * xi + a16i * xr + ei; xr = nr; xi = ni;
            }
        } else if (seg < 7) {
            const char* src = ugb + (size_t)(seg + 1) * 32768;
            for (int v = tid - 64; v < 2048; v += NTHREADS - 64) { const int o = v * 16; const h8 x = *(const h8*)(src + o); *(LAS h8*)(Un + (o >> 9) * SSM_UROW + (o & 511)) = x; }
        }
        __syncthreads();
        {
            f32x4 ya[4][2];
#pragma unroll
            for (int mt = 0; mt < 4; ++mt) { ya[mt][0] = (f32x4){0.f, 0.f, 0.f, 0.f}; ya[mt][1] = (f32x4){0.f, 0.f, 0.f, 0.f}; }
#pragma unroll
            for (int kk = 0; kk < 12; ++kk)
#pragma unroll
                for (int mt = 0; mt < 4; ++mt) {
                    const h8 a = kk < 8 ? *(const LAS h8*)(Uc + (16 * mt + fr) * SSM_UROW + (32 * kk + 8 * fq) * 2) : *(const LAS h8*)(lds + SSM_XP + (16 * mt + fr) * SSM_XROW + (32 * (kk - 8) + 8 * fq) * 2);
                    ya[mt][0] = __builtin_amdgcn_mfma_f32_16x16x32_f16(BY[0][kk], a, ya[mt][0], 0, 0, 0);
                    ya[mt][1] = __builtin_amdgcn_mfma_f32_16x16x32_f16(BY[1][kk], a, ya[mt][1], 0, 0, 0);
                }
#pragma unroll
            for (int mt = 0; mt < 4; ++mt)
#pragma unroll
                for (int n2 = 0; n2 < 2; ++n2) {
                    const int ch = 16 * mt + fr, ti = 2 * wave + n2; const size_t tok = (size_t)(seg * 64 + ch) * 16 + ti;
                    const h4 u4 = *(const LAS h4*)(Uc + ch * SSM_UROW + (ti * 16 + 4 * fq) * 2);
                    h4 o;
#pragma unroll
                    for (int e = 0; e < 4; ++e) o[e] = (f16)gelu_tanh(ya[mt][n2][e] + dsk[e] * (float)u4[e]);
                    *(h4*)(yh + tok * 512 + 4 * fq) = o;
                }
        }
    }
    __syncthreads();
}

__device__ __forceinline__ void p2_mixers(Frame& F, int pass) {
    const Args& A = *F.a;
    gu32* qctr = F.ctl + CW_QUEUE + 128 * pass;
    constexpr int NSSM = BATCH * NG, NATT = BATCH * NH * 32;
    volatile LAS int* slot = (volatile LAS int*)(F.lds + LDS_BARST + 16);
    for (;;) {
        if (F.tid == 0) slot[0] = (int)__hip_atomic_fetch_add(qctr, 1u, RLX_AGENT);
        __syncthreads();
        const int it = __builtin_amdgcn_readfirstlane(slot[0]);
        __syncthreads();
        if (it >= NSSM) break;
        if (pass == 1 && PROBE_SEL != 0 && PROBE_SEL != 1) continue;
        ssm_unit(F, it / NG, it % NG);
    }
    asm volatile("" ::: "memory");
    float lam;
    { float d1 = 0.f, d2 = 0.f;
#pragma unroll 1
      for (int i = 0; i < 32; ++i) { d1 += A.in[I_LQ1][i] * A.in[I_LK1][i]; d2 += A.in[I_LQ2][i] * A.in[I_LK2][i]; }
      lam = __expf(d1) - __expf(d2) + 0.2f; }
    asm volatile("" : "+v"(lam));
    for (;;) {
        if (F.tid == 0) slot[0] = (int)__hip_atomic_fetch_add(qctr + 64, 1u, RLX_AGENT);
        __syncthreads();
        const int it = __builtin_amdgcn_readfirstlane(slot[0]);
        __syncthreads();
        if (it >= NATT) break;
        const int qb = 31 - it / 32, bh = it % 32;
        if (pass == 1 && PROBE_SEL != 0) { const int hd_ = bh & 7; const bool sel = PROBE_SEL == 2 ? hd_ >= 6 : PROBE_SEL == 3 ? hd_ <= 3 : PROBE_SEL == 4 ? (hd_ == 7 && qb == 31) : PROBE_SEL == 5 ? (hd_ == 4 || hd_ == 5) : false; if (!sel) continue; }
        attn_unit(F, bh >> 3, bh & 7, qb, lam);
    }
    constexpr int NPLE = (T / 256) * 4, WDN_ITEMS = NE * 16 * 32, WDN_CHUNK = 32, NWDN = WDN_ITEMS / WDN_CHUNK;
    gu32* fctr = F.ctl + CW_QUEUE + 256 + 64 * pass;
    for (;;) {
        if (F.tid == 0) slot[0] = (int)__hip_atomic_fetch_add(fctr, 1u, RLX_AGENT);
        __syncthreads();
        const int it = __builtin_amdgcn_readfirstlane(slot[0]);
        __syncthreads();
        if (it >= NPLE + NWDN) break;
        if (it < NPLE) {
            ProbPleProj P{(const char*)(F.ws + WS_PH), (const char*)(F.ws + WS_WPP), (f16*)(F.ws + WS_PE)};
            pg8::OneOrder S; S.u.pm = it >> 2; S.u.pn = it & 3; S.u.e = 0; S.u.cnt = 0; pg8::gemm_phase(F.lds, P, S);
        } else {
            LAS float* scr = (LAS float*)(F.lds + F.wave * 16384);
#pragma unroll 1
            for (int j = 0; j < WDN_CHUNK / 8; ++j) { const int r = (it - NPLE) * WDN_CHUNK + j * 8 + F.wave; const int e = r / (16 * 32), ii = r % (16 * 32);
                tr_item(A.in[I_WDN] + (size_t)e * 1024 * 1024, 1024, 1024, (f16*)(F.ws + WS_WDN + (size_t)e * 1024 * 1024), ii, 4, nullptr, scr, F.lane); }
        }
        __syncthreads();
    }
}

__device__ __forceinline__ void p3_glu(Frame& F) {
    ProbGlu P{(const char*)(F.ws + WS_YH), (const char*)(F.ws + WS_WGLU), (f16*)(F.ws + WS_MIX)};
    pg8::DenseOrder S; S.init(T, 1024, F.G, (int)blockIdx.x); pg8::gemm_phase(F.lds, P, S);
}

__device__ __forceinline__ void p4_outproj(Frame& F) {
    ProbOut P{(const char*)(F.ws + WS_MIX), (const char*)(F.ws + WS_WOUT), (f16*)(F.ws + WS_MIXO)};
    pg8::DenseOrder S; S.init(T, DM, F.G, (int)blockIdx.x); pg8::gemm_phase(F.lds, P, S);
}

constexpr int RT_XROW = 2064;
constexpr int RT_XHI = 0, RT_XLO = 32 * RT_XROW;
constexpr int RT_PART = 0;
constexpr int RT_FIN = 2 * 32 * RT_XROW;
constexpr int RT_CNT = RT_FIN + 32 * 33 * 4;
__device__ __forceinline__ void p5_router(Frame& F, int pass) {
    const Args& A = *F.a; const int tid = F.tid, lane = F.lane, wave = F.wave, r32 = lane & 31, hi = lane >> 5;
    LAS unsigned char* lds = F.lds;
    LAS unsigned* lcnt = (LAS unsigned*)(lds + RT_CNT); LAS unsigned* lbase = lcnt + 32; LAS unsigned* asg = lcnt + 64;
    if (tid < 32) lcnt[tid] = 0u;
    const float* xin = A.in[I_X]; const f16* mixo = (const f16*)(F.ws + WS_MIXO); f16* x1h = (f16*)(F.ws + WS_X1H); unsigned char* x1q = (unsigned char*)(F.ws + WS_X1Q); float* gates = (float*)(F.ws + WS_GATES);
    h8 whi[8], wlo[8];
#pragma unroll
    for (int kk = 0; kk < 8; ++kk)
#pragma unroll
        for (int e = 0; e < 8; ++e) { const float w = A.in[I_WR][(128 * wave + 16 * kk + 8 * hi + e) * 32 + r32]; const f16 h = (f16)w; whi[kk][e] = h; wlo[kk][e] = (f16)(w - (float)h); }
    f32x4 gv[4], bv[4];
#pragma unroll
    for (int jx = 0; jx < 4; ++jx) { gv[jx] = *(const f32x4*)(A.in[I_LN1G] + 256 * jx + 4 * lane); bv[jx] = *(const f32x4*)(A.in[I_LN1B] + 256 * jx + 4 * lane); }
    const int rows_per_blk = T / F.G;
#pragma unroll 1
    for (int bt = 0; bt < rows_per_blk / 32; ++bt) {
        const int row0 = blockIdx.x * rows_per_blk + bt * 32;
#pragma unroll 1
        for (int rr = 0; rr < 4; ++rr) {
            const int lr = wave * 4 + rr; const size_t ro = (size_t)(row0 + lr) * 1024;
            f32x4 v[4]; float s1 = 0.f, s2 = 0.f;
#pragma unroll
            for (int jx = 0; jx < 4; ++jx) { const f32x4 xv = *(const f32x4*)(xin + ro + 256 * jx + 4 * lane); const h4 mv = *(const h4*)(mixo + ro + 256 * jx + 4 * lane);
#pragma unroll
                for (int e = 0; e < 4; ++e) { const float t = ALPHA * xv[e] + (float)mv[e]; v[jx][e] = t; s1 += t; } }
            const float mean = wave_sum(s1) * (1.0f / 1024.0f);
#pragma unroll
            for (int jx = 0; jx < 4; ++jx) { v[jx] = v[jx] - mean; s2 += (v[jx][0] * v[jx][0] + v[jx][1] * v[jx][1]) + (v[jx][2] * v[jx][2] + v[jx][3] * v[jx][3]); }
            const float rstd = rsqrtf(wave_sum(s2) * (1.0f / 1024.0f) + LN_EPS);
#pragma unroll
            for (int jx = 0; jx < 4; ++jx) {
                const f32x4 y = v[jx] * rstd * gv[jx] + bv[jx];
                h4 yh_, yl_;
#pragma unroll
                for (int e = 0; e < 4; ++e) { const f16 h = (f16)y[e]; yh_[e] = h; yl_[e] = (f16)(y[e] - (float)h); }
                *(h4*)(x1h + ro + 256 * jx + 4 * lane) = yh_;
                *(int*)(x1q + ro + 256 * jx + 4 * lane) = pack_fp8x4(y[0], y[1], y[2], y[3]);
                *(LAS h4*)(lds + RT_XHI + lr * RT_XROW + (256 * jx + 4 * lane) * 2) = yh_;
                *(LAS h4*)(lds + RT_XLO + lr * RT_XROW + (256 * jx + 4 * lane) * 2) = yl_;
            }
        }
        __syncthreads();
        f32x16 acc = {};
#pragma unroll
        for (int kk = 0; kk < 8; ++kk) {
            const int ko = (128 * wave + 16 * kk + 8 * hi) * 2;
            const h8 xh_ = *(const LAS h8*)(lds + RT_XHI + r32 * RT_XROW + ko), xl_ = *(const LAS h8*)(lds + RT_XLO + r32 * RT_XROW + ko);
            acc = __builtin_amdgcn_mfma_f32_32x32x16_f16(whi[kk], xh_, acc, 0, 0, 0);
            acc = __builtin_amdgcn_mfma_f32_32x32x16_f16(wlo[kk], xh_, acc, 0, 0, 0);
            acc = __builtin_amdgcn_mfma_f32_32x32x16_f16(whi[kk], xl_, acc, 0, 0, 0);
        }
        __syncthreads();
#pragma unroll
        for (int g = 0; g < 4; ++g) { f32x4 o; o[0] = acc[4 * g]; o[1] = acc[4 * g + 1]; o[2] = acc[4 * g + 2]; o[3] = acc[4 * g + 3];
            *(LAS f32x4*)(lds + RT_PART + (((wave * 32 + r32) * 32) + 8 * g + 4 * hi) * 4) = o; }
        __syncthreads();
        { const int row = tid >> 4, e0 = 2 * (tid & 15); float a0 = A.in[I_BR][e0], a1 = A.in[I_BR][e0 + 1];
#pragma unroll
          for (int w = 0; w < 8; ++w) { a0 += *(const LAS float*)(lds + RT_PART + (((w * 32 + row) * 32) + e0) * 4); a1 += *(const LAS float*)(lds + RT_PART + (((w * 32 + row) * 32) + e0 + 1) * 4); }
          *(LAS float*)(lds + RT_FIN + (row * 33 + e0) * 4) = a0; *(LAS float*)(lds + RT_FIN + (row * 33 + e0 + 1) * 4) = a1; }
        __syncthreads();
        if (tid < 32) {
            const LAS float* lg = (const LAS float*)(lds + RT_FIN + tid * 33 * 4);
            float tv[4]; int te[4];
#pragma unroll
            for (int k = 0; k < 4; ++k) { tv[k] = -INFINITY; te[k] = 0; }
#pragma unroll 1
            for (int e = 0; e < 32; ++e) { const float x = lg[e];
                if (x > tv[3]) {
                    if (x > tv[0]) { tv[3] = tv[2]; te[3] = te[2]; tv[2] = tv[1]; te[2] = te[1]; tv[1] = tv[0]; te[1] = te[0]; tv[0] = x; te[0] = e; }
                    else if (x > tv[1]) { tv[3] = tv[2]; te[3] = te[2]; tv[2] = tv[1]; te[2] = te[1]; tv[1] = x; te[1] = e; }
                    else if (x > tv[2]) { tv[3] = tv[2]; te[3] = te[2]; tv[2] = x; te[2] = e; }
                    else { tv[3] = x; te[3] = e; } } }
            const float e1 = __expf(tv[1] - tv[0]), e2 = __expf(tv[2] - tv[0]), e3 = __expf(tv[3] - tv[0]); const float inv = 1.0f / (1.0f + e1 + e2 + e3);
            const int row = row0 + tid; f32x4 gk; gk[0] = inv; gk[1] = e1 * inv; gk[2] = e2 * inv; gk[3] = e3 * inv;
            *(f32x4*)(gates + (size_t)row * 4) = gk;
#pragma unroll
            for (int k = 0; k < 4; ++k) { const unsigned rk = atomicAdd((unsigned*)&lcnt[te[k]], 1u); asg[(bt * 32 + tid) * 4 + k] = (unsigned)te[k] | (rk << 8); }
        }
        __syncthreads();
    }
    if (F.tid < 32) lbase[F.tid] = __hip_atomic_fetch_add(F.ctl + CW_CNT + 2048 * pass + 64 * F.tid, lcnt[F.tid], RLX_AGENT);
    __syncthreads();
    int* list = (int*)(F.ws + WS_LIST + (size_t)pass * 4 * MiB);
    { const unsigned a = asg[F.tid]; const int e = a & 255, rk = a >> 8; const int row = blockIdx.x * rows_per_blk + (F.tid >> 2);
      list[(size_t)e * ECAP + lbase[e] + rk] = row * 4 + (F.tid & 3); }
    __syncthreads();
}

template <int WHICH> __device__ __forceinline__ void p67_moe(Frame& F) {
    const Args& A = *F.a;
    LAS int* tab = (LAS int*)(F.lds + pg8::STAGE_BYTES + 2048);
    if (F.tid < 32) tab[F.tid] = (int)__hip_atomic_load(F.ctl + CW_CNT + 64 * F.tid, RLX_AGENT);
    __syncthreads();
    if (F.tid == 0) { int sacc = 0; for (int e = 0; e < 32; ++e) { tab[32 + e] = sacc; sacc += (tab[e] + 255) >> 8; } tab[64] = sacc; }
    __syncthreads();
    const int* list = (const int*)(F.ws + WS_LIST);
    if (WHICH == 0) {
        ProbMoeUp P{(const char*)(F.ws + WS_X1Q), (const char*)(F.ws + WS_WGU), list, A.in[I_BGU], (unsigned char*)(F.ws + WS_ACT)};
        pg8::MoeOrder S{tab, 8, F.G, F.vcu}; pg8::gemm_phase(F.lds, P, S);
    } else {
        ProbMoeDn P{(const char*)(F.ws + WS_ACT), (const char*)(F.ws + WS_WDN), list, A.in[I_BDN], (const float*)(F.ws + WS_GATES), (unsigned char*)(F.ws + WS_SLAB)};
        pg8::MoeOrder S{tab, 4, F.G, F.vcu}; pg8::gemm_phase(F.lds, P, S);
    }
    __syncthreads();
}

__device__ __forceinline__ void p8_combine(Frame& F) {
    const int lane = F.lane;
    typedef int i32x2 __attribute__((ext_vector_type(2))); typedef float f32x2 __attribute__((ext_vector_type(2)));
    const f16* x1h = (const f16*)(F.ws + WS_X1H); const unsigned char* slab = (const unsigned char*)(F.ws + WS_SLAB); f16* rh = (f16*)(F.ws + WS_RH);
    for (int row = F.gw; row < T; row += F.NGW) {
#pragma unroll
        for (int j = 0; j < 2; ++j) {
            const size_t o = (size_t)row * 1024 + 512 * j + 8 * lane;
            const h8 xv = *(const h8*)(x1h + o); float v[8], acc[8];
#pragma unroll
            for (int e = 0; e < 8; ++e) { v[e] = ALPHA * (float)xv[e]; acc[e] = 0.f; }
#pragma unroll
            for (int k = 0; k < 4; ++k) { const i32x2 sv = *(const i32x2*)(slab + ((size_t)row * 4 + k) * 1024 + 512 * j + 8 * lane);
#pragma unroll
                for (int q = 0; q < 2; ++q) { const f32x2 lo = __builtin_amdgcn_cvt_pk_f32_fp8(sv[q], false), hi = __builtin_amdgcn_cvt_pk_f32_fp8(sv[q], true);
                    acc[4 * q] += lo[0]; acc[4 * q + 1] += lo[1]; acc[4 * q + 2] += hi[0]; acc[4 * q + 3] += hi[1]; } }
            h8 hh;
#pragma unroll
            for (int e = 0; e < 8; ++e) hh[e] = (f16)(v[e] + acc[e] * (1.0f / SLAB_SCALE));
            *(h8*)(rh + o) = hh;
        }
    }
}

__device__ __forceinline__ void p9_ple(Frame& F) {
    ProbPleGate P{(const char*)(F.ws + WS_RH), (const char*)(F.ws + WS_WPG), (f16*)(F.ws + WS_GATEH)};
    pg8::DenseOrder S; S.init(T, DM, F.G, (int)blockIdx.x); pg8::gemm_phase(F.lds, P, S);
}

__device__ __forceinline__ void p10_ln2(Frame& F) {
    const Args& A = *F.a; const int lane = F.lane; float* out = A.out; const f16* rh = (const f16*)(F.ws + WS_RH); const f16* gateh = (const f16*)(F.ws + WS_GATEH); const f16* pe = (const f16*)(F.ws + WS_PE);
    f32x4 gv[4], bv[4];
#pragma unroll
    for (int j = 0; j < 2; ++j)
#pragma unroll
        for (int q = 0; q < 2; ++q) { gv[2 * j + q] = *(const f32x4*)(A.in[I_LN2G] + 512 * j + 8 * lane + 4 * q); bv[2 * j + q] = *(const f32x4*)(A.in[I_LN2B] + 512 * j + 8 * lane + 4 * q); }
    for (int row = F.gw; row < T; row += F.NGW) {
        f32x4 v[4]; float s = 0.f;
#pragma unroll
        for (int j = 0; j < 2; ++j) { const size_t o_ = (size_t)row * 1024 + 512 * j + 8 * lane; const h8 r8 = *(const h8*)(rh + o_), g8 = *(const h8*)(gateh + o_), p8 = *(const h8*)(pe + o_);
#pragma unroll
            for (int q = 0; q < 2; ++q) { f32x4 t;
#pragma unroll
                for (int e = 0; e < 4; ++e) t[e] = (float)r8[4 * q + e] + (float)g8[4 * q + e] * (float)p8[4 * q + e];
                v[2 * j + q] = t; s += (t[0] + t[1]) + (t[2] + t[3]); } }
        const float mean = wave_sum(s) * (1.0f / 1024.0f); float s2 = 0.f;
#pragma unroll
        for (int j = 0; j < 4; ++j) { v[j] = v[j] - mean; s2 += (v[j][0] * v[j][0] + v[j][1] * v[j][1]) + (v[j][2] * v[j][2] + v[j][3] * v[j][3]); }
        const float rstd = rsqrtf(wave_sum(s2) * (1.0f / 1024.0f) + LN_EPS);
#pragma unroll
        for (int j = 0; j < 2; ++j)
#pragma unroll
            for (int q = 0; q < 2; ++q) *(f32x4*)(out + (size_t)row * 1024 + 512 * j + 8 * lane + 4 * q) = v[2 * j + q] * rstd * gv[2 * j + q] + bv[2 * j + q];
    }
}

__global__ void __launch_bounds__(NTHREADS, 2) fwd_kernel(Args args) {
    extern __shared__ __attribute__((aligned(16))) unsigned char lds_raw[];
    Frame F;
    F.lds = (LAS unsigned char*)lds_raw; F.a = &args; F.ws = args.ws; F.ctl = (gu32*)(args.ws + WS_CTL);
    F.tid = threadIdx.x; F.lane = F.tid & 63; F.wave = __builtin_amdgcn_readfirstlane(F.tid >> 6);
    F.G = gridDim.x; F.gw = blockIdx.x * NWAVES + F.wave; F.NGW = F.G * NWAVES;
    { const int bx = blockIdx.x; F.vcu = (F.G % 8 == 0) ? (bx % 8) * (F.G / 8) + bx / 8 : bx; }
    volatile LAS unsigned* barst = (volatile LAS unsigned*)(F.lds + LDS_BARST);
    if (F.tid < 16) barst[F.tid] = 0u;
    __syncthreads();
    XcdBarrier bar; bar.bar = (unsigned*)(F.ctl + CW_BAR); bar.x = 0; bar.st = nullptr;
    if (MK_N_LAUNCHES == 1) bar = xcd_barrier_post((unsigned*)(F.ctl + CW_BAR), barst);
    const int lo = args.ph_lo, hi = args.ph_hi;
#define IN(k) (lo <= (k) && (k) < hi)
#define SEAM(k) do { if (IN(k) && IN((k) + 1)) xcd_barrier(bar); } while (0)
#define REP(k, body) do { if (IN(k)) { body; if ((PROBE_MASK >> (k)) & 1) { xcd_barrier(bar); body; } } } while (0)
    REP(0, p0_prologue(F)); SEAM(0);
    REP(1, p1_inproj(F)); SEAM(1);
    if (IN(2)) { p2_mixers(F, args.pass); if ((PROBE_MASK >> 2) & 1) { xcd_barrier(bar); p2_mixers(F, 1); } } SEAM(2);
    REP(3, p3_glu(F)); SEAM(3);
    REP(4, p4_outproj(F)); SEAM(4);
    if (IN(5)) { p5_router(F, args.pass); } SEAM(5);
    REP(6, p67_moe<0>(F)); SEAM(6);
    REP(7, p67_moe<1>(F)); SEAM(7);
    REP(8, p8_combine(F)); SEAM(8);
    REP(9, p9_ple(F)); SEAM(9);
    if (IN(10)) { p10_ln2(F); }
#undef REP
#undef IN
#undef SEAM
}
}

extern "C" void kernel_launch(void* const* d_in, const int* in_sizes, int n_in, void* d_out, int out_size, void* d_ws, size_t ws_size, hipStream_t stream) {
    static int grid = 0;
    if (grid == 0) {
        if (n_in != 31 || out_size != T * DM || ws_size < WS_END) { fprintf(stderr, "kernel_launch: unexpected problem (n_in %d, out %d, ws %zu)\n", n_in, out_size, ws_size); grid = -1; return; }
        int dev = 0, cus = 0;
        if (hipGetDevice(&dev) != hipSuccess || hipDeviceGetAttribute(&cus, hipDeviceAttributeMultiprocessorCount, dev) != hipSuccess) { grid = -1; return; }
        if (hipFuncSetAttribute((const void*)fwd_kernel, hipFuncAttributeMaxDynamicSharedMemorySize, LDS_BYTES) != hipSuccess) { fprintf(stderr, "kernel_launch: hipFuncSetAttribute failed\n"); grid = -1; return; }
        int per_cu = 0;
        if (hipOccupancyMaxActiveBlocksPerMultiprocessor(&per_cu, (const void*)fwd_kernel, NTHREADS, LDS_BYTES) != hipSuccess || per_cu < 1) { fprintf(stderr, "kernel_launch: occupancy query says %d\n", per_cu); }
        (void)hipGetLastError();
        grid = cus;
    }
    if (grid < 0) return;
    (void)hipMemsetAsync((char*)d_ws + WS_CTL, 0, CTL_ZERO_BYTES, stream);
    Args a{};
    for (int i = 0; i < 31; ++i) a.in[i] = (const float*)d_in[i];
    a.out = (float*)d_out; a.ws = (unsigned char*)d_ws;
    if (MK_N_LAUNCHES == 1) { a.ph_lo = 0; a.ph_hi = NPHASE; hipLaunchKernelGGL(fwd_kernel, dim3(grid), dim3(NTHREADS), LDS_BYTES, stream, a); }
    else { for (int p = 0; p < NPHASE; ++p) { a.ph_lo = p; a.ph_hi = p + 1; a.pass = 0; hipLaunchKernelGGL(fwd_kernel, dim3(grid), dim3(NTHREADS), LDS_BYTES, stream, a);
             if (p == PROBE_DUP) { a.pass = 1; hipLaunchKernelGGL(fwd_kernel, dim3(grid), dim3(NTHREADS), LDS_BYTES, stream, a); } } }
}
```

```cpp
#include <hip/hip_runtime.h>
#include <cstdio>
#include <cstdint>

#ifndef PROBE_MASK
#define PROBE_MASK 0
#endif
#ifndef PROBE_SEL
#define PROBE_SEL 0
#endif
#ifndef PROBE_DUP
#define PROBE_DUP -1
#endif
#ifndef MK_N_LAUNCHES
#define MK_N_LAUNCHES 1
#endif

namespace {
constexpr int BATCH = 4, SEQ = 8192, DM = 1024, T = BATCH * SEQ;
constexpr int NH = 8, NG = 32, NS = 64, DIN = 2048;
constexpr int NE = 32, PLE = 256;
constexpr int ECAP = T;
constexpr float LN_EPS = 1e-5f, RMS_EPS = 1e-5f;
constexpr float ALPHA = 1.189207115002721f;
constexpr float QSCALE = 0.17677669529663687f * 1.4426950408889634f;
constexpr float LOG2E = 1.4426950408889634f;
constexpr int NPHASE = 11;
constexpr int NWAVES = 8, NTHREADS = 512;

typedef _Float16 f16;
typedef f16 h8 __attribute__((ext_vector_type(8)));
typedef f16 h4 __attribute__((ext_vector_type(4)));
typedef f16 h2 __attribute__((ext_vector_type(2)));
typedef float f32x4 __attribute__((ext_vector_type(4)));
typedef float f32x16 __attribute__((ext_vector_type(16)));
typedef int i32x4 __attribute__((ext_vector_type(4)));
typedef int i32x8 __attribute__((ext_vector_type(8)));
#define LAS __attribute__((address_space(3)))
#define GAS __attribute__((address_space(1)))
typedef GAS unsigned gu32;
#define RLX_AGENT __ATOMIC_RELAXED, __HIP_MEMORY_SCOPE_AGENT

constexpr size_t MiB = 1u << 20;
constexpr size_t WS_CTL = 0, CTL_ZERO_BYTES = 1 * MiB;
constexpr size_t WS_STATS = 3 * MiB;
constexpr size_t WS_GATES = 5 * MiB;
constexpr size_t WS_LIST = 6 * MiB;
constexpr size_t WS_WIN = 16 * MiB;
constexpr size_t WS_WGLU = 20 * MiB;
constexpr size_t WS_WOUT = 21 * MiB;
constexpr size_t WS_WPG = 23 * MiB;
constexpr size_t WS_WPP = 25 * MiB;
constexpr size_t WS_WGU = 32 * MiB;
constexpr size_t WS_WDN = 160 * MiB;
constexpr size_t WS_PE = 224 * MiB;
constexpr size_t WS_V1 = 288 * MiB;
constexpr size_t WS_A = 416 * MiB;
constexpr size_t WS_XH = WS_A;
constexpr size_t WS_PH = WS_A + 64 * MiB;
constexpr size_t WS_QH = WS_A + 80 * MiB;
constexpr size_t WS_KT = WS_A + 112 * MiB;
constexpr size_t WS_VT = WS_A + 144 * MiB;
constexpr size_t WS_UG = WS_A + 176 * MiB;
constexpr size_t WS_ACT = WS_A;
constexpr size_t WS_X1Q = WS_A + 128 * MiB;
constexpr size_t WS_R = WS_A;
constexpr size_t WS_RH = WS_A + 128 * MiB;
constexpr size_t WS_B = 672 * MiB;
constexpr size_t WS_YH = WS_B;
constexpr size_t WS_MIX = WS_B + 32 * MiB;
constexpr size_t WS_X1H = 940 * MiB;
constexpr size_t WS_SLAB = WS_B;
constexpr size_t WS_SSMOP = 928 * MiB;
constexpr size_t WS_A16 = 936 * MiB;
constexpr size_t WS_GATEH = WS_V1;
constexpr size_t WS_MIXO = WS_XH;
constexpr size_t WS_END = 1004 * MiB;

constexpr int CW_BAR = 4096;
constexpr int CW_CNT = 8192;
constexpr int CW_QUEUE = 12288;
constexpr int CW_KMAX = 16384;

constexpr int LDS_BYTES = 147456;
constexpr int LDS_BARST = LDS_BYTES - 64;

__device__ __forceinline__ float wave_sum(float v) {
#pragma unroll
    for (int o = 1; o < 64; o <<= 1) v += __shfl_xor(v, o);
    return v;
}
__device__ __forceinline__ float sigmoidf_(float x) { return __builtin_amdgcn_rcpf(1.0f + __builtin_amdgcn_exp2f(-LOG2E * x)); }
__device__ __forceinline__ float gelu_tanh(float x) {
    const float z = 0.7978845608028654f * (x + 0.044715f * x * x * x);
    const float e = __builtin_amdgcn_exp2f(fminf(2.0f * LOG2E * z, 80.0f));
    const float t = 1.0f - 2.0f * __builtin_amdgcn_rcpf(e + 1.0f);
    return 0.5f * x * (1.0f + t);
}
__device__ __forceinline__ int crow(int r, int hi) { return (r & 3) + 8 * (r >> 2) + 4 * hi; }
__device__ __forceinline__ float swap_add(float v) { return v + __shfl_xor(v, 32); }
__device__ __forceinline__ float swap_max(float v) { return fmaxf(v, __shfl_xor(v, 32)); }

#define XB_TMO      128
#define XB_XCNT(j)  (256  + 64 * (j))
#define XB_XSUB(j)  (1280 + 64 * (j))
#define XB_XGEN(j)  (2304 + 64 * (j))
#define XB_TOP      3328
#define XB_TOPGEN   3392
#define XCD_BAR_WORDS 3456
#define XB_SPIN_CAP (1u << 20)
__device__ __forceinline__ unsigned xb_ld(unsigned* p)              { return __hip_atomic_load(p, __ATOMIC_RELAXED, __HIP_MEMORY_SCOPE_AGENT); }
__device__ __forceinline__ unsigned xb_add(unsigned* p, unsigned v) { return __hip_atomic_fetch_add(p, v, __ATOMIC_RELAXED, __HIP_MEMORY_SCOPE_AGENT); }
__device__ __forceinline__ unsigned xb_xcc_id() { return (unsigned)__builtin_amdgcn_s_getreg((3 << 11) | 20) & 0xFu; }
#define XB_SPIN(cond, bar) do { unsigned _sp = 0; while (cond) { __builtin_amdgcn_s_sleep(1); \
    if ((++_sp & 255u) == 0u) { if (xb_ld(&(bar)[XB_TMO])) break; if (_sp > XB_SPIN_CAP) { atomicAdd(&(bar)[XB_TMO], 1u); break; } } } } while (0)
struct XcdBarrier { unsigned* bar; unsigned x; volatile LAS unsigned* st; };
__device__ __forceinline__ XcdBarrier xcd_barrier_post(unsigned* bar, volatile LAS unsigned* st) {
    XcdBarrier b; b.bar = bar; b.x = xb_xcc_id(); b.st = st;
    if (threadIdx.x == 0) (void)xb_add(&bar[XB_XCNT(b.x)], 1u);
    return b;
}
__device__ __forceinline__ void xcd_barrier_complete(unsigned* bar, unsigned x, unsigned& nloc, unsigned& nx) {
    const unsigned G = gridDim.x * gridDim.y * gridDim.z;
    unsigned sum, cnt, mine, sp = 0u;
    for (;;) {
        sum = 0u; cnt = 0u; mine = 0u;
#pragma unroll
        for (unsigned j = 0; j < 16; ++j) { const unsigned c = xb_ld(&bar[XB_XCNT(j)]); sum += c; cnt += (c > 0u) ? 1u : 0u; mine = (j == x) ? c : mine; }
        if (sum == G) break;
        __builtin_amdgcn_s_sleep(1);
        if ((++sp & 255u) == 0u) { if (xb_ld(&bar[XB_TMO])) break; if (sp > XB_SPIN_CAP) { atomicAdd(&bar[XB_TMO], 1u); break; } }
    }
    nloc = mine > 0u ? mine : 1u; nx = cnt > 0u ? cnt : 1u;
}
__device__ __forceinline__ void xcd_barrier(const XcdBarrier& b) {
    asm volatile("s_waitcnt vmcnt(0)" ::: "memory");
    __syncthreads();
    if (threadIdx.x == 0) {
        unsigned* bar = b.bar;
        __builtin_amdgcn_s_waitcnt(0);
        unsigned nloc = b.st[0], nx = b.st[1];
        if (nloc == 0u) { xcd_barrier_complete(bar, b.x, nloc, nx); b.st[0] = nloc; b.st[1] = nx; }
        const unsigned old = xb_add(&bar[XB_XSUB(b.x)], 1u);
        const unsigned gen = old / nloc;
        if (old + 1u == (gen + 1u) * nloc) {
            __builtin_amdgcn_fence(__ATOMIC_RELEASE, "agent");
            asm volatile("s_waitcnt vmcnt(0)" ::: "memory");
            const unsigned og = xb_add(&bar[XB_TOP], 1u);
            const unsigned tg = og / nx;
            if (og + 1u == (tg + 1u) * nx) xb_add(&bar[XB_TOPGEN], 1u);
            else XB_SPIN(xb_ld(&bar[XB_TOPGEN]) == tg, bar);
            __builtin_amdgcn_fence(__ATOMIC_ACQUIRE, "agent");
            xb_add(&bar[XB_XGEN(b.x)], 1u);
            asm volatile("s_waitcnt vmcnt(0)" ::: "memory");
        } else {
            XB_SPIN(xb_ld(&bar[XB_XGEN(b.x)]) == gen, bar);
            __builtin_amdgcn_fence(__ATOMIC_ACQUIRE, "agent");
            asm volatile("s_waitcnt vmcnt(0)" ::: "memory");
        }
    }
    __syncthreads();
}

struct Args { const float* in[31]; float* out; unsigned char* ws; int ph_lo, ph_hi, pass, pad; };
enum { I_X = 0, I_P, I_WIN, I_LQ1, I_LK1, I_LQ2, I_LK2, I_SUBLN, I_ARE, I_AIM, I_LOGDT, I_BRE, I_BIM, I_CRE, I_CIM, I_SSMD, I_WGLU, I_SSMG, I_WOUT,
       I_LN1G, I_LN1B, I_WR, I_BR, I_WGU, I_BGU, I_WDN, I_BDN, I_WPG, I_WPP, I_LN2G, I_LN2B };

struct Frame {
    LAS unsigned char* lds;
    const Args* a;
    unsigned char* ws;
    gu32* ctl;
    int tid, lane, wave, gw, NGW, G, vcu;
};

namespace pg8 {
constexpr int BM = 256, BK = 64, HALF = 128, HTB = HALF * BK * 2, STAGE_BYTES = 8 * HTB, NXCD = 8, WGM = 8;
__device__ __forceinline__ int lds_byte(int r, int c) { const int st = (r >> 4) * 2 + (c >> 5), rr = r & 15, cc = c & 31, ob = rr * 64 + cc * 2; return st * 1024 + (ob ^ (((ob >> 9) & 1) << 5)); }
__device__ __forceinline__ void stage_rc(int b, int& R, int& C) { const int st = b / 1024, sb = b % 1024, swz = sb ^ (((sb >> 9) & 1) << 5); R = (st >> 1) * 16 + swz / 64; C = (st & 1) * 32 + (swz % 64) / 2; }
struct Unit { int pm, pn, e, cnt; };
struct DenseOrder {
    int nM, nN, nwg, G, c;
    __device__ __forceinline__ void init(int M, int N, int G_, int c_) { nM = M / BM; nN = N / BM; nwg = nM * nN; G = G_; c = c_; }
    __device__ __forceinline__ bool next(int i, Unit& u) const {
        const long L = (long)i * G + c; if (L >= nwg) return false;
        int wgid = (int)L; { const int q = nwg / NXCD, r = nwg % NXCD, xcd = wgid % NXCD, off = wgid / NXCD; wgid = (xcd < r ? xcd * (q + 1) : r * (q + 1) + (xcd - r) * q) + off; }
        const int nig = WGM * nN, gid = wgid / nig, fm = gid * WGM, gsz = (nM - fm) < WGM ? (nM - fm) : WGM;
        u.pm = fm + ((wgid % nig) % gsz); u.pn = (wgid % nig) / gsz; u.e = 0; u.cnt = 0; return true;
    }
};
struct OneOrder { Unit u; __device__ __forceinline__ bool next(int i, Unit& o) const { if (i != 0) return false; o = u; return true; } };
struct MoeOrder {
    const LAS int* tab; int ntn, G, c;
    __device__ __forceinline__ bool next(int i, Unit& u) const {
        const int L = i * G + c; if (L >= tab[64] * ntn) return false;
        int e = 0;
#pragma unroll 1
        for (int q = 1; q < 32; ++q) if (L >= tab[32 + q] * ntn) e = q;
        const int cnt = tab[e], lu = L - tab[32 + e] * ntn;
        u.e = e; u.cnt = cnt; u.pn = lu % ntn; u.pm = lu / ntn; return true;
    }
};

template <class P, class Sched>
__device__ __forceinline__ void gemm_phase(LAS unsigned char* lds, const P& p, const Sched& S) {
    const int tid = threadIdx.x, wid = __builtin_amdgcn_readfirstlane(tid >> 6), lane = tid & 63, wr = wid >> 2, wc = wid & 3, fr = lane & 15, fq = lane >> 4;
    constexpr int K = P::K, PB = P::FP8 ? K : 2 * K  , nt = PB / 128;
    int RA[2]; unsigned CB[2], voffB[2];
#pragma unroll
    for (int i = 0; i < 2; ++i) { int R, C; stage_rc(tid * 16 + i * 8192, R, C); RA[i] = R; CB[i] = (unsigned)C * 2u; voffB[i] = (unsigned)(R * PB + C * 2); }
    constexpr size_t kstep = 128, hstep = (size_t)HALF * PB, tstep = 2 * hstep;
    const unsigned ldsw = (unsigned)wid * 1024u;
    const int aoff = lds_byte(wr * 64 + fr, fq * 8), boff = lds_byte(wc * 32 + fr, fq * 8);
    LAS float* rsl = (LAS float*)(lds + STAGE_BYTES);
    const char* abase = p.abase();
#define PG8_SA(b, h) (((b) * 2 + (h)) * HTB)
#define PG8_SB(b, h) ((4 + (b) * 2 + (h)) * HTB)
#define PG8_STAGE(bufoff, gbase, voff) do { _Pragma("unroll") for (int _i = 0; _i < 2; ++_i) \
        __builtin_amdgcn_global_load_lds((const unsigned*)((const char*)(gbase) + (voff)[_i]), (LAS unsigned*)(lds + (bufoff) + ldsw + _i * 8192), 16, 0, 0); } while (0)
#define PG8_LDA(dst, b, h) do { _Pragma("unroll") for (int m = 0; m < 4; ++m) { \
        if constexpr (P::FP8) { const i32x4 lo_ = *(const LAS i32x4*)(lds + PG8_SA(b, h) + aoff + m * 2048), hi_ = *(const LAS i32x4*)(lds + PG8_SA(b, h) + aoff + m * 2048 + 1024); dst##8[m] = __builtin_shufflevector(lo_, hi_, 0, 1, 2, 3, 4, 5, 6, 7); } \
        else { _Pragma("unroll") for (int k = 0; k < 2; ++k) dst[m][k] = *(const LAS h8*)(lds + PG8_SA(b, h) + aoff + m * 2048 + k * 1024); } } } while (0)
#define PG8_LDB(dst, b, h) do { _Pragma("unroll") for (int n = 0; n < 2; ++n) { \
        if constexpr (P::FP8) { const i32x4 lo_ = *(const LAS i32x4*)(lds + PG8_SB(b, h) + boff + n * 2048), hi_ = *(const LAS i32x4*)(lds + PG8_SB(b, h) + boff + n * 2048 + 1024); dst##8[n] = __builtin_shufflevector(lo_, hi_, 0, 1, 2, 3, 4, 5, 6, 7); } \
        else { _Pragma("unroll") for (int k = 0; k < 2; ++k) dst[n][k] = *(const LAS h8*)(lds + PG8_SB(b, h) + boff + n * 2048 + k * 1024); } } } while (0)
#define PG8_MMA(ai, bj, At, Bt) do { __builtin_amdgcn_s_setprio(1); _Pragma("unroll") for (int m = 0; m < 4; ++m) _Pragma("unroll") for (int n = 0; n < 2; ++n) { \
        if constexpr (P::FP8) asm volatile("v_mfma_scale_f32_16x16x128_f8f6f4 %0, %1, %2, %0, %3, %3 op_sel_hi:[0,0,0]" : "+v"(acc[ai][bj][m][n]) : "v"(Bt##8[n]), "v"(At##8[m]), "v"(one_scale)); \
        else { _Pragma("unroll") for (int k = 0; k < 2; ++k) acc[ai][bj][m][n] = __builtin_amdgcn_mfma_f32_16x16x32_f16(Bt[n][k], At[m][k], acc[ai][bj][m][n], 0, 0, 0); } } \
        __builtin_amdgcn_s_setprio(0); } while (0)
#define PG8_WAIT_V(n) asm volatile("s_waitcnt vmcnt(" #n ")" ::: "memory")
#define PG8_WAIT_L(n) asm volatile("s_waitcnt lgkmcnt(" #n ")" ::: "memory")
#define PG8_BAR __builtin_amdgcn_s_barrier()
#define PG8_SCHED __builtin_amdgcn_sched_barrier(0)
    Unit cur, nxt; int ui = 0;
    if (!S.next(0, cur)) return;
    f32x4 acc[2][2][4][2];
#pragma unroll
    for (int a = 0; a < 2; ++a)
#pragma unroll
        for (int b = 0; b < 2; ++b)
#pragma unroll
            for (int m = 0; m < 4; ++m)
#pragma unroll
                for (int n = 0; n < 2; ++n) acc[a][b][m][n] = (f32x4){0.f, 0.f, 0.f, 0.f};
    h8 At[4][2], B0[2][2], B1[2][2]; i32x8 At8[4], B08[2], B18[2];
    int one_scale = 0x7f7f7f7f; asm volatile("" : "+v"(one_scale));
    LAS int* ginfo = (LAS int*)(lds + STAGE_BYTES + 4096);
    unsigned voffA[2];
    const char* cA = abase; const char* nA = abase;
#pragma unroll
    for (int i = 0; i < 2; ++i) voffA[i] = P::GATHER ? CB[i] : (unsigned)(RA[i] * PB) + CB[i];
    if constexpr (P::GATHER) {
        if (tid < 256) p.fill_rows(cur, ginfo, tid);
        asm volatile("s_waitcnt lgkmcnt(0)" ::: "memory"); PG8_BAR; asm volatile("" ::: "memory");
    } else cA = abase + (size_t)cur.pm * tstep;
    constexpr size_t hA = P::GATHER ? 0 : hstep;
#define PG8_STAGE_A(bufoff, gbase, par, half) do { if constexpr (P::GATHER) { _Pragma("unroll") for (int _i = 0; _i < 2; ++_i) { \
            const unsigned ro_ = p.rowbytes(ginfo[(par) * 512 + (half) * 128 + RA[_i]] & 0x7fffffff) + voffA[_i]; \
            __builtin_amdgcn_global_load_lds((const unsigned*)((const char*)(gbase) + ro_), (LAS unsigned*)(lds + (bufoff) + ldsw + _i * 8192), 16, 0, 0); } } \
        else PG8_STAGE(bufoff, (const char*)(gbase) + (half) * hA, voffA); } while (0)
    const char* cB = p.bptr(cur);
    if constexpr (P::MID) p.mid_prepare(cur, rsl, tid);
    PG8_STAGE(PG8_SB(0, 0), cB, voffB); PG8_STAGE(PG8_SB(0, 1), cB + hstep, voffB); PG8_STAGE_A(PG8_SA(0, 0), cA, 0, 0); PG8_STAGE_A(PG8_SA(0, 1), cA, 0, 1);
    if (wr == 1) PG8_BAR;
    PG8_WAIT_V(2); PG8_BAR;
    PG8_STAGE(PG8_SB(1, 0), cB + kstep, voffB); PG8_STAGE_A(PG8_SA(1, 0), cA + kstep, 0, 0); PG8_STAGE(PG8_SB(1, 1), cB + hstep + kstep, voffB);
    PG8_WAIT_V(6); PG8_BAR;
    for (;;) {
        const bool has_next = S.next(ui + 1, nxt);
        const char* nB = cB; nA = cA;
        const int cpar = ui & 1; int npar = cpar;
        if (has_next) {
            nB = p.bptr(nxt); npar = cpar ^ 1;
            if constexpr (P::GATHER) { if (tid < 256) p.fill_rows(nxt, ginfo + npar * 512, tid); }
            else nA = abase + (size_t)nxt.pm * tstep;
            if constexpr (P::MID) p.mid_prepare(nxt, rsl + 256 * ((ui + 1) & 1), tid);
        }
#pragma unroll 1
        for (int t = 0; t < nt; t += 2) {
            const bool last = (t == nt - 2);
            if constexpr (P::MID) {
                if (t == nt / 2) {
                    const LAS float* rs = rsl + 256 * (ui & 1);
#pragma unroll
                    for (int a = 0; a < 2; ++a)
#pragma unroll
                        for (int m = 0; m < 4; ++m) { const float sc = rs[a * 128 + wr * 64 + m * 16 + fr];
#pragma unroll
                            for (int b = 0; b < 2; ++b)
#pragma unroll
                                for (int n = 0; n < 2; ++n) acc[a][b][m][n] *= sc; }
                }
            }
            const char* a1 = cA + (size_t)(t + 1) * kstep;
            const char* a2 = last ? nA : cA + (size_t)(t + 2) * kstep; const char* b2 = last ? nB : cB + (size_t)(t + 2) * kstep;
            const char* a3 = a2 + kstep; const char* b3 = b2 + kstep;
            const int par2 = last ? npar : cpar;
            PG8_LDB(B0, 0, 0); PG8_LDB(B1, 0, 1); PG8_SCHED; PG8_LDA(At, 0, 0); PG8_STAGE_A(PG8_SA(1, 1), a1, cpar, 1);
            PG8_WAIT_V(8); PG8_WAIT_L(0); PG8_BAR; PG8_MMA(0, 0, At, B0); PG8_MMA(0, 1, At, B1); PG8_BAR; PG8_SCHED;
            PG8_LDA(At, 0, 1); PG8_STAGE(PG8_SB(0, 0), b2, voffB); PG8_STAGE(PG8_SB(0, 1), b2 + hstep, voffB); PG8_STAGE_A(PG8_SA(0, 0), a2, par2, 0);
            PG8_WAIT_V(8); PG8_WAIT_L(0); PG8_BAR; PG8_MMA(1, 0, At, B0); PG8_MMA(1, 1, At, B1); PG8_BAR; PG8_SCHED;
            PG8_LDB(B0, 1, 0); PG8_LDB(B1, 1, 1); PG8_SCHED; PG8_LDA(At, 1, 0); PG8_STAGE_A(PG8_SA(0, 1), a2, par2, 1);
            PG8_WAIT_V(8); PG8_WAIT_L(0); PG8_BAR; PG8_MMA(0, 0, At, B0); PG8_MMA(0, 1, At, B1); PG8_BAR; PG8_SCHED;
            PG8_LDA(At, 1, 1); PG8_STAGE(PG8_SB(1, 0), b3, voffB); PG8_STAGE(PG8_SB(1, 1), b3 + hstep, voffB); PG8_STAGE_A(PG8_SA(1, 0), a3, par2, 0);
            PG8_WAIT_V(8); PG8_WAIT_L(0); PG8_BAR; PG8_MMA(1, 0, At, B0); PG8_MMA(1, 1, At, B1); PG8_BAR; PG8_SCHED;
        }
        if (wr == 0) PG8_BAR;
        if constexpr (P::FP8) asm volatile("s_nop 15\n\ts_nop 7" ::: "memory");
        {
            const int cb = wc * 32 + fq * 8;
#define PG8_EPI_LOOP(RI, CALL) do { const auto pre = p.pre(cur, cb); (void)pre; \
                _Pragma("unroll") for (int a = 0; a < 2; ++a) { \
                    int lrow = a * 128 + wr * 64 + fr; decltype(RI) ris[4]; \
                    _Pragma("unroll") for (int m = 0; m < 4; ++m) { lrow = a * 128 + wr * 64 + m * 16 + fr; ris[m] = RI; } \
                    _Pragma("unroll") for (int m = 0; m < 4; ++m) { lrow = a * 128 + wr * 64 + m * 16 + fr; const auto ri = ris[m]; CALL; } } } while (0)
            if constexpr (P::KINDS) {
                const int kd = __builtin_amdgcn_readfirstlane(p.kind(cur));
                if (kd == 1) p.knorm(cur, acc, wc, lane);
                if (kd == 0) PG8_EPI_LOOP(p.template rowpart<0>(cur, lrow), p.template epik<0>(cur, ri, cb, acc[a][0][m][0], acc[a][0][m][1], acc[a][1][m][0], acc[a][1][m][1]));
                else if (kd == 1) PG8_EPI_LOOP(p.template rowpart<1>(cur, lrow), p.template epik<1>(cur, ri, cb, acc[a][0][m][0], acc[a][0][m][1], acc[a][1][m][0], acc[a][1][m][1]));
                else if (kd == 2) PG8_EPI_LOOP(p.template rowpart<2>(cur, lrow), p.template epik<2>(cur, ri, cb, acc[a][0][m][0], acc[a][0][m][1], acc[a][1][m][0], acc[a][1][m][1]));
                else PG8_EPI_LOOP(p.template rowpart<3>(cur, lrow), p.template epik<3>(cur, ri, cb, acc[a][0][m][0], acc[a][0][m][1], acc[a][1][m][0], acc[a][1][m][1]));
            } else {
                if constexpr (P::GATHER) { const LAS int* gi_ = ginfo + (ui & 1) * 512; PG8_EPI_LOOP(p.rowinfo_lds(gi_, lrow), p.epi(cur, pre, ri, lrow, cb, acc[a][0][m][0], acc[a][0][m][1], acc[a][1][m][0], acc[a][1][m][1])); }
                else PG8_EPI_LOOP(p.rowinfo(cur, lrow), p.epi(cur, pre, ri, lrow, cb, acc[a][0][m][0], acc[a][0][m][1], acc[a][1][m][0], acc[a][1][m][1]));
            }
#undef PG8_EPI_LOOP
        }
        if (!has_next) break;
#pragma unroll
        for (int a = 0; a < 2; ++a)
#pragma unroll
            for (int b = 0; b < 2; ++b)
#pragma unroll
                for (int m = 0; m < 4; ++m)
#pragma unroll
                    for (int n = 0; n < 2; ++n) acc[a][b][m][n] = (f32x4){0.f, 0.f, 0.f, 0.f};
        cur = nxt; cB = nB; cA = nA; ++ui;
        if (wr == 1) PG8_BAR;
    }
    PG8_WAIT_V(0);
    PG8_BAR;
#undef PG8_SA
#undef PG8_SB
#undef PG8_STAGE
#undef PG8_STAGE_A
#undef PG8_LDA
#undef PG8_LDB
#undef PG8_MMA
#undef PG8_WAIT_V
#undef PG8_WAIT_L
#undef PG8_BAR
#undef PG8_SCHED
}
}

struct NoPre {};
__device__ __forceinline__ int pack_fp8x4(float a, float b, float c, float d) { int w = 0; w = __builtin_amdgcn_cvt_pk_fp8_f32(a, b, w, false); w = __builtin_amdgcn_cvt_pk_fp8_f32(c, d, w, true); return w; }
constexpr float WGU_SCALE = 32.0f, WDN_SCALE = 64.0f, ACT_SCALE = 4.0f, SLAB_SCALE = 16.0f;
__device__ __forceinline__ h8 pack8(f32x4 lo, f32x4 hi) { h8 o; o[0] = (f16)lo[0]; o[1] = (f16)lo[1]; o[2] = (f16)lo[2]; o[3] = (f16)lo[3]; o[4] = (f16)hi[0]; o[5] = (f16)hi[1]; o[6] = (f16)hi[2]; o[7] = (f16)hi[3]; return o; }
struct ProbInproj {
    static constexpr int K = 1024; static constexpr bool KINDS = true; static constexpr bool GATHER = false; static constexpr bool FP8 = false; static constexpr bool MID = false;
    const char* xh; const char* win; f16 *qh, *kt, *vt, *ug; gu32* kmax;
    __device__ __forceinline__ const char* abase() const { return xh; }
    __device__ __forceinline__ unsigned rowoff(const pg8::Unit& u, int r) const { return (unsigned)(u.pm * 256 + r) * (unsigned)(K * 2); }
    __device__ __forceinline__ const char* bptr(const pg8::Unit& u) const { return win + (size_t)u.pn * 256 * K * 2; }
    __device__ __forceinline__ NoPre pre(const pg8::Unit&, int) const { return NoPre{}; }
    __device__ __forceinline__ int kind(const pg8::Unit& u) const { return u.pn >> 1; }
    __device__ __forceinline__ void knorm(const pg8::Unit& u, const f32x4 (&acc)[2][2][4][2], int wc, int lane) const {
#pragma unroll
        for (int b = 0; b < 2; ++b) {
            float mx = 0.f;
#pragma unroll
            for (int a = 0; a < 2; ++a)
#pragma unroll
                for (int m = 0; m < 4; ++m) { const f32x4 x = acc[a][b][m][0], y = acc[a][b][m][1];
                    float q = (x[0] * x[0] + x[1] * x[1]) + (x[2] * x[2] + x[3] * x[3]) + (y[0] * y[0] + y[1] * y[1]) + (y[2] * y[2] + y[3] * y[3]);
                    q += __shfl_xor(q, 16); q += __shfl_xor(q, 32); mx = fmaxf(mx, q); }
            mx = fmaxf(mx, __shfl_xor(mx, 1)); mx = fmaxf(mx, __shfl_xor(mx, 2)); mx = fmaxf(mx, __shfl_xor(mx, 4)); mx = fmaxf(mx, __shfl_xor(mx, 8));
            if (lane == 0) { const int bt = (u.pm * 256) >> 13, hd = (u.pn & 1) * 4 + 2 * b + (wc >> 1), mp = wc & 1;
                __hip_atomic_fetch_max(kmax + (bt * 8 + hd) * 2 + mp, __float_as_uint(sqrtf(mx)), RLX_AGENT); }
        }
    }
    template <int KIND> __device__ __forceinline__ unsigned rowpart(const pg8::Unit& u, int lr) const {
        const int row = u.pm * 256 + lr, b = row >> 13, tt = row & 8191, tile = tt >> 6, key = tt & 63;
        if (KIND == 0) return (unsigned)row * 512u;
        if (KIND == 1) return (unsigned)((b * 8 * 128 + tile) * 4096 + key * 8);
        if (KIND == 2) { const int sx = key >> 4, w = key & 15, hh = (w >> 2) & 1, j = (w & 3) + 4 * (w >> 3); return (unsigned)((b * 8 * 128 + tile) * 4096 + (2 * sx + hh) * 512 + j); }
        return (unsigned)((b * 32 * 8192 + tt) * 16);
    }
    template <int KIND> __device__ __forceinline__ void epik(const pg8::Unit& u, unsigned rp, int cb, f32x4 v00, f32x4 v01, f32x4 v10, f32x4 v11) const {
#pragma unroll
        for (int b = 0; b < 2; ++b) {
            const int col = (u.pn & 1) * 256 + b * 128 + cb; const f32x4 lo = b ? v10 : v00, hi = b ? v11 : v01;
            if (KIND == 0) { *(h8*)(qh + rp + col) = pack8(lo * QSCALE, hi * QSCALE); }
            else if (KIND == 1) { const int hd = col >> 6, d = col & 63; *(h8*)(kt + rp + (unsigned)(hd * 128 * 4096 + (d >> 3) * 512)) = pack8(lo, hi); }
            else if (KIND == 2) { const int hd = col >> 6, dv = col & 63; f16* q = vt + rp + (unsigned)(hd * 128 * 4096 + dv * 8);
                q[0] = (f16)lo[0]; q[8] = (f16)lo[1]; q[16] = (f16)lo[2]; q[24] = (f16)lo[3]; q[32] = (f16)hi[0]; q[40] = (f16)hi[1]; q[48] = (f16)hi[2]; q[56] = (f16)hi[3]; }
            else { const int g = col >> 4, c0 = col & 15; *(h8*)(ug + rp + (unsigned)(g * 8192 * 16 + c0)) = pack8(lo, hi); }
        }
    }
};
struct ProbPleProj {
    static constexpr int K = 256; static constexpr bool KINDS = false; static constexpr bool GATHER = false; static constexpr bool FP8 = false; static constexpr bool MID = false;
    const char* ph; const char* wpp; f16* pe;
    __device__ __forceinline__ const char* abase() const { return ph; }
    __device__ __forceinline__ unsigned rowoff(const pg8::Unit& u, int r) const { return (unsigned)(u.pm * 256 + r) * (unsigned)(K * 2); }
    __device__ __forceinline__ const char* bptr(const pg8::Unit& u) const { return wpp + (size_t)u.pn * 256 * K * 2; }
    __device__ __forceinline__ NoPre pre(const pg8::Unit&, int) const { return NoPre{}; }
    __device__ __forceinline__ int rowinfo(const pg8::Unit&, int) const { return 0; }
    __device__ __forceinline__ void epi(const pg8::Unit& u, NoPre, int, int lr, int cb, f32x4 v00, f32x4 v01, f32x4 v10, f32x4 v11) const {
        f16* o = pe + (size_t)(u.pm * 256 + lr) * 1024 + u.pn * 256 + cb; *(h8*)o = pack8(v00, v01); *(h8*)(o + 128) = pack8(v10, v11); }
};
struct ProbGlu {
    static constexpr int K = 512; static constexpr bool KINDS = false; static constexpr bool GATHER = false; static constexpr bool FP8 = false; static constexpr bool MID = false;
    const char* yh; const char* wg; f16* mix;
    __device__ __forceinline__ const char* abase() const { return yh; }
    __device__ __forceinline__ unsigned rowoff(const pg8::Unit& u, int r) const { return (unsigned)(u.pm * 256 + r) * (unsigned)(K * 2); }
    __device__ __forceinline__ const char* bptr(const pg8::Unit& u) const { return wg + (size_t)u.pn * 256 * K * 2; }
    __device__ __forceinline__ NoPre pre(const pg8::Unit&, int) const { return NoPre{}; }
    __device__ __forceinline__ int rowinfo(const pg8::Unit&, int) const { return 0; }
    __device__ __forceinline__ void epi(const pg8::Unit& u, NoPre, int, int lr, int cb, f32x4 v00, f32x4 v01, f32x4 v10, f32x4 v11) const {
        h8 o;
#pragma unroll
        for (int e = 0; e < 4; ++e) { o[e] = (f16)(v00[e] * sigmoidf_(v10[e])); o[4 + e] = (f16)(v01[e] * sigmoidf_(v11[e])); }
        *(h8*)(mix + (size_t)(u.pm * 256 + lr) * 1024 + u.pn * 128 + cb) = o; }
};
struct ProbOut {
    static constexpr int K = 1024; static constexpr bool KINDS = false; static constexpr bool GATHER = false; static constexpr bool FP8 = false; static constexpr bool MID = true;
    const char* mixb; const char* wo; f16* mixo;
    __device__ __forceinline__ const char* abase() const { return mixb; }
    __device__ __forceinline__ unsigned rowoff(const pg8::Unit& u, int r) const { return (unsigned)(u.pm * 256 + r) * (unsigned)(K * 2); }
    __device__ __forceinline__ const char* bptr(const pg8::Unit& u) const { return wo + (size_t)u.pn * 256 * K * 2; }
    __device__ __forceinline__ NoPre pre(const pg8::Unit&, int) const { return NoPre{}; }
    __device__ __forceinline__ int rowinfo(const pg8::Unit&, int) const { return 0; }
    __device__ __forceinline__ void mid_prepare(const pg8::Unit& u, LAS float* slot, int tid) const {
        const int row = tid >> 1; const h8* q = (const h8*)(mixb + (size_t)(u.pm * 256 + row) * 2048 + (tid & 1) * 512); float sacc = 0.f;
#pragma unroll 4
        for (int j = 0; j < 32; ++j) { const h8 v = q[j];
#pragma unroll
            for (int e = 0; e < 8; ++e) { const float f = (float)v[e]; sacc += f * f; } }
        sacc += __shfl_xor(sacc, 1);
        if (!(tid & 1)) slot[row] = rsqrtf(sacc * (1.0f / 512.0f) + RMS_EPS);
    }
    __device__ __forceinline__ void epi(const pg8::Unit& u, NoPre, int, int lr, int cb, f32x4 v00, f32x4 v01, f32x4 v10, f32x4 v11) const {
        f16* o = mixo + (size_t)(u.pm * 256 + lr) * 1024 + u.pn * 256 + cb; *(h8*)o = pack8(v00, v01); *(h8*)(o + 128) = pack8(v10, v11); }
};
struct Pre16 { f32x4 a, b, c, d; };
struct ProbMoeUp {
    static constexpr int K = 1024; static constexpr bool KINDS = false; static constexpr bool GATHER = true; static constexpr bool FP8 = true; static constexpr bool MID = false;
    const char* x1q; const char* wgu; const int* list; const float* bias; unsigned char* act;
    __device__ __forceinline__ const char* abase() const { return x1q; }
    __device__ __forceinline__ unsigned rowoff(const pg8::Unit&, int) const { return 0u; }
    __device__ __forceinline__ void fill_rows(const pg8::Unit& u, LAS int* tabp, int r) const { const int i = u.pm * 256 + r; const bool ok = i < u.cnt; const int a = list[(size_t)u.e * ECAP + (ok ? i : 0)]; tabp[r] = ok ? a : (a | (int)0x80000000); }
    __device__ __forceinline__ unsigned rowbytes(int a) const { return (unsigned)(a >> 2) * (unsigned)K; }
    __device__ __forceinline__ int rowinfo_lds(const LAS int* tabp, int lr) const { return tabp[lr]; }
    __device__ __forceinline__ const char* bptr(const pg8::Unit& u) const { return wgu + ((size_t)u.e * 2048 + (size_t)u.pn * 256) * K; }
    __device__ __forceinline__ Pre16 pre(const pg8::Unit& u, int cb) const {
        const float* bp = bias + u.e * 2048 + 2 * (u.pn * 128 + cb); Pre16 r; r.a = *(const f32x4*)bp; r.b = *(const f32x4*)(bp + 4); r.c = *(const f32x4*)(bp + 8); r.d = *(const f32x4*)(bp + 12); return r; }
    __device__ __forceinline__ int rowinfo(const pg8::Unit& u, int lr) const { const int i = u.pm * 256 + lr; return i < u.cnt ? list[(size_t)u.e * ECAP + i] : -1; }
    __device__ __forceinline__ void epi(const pg8::Unit& u, const Pre16& pb, int a, int, int cb, f32x4 v00, f32x4 v01, f32x4 v10, f32x4 v11) const {
        if (a < 0) return;
        const float bg[8] = {pb.a[0], pb.a[2], pb.b[0], pb.b[2], pb.c[0], pb.c[2], pb.d[0], pb.d[2]}, bl[8] = {pb.a[1], pb.a[3], pb.b[1], pb.b[3], pb.c[1], pb.c[3], pb.d[1], pb.d[3]};
        float o[8];
#pragma unroll
        for (int e = 0; e < 8; ++e) { const float g = fminf((e < 4 ? v00[e] : v01[e - 4]) * (1.0f / WGU_SCALE) + bg[e], 7.0f), l = fminf(fmaxf((e < 4 ? v10[e] : v11[e - 4]) * (1.0f / WGU_SCALE) + bl[e], -7.0f), 7.0f);
            o[e] = g * sigmoidf_(1.702f * g) * (l + 1.0f) * ACT_SCALE; }
        int w0 = pack_fp8x4(o[0], o[1], o[2], o[3]), w1 = pack_fp8x4(o[4], o[5], o[6], o[7]);
        typedef int i32x2 __attribute__((ext_vector_type(2))); i32x2 ww = {w0, w1};
        *(i32x2*)(act + (size_t)a * 1024 + u.pn * 128 + cb) = ww; }
};
struct RowAG { int a; float g; };
struct ProbMoeDn {
    static constexpr int K = 1024; static constexpr bool KINDS = false; static constexpr bool GATHER = true; static constexpr bool FP8 = true; static constexpr bool MID = false;
    const char* actb; const char* wdn; const int* list; const float* bias; const float* gates; unsigned char* slab;
    __device__ __forceinline__ const char* abase() const { return actb; }
    __device__ __forceinline__ unsigned rowoff(const pg8::Unit&, int) const { return 0u; }
    __device__ __forceinline__ void fill_rows(const pg8::Unit& u, LAS int* tabp, int r) const { const int i = u.pm * 256 + r; const bool ok = i < u.cnt; const int a = list[(size_t)u.e * ECAP + (ok ? i : 0)];
        tabp[r] = ok ? a : (a | (int)0x80000000); tabp[256 + r] = __float_as_int(ok ? gates[a] : 0.f); }
    __device__ __forceinline__ unsigned rowbytes(int a) const { return (unsigned)a * (unsigned)K; }
    __device__ __forceinline__ RowAG rowinfo_lds(const LAS int* tabp, int lr) const { RowAG r; r.a = tabp[lr]; r.g = __int_as_float(tabp[256 + lr]); return r; }
    __device__ __forceinline__ const char* bptr(const pg8::Unit& u) const { return wdn + ((size_t)u.e * 1024 + (size_t)u.pn * 256) * K; }
    __device__ __forceinline__ Pre16 pre(const pg8::Unit& u, int cb) const {
        const float* bp = bias + u.e * 1024 + u.pn * 256 + cb; Pre16 r; r.a = *(const f32x4*)bp; r.b = *(const f32x4*)(bp + 4); r.c = *(const f32x4*)(bp + 128); r.d = *(const f32x4*)(bp + 132); return r; }
    __device__ __forceinline__ RowAG rowinfo(const pg8::Unit& u, int lr) const { const int i = u.pm * 256 + lr; RowAG r; r.a = i < u.cnt ? list[(size_t)u.e * ECAP + i] : -1; r.g = r.a >= 0 ? gates[r.a] : 0.f; return r; }
    __device__ __forceinline__ void epi(const pg8::Unit& u, const Pre16& pb, const RowAG& ri, int, int cb, f32x4 v00, f32x4 v01, f32x4 v10, f32x4 v11) const {
        if (ri.a < 0) return;
        constexpr float S = 1.0f / (WDN_SCALE * ACT_SCALE);
        typedef int i32x2 __attribute__((ext_vector_type(2)));
        unsigned char* o = slab + (size_t)ri.a * 1024 + u.pn * 256 + cb; const float g = ri.g * SLAB_SCALE;
        f32x4 a = (v00 * S + pb.a) * g, b = (v01 * S + pb.b) * g, c = (v10 * S + pb.c) * g, d = (v11 * S + pb.d) * g;
#pragma unroll
        for (int e = 0; e < 4; ++e) { a[e] = fminf(fmaxf(a[e], -448.f), 448.f); b[e] = fminf(fmaxf(b[e], -448.f), 448.f); c[e] = fminf(fmaxf(c[e], -448.f), 448.f); d[e] = fminf(fmaxf(d[e], -448.f), 448.f); }
        i32x2 w0 = {pack_fp8x4(a[0], a[1], a[2], a[3]), pack_fp8x4(b[0], b[1], b[2], b[3])}, w1 = {pack_fp8x4(c[0], c[1], c[2], c[3]), pack_fp8x4(d[0], d[1], d[2], d[3])};
        *(i32x2*)o = w0; *(i32x2*)(o + 128) = w1; }
};
struct ProbPleGate {
    static constexpr int K = 1024; static constexpr bool KINDS = false; static constexpr bool GATHER = false; static constexpr bool FP8 = false; static constexpr bool MID = false;
    const char* rh; const char* wpg; f16* gateh;
    __device__ __forceinline__ const char* abase() const { return rh; }
    __device__ __forceinline__ unsigned rowoff(const pg8::Unit& u, int r) const { return (unsigned)(u.pm * 256 + r) * (unsigned)(K * 2); }
    __device__ __forceinline__ const char* bptr(const pg8::Unit& u) const { return wpg + (size_t)u.pn * 256 * K * 2; }
    __device__ __forceinline__ NoPre pre(const pg8::Unit&, int) const { return NoPre{}; }
    __device__ __forceinline__ int rowinfo(const pg8::Unit&, int) const { return 0; }
    __device__ __forceinline__ void epi(const pg8::Unit& u, NoPre, int, int lr, int cb, f32x4 v00, f32x4 v01, f32x4 v10, f32x4 v11) const {
        f16* o = gateh + (size_t)(u.pm * 256 + lr) * 1024 + u.pn * 256 + cb;
        f32x4 a, b, c, d;
#pragma unroll
        for (int e = 0; e < 4; ++e) { a[e] = sigmoidf_(v00[e]); b[e] = sigmoidf_(v01[e]); c[e] = sigmoidf_(v10[e]); d[e] = sigmoidf_(v11[e]); }
        *(h8*)o = pack8(a, b); *(h8*)(o + 128) = pack8(c, d); }
};

__device__ __forceinline__ int invperm32(int c) { return 16 * ((c >> 2) & 1) + 4 * (c >> 3) + (c & 3); }
__device__ __forceinline__ void tr_item(const float* W, int K, int N, f16* WT, int item, int mode, const float* gsc, LAS float* scr, int lane) {
    const int nblk = N / 32, kb = item / nblk, nb = item % nblk, k0 = 64 * kb, n0 = 32 * nb;
#pragma unroll 8
    for (int i = 0; i < 32; ++i) {
        const int kk = 2 * i + (lane >> 5);
        float v = W[(size_t)(k0 + kk) * N + n0 + (lane & 31)];
        if (mode == 2 && k0 + kk >= 512) v *= gsc[k0 + kk - 512];
        scr[kk * 33 + (lane & 31)] = v;
    }
    asm volatile("s_waitcnt lgkmcnt(0)" ::: "memory");
    const int c = lane & 7;
#pragma unroll
    for (int j = 0; j < 4; ++j) {
        const int n = (lane >> 3) + 8 * j; const LAS float* s = scr + (8 * c) * 33 + n;
        const int ns = n0 + n; int nd;
        if (mode == 1 || mode == 3) { const int ja = mode == 1 ? (ns & 511) : (ns >> 1), bj = mode == 1 ? (ns >> 9) : (ns & 1), jl = ja & 127;
            nd = 256 * (ja >> 7) + 128 * bj + (jl & ~31) + invperm32(jl & 31); }
        else nd = (ns & ~31) + invperm32(ns & 31);
        int kd = k0 + 8 * c; if (mode == 2) kd = (kd + 512) & 1023;
        if (mode >= 3) {
            const float sc = mode == 3 ? WGU_SCALE : WDN_SCALE;
            typedef int i32x2 __attribute__((ext_vector_type(2)));
            i32x2 o; o[0] = pack_fp8x4(s[0] * sc, s[33] * sc, s[66] * sc, s[99] * sc); o[1] = pack_fp8x4(s[132] * sc, s[165] * sc, s[198] * sc, s[231] * sc);
            *(i32x2*)((unsigned char*)WT + (size_t)nd * K + kd) = o;
        } else {
            h8 o; o[0] = (f16)s[0]; o[1] = (f16)s[33]; o[2] = (f16)s[66]; o[3] = (f16)s[99]; o[4] = (f16)s[132]; o[5] = (f16)s[165]; o[6] = (f16)s[198]; o[7] = (f16)s[231];
            *(h8*)(WT + (size_t)nd * K + kd) = o;
        }
    }
    asm volatile("s_waitcnt lgkmcnt(0)" ::: "memory");
}

__device__ __forceinline__ void ssm_precompute(Frame& F, int g) {
    const Args& A = *F.a; const int tid = F.tid;
    LAS float* pwr = (LAS float*)F.lds;
    LAS float* pwi = pwr + 17 * 64;
    LAS float* Bbr = pwi + 17 * 64;
    LAS float* Bbi = Bbr + 1024;
    LAS float* Cr = Bbi + 1024;
    LAS float* Ci = Cr + 1024;
    LAS float* Kd = Ci + 1024;
    if (tid < 64) {
        const int p = tid;
        const float are = A.in[I_ARE][g * 64 + p], aim = A.in[I_AIM][g * 64 + p], dt = __expf(A.in[I_LOGDT][g]);
        for (int d = 0; d <= 16; ++d) { const float mag = __expf(are * dt * (float)d); float sn, cs; sincosf(aim * dt * (float)d, &sn, &cs); pwr[d * 64 + p] = mag * cs; pwi[d * 64 + p] = mag * sn; }
        const float abr = pwr[64 + p], abi = pwi[64 + p];
        const float nr = abr - 1.0f, ni = abi, den = 1.0f / (are * are + aim * aim);
        const float fr_ = (nr * are + ni * aim) * den, fi_ = (ni * are - nr * aim) * den;
        for (int c = 0; c < 16; ++c) { const float br = A.in[I_BRE][(g * 64 + p) * 16 + c], bi = A.in[I_BIM][(g * 64 + p) * 16 + c]; Bbr[p * 16 + c] = fr_ * br - fi_ * bi; Bbi[p * 16 + c] = fr_ * bi + fi_ * br; }
        float* a16 = (float*)(F.ws + WS_A16) + (g * 64 + p) * 2; a16[0] = pwr[16 * 64 + p]; a16[1] = pwi[16 * 64 + p];
    }
    for (int i = tid; i < 1024; i += NTHREADS) { Cr[i] = A.in[I_CRE][g * 1024 + i]; Ci[i] = A.in[I_CIM][g * 1024 + i]; }
    __syncthreads();
    for (int q = 0; q < 8; ++q) {
        const int idx = tid * 8 + q, d = idx >> 8, cp = (idx >> 4) & 15, c = idx & 15; float acc = 0.f;
        for (int p = 0; p < 64; ++p) { const float cr = Cr[cp * 64 + p], ci = Ci[cp * 64 + p], pr = pwr[d * 64 + p], pi = pwi[d * 64 + p];
            const float zr = cr * pr - ci * pi, zi = cr * pi + ci * pr; acc += zr * Bbr[p * 16 + c] - zi * Bbi[p * 16 + c]; }
        Kd[idx] = acc;
    }
    __syncthreads();
    f16* ops = (f16*)(F.ws + WS_SSMOP) + (size_t)g * 131072;
    f16* Top = ops; f16* We = ops + 65536; f16* Wc = ops + 65536 + 32768;
    for (int v = tid; v < 8192; v += NTHREADS) {
        const int row = v >> 5, kv = v & 31, j = kv >> 1, half = kv & 1, i = row >> 4, cp = row & 15; h8 o;
#pragma unroll
        for (int e = 0; e < 8; ++e) o[e] = (j <= i) ? (f16)Kd[((i - j) * 16 + cp) * 16 + 8 * half + e] : (f16)0.f;
        *(h8*)(Top + row * 256 + kv * 8) = o;
    }
    for (int v = tid; v < 4096; v += NTHREADS) {
        const int sx = v >> 5, kv = v & 31, j = kv >> 1, half = kv & 1, p = sx & 63; const float pr = pwr[(15 - j) * 64 + p], pi = pwi[(15 - j) * 64 + p]; h8 o;
#pragma unroll
        for (int e = 0; e < 8; ++e) { const float br = Bbr[p * 16 + 8 * half + e], bi = Bbi[p * 16 + 8 * half + e]; o[e] = (f16)(sx < 64 ? pr * br - pi * bi : pr * bi + pi * br); }
        *(h8*)(We + sx * 256 + kv * 8) = o;
    }
    for (int v = tid; v < 4096; v += NTHREADS) {
        const int row = v >> 4, kv = v & 15, i = row >> 4, cp = row & 15; h8 o;
#pragma unroll
        for (int e = 0; e < 8; ++e) { const int sx = 8 * kv + e, p = sx & 63; const float cr = Cr[cp * 64 + p], ci = Ci[cp * 64 + p], pr = pwr[(i + 1) * 64 + p], pi = pwi[(i + 1) * 64 + p];
            o[e] = (f16)(sx < 64 ? cr * pr - ci * pi : -(cr * pi + ci * pr)); }
        *(h8*)(Wc + row * 128 + kv * 8) = o;
    }
    __syncthreads();
}

__device__ __forceinline__ void p0_prologue(Frame& F) {
    const Args& A = *F.a;
    if (blockIdx.x < NG) ssm_precompute(F, (int)blockIdx.x);
    LAS float* scr = (LAS float*)(F.lds + F.wave * 16384);
    constexpr int I0 = 16 * 64, I1 = 8 * 32, I2 = 16 * 32, I3 = 16 * 32, I4 = 4 * 32, I5 = NE * 16 * 64, I6 = NE * 16 * 32;
    constexpr int NIT = I0 + I1 + I2 + I3 + I4 + I5;
    for (int it = F.gw; it < NIT; it += F.NGW) {
        int r = it;
        if (r < I0) { tr_item(A.in[I_WIN], 1024, 2048, (f16*)(F.ws + WS_WIN), r, 0, nullptr, scr, F.lane); continue; } r -= I0;
        if (r < I1) { tr_item(A.in[I_WGLU], 512, 1024, (f16*)(F.ws + WS_WGLU), r, 1, nullptr, scr, F.lane); continue; } r -= I1;
        if (r < I2) { tr_item(A.in[I_WOUT], 1024, 1024, (f16*)(F.ws + WS_WOUT), r, 2, A.in[I_SSMG], scr, F.lane); continue; } r -= I2;
        if (r < I3) { tr_item(A.in[I_WPG], 1024, 1024, (f16*)(F.ws + WS_WPG), r, 0, nullptr, scr, F.lane); continue; } r -= I3;
        if (r < I4) { tr_item(A.in[I_WPP], 256, 1024, (f16*)(F.ws + WS_WPP), r, 0, nullptr, scr, F.lane); continue; } r -= I4;
        if (r < I5) { const int e = r / (16 * 64), ii = r % (16 * 64);
            tr_item(A.in[I_WGU] + (size_t)e * 1024 * 2048, 1024, 2048, (f16*)(F.ws + WS_WGU + (size_t)e * 2048 * 1024), ii, 3, nullptr, scr, F.lane); continue; }
    }
    const size_t gt = (size_t)blockIdx.x * NTHREADS + F.tid, NT = (size_t)F.G * NTHREADS;
    { const f32x4* s = (const f32x4*)A.in[I_X]; h8* d = (h8*)(F.ws + WS_XH);
      for (size_t i = gt; i < (size_t)T * DM / 8; i += NT) { const f32x4 a = s[2 * i], b = s[2 * i + 1]; h8 o; o[0] = (f16)a[0]; o[1] = (f16)a[1]; o[2] = (f16)a[2]; o[3] = (f16)a[3]; o[4] = (f16)b[0]; o[5] = (f16)b[1]; o[6] = (f16)b[2]; o[7] = (f16)b[3]; d[i] = o; } }
    { const f32x4* s = (const f32x4*)A.in[I_P]; h8* d = (h8*)(F.ws + WS_PH);
      for (size_t i = gt; i < (size_t)T * PLE / 8; i += NT) { const f32x4 a = s[2 * i], b = s[2 * i + 1]; h8 o; o[0] = (f16)a[0]; o[1] = (f16)a[1]; o[2] = (f16)a[2]; o[3] = (f16)a[3]; o[4] = (f16)b[0]; o[5] = (f16)b[1]; o[6] = (f16)b[2]; o[7] = (f16)b[3]; d[i] = o; } }
}

__device__ __forceinline__ void p1_inproj(Frame& F) {
    { ProbInproj P{(const char*)(F.ws + WS_XH), (const char*)(F.ws + WS_WIN), (f16*)(F.ws + WS_QH), (f16*)(F.ws + WS_KT), (f16*)(F.ws + WS_VT), (f16*)(F.ws + WS_UG), F.ctl + CW_KMAX};
      pg8::DenseOrder S; S.init(T, DIN, F.G, (int)blockIdx.x); pg8::gemm_phase(F.lds, P, S); }
}

constexpr int ATT_SLOT = 32768, ATT_FLAGS = 3 * ATT_SLOT;
constexpr float ATT_SKIP = -40.0f;
constexpr int ATT_SG = 143360;
__device__ __forceinline__ int attn_unit(Frame& F, int b, int hd, int qb, float lam, gu32* qc, volatile LAS int* slot) {
    const int lane = F.lane, wave = F.wave, r32 = lane & 31, hi = lane >> 5;
    LAS unsigned char* lds = F.lds;
    const f16* qh = (const f16*)(F.ws + WS_QH);
    const f16* ktb = (const f16*)(F.ws + WS_KT) + (size_t)((b * 8 + hd) * 128) * 4096;
    const f16* vtb = (const f16*)(F.ws + WS_VT) + (size_t)((b * 8 + hd) * 128) * 4096;
    f16* mix = (f16*)(F.ws + WS_MIX);
    const int q0 = qb * 256, q0w = q0 + 32 * wave, NT = 4 * (qb + 1), NI = NT / 2; const size_t rowbase = (size_t)b * SEQ;
    volatile LAS int* flags = (volatile LAS int*)(lds + ATT_FLAGS);
#define ATT_ISSUE(ii) do { const int t0_ = NT - 1 - 2 * (ii); const unsigned so_ = (unsigned)(((ii) % 3) * ATT_SLOT + wave * 1024); \
        __builtin_amdgcn_global_load_lds((const unsigned*)(ktb + (size_t)t0_ * 4096 + wave * 512 + lane * 8), (LAS unsigned*)(lds + so_), 16, 0, 0); \
        __builtin_amdgcn_global_load_lds((const unsigned*)(vtb + (size_t)t0_ * 4096 + wave * 512 + lane * 8), (LAS unsigned*)(lds + so_ + 8192), 16, 0, 0); \
        __builtin_amdgcn_global_load_lds((const unsigned*)(ktb + (size_t)(t0_ - 1) * 4096 + wave * 512 + lane * 8), (LAS unsigned*)(lds + so_ + 16384), 16, 0, 0); \
        __builtin_amdgcn_global_load_lds((const unsigned*)(vtb + (size_t)(t0_ - 1) * 4096 + wave * 512 + lane * 8), (LAS unsigned*)(lds + so_ + 24576), 16, 0, 0); } while (0)
    ATT_ISSUE(0); ATT_ISSUE(1);
    if (lane == 0) { flags[wave] = 1; flags[8 + wave] = 1; }
    h8 qf[2][2];
#pragma unroll
    for (int mp = 0; mp < 2; ++mp)
#pragma unroll
        for (int kk = 0; kk < 2; ++kk) qf[mp][kk] = *(const h8*)(qh + (rowbase + q0w + r32) * 512 + hd * 64 + mp * 32 + kk * 16 + hi * 8);
    float sb1, sb2;
    { float n1 = 0.f, n2 = 0.f;
#pragma unroll
      for (int kk = 0; kk < 2; ++kk)
#pragma unroll
          for (int e = 0; e < 8; ++e) { const float a = (float)qf[0][kk][e], c = (float)qf[1][kk][e]; n1 += a * a; n2 += c * c; }
      n1 = swap_add(n1); n2 = swap_add(n2);
      const float k1 = __uint_as_float(__hip_atomic_load(F.ctl + CW_KMAX + (b * 8 + hd) * 2, RLX_AGENT)), k2 = __uint_as_float(__hip_atomic_load(F.ctl + CW_KMAX + (b * 8 + hd) * 2 + 1, RLX_AGENT));
      sb1 = sqrtf(n1) * k1 * 1.01f; sb2 = sqrtf(n2) * k2 * 1.01f; }
    const float slope2 = exp2f(-(float)(hd + 1)) * LOG2E;
    const int td = q0w >> 6, wo = q0w & 63;
    const f16 s_hi = (f16)slope2, s_lo = (f16)(slope2 - (float)s_hi);
    float mr1 = 0.f, mr2 = 0.f, l1 = 0.f, l2 = 0.f;
    h8 qx1, qx2;
    { h8 z; z[0] = (f16)(64.0f * (float)s_hi); z[1] = s_hi; z[2] = (f16)(64.0f * (float)s_lo); z[3] = s_lo; z[4] = (f16)0.f; z[5] = (f16)0.f; z[6] = (f16)0.f; z[7] = (f16)0.f;
      if (hi) { z[0] = (f16)0.f; z[1] = (f16)0.f; z[2] = (f16)0.f; z[3] = (f16)0.f; }
      qx1 = z; qx2 = z; }
    f32x16 o1[2], o2[2];
#pragma unroll
    for (int i = 0; i < 2; ++i) { o1[i] = (f32x16){}; o2[i] = (f32x16){}; }
    bool wdone = false, started = false;
    h2 ones; ones[0] = (f16)1.f; ones[1] = (f16)1.f;
#pragma unroll 1
    for (int ii = 0; ii < NI; ++ii) {
        if (ii + 1 < NI) asm volatile("s_waitcnt vmcnt(4) lgkmcnt(0)" ::: "memory"); else asm volatile("s_waitcnt vmcnt(0) lgkmcnt(0)" ::: "memory");
        __builtin_amdgcn_s_barrier();
        asm volatile("" ::: "memory");
        { const volatile LAS int* fl = flags + 8 * (ii & 1); const int any = fl[0] | fl[1] | fl[2] | fl[3] | fl[4] | fl[5] | fl[6] | fl[7];
          if (__builtin_amdgcn_readfirstlane(any) == 0) break; }
        if (ii + 2 < NI) ATT_ISSUE(ii + 2);
        bool need = !wdone;
        const int T0 = NT - 1 - 2 * ii, T1 = T0 - 1;
        if (T1 <= td && !wdone) {
            const bool first = !started; started = true;
            const LAS unsigned char* kp = lds + (ii % 3) * ATT_SLOT;
            const LAS unsigned char* kbase = kp + (hi * 512 + r32 * 8) * 2;
            const LAS unsigned char* vbase = kp + 8192 + (hi * 512 + r32 * 8) * 2;
            const float bmax = slope2 * (float)(64 * (T0 - td) + 63 - wo);
            const bool gen = first || T0 >= td || (__any(fmaxf(sb1 - mr1, sb2 - mr2) + bmax > 12.0f) != 0);
            const bool tlo = T0 > td;
            f32x16 s0[2], s1[2]; h8 kfr[4], vfr[6], pf[4], kxa, kxb; float ls;
#define ATT_SB __builtin_amdgcn_sched_barrier(0)
#define ATT_KX(tl) do { const f16 tr_ = (f16)(float)(T0 - (tl) - td); const f16 wa_ = (f16)(float)(r32 - wo), wb_ = (f16)(float)(32 + r32 - wo); h8 za, zb; \
                za[0] = tr_; za[1] = wa_; za[2] = tr_; za[3] = wa_; za[4] = (f16)1.f; za[5] = (f16)0.f; za[6] = (f16)0.f; za[7] = (f16)0.f; \
                zb[0] = tr_; zb[1] = wb_; zb[2] = tr_; zb[3] = wb_; zb[4] = (f16)1.f; zb[5] = (f16)0.f; zb[6] = (f16)0.f; zb[7] = (f16)0.f; \
                if (hi) { za[0] = (f16)0.f; za[1] = (f16)0.f; za[2] = (f16)0.f; za[3] = (f16)0.f; za[4] = (f16)0.f; zb[0] = (f16)0.f; zb[1] = (f16)0.f; zb[2] = (f16)0.f; zb[3] = (f16)0.f; zb[4] = (f16)0.f; } \
                kxa = za; kxb = zb; } while (0)
#define ATT_KLD(mp, tl) do { _Pragma("unroll") for (int kb = 0; kb < 2; ++kb) _Pragma("unroll") for (int j = 0; j < 2; ++j) \
                kfr[kb * 2 + j] = *(const LAS h8*)(kbase + (tl) * 16384 + ((mp) * 4 + j * 2) * 1024 + kb * 512); } while (0)
#define ATT_VLD(d, tl, sx, dh) vfr[d] = *(const LAS h8*)(vbase + (tl) * 16384 + (sx) * 2048 + (dh) * 512)
#define ATT_QKM(sn, mpn, qxn, j) do { if ((j) == 0) sn[0] = __builtin_amdgcn_mfma_f32_32x32x16_f16(kxa, qxn, (f32x16){}, 0, 0, 0); \
                else if ((j) == 1) sn[1] = __builtin_amdgcn_mfma_f32_32x32x16_f16(kxb, qxn, (f32x16){}, 0, 0, 0); \
                else if ((j) == 2) sn[0] = __builtin_amdgcn_mfma_f32_32x32x16_f16(kfr[0], qf[mpn][0], sn[0], 0, 0, 0); \
                else if ((j) == 3) sn[1] = __builtin_amdgcn_mfma_f32_32x32x16_f16(kfr[2], qf[mpn][0], sn[1], 0, 0, 0); \
                else if ((j) == 4) sn[0] = __builtin_amdgcn_mfma_f32_32x32x16_f16(kfr[1], qf[mpn][1], sn[0], 0, 0, 0); \
                else sn[1] = __builtin_amdgcn_mfma_f32_32x32x16_f16(kfr[3], qf[mpn][1], sn[1], 0, 0, 0); } while (0)
#define ATT_EXPH(sc, h) do { const float a0_ = __builtin_amdgcn_exp2f(sc[(h) >> 3][2 * ((h) & 7)]), a1_ = __builtin_amdgcn_exp2f(sc[(h) >> 3][2 * ((h) & 7) + 1]); \
                h2 p_; p_[0] = (f16)a0_; p_[1] = (f16)a1_; pf[(h) >> 2][2 * ((h) & 3)] = p_[0]; pf[(h) >> 2][2 * ((h) & 3) + 1] = p_[1]; \
                if (((h) & 1) == 0) hacc = p_; else { hacc = hacc + p_; asm volatile("v_dot2c_f32_f16 %0, %1, %2" : "+v"(ls) : "v"(hacc), "v"(ones)); } } while (0)
#define ATT_PLAINQK(sn, mpn, qxn) do { ATT_QKM(sn, mpn, qxn, 0); ATT_QKM(sn, mpn, qxn, 1); ATT_QKM(sn, mpn, qxn, 2); ATT_QKM(sn, mpn, qxn, 3); ATT_QKM(sn, mpn, qxn, 4); ATT_QKM(sn, mpn, qxn, 5); } while (0)
#define ATT_GENI(sc, mr, l, o, qx, tile, FIRST) do { \
                if ((tile) >= td) { _Pragma("unroll") for (int kb = 0; kb < 2; ++kb) _Pragma("unroll") for (int r = 0; r < 16; ++r) { const int kpos = 64 * (tile) + 32 * kb + crow(r, hi); if (kpos > q0w + r32) sc[kb][r] = -1e30f; } } \
                float rm = sc[0][0]; \
                _Pragma("unroll") for (int kb = 0; kb < 2; ++kb) _Pragma("unroll") for (int r = 0; r < 16; ++r) rm = fmaxf(rm, sc[kb][r]); \
                rm = swap_max(rm); \
                if ((FIRST) || __any(rm > 4.0f) != 0) { const float d = (FIRST) ? rm : fmaxf(rm, 0.f); const float f = __builtin_amdgcn_exp2f(-d); \
                    _Pragma("unroll") for (int kb = 0; kb < 2; ++kb) _Pragma("unroll") for (int r = 0; r < 16; ++r) sc[kb][r] -= d; \
                    mr += d; l *= f; o[0] *= f; o[1] *= f; if (!hi) qx[4] = (f16)(-mr); } } while (0)
#define ATT_BLOCK(sc, l, o, tlc, HASN, sn, mpn, qxn, NKLD) do { ls = 0.f; h2 hacc; \
                if (HASN) ATT_QKM(sn, mpn, qxn, 0); ATT_EXPH(sc, 0); ATT_SB; \
                if (HASN) ATT_QKM(sn, mpn, qxn, 1); ATT_EXPH(sc, 1); ATT_SB; \
                if (HASN) ATT_QKM(sn, mpn, qxn, 2); ATT_EXPH(sc, 2); ATT_VLD(0, tlc, 0, 0); ATT_VLD(1, tlc, 0, 1); ATT_SB; \
                if (HASN) ATT_QKM(sn, mpn, qxn, 3); ATT_EXPH(sc, 3); ATT_VLD(2, tlc, 1, 0); ATT_VLD(3, tlc, 1, 1); ATT_SB; \
                if (HASN) ATT_QKM(sn, mpn, qxn, 4); ATT_EXPH(sc, 4); ATT_VLD(4, tlc, 2, 0); ATT_VLD(5, tlc, 2, 1); ATT_SB; \
                if (HASN) ATT_QKM(sn, mpn, qxn, 5); ATT_EXPH(sc, 5); ATT_SB; \
                o[0] = __builtin_amdgcn_mfma_f32_32x32x16_f16(vfr[0], pf[0], o[0], 0, 0, 0); ATT_EXPH(sc, 6); ATT_EXPH(sc, 7); ATT_SB; \
                o[1] = __builtin_amdgcn_mfma_f32_32x32x16_f16(vfr[1], pf[0], o[1], 0, 0, 0); ATT_EXPH(sc, 8); NKLD; ATT_SB; \
                o[0] = __builtin_amdgcn_mfma_f32_32x32x16_f16(vfr[2], pf[1], o[0], 0, 0, 0); ATT_EXPH(sc, 9); ATT_EXPH(sc, 10); ATT_VLD(0, tlc, 3, 0); ATT_VLD(1, tlc, 3, 1); ATT_SB; \
                o[1] = __builtin_amdgcn_mfma_f32_32x32x16_f16(vfr[3], pf[1], o[1], 0, 0, 0); ATT_EXPH(sc, 11); ATT_SB; \
                o[0] = __builtin_amdgcn_mfma_f32_32x32x16_f16(vfr[4], pf[2], o[0], 0, 0, 0); ATT_EXPH(sc, 12); ATT_EXPH(sc, 13); ATT_SB; \
                o[1] = __builtin_amdgcn_mfma_f32_32x32x16_f16(vfr[5], pf[2], o[1], 0, 0, 0); ATT_EXPH(sc, 14); ATT_EXPH(sc, 15); ATT_SB; \
                o[0] = __builtin_amdgcn_mfma_f32_32x32x16_f16(vfr[0], pf[3], o[0], 0, 0, 0); ATT_SB; \
                o[1] = __builtin_amdgcn_mfma_f32_32x32x16_f16(vfr[1], pf[3], o[1], 0, 0, 0); ATT_SB; \
                l += ls; } while (0)
            if (!tlo) {
                ATT_KX(0); ATT_KLD(0, 0); ATT_PLAINQK(s0, 0, qx1); ATT_SB; ATT_KLD(1, 0); ATT_SB;
                if (gen) ATT_GENI(s0, mr1, l1, o1, qx1, T0, first);
                ATT_BLOCK(s0, l1, o1, 0, true, s1, 1, qx2, ATT_KLD(0, 1));
                ATT_KX(1);
                if (gen) ATT_GENI(s1, mr2, l2, o2, qx2, T0, first);
                ATT_BLOCK(s1, l2, o2, 0, true, s0, 0, qx1, ATT_KLD(1, 1));
            } else {
                ATT_KX(1); ATT_KLD(0, 1); ATT_PLAINQK(s0, 0, qx1); ATT_SB; ATT_KLD(1, 1); ATT_SB;
            }
            { const bool f2 = first && tlo;
              if (gen) ATT_GENI(s0, mr1, l1, o1, qx1, T1, f2);
              ATT_BLOCK(s0, l1, o1, 1, true, s1, 1, qx2, (void)0);
              if (gen) ATT_GENI(s1, mr2, l2, o2, qx2, T1, f2);
              ATT_BLOCK(s1, l2, o2, 1, false, s0, 0, qx1, (void)0); }
#undef ATT_SB
#undef ATT_KX
#undef ATT_KLD
#undef ATT_VLD
#undef ATT_QKM
#undef ATT_EXPH
#undef ATT_PLAINQK
#undef ATT_GENI
#undef ATT_BLOCK
            const float far = fmaxf(sb1 - mr1, sb2 - mr2) + slope2 * (float)(64 * T1 - 1 - q0w);
            need = (T1 >= 1) && (__any(far >= ATT_SKIP) != 0);
            if (!need) wdone = true;
        }
        if (lane == 0) flags[8 * ((ii + 1) & 1) + wave] = need ? 1 : 0;
    }
    asm volatile("s_waitcnt vmcnt(0) lgkmcnt(0)" ::: "memory");
    __builtin_amdgcn_s_barrier();
    asm volatile("" ::: "memory");
#undef ATT_ISSUE
    unsigned nxt = 0;
    if (F.tid == 0) nxt = __hip_atomic_fetch_add(qc, 1u, RLX_AGENT);
    l1 = swap_add(l1); l2 = swap_add(l2);
    const float i1 = 1.0f / l1, i2 = lam / l2;
    float ss = 0.f;
#pragma unroll
    for (int dh = 0; dh < 2; ++dh)
#pragma unroll
        for (int r = 0; r < 16; ++r) { const float v = o1[dh][r] * i1 - o2[dh][r] * i2; o1[dh][r] = v; ss += v * v; }
    ss = swap_add(ss);
    const float rs = rsqrtf(ss * (1.0f / 64.0f) + RMS_EPS) * 0.8f;
    const LAS float* sg = (const LAS float*)(lds + ATT_SG);
    f16* orow = mix + (rowbase + q0w + r32) * 1024 + 512 + hd * 64;
#pragma unroll
    for (int dh = 0; dh < 2; ++dh)
#pragma unroll
        for (int gq = 0; gq < 4; ++gq) {
            const int dv = 32 * dh + 8 * gq + 4 * hi; const f32x4 gg = *(const LAS f32x4*)(sg + dv);
            h4 o; o[0] = (f16)(o1[dh][4 * gq] * rs * gg[0]); o[1] = (f16)(o1[dh][4 * gq + 1] * rs * gg[1]); o[2] = (f16)(o1[dh][4 * gq + 2] * rs * gg[2]); o[3] = (f16)(o1[dh][4 * gq + 3] * rs * gg[3]);
            *(h4*)(orow + dv) = o;
        }
    if (F.tid == 0) slot[0] = (int)nxt;
    __syncthreads();
    const int nit = __builtin_amdgcn_readfirstlane(slot[0]);
    __syncthreads();
    return nit;
}

constexpr int SSM_UROW = 528, SSM_EROW = 528, SSM_XROW = 272;
constexpr int SSM_U0 = 0, SSM_U1 = 64 * SSM_UROW, SSM_E = 2 * 64 * SSM_UROW, SSM_XP = SSM_E + 64 * SSM_EROW;
typedef float f32x4_t __attribute__((ext_vector_type(4)));
__device__ __forceinline__ void ssm_unit(Frame& F, int b, int g) {
    const Args& A = *F.a; const int tid = F.tid, wave = F.wave, lane = F.lane, fr = lane & 15, fq = lane >> 4;
    const f16* ops = (const f16*)(F.ws + WS_SSMOP) + (size_t)g * 131072;
    const f16* Top = ops; const f16* We = ops + 65536; const f16* Wc = ops + 65536 + 32768;
    const char* ugb = (const char*)((const f16*)(F.ws + WS_UG) + (size_t)((b * 32 + g) * 8192) * 16);
    f16* yh = (f16*)(F.ws + WS_YH) + (size_t)b * SEQ * 512 + g * 16;
    LAS unsigned char* lds = F.lds;
    h8 BY[2][12];
#pragma unroll
    for (int n2 = 0; n2 < 2; ++n2) {
        const int nrow = 16 * (2 * wave + n2) + fr;
#pragma unroll
        for (int kk = 0; kk < 8; ++kk) BY[n2][kk] = *(const h8*)(Top + nrow * 256 + 32 * kk + 8 * fq);
#pragma unroll
        for (int kk = 0; kk < 4; ++kk) BY[n2][8 + kk] = *(const h8*)(Wc + nrow * 128 + 32 * kk + 8 * fq);
    }
    const float* a16 = (const float*)(F.ws + WS_A16) + (g * 64 + lane) * 2;
    const float a16r = a16[0], a16i = a16[1];
    const f32x4 dsk = *(const f32x4*)(A.in[I_SSMD] + g * 16 + 4 * fq);
    float xr = 0.f, xi = 0.f;
#pragma unroll
    for (int q = 0; q < 4; ++q) { const int o = (q * NTHREADS + tid) * 16; const h8 v = *(const h8*)(ugb + o); *(LAS h8*)(lds + SSM_U0 + (o >> 9) * SSM_UROW + (o & 511)) = v; }
    __syncthreads();
#pragma unroll 1
    for (int seg = 0; seg < 8; ++seg) {
        LAS unsigned char* Uc = lds + ((seg & 1) ? SSM_U1 : SSM_U0);
        LAS unsigned char* Un = lds + ((seg & 1) ? SSM_U0 : SSM_U1);
        {
            f32x4 ea[4]; h8 BE[8];
#pragma unroll
            for (int kk = 0; kk < 8; ++kk) BE[kk] = *(const h8*)(We + (16 * wave + fr) * 256 + 32 * kk + 8 * fq);
#pragma unroll
            for (int mt = 0; mt < 4; ++mt) ea[mt] = (f32x4){0.f, 0.f, 0.f, 0.f};
#pragma unroll
            for (int kk = 0; kk < 8; ++kk)
#pragma unroll
                for (int mt = 0; mt < 4; ++mt) { const h8 a = *(const LAS h8*)(Uc + (16 * mt + fr) * SSM_UROW + (32 * kk + 8 * fq) * 2); ea[mt] = __builtin_amdgcn_mfma_f32_16x16x32_f16(BE[kk], a, ea[mt], 0, 0, 0); }
#pragma unroll
            for (int mt = 0; mt < 4; ++mt) *(LAS f32x4*)(lds + SSM_E + (16 * mt + fr) * SSM_EROW + (16 * wave + 4 * fq) * 4) = ea[mt];
        }
        __syncthreads();
        if (wave == 0) {
#pragma unroll 8
            for (int n = 0; n < 64; ++n) {
                const float er = *(const LAS float*)(lds + SSM_E + n * SSM_EROW + lane * 4), ei = *(const LAS float*)(lds + SSM_E + n * SSM_EROW + (64 + lane) * 4);
                *(LAS f16*)(lds + SSM_XP + n * SSM_XROW + lane * 2) = (f16)xr; *(LAS f16*)(lds + SSM_XP + n * SSM_XROW + (64 + lane) * 2) = (f16)xi;
                const float nr = a16r * xr - a16i * xi + er, ni = a16r * xi + a16i * xr + ei; xr = nr; xi = ni;
            }
        } else if (seg < 7) {
            const char* src = ugb + (size_t)(seg + 1) * 32768;
            for (int v = tid - 64; v < 2048; v += NTHREADS - 64) { const int o = v * 16; const h8 x = *(const h8*)(src + o); *(LAS h8*)(Un + (o >> 9) * SSM_UROW + (o & 511)) = x; }
        }
        __syncthreads();
        {
            f32x4 ya[4][2];
#pragma unroll
            for (int mt = 0; mt < 4; ++mt) { ya[mt][0] = (f32x4){0.f, 0.f, 0.f, 0.f}; ya[mt][1] = (f32x4){0.f, 0.f, 0.f, 0.f}; }
#pragma unroll
            for (int kk = 0; kk < 12; ++kk)
#pragma unroll
                for (int mt = 0; mt < 4; ++mt) {
                    const h8 a = kk < 8 ? *(const LAS h8*)(Uc + (16 * mt + fr) * SSM_UROW + (32 * kk + 8 * fq) * 2) : *(const LAS h8*)(lds + SSM_XP + (16 * mt + fr) * SSM_XROW + (32 * (kk - 8) + 8 * fq) * 2);
                    ya[mt][0] = __builtin_amdgcn_mfma_f32_16x16x32_f16(BY[0][kk], a, ya[mt][0], 0, 0, 0);
                    ya[mt][1] = __builtin_amdgcn_mfma_f32_16x16x32_f16(BY[1][kk], a, ya[mt][1], 0, 0, 0);
                }
#pragma unroll
            for (int mt = 0; mt < 4; ++mt)
#pragma unroll
                for (int n2 = 0; n2 < 2; ++n2) {
                    const int ch = 16 * mt + fr, ti = 2 * wave + n2; const size_t tok = (size_t)(seg * 64 + ch) * 16 + ti;
                    const h4 u4 = *(const LAS h4*)(Uc + ch * SSM_UROW + (ti * 16 + 4 * fq) * 2);
                    h4 o;
#pragma unroll
                    for (int e = 0; e < 4; ++e) o[e] = (f16)gelu_tanh(ya[mt][n2][e] + dsk[e] * (float)u4[e]);
                    *(h4*)(yh + tok * 512 + 4 * fq) = o;
                }
        }
    }
    __syncthreads();
}

__device__ __forceinline__ void p2_mixers(Frame& F, int pass) {
    const Args& A = *F.a;
    gu32* qctr = F.ctl + CW_QUEUE + 128 * pass;
    constexpr int NSSM = BATCH * NG, NATT = BATCH * NH * 32;
    volatile LAS int* slot = (volatile LAS int*)(F.lds + LDS_BARST + 16);
    for (;;) {
        if (F.tid == 0) slot[0] = (int)__hip_atomic_fetch_add(qctr, 1u, RLX_AGENT);
        __syncthreads();
        const int it = __builtin_amdgcn_readfirstlane(slot[0]);
        __syncthreads();
        if (it >= NSSM) break;
        if (pass == 1 && PROBE_SEL != 0 && PROBE_SEL != 1) continue;
        ssm_unit(F, it / NG, it % NG);
    }
    asm volatile("" ::: "memory");
    float lam;
    { float d1 = 0.f, d2 = 0.f;
#pragma unroll 1
      for (int i = 0; i < 32; ++i) { d1 += A.in[I_LQ1][i] * A.in[I_LK1][i]; d2 += A.in[I_LQ2][i] * A.in[I_LK2][i]; }
      lam = __expf(d1) - __expf(d2) + 0.2f; }
    asm volatile("" : "+v"(lam));
    if (F.tid < 64) *(LAS float*)(F.lds + ATT_SG + F.tid * 4) = A.in[I_SUBLN][F.tid];
    int ait;
    { if (F.tid == 0) slot[0] = (int)__hip_atomic_fetch_add(qctr + 64, 1u, RLX_AGENT);
      __syncthreads();
      ait = __builtin_amdgcn_readfirstlane(slot[0]);
      __syncthreads(); }
    while (ait < NATT) {
        const int qb = 31 - ait / 32, bh = ait % 32;
        if (pass == 1 && PROBE_SEL != 0) { const int hd_ = bh & 7; const bool sel = PROBE_SEL == 2 ? hd_ >= 6 : PROBE_SEL == 3 ? hd_ <= 3 : PROBE_SEL == 4 ? (hd_ == 7 && qb == 31) : PROBE_SEL == 5 ? (hd_ == 4 || hd_ == 5) : false;
            if (!sel) { if (F.tid == 0) slot[0] = (int)__hip_atomic_fetch_add(qctr + 64, 1u, RLX_AGENT); __syncthreads(); ait = __builtin_amdgcn_readfirstlane(slot[0]); __syncthreads(); continue; } }
        ait = attn_unit(F, bh >> 3, bh & 7, qb, lam, qctr + 64, slot);
    }
    constexpr int NPLE = (T / 256) * 4, WDN_ITEMS = NE * 16 * 32, WDN_CHUNK = 32, NWDN = WDN_ITEMS / WDN_CHUNK;
    gu32* fctr = F.ctl + CW_QUEUE + 256 + 64 * pass;
    for (;;) {
        if (F.tid == 0) slot[0] = (int)__hip_atomic_fetch_add(fctr, 1u, RLX_AGENT);
        __syncthreads();
        const int it = __builtin_amdgcn_readfirstlane(slot[0]);
        __syncthreads();
        if (it >= NPLE + NWDN) break;
        if (it < NPLE) {
            ProbPleProj P{(const char*)(F.ws + WS_PH), (const char*)(F.ws + WS_WPP), (f16*)(F.ws + WS_PE)};
            pg8::OneOrder S; S.u.pm = it >> 2; S.u.pn = it & 3; S.u.e = 0; S.u.cnt = 0; pg8::gemm_phase(F.lds, P, S);
        } else {
            LAS float* scr = (LAS float*)(F.lds + F.wave * 16384);
#pragma unroll 1
            for (int j = 0; j < WDN_CHUNK / 8; ++j) { const int r = (it - NPLE) * WDN_CHUNK + j * 8 + F.wave; const int e = r / (16 * 32), ii = r % (16 * 32);
                tr_item(A.in[I_WDN] + (size_t)e * 1024 * 1024, 1024, 1024, (f16*)(F.ws + WS_WDN + (size_t)e * 1024 * 1024), ii, 4, nullptr, scr, F.lane); }
        }
        __syncthreads();
    }
}

__device__ __forceinline__ void p3_glu(Frame& F) {
    ProbGlu P{(const char*)(F.ws + WS_YH), (const char*)(F.ws + WS_WGLU), (f16*)(F.ws + WS_MIX)};
    pg8::DenseOrder S; S.init(T, 1024, F.G, (int)blockIdx.x); pg8::gemm_phase(F.lds, P, S);
}

__device__ __forceinline__ void p4_outproj(Frame& F) {
    ProbOut P{(const char*)(F.ws + WS_MIX), (const char*)(F.ws + WS_WOUT), (f16*)(F.ws + WS_MIXO)};
    pg8::DenseOrder S; S.init(T, DM, F.G, (int)blockIdx.x); pg8::gemm_phase(F.lds, P, S);
}

constexpr int RT_XROW = 2064;
constexpr int RT_XHI = 0, RT_XLO = 32 * RT_XROW;
constexpr int RT_PART = 0;
constexpr int RT_FIN = 2 * 32 * RT_XROW;
constexpr int RT_CNT = RT_FIN + 32 * 33 * 4;
__device__ __forceinline__ void p5_router(Frame& F, int pass) {
    const Args& A = *F.a; const int tid = F.tid, lane = F.lane, wave = F.wave, r32 = lane & 31, hi = lane >> 5;
    LAS unsigned char* lds = F.lds;
    LAS unsigned* lcnt = (LAS unsigned*)(lds + RT_CNT); LAS unsigned* lbase = lcnt + 32; LAS unsigned* asg = lcnt + 64;
    if (tid < 32) lcnt[tid] = 0u;
    const float* xin = A.in[I_X]; const f16* mixo = (const f16*)(F.ws + WS_MIXO); f16* x1h = (f16*)(F.ws + WS_X1H); unsigned char* x1q = (unsigned char*)(F.ws + WS_X1Q); float* gates = (float*)(F.ws + WS_GATES);
    h8 whi[8], wlo[8];
#pragma unroll
    for (int kk = 0; kk < 8; ++kk)
#pragma unroll
        for (int e = 0; e < 8; ++e) { const float w = A.in[I_WR][(128 * wave + 16 * kk + 8 * hi + e) * 32 + r32]; const f16 h = (f16)w; whi[kk][e] = h; wlo[kk][e] = (f16)(w - (float)h); }
    f32x4 gv[4], bv[4];
#pragma unroll
    for (int jx = 0; jx < 4; ++jx) { gv[jx] = *(const f32x4*)(A.in[I_LN1G] + 256 * jx + 4 * lane); bv[jx] = *(const f32x4*)(A.in[I_LN1B] + 256 * jx + 4 * lane); }
    const int rows_per_blk = T / F.G;
#pragma unroll 1
    for (int bt = 0; bt < rows_per_blk / 32; ++bt) {
        const int row0 = blockIdx.x * rows_per_blk + bt * 32;
#pragma unroll 1
        for (int rr = 0; rr < 4; ++rr) {
            const int lr = wave * 4 + rr; const size_t ro = (size_t)(row0 + lr) * 1024;
            f32x4 v[4]; float s1 = 0.f, s2 = 0.f;
#pragma unroll
            for (int jx = 0; jx < 4; ++jx) { const f32x4 xv = *(const f32x4*)(xin + ro + 256 * jx + 4 * lane); const h4 mv = *(const h4*)(mixo + ro + 256 * jx + 4 * lane);
#pragma unroll
                for (int e = 0; e < 4; ++e) { const float t = ALPHA * xv[e] + (float)mv[e]; v[jx][e] = t; s1 += t; } }
            const float mean = wave_sum(s1) * (1.0f / 1024.0f);
#pragma unroll
            for (int jx = 0; jx < 4; ++jx) { v[jx] = v[jx] - mean; s2 += (v[jx][0] * v[jx][0] + v[jx][1] * v[jx][1]) + (v[jx][2] * v[jx][2] + v[jx][3] * v[jx][3]); }
            const float rstd = rsqrtf(wave_sum(s2) * (1.0f / 1024.0f) + LN_EPS);
#pragma unroll
            for (int jx = 0; jx < 4; ++jx) {
                const f32x4 y = v[jx] * rstd * gv[jx] + bv[jx];
                h4 yh_, yl_;
#pragma unroll
                for (int e = 0; e < 4; ++e) { const f16 h = (f16)y[e]; yh_[e] = h; yl_[e] = (f16)(y[e] - (float)h); }
                *(h4*)(x1h + ro + 256 * jx + 4 * lane) = yh_;
                *(int*)(x1q + ro + 256 * jx + 4 * lane) = pack_fp8x4(y[0], y[1], y[2], y[3]);
                *(LAS h4*)(lds + RT_XHI + lr * RT_XROW + (256 * jx + 4 * lane) * 2) = yh_;
                *(LAS h4*)(lds + RT_XLO + lr * RT_XROW + (256 * jx + 4 * lane) * 2) = yl_;
            }
        }
        __syncthreads();
        f32x16 acc = {};
#pragma unroll
        for (int kk = 0; kk < 8; ++kk) {
            const int ko = (128 * wave + 16 * kk + 8 * hi) * 2;
            const h8 xh_ = *(const LAS h8*)(lds + RT_XHI + r32 * RT_XROW + ko), xl_ = *(const LAS h8*)(lds + RT_XLO + r32 * RT_XROW + ko);
            acc = __builtin_amdgcn_mfma_f32_32x32x16_f16(whi[kk], xh_, acc, 0, 0, 0);
            acc = __builtin_amdgcn_mfma_f32_32x32x16_f16(wlo[kk], xh_, acc, 0, 0, 0);
            acc = __builtin_amdgcn_mfma_f32_32x32x16_f16(whi[kk], xl_, acc, 0, 0, 0);
        }
        __syncthreads();
#pragma unroll
        for (int g = 0; g < 4; ++g) { f32x4 o; o[0] = acc[4 * g]; o[1] = acc[4 * g + 1]; o[2] = acc[4 * g + 2]; o[3] = acc[4 * g + 3];
            *(LAS f32x4*)(lds + RT_PART + (((wave * 32 + r32) * 32) + 8 * g + 4 * hi) * 4) = o; }
        __syncthreads();
        { const int row = tid >> 4, e0 = 2 * (tid & 15); float a0 = A.in[I_BR][e0], a1 = A.in[I_BR][e0 + 1];
#pragma unroll
          for (int w = 0; w < 8; ++w) { a0 += *(const LAS float*)(lds + RT_PART + (((w * 32 + row) * 32) + e0) * 4); a1 += *(const LAS float*)(lds + RT_PART + (((w * 32 + row) * 32) + e0 + 1) * 4); }
          *(LAS float*)(lds + RT_FIN + (row * 33 + e0) * 4) = a0; *(LAS float*)(lds + RT_FIN + (row * 33 + e0 + 1) * 4) = a1; }
        __syncthreads();
        if (tid < 32) {
            const LAS float* lg = (const LAS float*)(lds + RT_FIN + tid * 33 * 4);
            float tv[4]; int te[4];
#pragma unroll
            for (int k = 0; k < 4; ++k) { tv[k] = -INFINITY; te[k] = 0; }
#pragma unroll 1
            for (int e = 0; e < 32; ++e) { const float x = lg[e];
                if (x > tv[3]) {
                    if (x > tv[0]) { tv[3] = tv[2]; te[3] = te[2]; tv[2] = tv[1]; te[2] = te[1]; tv[1] = tv[0]; te[1] = te[0]; tv[0] = x; te[0] = e; }
                    else if (x > tv[1]) { tv[3] = tv[2]; te[3] = te[2]; tv[2] = tv[1]; te[2] = te[1]; tv[1] = x; te[1] = e; }
                    else if (x > tv[2]) { tv[3] = tv[2]; te[3] = te[2]; tv[2] = x; te[2] = e; }
                    else { tv[3] = x; te[3] = e; } } }
            const float e1 = __expf(tv[1] - tv[0]), e2 = __expf(tv[2] - tv[0]), e3 = __expf(tv[3] - tv[0]); const float inv = 1.0f / (1.0f + e1 + e2 + e3);
            const int row = row0 + tid; f32x4 gk; gk[0] = inv; gk[1] = e1 * inv; gk[2] = e2 * inv; gk[3] = e3 * inv;
            *(f32x4*)(gates + (size_t)row * 4) = gk;
#pragma unroll
            for (int k = 0; k < 4; ++k) { const unsigned rk = atomicAdd((unsigned*)&lcnt[te[k]], 1u); asg[(bt * 32 + tid) * 4 + k] = (unsigned)te[k] | (rk << 8); }
        }
        __syncthreads();
    }
    if (F.tid < 32) lbase[F.tid] = __hip_atomic_fetch_add(F.ctl + CW_CNT + 2048 * pass + 64 * F.tid, lcnt[F.tid], RLX_AGENT);
    __syncthreads();
    int* list = (int*)(F.ws + WS_LIST + (size_t)pass * 4 * MiB);
    { const unsigned a = asg[F.tid]; const int e = a & 255, rk = a >> 8; const int row = blockIdx.x * rows_per_blk + (F.tid >> 2);
      list[(size_t)e * ECAP + lbase[e] + rk] = row * 4 + (F.tid & 3); }
    __syncthreads();
}

template <int WHICH> __device__ __forceinline__ void p67_moe(Frame& F) {
    const Args& A = *F.a;
    LAS int* tab = (LAS int*)(F.lds + pg8::STAGE_BYTES + 2048);
    if (F.tid < 32) tab[F.tid] = (int)__hip_atomic_load(F.ctl + CW_CNT + 64 * F.tid, RLX_AGENT);
    __syncthreads();
    if (F.tid == 0) { int sacc = 0; for (int e = 0; e < 32; ++e) { tab[32 + e] = sacc; sacc += (tab[e] + 255) >> 8; } tab[64] = sacc; }
    __syncthreads();
    const int* list = (const int*)(F.ws + WS_LIST);
    if (WHICH == 0) {
        ProbMoeUp P{(const char*)(F.ws + WS_X1Q), (const char*)(F.ws + WS_WGU), list, A.in[I_BGU], (unsigned char*)(F.ws + WS_ACT)};
        pg8::MoeOrder S{tab, 8, F.G, F.vcu}; pg8::gemm_phase(F.lds, P, S);
    } else {
        ProbMoeDn P{(const char*)(F.ws + WS_ACT), (const char*)(F.ws + WS_WDN), list, A.in[I_BDN], (const float*)(F.ws + WS_GATES), (unsigned char*)(F.ws + WS_SLAB)};
        pg8::MoeOrder S{tab, 4, F.G, F.vcu}; pg8::gemm_phase(F.lds, P, S);
    }
    __syncthreads();
}

__device__ __forceinline__ void p8_combine(Frame& F) {
    const int lane = F.lane;
    typedef int i32x2 __attribute__((ext_vector_type(2))); typedef float f32x2 __attribute__((ext_vector_type(2)));
    const f16* x1h = (const f16*)(F.ws + WS_X1H); const unsigned char* slab = (const unsigned char*)(F.ws + WS_SLAB); f16* rh = (f16*)(F.ws + WS_RH);
    for (int row = F.gw; row < T; row += F.NGW) {
#pragma unroll
        for (int j = 0; j < 2; ++j) {
            const size_t o = (size_t)row * 1024 + 512 * j + 8 * lane;
            const h8 xv = *(const h8*)(x1h + o); float v[8], acc[8];
#pragma unroll
            for (int e = 0; e < 8; ++e) { v[e] = ALPHA * (float)xv[e]; acc[e] = 0.f; }
#pragma unroll
            for (int k = 0; k < 4; ++k) { const i32x2 sv = *(const i32x2*)(slab + ((size_t)row * 4 + k) * 1024 + 512 * j + 8 * lane);
#pragma unroll
                for (int q = 0; q < 2; ++q) { const f32x2 lo = __builtin_amdgcn_cvt_pk_f32_fp8(sv[q], false), hi = __builtin_amdgcn_cvt_pk_f32_fp8(sv[q], true);
                    acc[4 * q] += lo[0]; acc[4 * q + 1] += lo[1]; acc[4 * q + 2] += hi[0]; acc[4 * q + 3] += hi[1]; } }
            h8 hh;
#pragma unroll
            for (int e = 0; e < 8; ++e) hh[e] = (f16)(v[e] + acc[e] * (1.0f / SLAB_SCALE));
            *(h8*)(rh + o) = hh;
        }
    }
}

__device__ __forceinline__ void p9_ple(Frame& F) {
    ProbPleGate P{(const char*)(F.ws + WS_RH), (const char*)(F.ws + WS_WPG), (f16*)(F.ws + WS_GATEH)};
    pg8::DenseOrder S; S.init(T, DM, F.G, (int)blockIdx.x); pg8::gemm_phase(F.lds, P, S);
}

__device__ __forceinline__ void p10_ln2(Frame& F) {
    const Args& A = *F.a; const int lane = F.lane; float* out = A.out; const f16* rh = (const f16*)(F.ws + WS_RH); const f16* gateh = (const f16*)(F.ws + WS_GATEH); const f16* pe = (const f16*)(F.ws + WS_PE);
    f32x4 gv[4], bv[4];
#pragma unroll
    for (int j = 0; j < 2; ++j)
#pragma unroll
        for (int q = 0; q < 2; ++q) { gv[2 * j + q] = *(const f32x4*)(A.in[I_LN2G] + 512 * j + 8 * lane + 4 * q); bv[2 * j + q] = *(const f32x4*)(A.in[I_LN2B] + 512 * j + 8 * lane + 4 * q); }
    for (int row = F.gw; row < T; row += F.NGW) {
        f32x4 v[4]; float s = 0.f;
#pragma unroll
        for (int j = 0; j < 2; ++j) { const size_t o_ = (size_t)row * 1024 + 512 * j + 8 * lane; const h8 r8 = *(const h8*)(rh + o_), g8 = *(const h8*)(gateh + o_), p8 = *(const h8*)(pe + o_);
#pragma unroll
            for (int q = 0; q < 2; ++q) { f32x4 t;
#pragma unroll
                for (int e = 0; e < 4; ++e) t[e] = (float)r8[4 * q + e] + (float)g8[4 * q + e] * (float)p8[4 * q + e];
                v[2 * j + q] = t; s += (t[0] + t[1]) + (t[2] + t[3]); } }
        const float mean = wave_sum(s) * (1.0f / 1024.0f); float s2 = 0.f;
#pragma unroll
        for (int j = 0; j < 4; ++j) { v[j] = v[j] - mean; s2 += (v[j][0] * v[j][0] + v[j][1] * v[j][1]) + (v[j][2] * v[j][2] + v[j][3] * v[j][3]); }
        const float rstd = rsqrtf(wave_sum(s2) * (1.0f / 1024.0f) + LN_EPS);
#pragma unroll
        for (int j = 0; j < 2; ++j)
#pragma unroll
            for (int q = 0; q < 2; ++q) *(f32x4*)(out + (size_t)row * 1024 + 512 * j + 8 * lane + 4 * q) = v[2 * j + q] * rstd * gv[2 * j + q] + bv[2 * j + q];
    }
}

__global__ void __launch_bounds__(NTHREADS, 2) fwd_kernel(Args args) {
    extern __shared__ __attribute__((aligned(16))) unsigned char lds_raw[];
    Frame F;
    F.lds = (LAS unsigned char*)lds_raw; F.a = &args; F.ws = args.ws; F.ctl = (gu32*)(args.ws + WS_CTL);
    F.tid = threadIdx.x; F.lane = F.tid & 63; F.wave = __builtin_amdgcn_readfirstlane(F.tid >> 6);
    F.G = gridDim.x; F.gw = blockIdx.x * NWAVES + F.wave; F.NGW = F.G * NWAVES;
    { const int bx = blockIdx.x; F.vcu = (F.G % 8 == 0) ? (bx % 8) * (F.G / 8) + bx / 8 : bx; }
    volatile LAS unsigned* barst = (volatile LAS unsigned*)(F.lds + LDS_BARST);
    if (F.tid < 16) barst[F.tid] = 0u;
    __syncthreads();
    XcdBarrier bar; bar.bar = (unsigned*)(F.ctl + CW_BAR); bar.x = 0; bar.st = nullptr;
    if (MK_N_LAUNCHES == 1) bar = xcd_barrier_post((unsigned*)(F.ctl + CW_BAR), barst);
    const int lo = args.ph_lo, hi = args.ph_hi;
#define IN(k) (lo <= (k) && (k) < hi)
#define SEAM(k) do { if (IN(k) && IN((k) + 1)) xcd_barrier(bar); } while (0)
#define REP(k, body) do { if (IN(k)) { body; if ((PROBE_MASK >> (k)) & 1) { xcd_barrier(bar); body; } } } while (0)
    REP(0, p0_prologue(F)); SEAM(0);
    REP(1, p1_inproj(F)); SEAM(1);
    if (IN(2)) { p2_mixers(F, args.pass); if ((PROBE_MASK >> 2) & 1) { xcd_barrier(bar); p2_mixers(F, 1); } } SEAM(2);
    REP(3, p3_glu(F)); SEAM(3);
    REP(4, p4_outproj(F)); SEAM(4);
    if (IN(5)) { p5_router(F, args.pass); } SEAM(5);
    REP(6, p67_moe<0>(F)); SEAM(6);
    REP(7, p67_moe<1>(F)); SEAM(7);
    REP(8, p8_combine(F)); SEAM(8);
    REP(9, p9_ple(F)); SEAM(9);
    if (IN(10)) { p10_ln2(F); }
#undef REP
#undef IN
#undef SEAM
}
}

extern "C" void kernel_launch(void* const* d_in, const int* in_sizes, int n_in, void* d_out, int out_size, void* d_ws, size_t ws_size, hipStream_t stream) {
    static int grid = 0;
    if (grid == 0) {
        if (n_in != 31 || out_size != T * DM || ws_size < WS_END) { fprintf(stderr, "kernel_launch: unexpected problem (n_in %d, out %d, ws %zu)\n", n_in, out_size, ws_size); grid = -1; return; }
        int dev = 0, cus = 0;
        if (hipGetDevice(&dev) != hipSuccess || hipDeviceGetAttribute(&cus, hipDeviceAttributeMultiprocessorCount, dev) != hipSuccess) { grid = -1; return; }
        if (hipFuncSetAttribute((const void*)fwd_kernel, hipFuncAttributeMaxDynamicSharedMemorySize, LDS_BYTES) != hipSuccess) { fprintf(stderr, "kernel_launch: hipFuncSetAttribute failed\n"); grid = -1; return; }
        int per_cu = 0;
        if (hipOccupancyMaxActiveBlocksPerMultiprocessor(&per_cu, (const void*)fwd_kernel, NTHREADS, LDS_BYTES) != hipSuccess || per_cu < 1) { fprintf(stderr, "kernel_launch: occupancy query says %d\n", per_cu); }
        (void)hipGetLastError();
        grid = cus;
    }
    if (grid < 0) return;
    (void)hipMemsetAsync((char*)d_ws + WS_CTL, 0, CTL_ZERO_BYTES, stream);
    Args a{};
    for (int i = 0; i < 31; ++i) a.in[i] = (const float*)d_in[i];
    a.out = (float*)d_out; a.ws = (unsigned char*)d_ws;
    if (MK_N_LAUNCHES == 1) { a.ph_lo = 0; a.ph_hi = NPHASE; hipLaunchKernelGGL(fwd_kernel, dim3(grid), dim3(NTHREADS), LDS_BYTES, stream, a); }
    else { for (int p = 0; p < NPHASE; ++p) { a.ph_lo = p; a.ph_hi = p + 1; a.pass = 0; hipLaunchKernelGGL(fwd_kernel, dim3(grid), dim3(NTHREADS), LDS_BYTES, stream, a);
             if (p == PROBE_DUP) { a.pass = 1; hipLaunchKernelGGL(fwd_kernel, dim3(grid), dim3(NTHREADS), LDS_BYTES, stream, a); } } }
}
```

```cpp
#include <hip/hip_runtime.h>
#include <cstdio>
#include <cstdint>

#ifndef PROBE_MASK
#define PROBE_MASK 0
#endif
#ifndef PROBE_SEL
#define PROBE_SEL 0
#endif
#ifndef PROBE_DUP
#define PROBE_DUP -1
#endif
#ifndef MK_N_LAUNCHES
#define MK_N_LAUNCHES 1
#endif

namespace {
constexpr int BATCH = 4, SEQ = 8192, DM = 1024, T = BATCH * SEQ;
constexpr int NH = 8, NG = 32, NS = 64, DIN = 2048;
constexpr int NE = 32, PLE = 256;
constexpr int ECAP = T;
constexpr float LN_EPS = 1e-5f, RMS_EPS = 1e-5f;
constexpr float ALPHA = 1.189207115002721f;
constexpr float QSCALE = 0.17677669529663687f * 1.4426950408889634f;
constexpr float LOG2E = 1.4426950408889634f;
constexpr int NPHASE = 11;
constexpr int NWAVES = 8, NTHREADS = 512;

typedef _Float16 f16;
typedef f16 h8 __attribute__((ext_vector_type(8)));
typedef f16 h4 __attribute__((ext_vector_type(4)));
typedef f16 h2 __attribute__((ext_vector_type(2)));
typedef float f32x4 __attribute__((ext_vector_type(4)));
typedef float f32x16 __attribute__((ext_vector_type(16)));
typedef int i32x4 __attribute__((ext_vector_type(4)));
typedef int i32x8 __attribute__((ext_vector_type(8)));
#define LAS __attribute__((address_space(3)))
#define GAS __attribute__((address_space(1)))
typedef GAS unsigned gu32;
#define RLX_AGENT __ATOMIC_RELAXED, __HIP_MEMORY_SCOPE_AGENT

constexpr size_t MiB = 1u << 20;
constexpr size_t WS_CTL = 0, CTL_ZERO_BYTES = 1 * MiB;
constexpr size_t WS_STATS = 3 * MiB;
constexpr size_t WS_GATES = 5 * MiB;
constexpr size_t WS_LIST = 6 * MiB;
constexpr size_t WS_WIN = 16 * MiB;
constexpr size_t WS_WGLU = 20 * MiB;
constexpr size_t WS_WOUT = 21 * MiB;
constexpr size_t WS_WPG = 23 * MiB;
constexpr size_t WS_WPP = 25 * MiB;
constexpr size_t WS_WGU = 32 * MiB;
constexpr size_t WS_WDN = 160 * MiB;
constexpr size_t WS_PE = 224 * MiB;
constexpr size_t WS_V1 = 288 * MiB;
constexpr size_t WS_A = 416 * MiB;
constexpr size_t WS_XH = WS_A;
constexpr size_t WS_PH = WS_A + 64 * MiB;
constexpr size_t WS_QH = WS_A + 80 * MiB;
constexpr size_t WS_KT = WS_A + 112 * MiB;
constexpr size_t WS_VT = WS_A + 144 * MiB;
constexpr size_t WS_UG = WS_A + 176 * MiB;
constexpr size_t WS_ACT = WS_A;
constexpr size_t WS_X1Q = WS_A + 128 * MiB;
constexpr size_t WS_R = WS_A;
constexpr size_t WS_RH = WS_A + 128 * MiB;
constexpr size_t WS_RQ = WS_A + 192 * MiB;
constexpr size_t WS_B = 672 * MiB;
constexpr size_t WS_YH = WS_B;
constexpr size_t WS_MIX = WS_B + 32 * MiB;
constexpr size_t WS_X1H = 940 * MiB;
constexpr size_t WS_SLAB = WS_B;
constexpr size_t WS_SSMOP = 928 * MiB;
constexpr size_t WS_A16 = 936 * MiB;
constexpr size_t WS_GATEH = WS_V1;
constexpr size_t WS_MIXO = WS_XH;
constexpr size_t WS_END = 1004 * MiB;

constexpr int CW_BAR = 4096;
constexpr int CW_CNT = 8192;
constexpr int CW_QUEUE = 12288;
constexpr int CW_KMAX = 16384;

constexpr int LDS_BYTES = 147456;
constexpr int LDS_BARST = LDS_BYTES - 64;

__device__ __forceinline__ float wave_sum(float v) {
#pragma unroll
    for (int o = 1; o < 64; o <<= 1) v += __shfl_xor(v, o);
    return v;
}
__device__ __forceinline__ float sigmoidf_(float x) { return __builtin_amdgcn_rcpf(1.0f + __builtin_amdgcn_exp2f(-LOG2E * x)); }
__device__ __forceinline__ float gelu_tanh(float x) {
    const float z = 0.7978845608028654f * (x + 0.044715f * x * x * x);
    const float e = __builtin_amdgcn_exp2f(fminf(2.0f * LOG2E * z, 80.0f));
    const float t = 1.0f - 2.0f * __builtin_amdgcn_rcpf(e + 1.0f);
    return 0.5f * x * (1.0f + t);
}
__device__ __forceinline__ int crow(int r, int hi) { return (r & 3) + 8 * (r >> 2) + 4 * hi; }
__device__ __forceinline__ float swap_add(float v) { return v + __shfl_xor(v, 32); }
__device__ __forceinline__ float swap_max(float v) { return fmaxf(v, __shfl_xor(v, 32)); }

#define XB_TMO      128
#define XB_XCNT(j)  (256  + 64 * (j))
#define XB_XSUB(j)  (1280 + 64 * (j))
#define XB_XGEN(j)  (2304 + 64 * (j))
#define XB_TOP      3328
#define XB_TOPGEN   3392
#define XCD_BAR_WORDS 3456
#define XB_SPIN_CAP (1u << 20)
__device__ __forceinline__ unsigned xb_ld(unsigned* p)              { return __hip_atomic_load(p, __ATOMIC_RELAXED, __HIP_MEMORY_SCOPE_AGENT); }
__device__ __forceinline__ unsigned xb_add(unsigned* p, unsigned v) { return __hip_atomic_fetch_add(p, v, __ATOMIC_RELAXED, __HIP_MEMORY_SCOPE_AGENT); }
__device__ __forceinline__ unsigned xb_xcc_id() { return (unsigned)__builtin_amdgcn_s_getreg((3 << 11) | 20) & 0xFu; }
#define XB_SPIN(cond, bar) do { unsigned _sp = 0; while (cond) { __builtin_amdgcn_s_sleep(1); \
    if ((++_sp & 255u) == 0u) { if (xb_ld(&(bar)[XB_TMO])) break; if (_sp > XB_SPIN_CAP) { atomicAdd(&(bar)[XB_TMO], 1u); break; } } } } while (0)
struct XcdBarrier { unsigned* bar; unsigned x; volatile LAS unsigned* st; };
__device__ __forceinline__ XcdBarrier xcd_barrier_post(unsigned* bar, volatile LAS unsigned* st) {
    XcdBarrier b; b.bar = bar; b.x = xb_xcc_id(); b.st = st;
    if (threadIdx.x == 0) (void)xb_add(&bar[XB_XCNT(b.x)], 1u);
    return b;
}
__device__ __forceinline__ void xcd_barrier_complete(unsigned* bar, unsigned x, unsigned& nloc, unsigned& nx) {
    const unsigned G = gridDim.x * gridDim.y * gridDim.z;
    unsigned sum, cnt, mine, sp = 0u;
    for (;;) {
        sum = 0u; cnt = 0u; mine = 0u;
#pragma unroll
        for (unsigned j = 0; j < 16; ++j) { const unsigned c = xb_ld(&bar[XB_XCNT(j)]); sum += c; cnt += (c > 0u) ? 1u : 0u; mine = (j == x) ? c : mine; }
        if (sum == G) break;
        __builtin_amdgcn_s_sleep(1);
        if ((++sp & 255u) == 0u) { if (xb_ld(&bar[XB_TMO])) break; if (sp > XB_SPIN_CAP) { atomicAdd(&bar[XB_TMO], 1u); break; } }
    }
    nloc = mine > 0u ? mine : 1u; nx = cnt > 0u ? cnt : 1u;
}
__device__ __forceinline__ void xcd_barrier(const XcdBarrier& b) {
    asm volatile("s_waitcnt vmcnt(0)" ::: "memory");
    __syncthreads();
    if (threadIdx.x == 0) {
        unsigned* bar = b.bar;
        __builtin_amdgcn_s_waitcnt(0);
        unsigned nloc = b.st[0], nx = b.st[1];
        if (nloc == 0u) { xcd_barrier_complete(bar, b.x, nloc, nx); b.st[0] = nloc; b.st[1] = nx; }
        const unsigned old = xb_add(&bar[XB_XSUB(b.x)], 1u);
        const unsigned gen = old / nloc;
        if (old + 1u == (gen + 1u) * nloc) {
            __builtin_amdgcn_fence(__ATOMIC_RELEASE, "agent");
            asm volatile("s_waitcnt vmcnt(0)" ::: "memory");
            const unsigned og = xb_add(&bar[XB_TOP], 1u);
            const unsigned tg = og / nx;
            if (og + 1u == (tg + 1u) * nx) xb_add(&bar[XB_TOPGEN], 1u);
            else XB_SPIN(xb_ld(&bar[XB_TOPGEN]) == tg, bar);
            __builtin_amdgcn_fence(__ATOMIC_ACQUIRE, "agent");
            xb_add(&bar[XB_XGEN(b.x)], 1u);
            asm volatile("s_waitcnt vmcnt(0)" ::: "memory");
        } else {
            XB_SPIN(xb_ld(&bar[XB_XGEN(b.x)]) == gen, bar);
            __builtin_amdgcn_fence(__ATOMIC_ACQUIRE, "agent");
            asm volatile("s_waitcnt vmcnt(0)" ::: "memory");
        }
    }
    __syncthreads();
}

struct Args { const float* in[31]; float* out; unsigned char* ws; int ph_lo, ph_hi, pass, pad; };
enum { I_X = 0, I_P, I_WIN, I_LQ1, I_LK1, I_LQ2, I_LK2, I_SUBLN, I_ARE, I_AIM, I_LOGDT, I_BRE, I_BIM, I_CRE, I_CIM, I_SSMD, I_WGLU, I_SSMG, I_WOUT,
       I_LN1G, I_LN1B, I_WR, I_BR, I_WGU, I_BGU, I_WDN, I_BDN, I_WPG, I_WPP, I_LN2G, I_LN2B };

struct Frame {
    LAS unsigned char* lds;
    const Args* a;
    unsigned char* ws;
    gu32* ctl;
    int tid, lane, wave, gw, NGW, G, vcu;
};

namespace pg8 {
constexpr int BM = 256, BK = 64, HALF = 128, HTB = HALF * BK * 2, STAGE_BYTES = 8 * HTB, NXCD = 8, WGM = 8;
__device__ __forceinline__ int lds_byte(int r, int c) { const int st = (r >> 4) * 2 + (c >> 5), rr = r & 15, cc = c & 31, ob = rr * 64 + cc * 2; return st * 1024 + (ob ^ (((ob >> 9) & 1) << 5)); }
__device__ __forceinline__ void stage_rc(int b, int& R, int& C) { const int st = b / 1024, sb = b % 1024, swz = sb ^ (((sb >> 9) & 1) << 5); R = (st >> 1) * 16 + swz / 64; C = (st & 1) * 32 + (swz % 64) / 2; }
struct Unit { int pm, pn, e, cnt; };
struct DenseOrder {
    int nM, nN, nwg, G, c;
    __device__ __forceinline__ void init(int M, int N, int G_, int c_) { nM = M / BM; nN = N / BM; nwg = nM * nN; G = G_; c = c_; }
    __device__ __forceinline__ bool next(int i, Unit& u) const {
        const long L = (long)i * G + c; if (L >= nwg) return false;
        int wgid = (int)L; { const int q = nwg / NXCD, r = nwg % NXCD, xcd = wgid % NXCD, off = wgid / NXCD; wgid = (xcd < r ? xcd * (q + 1) : r * (q + 1) + (xcd - r) * q) + off; }
        const int nig = WGM * nN, gid = wgid / nig, fm = gid * WGM, gsz = (nM - fm) < WGM ? (nM - fm) : WGM;
        u.pm = fm + ((wgid % nig) % gsz); u.pn = (wgid % nig) / gsz; u.e = 0; u.cnt = 0; return true;
    }
};
struct OneOrder { Unit u; __device__ __forceinline__ bool next(int i, Unit& o) const { if (i != 0) return false; o = u; return true; } };
struct MoeOrder {
    const LAS int* tab; int ntn, G, c;
    __device__ __forceinline__ bool next(int i, Unit& u) const {
        const int L = i * G + c; if (L >= tab[64] * ntn) return false;
        int e = 0;
#pragma unroll 1
        for (int q = 1; q < 32; ++q) if (L >= tab[32 + q] * ntn) e = q;
        const int cnt = tab[e], lu = L - tab[32 + e] * ntn;
        u.e = e; u.cnt = cnt; u.pn = lu % ntn; u.pm = lu / ntn; return true;
    }
};

template <class P, class Sched>
__device__ __forceinline__ void gemm_phase(LAS unsigned char* lds, const P& p, const Sched& S) {
    const int tid = threadIdx.x, wid = __builtin_amdgcn_readfirstlane(tid >> 6), lane = tid & 63, wr = wid >> 2, wc = wid & 3, fr = lane & 15, fq = lane >> 4;
    constexpr int K = P::K, PB = P::FP8 ? K : 2 * K  , nt = PB / 128;
    int RA[2]; unsigned CB[2], voffB[2];
#pragma unroll
    for (int i = 0; i < 2; ++i) { int R, C; stage_rc(tid * 16 + i * 8192, R, C); RA[i] = R; CB[i] = (unsigned)C * 2u; voffB[i] = (unsigned)(R * PB + C * 2); }
    constexpr size_t kstep = 128, hstep = (size_t)HALF * PB, tstep = 2 * hstep;
    const unsigned ldsw = (unsigned)wid * 1024u;
    const int aoff = lds_byte(wr * 64 + fr, fq * 8), boff = lds_byte(wc * 32 + fr, fq * 8);
    LAS float* rsl = (LAS float*)(lds + STAGE_BYTES);
    const char* abase = p.abase();
#define PG8_SA(b, h) (((b) * 2 + (h)) * HTB)
#define PG8_SB(b, h) ((4 + (b) * 2 + (h)) * HTB)
#define PG8_STAGE(bufoff, gbase, voff) do { _Pragma("unroll") for (int _i = 0; _i < 2; ++_i) \
        __builtin_amdgcn_global_load_lds((const unsigned*)((const char*)(gbase) + (voff)[_i]), (LAS unsigned*)(lds + (bufoff) + ldsw + _i * 8192), 16, 0, 0); } while (0)
#define PG8_LDA(dst, b, h) do { _Pragma("unroll") for (int m = 0; m < 4; ++m) { \
        if constexpr (P::FP8) { const i32x4 lo_ = *(const LAS i32x4*)(lds + PG8_SA(b, h) + aoff + m * 2048), hi_ = *(const LAS i32x4*)(lds + PG8_SA(b, h) + aoff + m * 2048 + 1024); dst##8[m] = __builtin_shufflevector(lo_, hi_, 0, 1, 2, 3, 4, 5, 6, 7); } \
        else { _Pragma("unroll") for (int k = 0; k < 2; ++k) dst[m][k] = *(const LAS h8*)(lds + PG8_SA(b, h) + aoff + m * 2048 + k * 1024); } } } while (0)
#define PG8_LDB(dst, b, h) do { _Pragma("unroll") for (int n = 0; n < 2; ++n) { \
        if constexpr (P::FP8) { const i32x4 lo_ = *(const LAS i32x4*)(lds + PG8_SB(b, h) + boff + n * 2048), hi_ = *(const LAS i32x4*)(lds + PG8_SB(b, h) + boff + n * 2048 + 1024); dst##8[n] = __builtin_shufflevector(lo_, hi_, 0, 1, 2, 3, 4, 5, 6, 7); } \
        else { _Pragma("unroll") for (int k = 0; k < 2; ++k) dst[n][k] = *(const LAS h8*)(lds + PG8_SB(b, h) + boff + n * 2048 + k * 1024); } } } while (0)
#define PG8_MMA(ai, bj, At, Bt) do { __builtin_amdgcn_s_setprio(1); _Pragma("unroll") for (int m = 0; m < 4; ++m) _Pragma("unroll") for (int n = 0; n < 2; ++n) { \
        if constexpr (P::FP8) asm volatile("v_mfma_scale_f32_16x16x128_f8f6f4 %0, %1, %2, %0, %3, %3 op_sel_hi:[0,0,0]" : "+v"(acc[ai][bj][m][n]) : "v"(Bt##8[n]), "v"(At##8[m]), "v"(one_scale)); \
        else { _Pragma("unroll") for (int k = 0; k < 2; ++k) acc[ai][bj][m][n] = __builtin_amdgcn_mfma_f32_16x16x32_f16(Bt[n][k], At[m][k], acc[ai][bj][m][n], 0, 0, 0); } } \
        __builtin_amdgcn_s_setprio(0); } while (0)
#define PG8_WAIT_V(n) asm volatile("s_waitcnt vmcnt(" #n ")" ::: "memory")
#define PG8_WAIT_L(n) asm volatile("s_waitcnt lgkmcnt(" #n ")" ::: "memory")
#define PG8_BAR __builtin_amdgcn_s_barrier()
#define PG8_SCHED __builtin_amdgcn_sched_barrier(0)
    Unit cur, nxt; int ui = 0;
    if (!S.next(0, cur)) return;
    f32x4 acc[2][2][4][2];
#pragma unroll
    for (int a = 0; a < 2; ++a)
#pragma unroll
        for (int b = 0; b < 2; ++b)
#pragma unroll
            for (int m = 0; m < 4; ++m)
#pragma unroll
                for (int n = 0; n < 2; ++n) acc[a][b][m][n] = (f32x4){0.f, 0.f, 0.f, 0.f};
    h8 At[4][2], B0[2][2], B1[2][2]; i32x8 At8[4], B08[2], B18[2];
    int one_scale = 0x7f7f7f7f; asm volatile("" : "+v"(one_scale));
    LAS int* ginfo = (LAS int*)(lds + STAGE_BYTES + 4096);
    unsigned voffA[2];
    const char* cA = abase; const char* nA = abase;
#pragma unroll
    for (int i = 0; i < 2; ++i) voffA[i] = P::GATHER ? CB[i] : (unsigned)(RA[i] * PB) + CB[i];
    if constexpr (P::GATHER) {
        if (tid < 256) p.fill_rows(cur, ginfo, tid);
        asm volatile("s_waitcnt lgkmcnt(0)" ::: "memory"); PG8_BAR; asm volatile("" ::: "memory");
    } else cA = abase + (size_t)cur.pm * tstep;
    constexpr size_t hA = P::GATHER ? 0 : hstep;
#define PG8_STAGE_A(bufoff, gbase, par, half) do { if constexpr (P::GATHER) { _Pragma("unroll") for (int _i = 0; _i < 2; ++_i) { \
            const unsigned ro_ = p.rowbytes(ginfo[(par) * 512 + (half) * 128 + RA[_i]] & 0x7fffffff) + voffA[_i]; \
            __builtin_amdgcn_global_load_lds((const unsigned*)((const char*)(gbase) + ro_), (LAS unsigned*)(lds + (bufoff) + ldsw + _i * 8192), 16, 0, 0); } } \
        else PG8_STAGE(bufoff, (const char*)(gbase) + (half) * hA, voffA); } while (0)
    const char* cB = p.bptr(cur);
    if constexpr (P::MID) p.mid_prepare(cur, rsl, tid);
    PG8_STAGE(PG8_SB(0, 0), cB, voffB); PG8_STAGE(PG8_SB(0, 1), cB + hstep, voffB); PG8_STAGE_A(PG8_SA(0, 0), cA, 0, 0); PG8_STAGE_A(PG8_SA(0, 1), cA, 0, 1);
    if (wr == 1) PG8_BAR;
    PG8_WAIT_V(2); PG8_BAR;
    PG8_STAGE(PG8_SB(1, 0), cB + kstep, voffB); PG8_STAGE_A(PG8_SA(1, 0), cA + kstep, 0, 0); PG8_STAGE(PG8_SB(1, 1), cB + hstep + kstep, voffB);
    PG8_WAIT_V(6); PG8_BAR;
    for (;;) {
        const bool has_next = S.next(ui + 1, nxt);
        const char* nB = cB; nA = cA;
        const int cpar = ui & 1; int npar = cpar;
        if (has_next) {
            nB = p.bptr(nxt); npar = cpar ^ 1;
            if constexpr (P::GATHER) { if (tid < 256) p.fill_rows(nxt, ginfo + npar * 512, tid); }
            else nA = abase + (size_t)nxt.pm * tstep;
            if constexpr (P::MID) p.mid_prepare(nxt, rsl + 256 * ((ui + 1) & 1), tid);
        }
#pragma unroll 1
        for (int t = 0; t < nt; t += 2) {
            const bool last = (t == nt - 2);
            if constexpr (P::MID) {
                if (t == nt / 2) {
                    const LAS float* rs = rsl + 256 * (ui & 1);
#pragma unroll
                    for (int a = 0; a < 2; ++a)
#pragma unroll
                        for (int m = 0; m < 4; ++m) { const float sc = rs[a * 128 + wr * 64 + m * 16 + fr];
#pragma unroll
                            for (int b = 0; b < 2; ++b)
#pragma unroll
                                for (int n = 0; n < 2; ++n) acc[a][b][m][n] *= sc; }
                }
            }
            const char* a1 = cA + (size_t)(t + 1) * kstep;
            const char* a2 = last ? nA : cA + (size_t)(t + 2) * kstep; const char* b2 = last ? nB : cB + (size_t)(t + 2) * kstep;
            const char* a3 = a2 + kstep; const char* b3 = b2 + kstep;
            const int par2 = last ? npar : cpar;
            PG8_LDB(B0, 0, 0); PG8_LDB(B1, 0, 1); PG8_SCHED; PG8_LDA(At, 0, 0); PG8_STAGE_A(PG8_SA(1, 1), a1, cpar, 1);
            PG8_WAIT_V(8); PG8_WAIT_L(0); PG8_BAR; PG8_MMA(0, 0, At, B0); PG8_MMA(0, 1, At, B1); PG8_BAR; PG8_SCHED;
            PG8_LDA(At, 0, 1); PG8_STAGE(PG8_SB(0, 0), b2, voffB); PG8_STAGE(PG8_SB(0, 1), b2 + hstep, voffB); PG8_STAGE_A(PG8_SA(0, 0), a2, par2, 0);
            PG8_WAIT_V(8); PG8_WAIT_L(0); PG8_BAR; PG8_MMA(1, 0, At, B0); PG8_MMA(1, 1, At, B1); PG8_BAR; PG8_SCHED;
            PG8_LDB(B0, 1, 0); PG8_LDB(B1, 1, 1); PG8_SCHED; PG8_LDA(At, 1, 0); PG8_STAGE_A(PG8_SA(0, 1), a2, par2, 1);
            PG8_WAIT_V(8); PG8_WAIT_L(0); PG8_BAR; PG8_MMA(0, 0, At, B0); PG8_MMA(0, 1, At, B1); PG8_BAR; PG8_SCHED;
            PG8_LDA(At, 1, 1); PG8_STAGE(PG8_SB(1, 0), b3, voffB); PG8_STAGE(PG8_SB(1, 1), b3 + hstep, voffB); PG8_STAGE_A(PG8_SA(1, 0), a3, par2, 0);
            PG8_WAIT_V(8); PG8_WAIT_L(0); PG8_BAR; PG8_MMA(1, 0, At, B0); PG8_MMA(1, 1, At, B1); PG8_BAR; PG8_SCHED;
        }
        if (wr == 0) PG8_BAR;
        if constexpr (P::FP8) asm volatile("s_nop 15\n\ts_nop 7" ::: "memory");
        {
            const int cb = wc * 32 + fq * 8;
#define PG8_EPI_LOOP(RI, CALL) do { const auto pre = p.pre(cur, cb); (void)pre; \
                _Pragma("unroll") for (int a = 0; a < 2; ++a) { \
                    int lrow = a * 128 + wr * 64 + fr; decltype(RI) ris[4]; \
                    _Pragma("unroll") for (int m = 0; m < 4; ++m) { lrow = a * 128 + wr * 64 + m * 16 + fr; ris[m] = RI; } \
                    _Pragma("unroll") for (int m = 0; m < 4; ++m) { lrow = a * 128 + wr * 64 + m * 16 + fr; const auto ri = ris[m]; CALL; } } } while (0)
            if constexpr (P::KINDS) {
                const int kd = __builtin_amdgcn_readfirstlane(p.kind(cur));
                if (kd == 1) p.knorm(cur, acc, wc, lane);
                if (kd == 0) PG8_EPI_LOOP(p.template rowpart<0>(cur, lrow), p.template epik<0>(cur, ri, cb, acc[a][0][m][0], acc[a][0][m][1], acc[a][1][m][0], acc[a][1][m][1]));
                else if (kd == 1) PG8_EPI_LOOP(p.template rowpart<1>(cur, lrow), p.template epik<1>(cur, ri, cb, acc[a][0][m][0], acc[a][0][m][1], acc[a][1][m][0], acc[a][1][m][1]));
                else if (kd == 2) PG8_EPI_LOOP(p.template rowpart<2>(cur, lrow), p.template epik<2>(cur, ri, cb, acc[a][0][m][0], acc[a][0][m][1], acc[a][1][m][0], acc[a][1][m][1]));
                else PG8_EPI_LOOP(p.template rowpart<3>(cur, lrow), p.template epik<3>(cur, ri, cb, acc[a][0][m][0], acc[a][0][m][1], acc[a][1][m][0], acc[a][1][m][1]));
            } else {
                if constexpr (P::GATHER) { const LAS int* gi_ = ginfo + (ui & 1) * 512; PG8_EPI_LOOP(p.rowinfo_lds(gi_, lrow), p.epi(cur, pre, ri, lrow, cb, acc[a][0][m][0], acc[a][0][m][1], acc[a][1][m][0], acc[a][1][m][1])); }
                else PG8_EPI_LOOP(p.rowinfo(cur, lrow), p.epi(cur, pre, ri, lrow, cb, acc[a][0][m][0], acc[a][0][m][1], acc[a][1][m][0], acc[a][1][m][1]));
            }
#undef PG8_EPI_LOOP
        }
        if (!has_next) break;
#pragma unroll
        for (int a = 0; a < 2; ++a)
#pragma unroll
            for (int b = 0; b < 2; ++b)
#pragma unroll
                for (int m = 0; m < 4; ++m)
#pragma unroll
                    for (int n = 0; n < 2; ++n) acc[a][b][m][n] = (f32x4){0.f, 0.f, 0.f, 0.f};
        cur = nxt; cB = nB; cA = nA; ++ui;
        if (wr == 1) PG8_BAR;
    }
    PG8_WAIT_V(0);
    PG8_BAR;
#undef PG8_SA
#undef PG8_SB
#undef PG8_STAGE
#undef PG8_STAGE_A
#undef PG8_LDA
#undef PG8_LDB
#undef PG8_MMA
#undef PG8_WAIT_V
#undef PG8_WAIT_L
#undef PG8_BAR
#undef PG8_SCHED
}
}

struct NoPre {};
__device__ __forceinline__ int pack_fp8x4(float a, float b, float c, float d) { int w = 0; w = __builtin_amdgcn_cvt_pk_fp8_f32(a, b, w, false); w = __builtin_amdgcn_cvt_pk_fp8_f32(c, d, w, true); return w; }
constexpr float WGU_SCALE = 32.0f, WDN_SCALE = 64.0f, ACT_SCALE = 4.0f, SLAB_SCALE = 16.0f, RQ_SCALE = 8.0f;
__device__ __forceinline__ h8 pack8(f32x4 lo, f32x4 hi) { h8 o; o[0] = (f16)lo[0]; o[1] = (f16)lo[1]; o[2] = (f16)lo[2]; o[3] = (f16)lo[3]; o[4] = (f16)hi[0]; o[5] = (f16)hi[1]; o[6] = (f16)hi[2]; o[7] = (f16)hi[3]; return o; }
struct ProbInproj {
    static constexpr int K = 1024; static constexpr bool KINDS = true; static constexpr bool GATHER = false; static constexpr bool FP8 = false; static constexpr bool MID = false;
    const char* xh; const char* win; f16 *qh, *kt, *vt, *ug; gu32* kmax;
    __device__ __forceinline__ const char* abase() const { return xh; }
    __device__ __forceinline__ unsigned rowoff(const pg8::Unit& u, int r) const { return (unsigned)(u.pm * 256 + r) * (unsigned)(K * 2); }
    __device__ __forceinline__ const char* bptr(const pg8::Unit& u) const { return win + (size_t)u.pn * 256 * K * 2; }
    __device__ __forceinline__ NoPre pre(const pg8::Unit&, int) const { return NoPre{}; }
    __device__ __forceinline__ int kind(const pg8::Unit& u) const { return u.pn >> 1; }
    __device__ __forceinline__ void knorm(const pg8::Unit& u, const f32x4 (&acc)[2][2][4][2], int wc, int lane) const {
#pragma unroll
        for (int b = 0; b < 2; ++b) {
            float mx = 0.f;
#pragma unroll
            for (int a = 0; a < 2; ++a)
#pragma unroll
                for (int m = 0; m < 4; ++m) { const f32x4 x = acc[a][b][m][0], y = acc[a][b][m][1];
                    float q = (x[0] * x[0] + x[1] * x[1]) + (x[2] * x[2] + x[3] * x[3]) + (y[0] * y[0] + y[1] * y[1]) + (y[2] * y[2] + y[3] * y[3]);
                    q += __shfl_xor(q, 16); q += __shfl_xor(q, 32); mx = fmaxf(mx, q); }
            mx = fmaxf(mx, __shfl_xor(mx, 1)); mx = fmaxf(mx, __shfl_xor(mx, 2)); mx = fmaxf(mx, __shfl_xor(mx, 4)); mx = fmaxf(mx, __shfl_xor(mx, 8));
            if (lane == 0) { const int bt = (u.pm * 256) >> 13, hd = (u.pn & 1) * 4 + 2 * b + (wc >> 1), mp = wc & 1;
                __hip_atomic_fetch_max(kmax + (bt * 8 + hd) * 2 + mp, __float_as_uint(sqrtf(mx)), RLX_AGENT); }
        }
    }
    template <int KIND> __device__ __forceinline__ unsigned rowpart(const pg8::Unit& u, int lr) const {
        const int row = u.pm * 256 + lr, b = row >> 13, tt = row & 8191, tile = tt >> 6, key = tt & 63;
        if (KIND == 0) return (unsigned)row * 512u;
        if (KIND == 1) return (unsigned)((b * 8 * 128 + tile) * 4096 + key * 8);
        if (KIND == 2) { const int sx = key >> 4, w = key & 15, hh = (w >> 2) & 1, j = (w & 3) + 4 * (w >> 3); return (unsigned)((b * 8 * 128 + tile) * 4096 + (2 * sx + hh) * 512 + j); }
        return (unsigned)((b * 32 * 8192 + tt) * 16);
    }
    template <int KIND> __device__ __forceinline__ void epik(const pg8::Unit& u, unsigned rp, int cb, f32x4 v00, f32x4 v01, f32x4 v10, f32x4 v11) const {
#pragma unroll
        for (int b = 0; b < 2; ++b) {
            const int col = (u.pn & 1) * 256 + b * 128 + cb; const f32x4 lo = b ? v10 : v00, hi = b ? v11 : v01;
            if (KIND == 0) { *(h8*)(qh + rp + col) = pack8(lo * QSCALE, hi * QSCALE); }
            else if (KIND == 1) { const int hd = col >> 6, d = col & 63; *(h8*)(kt + rp + (unsigned)(hd * 128 * 4096 + (d >> 3) * 512)) = pack8(lo, hi); }
            else if (KIND == 2) { const int hd = col >> 6, dv = col & 63; f16* q = vt + rp + (unsigned)(hd * 128 * 4096 + dv * 8);
                q[0] = (f16)lo[0]; q[8] = (f16)lo[1]; q[16] = (f16)lo[2]; q[24] = (f16)lo[3]; q[32] = (f16)hi[0]; q[40] = (f16)hi[1]; q[48] = (f16)hi[2]; q[56] = (f16)hi[3]; }
            else { const int g = col >> 4, c0 = col & 15; *(h8*)(ug + rp + (unsigned)(g * 8192 * 16 + c0)) = pack8(lo, hi); }
        }
    }
};
struct ProbPleProj {
    static constexpr int K = 256; static constexpr bool KINDS = false; static constexpr bool GATHER = false; static constexpr bool FP8 = false; static constexpr bool MID = false;
    const char* ph; const char* wpp; f16* pe;
    __device__ __forceinline__ const char* abase() const { return ph; }
    __device__ __forceinline__ unsigned rowoff(const pg8::Unit& u, int r) const { return (unsigned)(u.pm * 256 + r) * (unsigned)(K * 2); }
    __device__ __forceinline__ const char* bptr(const pg8::Unit& u) const { return wpp + (size_t)u.pn * 256 * K * 2; }
    __device__ __forceinline__ NoPre pre(const pg8::Unit&, int) const { return NoPre{}; }
    __device__ __forceinline__ int rowinfo(const pg8::Unit&, int) const { return 0; }
    __device__ __forceinline__ void epi(const pg8::Unit& u, NoPre, int, int lr, int cb, f32x4 v00, f32x4 v01, f32x4 v10, f32x4 v11) const {
        f16* o = pe + (size_t)(u.pm * 256 + lr) * 1024 + u.pn * 256 + cb; *(h8*)o = pack8(v00, v01); *(h8*)(o + 128) = pack8(v10, v11); }
};
struct ProbGlu {
    static constexpr int K = 512; static constexpr bool KINDS = false; static constexpr bool GATHER = false; static constexpr bool FP8 = false; static constexpr bool MID = false;
    const char* yh; const char* wg; f16* mix;
    __device__ __forceinline__ const char* abase() const { return yh; }
    __device__ __forceinline__ unsigned rowoff(const pg8::Unit& u, int r) const { return (unsigned)(u.pm * 256 + r) * (unsigned)(K * 2); }
    __device__ __forceinline__ const char* bptr(const pg8::Unit& u) const { return wg + (size_t)u.pn * 256 * K * 2; }
    __device__ __forceinline__ NoPre pre(const pg8::Unit&, int) const { return NoPre{}; }
    __device__ __forceinline__ int rowinfo(const pg8::Unit&, int) const { return 0; }
    __device__ __forceinline__ void epi(const pg8::Unit& u, NoPre, int, int lr, int cb, f32x4 v00, f32x4 v01, f32x4 v10, f32x4 v11) const {
        h8 o;
#pragma unroll
        for (int e = 0; e < 4; ++e) { o[e] = (f16)(v00[e] * sigmoidf_(v10[e])); o[4 + e] = (f16)(v01[e] * sigmoidf_(v11[e])); }
        *(h8*)(mix + (size_t)(u.pm * 256 + lr) * 1024 + u.pn * 128 + cb) = o; }
};
struct ProbOut {
    static constexpr int K = 1024; static constexpr bool KINDS = false; static constexpr bool GATHER = false; static constexpr bool FP8 = false; static constexpr bool MID = true;
    const char* mixb; const char* wo; f16* mixo;
    __device__ __forceinline__ const char* abase() const { return mixb; }
    __device__ __forceinline__ unsigned rowoff(const pg8::Unit& u, int r) const { return (unsigned)(u.pm * 256 + r) * (unsigned)(K * 2); }
    __device__ __forceinline__ const char* bptr(const pg8::Unit& u) const { return wo + (size_t)u.pn * 256 * K * 2; }
    __device__ __forceinline__ NoPre pre(const pg8::Unit&, int) const { return NoPre{}; }
    __device__ __forceinline__ int rowinfo(const pg8::Unit&, int) const { return 0; }
    __device__ __forceinline__ void mid_prepare(const pg8::Unit& u, LAS float* slot, int tid) const {
        const int row = tid >> 1; const h8* q = (const h8*)(mixb + (size_t)(u.pm * 256 + row) * 2048 + (tid & 1) * 512); float sacc = 0.f;
#pragma unroll 4
        for (int j = 0; j < 32; ++j) { const h8 v = q[j];
#pragma unroll
            for (int e = 0; e < 8; ++e) { const float f = (float)v[e]; sacc += f * f; } }
        sacc += __shfl_xor(sacc, 1);
        if (!(tid & 1)) slot[row] = rsqrtf(sacc * (1.0f / 512.0f) + RMS_EPS);
    }
    __device__ __forceinline__ void epi(const pg8::Unit& u, NoPre, int, int lr, int cb, f32x4 v00, f32x4 v01, f32x4 v10, f32x4 v11) const {
        f16* o = mixo + (size_t)(u.pm * 256 + lr) * 1024 + u.pn * 256 + cb; *(h8*)o = pack8(v00, v01); *(h8*)(o + 128) = pack8(v10, v11); }
};
struct Pre16 { f32x4 a, b, c, d; };
struct ProbMoeUp {
    static constexpr int K = 1024; static constexpr bool KINDS = false; static constexpr bool GATHER = true; static constexpr bool FP8 = true; static constexpr bool MID = false;
    const char* x1q; const char* wgu; const int* list; const float* bias; unsigned char* act;
    __device__ __forceinline__ const char* abase() const { return x1q; }
    __device__ __forceinline__ unsigned rowoff(const pg8::Unit&, int) const { return 0u; }
    __device__ __forceinline__ void fill_rows(const pg8::Unit& u, LAS int* tabp, int r) const { const int i = u.pm * 256 + r; const bool ok = i < u.cnt; const int a = list[(size_t)u.e * ECAP + (ok ? i : 0)]; tabp[r] = ok ? a : (a | (int)0x80000000); }
    __device__ __forceinline__ unsigned rowbytes(int a) const { return (unsigned)(a >> 2) * (unsigned)K; }
    __device__ __forceinline__ int rowinfo_lds(const LAS int* tabp, int lr) const { return tabp[lr]; }
    __device__ __forceinline__ const char* bptr(const pg8::Unit& u) const { return wgu + ((size_t)u.e * 2048 + (size_t)u.pn * 256) * K; }
    __device__ __forceinline__ Pre16 pre(const pg8::Unit& u, int cb) const {
        const float* bp = bias + u.e * 2048 + 2 * (u.pn * 128 + cb); Pre16 r; r.a = *(const f32x4*)bp; r.b = *(const f32x4*)(bp + 4); r.c = *(const f32x4*)(bp + 8); r.d = *(const f32x4*)(bp + 12); return r; }
    __device__ __forceinline__ int rowinfo(const pg8::Unit& u, int lr) const { const int i = u.pm * 256 + lr; return i < u.cnt ? list[(size_t)u.e * ECAP + i] : -1; }
    __device__ __forceinline__ void epi(const pg8::Unit& u, const Pre16& pb, int a, int, int cb, f32x4 v00, f32x4 v01, f32x4 v10, f32x4 v11) const {
        if (a < 0) return;
        const float bg[8] = {pb.a[0], pb.a[2], pb.b[0], pb.b[2], pb.c[0], pb.c[2], pb.d[0], pb.d[2]}, bl[8] = {pb.a[1], pb.a[3], pb.b[1], pb.b[3], pb.c[1], pb.c[3], pb.d[1], pb.d[3]};
        float o[8];
#pragma unroll
        for (int e = 0; e < 8; ++e) { const float g = fminf((e < 4 ? v00[e] : v01[e - 4]) * (1.0f / WGU_SCALE) + bg[e], 7.0f), l = fminf(fmaxf((e < 4 ? v10[e] : v11[e - 4]) * (1.0f / WGU_SCALE) + bl[e], -7.0f), 7.0f);
            o[e] = g * sigmoidf_(1.702f * g) * (l + 1.0f) * ACT_SCALE; }
        int w0 = pack_fp8x4(o[0], o[1], o[2], o[3]), w1 = pack_fp8x4(o[4], o[5], o[6], o[7]);
        typedef int i32x2 __attribute__((ext_vector_type(2))); i32x2 ww = {w0, w1};
        *(i32x2*)(act + (size_t)a * 1024 + u.pn * 128 + cb) = ww; }
};
struct RowAG { int a; float g; };
struct ProbMoeDn {
    static constexpr int K = 1024; static constexpr bool KINDS = false; static constexpr bool GATHER = true; static constexpr bool FP8 = true; static constexpr bool MID = false;
    const char* actb; const char* wdn; const int* list; const float* bias; const float* gates; unsigned char* slab;
    __device__ __forceinline__ const char* abase() const { return actb; }
    __device__ __forceinline__ unsigned rowoff(const pg8::Unit&, int) const { return 0u; }
    __device__ __forceinline__ void fill_rows(const pg8::Unit& u, LAS int* tabp, int r) const { const int i = u.pm * 256 + r; const bool ok = i < u.cnt; const int a = list[(size_t)u.e * ECAP + (ok ? i : 0)];
        tabp[r] = ok ? a : (a | (int)0x80000000); tabp[256 + r] = __float_as_int(ok ? gates[a] : 0.f); }
    __device__ __forceinline__ unsigned rowbytes(int a) const { return (unsigned)a * (unsigned)K; }
    __device__ __forceinline__ RowAG rowinfo_lds(const LAS int* tabp, int lr) const { RowAG r; r.a = tabp[lr]; r.g = __int_as_float(tabp[256 + lr]); return r; }
    __device__ __forceinline__ const char* bptr(const pg8::Unit& u) const { return wdn + ((size_t)u.e * 1024 + (size_t)u.pn * 256) * K; }
    __device__ __forceinline__ Pre16 pre(const pg8::Unit& u, int cb) const {
        const float* bp = bias + u.e * 1024 + u.pn * 256 + cb; Pre16 r; r.a = *(const f32x4*)bp; r.b = *(const f32x4*)(bp + 4); r.c = *(const f32x4*)(bp + 128); r.d = *(const f32x4*)(bp + 132); return r; }
    __device__ __forceinline__ RowAG rowinfo(const pg8::Unit& u, int lr) const { const int i = u.pm * 256 + lr; RowAG r; r.a = i < u.cnt ? list[(size_t)u.e * ECAP + i] : -1; r.g = r.a >= 0 ? gates[r.a] : 0.f; return r; }
    __device__ __forceinline__ void epi(const pg8::Unit& u, const Pre16& pb, const RowAG& ri, int, int cb, f32x4 v00, f32x4 v01, f32x4 v10, f32x4 v11) const {
        if (ri.a < 0) return;
        constexpr float S = 1.0f / (WDN_SCALE * ACT_SCALE);
        typedef int i32x2 __attribute__((ext_vector_type(2)));
        unsigned char* o = slab + (size_t)ri.a * 1024 + u.pn * 256 + cb; const float g = ri.g * SLAB_SCALE;
        f32x4 a = (v00 * S + pb.a) * g, b = (v01 * S + pb.b) * g, c = (v10 * S + pb.c) * g, d = (v11 * S + pb.d) * g;
#pragma unroll
        for (int e = 0; e < 4; ++e) { a[e] = fminf(fmaxf(a[e], -448.f), 448.f); b[e] = fminf(fmaxf(b[e], -448.f), 448.f); c[e] = fminf(fmaxf(c[e], -448.f), 448.f); d[e] = fminf(fmaxf(d[e], -448.f), 448.f); }
        i32x2 w0 = {pack_fp8x4(a[0], a[1], a[2], a[3]), pack_fp8x4(b[0], b[1], b[2], b[3])}, w1 = {pack_fp8x4(c[0], c[1], c[2], c[3]), pack_fp8x4(d[0], d[1], d[2], d[3])};
        *(i32x2*)o = w0; *(i32x2*)(o + 128) = w1; }
};
struct ProbPleGate {
    static constexpr int K = 1024; static constexpr bool KINDS = false; static constexpr bool GATHER = false; static constexpr bool FP8 = true; static constexpr bool MID = false;
    const char* rq; const char* wpg; f16* gateh;
    __device__ __forceinline__ const char* abase() const { return rq; }
    __device__ __forceinline__ unsigned rowoff(const pg8::Unit& u, int r) const { return (unsigned)(u.pm * 256 + r) * (unsigned)K; }
    __device__ __forceinline__ const char* bptr(const pg8::Unit& u) const { return wpg + (size_t)u.pn * 256 * K; }
    __device__ __forceinline__ NoPre pre(const pg8::Unit&, int) const { return NoPre{}; }
    __device__ __forceinline__ int rowinfo(const pg8::Unit&, int) const { return 0; }
    __device__ __forceinline__ void epi(const pg8::Unit& u, NoPre, int, int lr, int cb, f32x4 v00, f32x4 v01, f32x4 v10, f32x4 v11) const {
        f16* o = gateh + (size_t)(u.pm * 256 + lr) * 1024 + u.pn * 256 + cb;
        constexpr float S = 1.0f / (WDN_SCALE * RQ_SCALE);
        f32x4 a, b, c, d;
#pragma unroll
        for (int e = 0; e < 4; ++e) { a[e] = sigmoidf_(v00[e] * S); b[e] = sigmoidf_(v01[e] * S); c[e] = sigmoidf_(v10[e] * S); d[e] = sigmoidf_(v11[e] * S); }
        *(h8*)o = pack8(a, b); *(h8*)(o + 128) = pack8(c, d); }
};

__device__ __forceinline__ int invperm32(int c) { return 16 * ((c >> 2) & 1) + 4 * (c >> 3) + (c & 3); }
__device__ __forceinline__ void tr_item(const float* W, int K, int N, f16* WT, int item, int mode, const float* gsc, LAS float* scr, int lane) {
    const int nblk = N / 32, kb = item / nblk, nb = item % nblk, k0 = 64 * kb, n0 = 32 * nb;
#pragma unroll 8
    for (int i = 0; i < 32; ++i) {
        const int kk = 2 * i + (lane >> 5);
        float v = W[(size_t)(k0 + kk) * N + n0 + (lane & 31)];
        if (mode == 2 && k0 + kk >= 512) v *= gsc[k0 + kk - 512];
        scr[kk * 33 + (lane & 31)] = v;
    }
    asm volatile("s_waitcnt lgkmcnt(0)" ::: "memory");
    const int c = lane & 7;
#pragma unroll
    for (int j = 0; j < 4; ++j) {
        const int n = (lane >> 3) + 8 * j; const LAS float* s = scr + (8 * c) * 33 + n;
        const int ns = n0 + n; int nd;
        if (mode == 1 || mode == 3) { const int ja = mode == 1 ? (ns & 511) : (ns >> 1), bj = mode == 1 ? (ns >> 9) : (ns & 1), jl = ja & 127;
            nd = 256 * (ja >> 7) + 128 * bj + (jl & ~31) + invperm32(jl & 31); }
        else nd = (ns & ~31) + invperm32(ns & 31);
        int kd = k0 + 8 * c; if (mode == 2) kd = (kd + 512) & 1023;
        if (mode >= 3) {
            const float sc = mode == 3 ? WGU_SCALE : WDN_SCALE;
            typedef int i32x2 __attribute__((ext_vector_type(2)));
            i32x2 o; o[0] = pack_fp8x4(s[0] * sc, s[33] * sc, s[66] * sc, s[99] * sc); o[1] = pack_fp8x4(s[132] * sc, s[165] * sc, s[198] * sc, s[231] * sc);
            *(i32x2*)((unsigned char*)WT + (size_t)nd * K + kd) = o;
        } else {
            h8 o; o[0] = (f16)s[0]; o[1] = (f16)s[33]; o[2] = (f16)s[66]; o[3] = (f16)s[99]; o[4] = (f16)s[132]; o[5] = (f16)s[165]; o[6] = (f16)s[198]; o[7] = (f16)s[231];
            *(h8*)(WT + (size_t)nd * K + kd) = o;
        }
    }
    asm volatile("s_waitcnt lgkmcnt(0)" ::: "memory");
}

__device__ __forceinline__ void ssm_precompute(Frame& F, int g) {
    const Args& A = *F.a; const int tid = F.tid;
    LAS float* pwr = (LAS float*)F.lds;
    LAS float* pwi = pwr + 17 * 64;
    LAS float* Bbr = pwi + 17 * 64;
    LAS float* Bbi = Bbr + 1024;
    LAS float* Cr = Bbi + 1024;
    LAS float* Ci = Cr + 1024;
    LAS float* Kd = Ci + 1024;
    if (tid < 64) {
        const int p = tid;
        const float are = A.in[I_ARE][g * 64 + p], aim = A.in[I_AIM][g * 64 + p], dt = __expf(A.in[I_LOGDT][g]);
        for (int d = 0; d <= 16; ++d) { const float mag = __expf(are * dt * (float)d); float sn, cs; sincosf(aim * dt * (float)d, &sn, &cs); pwr[d * 64 + p] = mag * cs; pwi[d * 64 + p] = mag * sn; }
        const float abr = pwr[64 + p], abi = pwi[64 + p];
        const float nr = abr - 1.0f, ni = abi, den = 1.0f / (are * are + aim * aim);
        const float fr_ = (nr * are + ni * aim) * den, fi_ = (ni * are - nr * aim) * den;
        for (int c = 0; c < 16; ++c) { const float br = A.in[I_BRE][(g * 64 + p) * 16 + c], bi = A.in[I_BIM][(g * 64 + p) * 16 + c]; Bbr[p * 16 + c] = fr_ * br - fi_ * bi; Bbi[p * 16 + c] = fr_ * bi + fi_ * br; }
        float* a16 = (float*)(F.ws + WS_A16) + (g * 64 + p) * 2; a16[0] = pwr[16 * 64 + p]; a16[1] = pwi[16 * 64 + p];
    }
    for (int i = tid; i < 1024; i += NTHREADS) { Cr[i] = A.in[I_CRE][g * 1024 + i]; Ci[i] = A.in[I_CIM][g * 1024 + i]; }
    __syncthreads();
    for (int q = 0; q < 8; ++q) {
        const int idx = tid * 8 + q, d = idx >> 8, cp = (idx >> 4) & 15, c = idx & 15; float acc = 0.f;
        for (int p = 0; p < 64; ++p) { const float cr = Cr[cp * 64 + p], ci = Ci[cp * 64 + p], pr = pwr[d * 64 + p], pi = pwi[d * 64 + p];
            const float zr = cr * pr - ci * pi, zi = cr * pi + ci * pr; acc += zr * Bbr[p * 16 + c] - zi * Bbi[p * 16 + c]; }
        Kd[idx] = acc;
    }
    __syncthreads();
    f16* ops = (f16*)(F.ws + WS_SSMOP) + (size_t)g * 131072;
    f16* Top = ops; f16* We = ops + 65536; f16* Wc = ops + 65536 + 32768;
    for (int v = tid; v < 8192; v += NTHREADS) {
        const int row = v >> 5, kv = v & 31, j = kv >> 1, half = kv & 1, i = row >> 4, cp = row & 15; h8 o;
#pragma unroll
        for (int e = 0; e < 8; ++e) o[e] = (j <= i) ? (f16)Kd[((i - j) * 16 + cp) * 16 + 8 * half + e] : (f16)0.f;
        *(h8*)(Top + row * 256 + kv * 8) = o;
    }
    for (int v = tid; v < 4096; v += NTHREADS) {
        const int sx = v >> 5, kv = v & 31, j = kv >> 1, half = kv & 1, p = sx & 63; const float pr = pwr[(15 - j) * 64 + p], pi = pwi[(15 - j) * 64 + p]; h8 o;
#pragma unroll
        for (int e = 0; e < 8; ++e) { const float br = Bbr[p * 16 + 8 * half + e], bi = Bbi[p * 16 + 8 * half + e]; o[e] = (f16)(sx < 64 ? pr * br - pi * bi : pr * bi + pi * br); }
        *(h8*)(We + sx * 256 + kv * 8) = o;
    }
    for (int v = tid; v < 4096; v += NTHREADS) {
        const int row = v >> 4, kv = v & 15, i = row >> 4, cp = row & 15; h8 o;
#pragma unroll
        for (int e = 0; e < 8; ++e) { const int sx = 8 * kv + e, p = sx & 63; const float cr = Cr[cp * 64 + p], ci = Ci[cp * 64 + p], pr = pwr[(i + 1) * 64 + p], pi = pwi[(i + 1) * 64 + p];
            o[e] = (f16)(sx < 64 ? cr * pr - ci * pi : -(cr * pi + ci * pr)); }
        *(h8*)(Wc + row * 128 + kv * 8) = o;
    }
    __syncthreads();
}

__device__ __forceinline__ void p0_prologue(Frame& F) {
    const Args& A = *F.a;
    if (blockIdx.x < NG) ssm_precompute(F, (int)blockIdx.x);
    LAS float* scr = (LAS float*)(F.lds + F.wave * 16384);
    constexpr int I0 = 16 * 64, I1 = 8 * 32, I2 = 16 * 32, I3 = 16 * 32, I4 = 4 * 32, I5 = NE * 16 * 64, I6 = NE * 16 * 32;
    constexpr int NIT = I0 + I1 + I2 + I3 + I4 + I5;
    for (int it = F.gw; it < NIT; it += F.NGW) {
        int r = it;
        if (r < I0) { tr_item(A.in[I_WIN], 1024, 2048, (f16*)(F.ws + WS_WIN), r, 0, nullptr, scr, F.lane); continue; } r -= I0;
        if (r < I1) { tr_item(A.in[I_WGLU], 512, 1024, (f16*)(F.ws + WS_WGLU), r, 1, nullptr, scr, F.lane); continue; } r -= I1;
        if (r < I2) { tr_item(A.in[I_WOUT], 1024, 1024, (f16*)(F.ws + WS_WOUT), r, 2, A.in[I_SSMG], scr, F.lane); continue; } r -= I2;
        if (r < I3) { tr_item(A.in[I_WPG], 1024, 1024, (f16*)(F.ws + WS_WPG), r, 4, nullptr, scr, F.lane); continue; } r -= I3;
        if (r < I4) { tr_item(A.in[I_WPP], 256, 1024, (f16*)(F.ws + WS_WPP), r, 0, nullptr, scr, F.lane); continue; } r -= I4;
        if (r < I5) { const int e = r / (16 * 64), ii = r % (16 * 64);
            tr_item(A.in[I_WGU] + (size_t)e * 1024 * 2048, 1024, 2048, (f16*)(F.ws + WS_WGU + (size_t)e * 2048 * 1024), ii, 3, nullptr, scr, F.lane); continue; }
    }
    const size_t gt = (size_t)blockIdx.x * NTHREADS + F.tid, NT = (size_t)F.G * NTHREADS;
    { const f32x4* s = (const f32x4*)A.in[I_X]; h8* d = (h8*)(F.ws + WS_XH);
      for (size_t i = gt; i < (size_t)T * DM / 8; i += NT) { const f32x4 a = s[2 * i], b = s[2 * i + 1]; h8 o; o[0] = (f16)a[0]; o[1] = (f16)a[1]; o[2] = (f16)a[2]; o[3] = (f16)a[3]; o[4] = (f16)b[0]; o[5] = (f16)b[1]; o[6] = (f16)b[2]; o[7] = (f16)b[3]; d[i] = o; } }
    { const f32x4* s = (const f32x4*)A.in[I_P]; h8* d = (h8*)(F.ws + WS_PH);
      for (size_t i = gt; i < (size_t)T * PLE / 8; i += NT) { const f32x4 a = s[2 * i], b = s[2 * i + 1]; h8 o; o[0] = (f16)a[0]; o[1] = (f16)a[1]; o[2] = (f16)a[2]; o[3] = (f16)a[3]; o[4] = (f16)b[0]; o[5] = (f16)b[1]; o[6] = (f16)b[2]; o[7] = (f16)b[3]; d[i] = o; } }
}

__device__ __forceinline__ void p1_inproj(Frame& F) {
    { ProbInproj P{(const char*)(F.ws + WS_XH), (const char*)(F.ws + WS_WIN), (f16*)(F.ws + WS_QH), (f16*)(F.ws + WS_KT), (f16*)(F.ws + WS_VT), (f16*)(F.ws + WS_UG), F.ctl + CW_KMAX};
      pg8::DenseOrder S; S.init(T, DIN, F.G, (int)blockIdx.x); pg8::gemm_phase(F.lds, P, S); }
}

constexpr int ATT_SLOT = 32768, ATT_FLAGS = 3 * ATT_SLOT;
constexpr float ATT_SKIP = -40.0f;
constexpr int ATT_SG = 143360;
__device__ __forceinline__ int attn_unit(Frame& F, int b, int hd, int qb, float lam, gu32* qc, volatile LAS int* slot) {
    const int lane = F.lane, wave = F.wave, r32 = lane & 31, hi = lane >> 5;
    LAS unsigned char* lds = F.lds;
    const f16* qh = (const f16*)(F.ws + WS_QH);
    const f16* ktb = (const f16*)(F.ws + WS_KT) + (size_t)((b * 8 + hd) * 128) * 4096;
    const f16* vtb = (const f16*)(F.ws + WS_VT) + (size_t)((b * 8 + hd) * 128) * 4096;
    f16* mix = (f16*)(F.ws + WS_MIX);
    const int q0 = qb * 256, q0w = q0 + 32 * wave, NT = 4 * (qb + 1), NI = NT / 2; const size_t rowbase = (size_t)b * SEQ;
    volatile LAS int* flags = (volatile LAS int*)(lds + ATT_FLAGS);
#define ATT_ISSUE(ii) do { const int t0_ = NT - 1 - 2 * (ii); const unsigned so_ = (unsigned)(((ii) % 3) * ATT_SLOT + wave * 1024); \
        __builtin_amdgcn_global_load_lds((const unsigned*)(ktb + (size_t)t0_ * 4096 + wave * 512 + lane * 8), (LAS unsigned*)(lds + so_), 16, 0, 0); \
        __builtin_amdgcn_global_load_lds((const unsigned*)(vtb + (size_t)t0_ * 4096 + wave * 512 + lane * 8), (LAS unsigned*)(lds + so_ + 8192), 16, 0, 0); \
        __builtin_amdgcn_global_load_lds((const unsigned*)(ktb + (size_t)(t0_ - 1) * 4096 + wave * 512 + lane * 8), (LAS unsigned*)(lds + so_ + 16384), 16, 0, 0); \
        __builtin_amdgcn_global_load_lds((const unsigned*)(vtb + (size_t)(t0_ - 1) * 4096 + wave * 512 + lane * 8), (LAS unsigned*)(lds + so_ + 24576), 16, 0, 0); } while (0)
    ATT_ISSUE(0); ATT_ISSUE(1);
    if (lane == 0) { flags[wave] = 1; flags[8 + wave] = 1; }
    h8 qf[2][2];
#pragma unroll
    for (int mp = 0; mp < 2; ++mp)
#pragma unroll
        for (int kk = 0; kk < 2; ++kk) qf[mp][kk] = *(const h8*)(qh + (rowbase + q0w + r32) * 512 + hd * 64 + mp * 32 + kk * 16 + hi * 8);
    float sb1, sb2;
    { float n1 = 0.f, n2 = 0.f;
#pragma unroll
      for (int kk = 0; kk < 2; ++kk)
#pragma unroll
          for (int e = 0; e < 8; ++e) { const float a = (float)qf[0][kk][e], c = (float)qf[1][kk][e]; n1 += a * a; n2 += c * c; }
      n1 = swap_add(n1); n2 = swap_add(n2);
      const float k1 = __uint_as_float(__hip_atomic_load(F.ctl + CW_KMAX + (b * 8 + hd) * 2, RLX_AGENT)), k2 = __uint_as_float(__hip_atomic_load(F.ctl + CW_KMAX + (b * 8 + hd) * 2 + 1, RLX_AGENT));
      sb1 = sqrtf(n1) * k1 * 1.01f; sb2 = sqrtf(n2) * k2 * 1.01f; }
    const float slope2 = exp2f(-(float)(hd + 1)) * LOG2E;
    const int td = q0w >> 6, wo = q0w & 63;
    const f16 s_hi = (f16)slope2, s_lo = (f16)(slope2 - (float)s_hi);
    float mr1 = 0.f, mr2 = 0.f, l1 = 0.f, l2 = 0.f;
    h8 qx1, qx2;
    { h8 z; z[0] = (f16)(64.0f * (float)s_hi); z[1] = s_hi; z[2] = (f16)(64.0f * (float)s_lo); z[3] = s_lo; z[4] = (f16)0.f; z[5] = (f16)0.f; z[6] = (f16)0.f; z[7] = (f16)0.f;
      if (hi) { z[0] = (f16)0.f; z[1] = (f16)0.f; z[2] = (f16)0.f; z[3] = (f16)0.f; }
      qx1 = z; qx2 = z; }
    f32x16 o1[2], o2[2];
#pragma unroll
    for (int i = 0; i < 2; ++i) { o1[i] = (f32x16){}; o2[i] = (f32x16){}; }
    bool wdone = false, started = false;
    h2 ones; ones[0] = (f16)1.f; ones[1] = (f16)1.f;
#pragma unroll 1
    for (int ii = 0; ii < NI; ++ii) {
        if (ii + 1 < NI) asm volatile("s_waitcnt vmcnt(4) lgkmcnt(0)" ::: "memory"); else asm volatile("s_waitcnt vmcnt(0) lgkmcnt(0)" ::: "memory");
        __builtin_amdgcn_s_barrier();
        asm volatile("" ::: "memory");
        { const volatile LAS int* fl = flags + 8 * (ii & 1); const int any = fl[0] | fl[1] | fl[2] | fl[3] | fl[4] | fl[5] | fl[6] | fl[7];
          if (__builtin_amdgcn_readfirstlane(any) == 0) break; }
        if (ii + 2 < NI) ATT_ISSUE(ii + 2);
        bool need = !wdone;
        const int T0 = NT - 1 - 2 * ii, T1 = T0 - 1;
        if (T1 <= td && !wdone) {
            const bool first = !started; started = true;
            const LAS unsigned char* kp = lds + (ii % 3) * ATT_SLOT;
            const LAS unsigned char* kbase = kp + (hi * 512 + r32 * 8) * 2;
            const LAS unsigned char* vbase = kp + 8192 + (hi * 512 + r32 * 8) * 2;
            const float bmax = slope2 * (float)(64 * (T0 - td) + 63 - wo);
            const bool gen = first || T0 >= td || (__any(fmaxf(sb1 - mr1, sb2 - mr2) + bmax > 12.0f) != 0);
            const bool tlo = T0 > td;
            f32x16 s0[2], s1[2]; h8 kfr[4], vfr[6], pf[4], kxa, kxb; float ls;
#define ATT_SB __builtin_amdgcn_sched_barrier(0)
#define ATT_KX(tl) do { const f16 tr_ = (f16)(float)(T0 - (tl) - td); const f16 wa_ = (f16)(float)(r32 - wo), wb_ = (f16)(float)(32 + r32 - wo); h8 za, zb; \
                za[0] = tr_; za[1] = wa_; za[2] = tr_; za[3] = wa_; za[4] = (f16)1.f; za[5] = (f16)0.f; za[6] = (f16)0.f; za[7] = (f16)0.f; \
                zb[0] = tr_; zb[1] = wb_; zb[2] = tr_; zb[3] = wb_; zb[4] = (f16)1.f; zb[5] = (f16)0.f; zb[6] = (f16)0.f; zb[7] = (f16)0.f; \
                if (hi) { za[0] = (f16)0.f; za[1] = (f16)0.f; za[2] = (f16)0.f; za[3] = (f16)0.f; za[4] = (f16)0.f; zb[0] = (f16)0.f; zb[1] = (f16)0.f; zb[2] = (f16)0.f; zb[3] = (f16)0.f; zb[4] = (f16)0.f; } \
                kxa = za; kxb = zb; } while (0)
#define ATT_KLD(mp, tl) do { _Pragma("unroll") for (int kb = 0; kb < 2; ++kb) _Pragma("unroll") for (int j = 0; j < 2; ++j) \
                kfr[kb * 2 + j] = *(const LAS h8*)(kbase + (tl) * 16384 + ((mp) * 4 + j * 2) * 1024 + kb * 512); } while (0)
#define ATT_VLD(d, tl, sx, dh) vfr[d] = *(const LAS h8*)(vbase + (tl) * 16384 + (sx) * 2048 + (dh) * 512)
#define ATT_QKM(sn, mpn, qxn, j) do { if ((j) == 0) sn[0] = __builtin_amdgcn_mfma_f32_32x32x16_f16(kxa, qxn, (f32x16){}, 0, 0, 0); \
                else if ((j) == 1) sn[1] = __builtin_amdgcn_mfma_f32_32x32x16_f16(kxb, qxn, (f32x16){}, 0, 0, 0); \
                else if ((j) == 2) sn[0] = __builtin_amdgcn_mfma_f32_32x32x16_f16(kfr[0], qf[mpn][0], sn[0], 0, 0, 0); \
                else if ((j) == 3) sn[1] = __builtin_amdgcn_mfma_f32_32x32x16_f16(kfr[2], qf[mpn][0], sn[1], 0, 0, 0); \
                else if ((j) == 4) sn[0] = __builtin_amdgcn_mfma_f32_32x32x16_f16(kfr[1], qf[mpn][1], sn[0], 0, 0, 0); \
                else sn[1] = __builtin_amdgcn_mfma_f32_32x32x16_f16(kfr[3], qf[mpn][1], sn[1], 0, 0, 0); } while (0)
#define ATT_EXPH(sc, h) do { const float a0_ = __builtin_amdgcn_exp2f(sc[(h) >> 3][2 * ((h) & 7)]), a1_ = __builtin_amdgcn_exp2f(sc[(h) >> 3][2 * ((h) & 7) + 1]); \
                h2 p_; p_[0] = (f16)a0_; p_[1] = (f16)a1_; pf[(h) >> 2][2 * ((h) & 3)] = p_[0]; pf[(h) >> 2][2 * ((h) & 3) + 1] = p_[1]; \
                if (((h) & 1) == 0) hacc = p_; else { hacc = hacc + p_; asm volatile("v_dot2c_f32_f16 %0, %1, %2" : "+v"(ls) : "v"(hacc), "v"(ones)); } } while (0)
#define ATT_PLAINQK(sn, mpn, qxn) do { ATT_QKM(sn, mpn, qxn, 0); ATT_QKM(sn, mpn, qxn, 1); ATT_QKM(sn, mpn, qxn, 2); ATT_QKM(sn, mpn, qxn, 3); ATT_QKM(sn, mpn, qxn, 4); ATT_QKM(sn, mpn, qxn, 5); } while (0)
#define ATT_GENI(sc, mr, l, o, qx, tile, FIRST) do { \
                if ((tile) >= td) { _Pragma("unroll") for (int kb = 0; kb < 2; ++kb) _Pragma("unroll") for (int r = 0; r < 16; ++r) { const int kpos = 64 * (tile) + 32 * kb + crow(r, hi); if (kpos > q0w + r32) sc[kb][r] = -1e30f; } } \
                float rm = sc[0][0]; \
                _Pragma("unroll") for (int kb = 0; kb < 2; ++kb) _Pragma("unroll") for (int r = 0; r < 16; ++r) rm = fmaxf(rm, sc[kb][r]); \
                rm = swap_max(rm); \
                if ((FIRST) || __any(rm > 4.0f) != 0) { const float d = (FIRST) ? rm : fmaxf(rm, 0.f); const float f = __builtin_amdgcn_exp2f(-d); \
                    _Pragma("unroll") for (int kb = 0; kb < 2; ++kb) _Pragma("unroll") for (int r = 0; r < 16; ++r) sc[kb][r] -= d; \
                    mr += d; l *= f; o[0] *= f; o[1] *= f; if (!hi) qx[4] = (f16)(-mr); } } while (0)
#define ATT_BLOCK(sc, l, o, tlc, HASN, sn, mpn, qxn, NKLD) do { ls = 0.f; h2 hacc; \
                if (HASN) ATT_QKM(sn, mpn, qxn, 0); ATT_EXPH(sc, 0); ATT_SB; \
                if (HASN) ATT_QKM(sn, mpn, qxn, 1); ATT_EXPH(sc, 1); ATT_SB; \
                if (HASN) ATT_QKM(sn, mpn, qxn, 2); ATT_EXPH(sc, 2); ATT_VLD(0, tlc, 0, 0); ATT_VLD(1, tlc, 0, 1); ATT_SB; \
                if (HASN) ATT_QKM(sn, mpn, qxn, 3); ATT_EXPH(sc, 3); ATT_VLD(2, tlc, 1, 0); ATT_VLD(3, tlc, 1, 1); ATT_SB; \
                if (HASN) ATT_QKM(sn, mpn, qxn, 4); ATT_EXPH(sc, 4); ATT_VLD(4, tlc, 2, 0); ATT_VLD(5, tlc, 2, 1); ATT_SB; \
                if (HASN) ATT_QKM(sn, mpn, qxn, 5); ATT_EXPH(sc, 5); ATT_SB; \
                o[0] = __builtin_amdgcn_mfma_f32_32x32x16_f16(vfr[0], pf[0], o[0], 0, 0, 0); ATT_EXPH(sc, 6); ATT_EXPH(sc, 7); ATT_SB; \
                o[1] = __builtin_amdgcn_mfma_f32_32x32x16_f16(vfr[1], pf[0], o[1], 0, 0, 0); ATT_EXPH(sc, 8); NKLD; ATT_SB; \
                o[0] = __builtin_amdgcn_mfma_f32_32x32x16_f16(vfr[2], pf[1], o[0], 0, 0, 0); ATT_EXPH(sc, 9); ATT_EXPH(sc, 10); ATT_VLD(0, tlc, 3, 0); ATT_VLD(1, tlc, 3, 1); ATT_SB; \
                o[1] = __builtin_amdgcn_mfma_f32_32x32x16_f16(vfr[3], pf[1], o[1], 0, 0, 0); ATT_EXPH(sc, 11); ATT_SB; \
                o[0] = __builtin_amdgcn_mfma_f32_32x32x16_f16(vfr[4], pf[2], o[0], 0, 0, 0); ATT_EXPH(sc, 12); ATT_EXPH(sc, 13); ATT_SB; \
                o[1] = __builtin_amdgcn_mfma_f32_32x32x16_f16(vfr[5], pf[2], o[1], 0, 0, 0); ATT_EXPH(sc, 14); ATT_EXPH(sc, 15); ATT_SB; \
                o[0] = __builtin_amdgcn_mfma_f32_32x32x16_f16(vfr[0], pf[3], o[0], 0, 0, 0); ATT_SB; \
                o[1] = __builtin_amdgcn_mfma_f32_32x32x16_f16(vfr[1], pf[3], o[1], 0, 0, 0); ATT_SB; \
                l += ls; } while (0)
            if (!tlo) {
                ATT_KX(0); ATT_KLD(0, 0); ATT_PLAINQK(s0, 0, qx1); ATT_SB; ATT_KLD(1, 0); ATT_SB;
                if (gen) ATT_GENI(s0, mr1, l1, o1, qx1, T0, first);
                ATT_BLOCK(s0, l1, o1, 0, true, s1, 1, qx2, ATT_KLD(0, 1));
                ATT_KX(1);
                if (gen) ATT_GENI(s1, mr2, l2, o2, qx2, T0, first);
                ATT_BLOCK(s1, l2, o2, 0, true, s0, 0, qx1, ATT_KLD(1, 1));
            } else {
                ATT_KX(1); ATT_KLD(0, 1); ATT_PLAINQK(s0, 0, qx1); ATT_SB; ATT_KLD(1, 1); ATT_SB;
            }
            { const bool f2 = first && tlo;
              if (gen) ATT_GENI(s0, mr1, l1, o1, qx1, T1, f2);
              ATT_BLOCK(s0, l1, o1, 1, true, s1, 1, qx2, (void)0);
              if (gen) ATT_GENI(s1, mr2, l2, o2, qx2, T1, f2);
              ATT_BLOCK(s1, l2, o2, 1, false, s0, 0, qx1, (void)0); }
#undef ATT_SB
#undef ATT_KX
#undef ATT_KLD
#undef ATT_VLD
#undef ATT_QKM
#undef ATT_EXPH
#undef ATT_PLAINQK
#undef ATT_GENI
#undef ATT_BLOCK
            const float far = fmaxf(sb1 - mr1, sb2 - mr2) + slope2 * (float)(64 * T1 - 1 - q0w);
            need = (T1 >= 1) && (__any(far >= ATT_SKIP) != 0);
            if (!need) wdone = true;
        }
        if (lane == 0) flags[8 * ((ii + 1) & 1) + wave] = need ? 1 : 0;
    }
    asm volatile("s_waitcnt vmcnt(0) lgkmcnt(0)" ::: "memory");
    __builtin_amdgcn_s_barrier();
    asm volatile("" ::: "memory");
#undef ATT_ISSUE
    unsigned nxt = 0;
    if (F.tid == 0) nxt = __hip_atomic_fetch_add(qc, 1u, RLX_AGENT);
    l1 = swap_add(l1); l2 = swap_add(l2);
    const float i1 = 1.0f / l1, i2 = lam / l2;
    float ss = 0.f;
#pragma unroll
    for (int dh = 0; dh < 2; ++dh)
#pragma unroll
        for (int r = 0; r < 16; ++r) { const float v = o1[dh][r] * i1 - o2[dh][r] * i2; o1[dh][r] = v; ss += v * v; }
    ss = swap_add(ss);
    const float rs = rsqrtf(ss * (1.0f / 64.0f) + RMS_EPS) * 0.8f;
    const LAS float* sg = (const LAS float*)(lds + ATT_SG);
    f16* orow = mix + (rowbase + q0w + r32) * 1024 + 512 + hd * 64;
#pragma unroll
    for (int dh = 0; dh < 2; ++dh)
#pragma unroll
        for (int gq = 0; gq < 4; ++gq) {
            const int dv = 32 * dh + 8 * gq + 4 * hi; const f32x4 gg = *(const LAS f32x4*)(sg + dv);
            h4 o; o[0] = (f16)(o1[dh][4 * gq] * rs * gg[0]); o[1] = (f16)(o1[dh][4 * gq + 1] * rs * gg[1]); o[2] = (f16)(o1[dh][4 * gq + 2] * rs * gg[2]); o[3] = (f16)(o1[dh][4 * gq + 3] * rs * gg[3]);
            *(h4*)(orow + dv) = o;
        }
    if (F.tid == 0) slot[0] = (int)nxt;
    __syncthreads();
    const int nit = __builtin_amdgcn_readfirstlane(slot[0]);
    __syncthreads();
    return nit;
}

constexpr int SSM_UROW = 528, SSM_EROW = 528, SSM_XROW = 272;
constexpr int SSM_U0 = 0, SSM_U1 = 64 * SSM_UROW, SSM_E = 2 * 64 * SSM_UROW, SSM_XP = SSM_E + 64 * SSM_EROW;
typedef float f32x4_t __attribute__((ext_vector_type(4)));
__device__ __forceinline__ void ssm_unit(Frame& F, int b, int g) {
    const Args& A = *F.a; const int tid = F.tid, wave = F.wave, lane = F.lane, fr = lane & 15, fq = lane >> 4;
    const f16* ops = (const f16*)(F.ws + WS_SSMOP) + (size_t)g * 131072;
    const f16* Top = ops; const f16* We = ops + 65536; const f16* Wc = ops + 65536 + 32768;
    const char* ugb = (const char*)((const f16*)(F.ws + WS_UG) + (size_t)((b * 32 + g) * 8192) * 16);
    f16* yh = (f16*)(F.ws + WS_YH) + (size_t)b * SEQ * 512 + g * 16;
    LAS unsigned char* lds = F.lds;
    h8 BY[2][12];
#pragma unroll
    for (int n2 = 0; n2 < 2; ++n2) {
        const int nrow = 16 * (2 * wave + n2) + fr;
#pragma unroll
        for (int kk = 0; kk < 8; ++kk) BY[n2][kk] = *(const h8*)(Top + nrow * 256 + 32 * kk + 8 * fq);
#pragma unroll
        for (int kk = 0; kk < 4; ++kk) BY[n2][8 + kk] = *(const h8*)(Wc + nrow * 128 + 32 * kk + 8 * fq);
    }
    const float* a16 = (const float*)(F.ws + WS_A16) + (g * 64 + lane) * 2;
    const float a16r = a16[0], a16i = a16[1];
    const f32x4 dsk = *(const f32x4*)(A.in[I_SSMD] + g * 16 + 4 * fq);
    float xr = 0.f, xi = 0.f;
#pragma unroll
    for (int q = 0; q < 4; ++q) { const int o = (q * NTHREADS + tid) * 16; const h8 v = *(const h8*)(ugb + o); *(LAS h8*)(lds + SSM_U0 + (o >> 9) * SSM_UROW + (o & 511)) = v; }
    __syncthreads();
#pragma unroll 1
    for (int seg = 0; seg < 8; ++seg) {
        LAS unsigned char* Uc = lds + ((seg & 1) ? SSM_U1 : SSM_U0);
        LAS unsigned char* Un = lds + ((seg & 1) ? SSM_U0 : SSM_U1);
        {
            f32x4 ea[4]; h8 BE[8];
#pragma unroll
            for (int kk = 0; kk < 8; ++kk) BE[kk] = *(const h8*)(We + (16 * wave + fr) * 256 + 32 * kk + 8 * fq);
#pragma unroll
            for (int mt = 0; mt < 4; ++mt) ea[mt] = (f32x4){0.f, 0.f, 0.f, 0.f};
#pragma unroll
            for (int kk = 0; kk < 8; ++kk)
#pragma unroll
                for (int mt = 0; mt < 4; ++mt) { const h8 a = *(const LAS h8*)(Uc + (16 * mt + fr) * SSM_UROW + (32 * kk + 8 * fq) * 2); ea[mt] = __builtin_amdgcn_mfma_f32_16x16x32_f16(BE[kk], a, ea[mt], 0, 0, 0); }
#pragma unroll
            for (int mt = 0; mt < 4; ++mt) *(LAS f32x4*)(lds + SSM_E + (16 * mt + fr) * SSM_EROW + (16 * wave + 4 * fq) * 4) = ea[mt];
        }
        __syncthreads();
        if (wave == 0) {
#pragma unroll 8
            for (int n = 0; n < 64; ++n) {
                const float er = *(const LAS float*)(lds + SSM_E + n * SSM_EROW + lane * 4), ei = *(const LAS float*)(lds + SSM_E + n * SSM_EROW + (64 + lane) * 4);
                *(LAS f16*)(lds + SSM_XP + n * SSM_XROW + lane * 2) = (f16)xr; *(LAS f16*)(lds + SSM_XP + n * SSM_XROW + (64 + lane) * 2) = (f16)xi;
                const float nr = a16r * xr - a16i * xi + er, ni = a16r * xi + a16i * xr + ei; xr = nr; xi = ni;
            }
        } else if (seg < 7) {
            const char* src = ugb + (size_t)(seg + 1) * 32768;
            for (int v = tid - 64; v < 2048; v += NTHREADS - 64) { const int o = v * 16; const h8 x = *(const h8*)(src + o); *(LAS h8*)(Un + (o >> 9) * SSM_UROW + (o & 511)) = x; }
        }
        __syncthreads();
        {
            f32x4 ya[4][2];
#pragma unroll
            for (int mt = 0; mt < 4; ++mt) { ya[mt][0] = (f32x4){0.f, 0.f, 0.f, 0.f}; ya[mt][1] = (f32x4){0.f, 0.f, 0.f, 0.f}; }
#pragma unroll
            for (int kk = 0; kk < 12; ++kk)
#pragma unroll
                for (int mt = 0; mt < 4; ++mt) {
                    const h8 a = kk < 8 ? *(const LAS h8*)(Uc + (16 * mt + fr) * SSM_UROW + (32 * kk + 8 * fq) * 2) : *(const LAS h8*)(lds + SSM_XP + (16 * mt + fr) * SSM_XROW + (32 * (kk - 8) + 8 * fq) * 2);
                    ya[mt][0] = __builtin_amdgcn_mfma_f32_16x16x32_f16(BY[0][kk], a, ya[mt][0], 0, 0, 0);
                    ya[mt][1] = __builtin_amdgcn_mfma_f32_16x16x32_f16(BY[1][kk], a, ya[mt][1], 0, 0, 0);
                }
#pragma unroll
            for (int mt = 0; mt < 4; ++mt)
#pragma unroll
                for (int n2 = 0; n2 < 2; ++n2) {
                    const int ch = 16 * mt + fr, ti = 2 * wave + n2; const size_t tok = (size_t)(seg * 64 + ch) * 16 + ti;
                    const h4 u4 = *(const LAS h4*)(Uc + ch * SSM_UROW + (ti * 16 + 4 * fq) * 2);
                    h4 o;
#pragma unroll
                    for (int e = 0; e < 4; ++e) o[e] = (f16)gelu_tanh(ya[mt][n2][e] + dsk[e] * (float)u4[e]);
                    *(h4*)(yh + tok * 512 + 4 * fq) = o;
                }
        }
    }
    __syncthreads();
}

__device__ __forceinline__ void p2_mixers(Frame& F, int pass) {
    const Args& A = *F.a;
    gu32* qctr = F.ctl + CW_QUEUE + 128 * pass;
    constexpr int NSSM = BATCH * NG, NATT = BATCH * NH * 32;
    volatile LAS int* slot = (volatile LAS int*)(F.lds + LDS_BARST + 16);
    for (;;) {
        if (F.tid == 0) slot[0] = (int)__hip_atomic_fetch_add(qctr, 1u, RLX_AGENT);
        __syncthreads();
        const int it = __builtin_amdgcn_readfirstlane(slot[0]);
        __syncthreads();
        if (it >= NSSM) break;
        if (pass == 1 && PROBE_SEL != 0 && PROBE_SEL != 1) continue;
        ssm_unit(F, it / NG, it % NG);
    }
    asm volatile("" ::: "memory");
    float lam;
    { float d1 = 0.f, d2 = 0.f;
#pragma unroll 1
      for (int i = 0; i < 32; ++i) { d1 += A.in[I_LQ1][i] * A.in[I_LK1][i]; d2 += A.in[I_LQ2][i] * A.in[I_LK2][i]; }
      lam = __expf(d1) - __expf(d2) + 0.2f; }
    asm volatile("" : "+v"(lam));
    if (F.tid < 64) *(LAS float*)(F.lds + ATT_SG + F.tid * 4) = A.in[I_SUBLN][F.tid];
    int ait;
    { if (F.tid == 0) slot[0] = (int)__hip_atomic_fetch_add(qctr + 64, 1u, RLX_AGENT);
      __syncthreads();
      ait = __builtin_amdgcn_readfirstlane(slot[0]);
      __syncthreads(); }
    while (ait < NATT) {
        const int qb = 31 - ait / 32, bh = ait % 32;
        if (pass == 1 && PROBE_SEL != 0) { const int hd_ = bh & 7; const bool sel = PROBE_SEL == 2 ? hd_ >= 6 : PROBE_SEL == 3 ? hd_ <= 3 : PROBE_SEL == 4 ? (hd_ == 7 && qb == 31) : PROBE_SEL == 5 ? (hd_ == 4 || hd_ == 5) : false;
            if (!sel) { if (F.tid == 0) slot[0] = (int)__hip_atomic_fetch_add(qctr + 64, 1u, RLX_AGENT); __syncthreads(); ait = __builtin_amdgcn_readfirstlane(slot[0]); __syncthreads(); continue; } }
        ait = attn_unit(F, bh >> 3, bh & 7, qb, lam, qctr + 64, slot);
    }
    constexpr int NPLE = (T / 256) * 4, WDN_ITEMS = NE * 16 * 32, WDN_CHUNK = 32, NWDN = WDN_ITEMS / WDN_CHUNK;
    gu32* fctr = F.ctl + CW_QUEUE + 256 + 64 * pass;
    for (;;) {
        if (F.tid == 0) slot[0] = (int)__hip_atomic_fetch_add(fctr, 1u, RLX_AGENT);
        __syncthreads();
        const int it = __builtin_amdgcn_readfirstlane(slot[0]);
        __syncthreads();
        if (it >= NPLE + NWDN) break;
        if (it < NPLE) {
            ProbPleProj P{(const char*)(F.ws + WS_PH), (const char*)(F.ws + WS_WPP), (f16*)(F.ws + WS_PE)};
            pg8::OneOrder S; S.u.pm = it >> 2; S.u.pn = it & 3; S.u.e = 0; S.u.cnt = 0; pg8::gemm_phase(F.lds, P, S);
        } else {
            LAS float* scr = (LAS float*)(F.lds + F.wave * 16384);
#pragma unroll 1
            for (int j = 0; j < WDN_CHUNK / 8; ++j) { const int r = (it - NPLE) * WDN_CHUNK + j * 8 + F.wave; const int e = r / (16 * 32), ii = r % (16 * 32);
                tr_item(A.in[I_WDN] + (size_t)e * 1024 * 1024, 1024, 1024, (f16*)(F.ws + WS_WDN + (size_t)e * 1024 * 1024), ii, 4, nullptr, scr, F.lane); }
        }
        __syncthreads();
    }
}

__device__ __forceinline__ void p3_glu(Frame& F) {
    ProbGlu P{(const char*)(F.ws + WS_YH), (const char*)(F.ws + WS_WGLU), (f16*)(F.ws + WS_MIX)};
    pg8::DenseOrder S; S.init(T, 1024, F.G, (int)blockIdx.x); pg8::gemm_phase(F.lds, P, S);
}

__device__ __forceinline__ void p4_outproj(Frame& F) {
    ProbOut P{(const char*)(F.ws + WS_MIX), (const char*)(F.ws + WS_WOUT), (f16*)(F.ws + WS_MIXO)};
    pg8::DenseOrder S; S.init(T, DM, F.G, (int)blockIdx.x); pg8::gemm_phase(F.lds, P, S);
}

constexpr int RT_XROW = 2064;
constexpr int RT_XHI = 0, RT_XLO = 32 * RT_XROW;
constexpr int RT_PART = 0;
constexpr int RT_FIN = 2 * 32 * RT_XROW;
constexpr int RT_CNT = RT_FIN + 32 * 33 * 4;
__device__ __forceinline__ void p5_router(Frame& F, int pass) {
    const Args& A = *F.a; const int tid = F.tid, lane = F.lane, wave = F.wave, r32 = lane & 31, hi = lane >> 5;
    LAS unsigned char* lds = F.lds;
    LAS unsigned* lcnt = (LAS unsigned*)(lds + RT_CNT); LAS unsigned* lbase = lcnt + 32; LAS unsigned* asg = lcnt + 64;
    if (tid < 32) lcnt[tid] = 0u;
    const float* xin = A.in[I_X]; const f16* mixo = (const f16*)(F.ws + WS_MIXO); f16* x1h = (f16*)(F.ws + WS_X1H); unsigned char* x1q = (unsigned char*)(F.ws + WS_X1Q); float* gates = (float*)(F.ws + WS_GATES);
    h8 whi[8], wlo[8];
#pragma unroll
    for (int kk = 0; kk < 8; ++kk)
#pragma unroll
        for (int e = 0; e < 8; ++e) { const float w = A.in[I_WR][(128 * wave + 16 * kk + 8 * hi + e) * 32 + r32]; const f16 h = (f16)w; whi[kk][e] = h; wlo[kk][e] = (f16)(w - (float)h); }
    f32x4 gv[4], bv[4];
#pragma unroll
    for (int jx = 0; jx < 4; ++jx) { gv[jx] = *(const f32x4*)(A.in[I_LN1G] + 256 * jx + 4 * lane); bv[jx] = *(const f32x4*)(A.in[I_LN1B] + 256 * jx + 4 * lane); }
    const int rows_per_blk = T / F.G;
#pragma unroll 1
    for (int bt = 0; bt < rows_per_blk / 32; ++bt) {
        const int row0 = blockIdx.x * rows_per_blk + bt * 32;
#pragma unroll 1
        for (int rr = 0; rr < 4; ++rr) {
            const int lr = wave * 4 + rr; const size_t ro = (size_t)(row0 + lr) * 1024;
            f32x4 v[4]; float s1 = 0.f, s2 = 0.f;
#pragma unroll
            for (int jx = 0; jx < 4; ++jx) { const f32x4 xv = *(const f32x4*)(xin + ro + 256 * jx + 4 * lane); const h4 mv = *(const h4*)(mixo + ro + 256 * jx + 4 * lane);
#pragma unroll
                for (int e = 0; e < 4; ++e) { const float t = ALPHA * xv[e] + (float)mv[e]; v[jx][e] = t; s1 += t; } }
            const float mean = wave_sum(s1) * (1.0f / 1024.0f);
#pragma unroll
            for (int jx = 0; jx < 4; ++jx) { v[jx] = v[jx] - mean; s2 += (v[jx][0] * v[jx][0] + v[jx][1] * v[jx][1]) + (v[jx][2] * v[jx][2] + v[jx][3] * v[jx][3]); }
            const float rstd = rsqrtf(wave_sum(s2) * (1.0f / 1024.0f) + LN_EPS);
#pragma unroll
            for (int jx = 0; jx < 4; ++jx) {
                const f32x4 y = v[jx] * rstd * gv[jx] + bv[jx];
                h4 yh_, yl_;
#pragma unroll
                for (int e = 0; e < 4; ++e) { const f16 h = (f16)y[e]; yh_[e] = h; yl_[e] = (f16)(y[e] - (float)h); }
                *(h4*)(x1h + ro + 256 * jx + 4 * lane) = yh_;
                *(int*)(x1q + ro + 256 * jx + 4 * lane) = pack_fp8x4(y[0], y[1], y[2], y[3]);
                *(LAS h4*)(lds + RT_XHI + lr * RT_XROW + (256 * jx + 4 * lane) * 2) = yh_;
                *(LAS h4*)(lds + RT_XLO + lr * RT_XROW + (256 * jx + 4 * lane) * 2) = yl_;
            }
        }
        __syncthreads();
        f32x16 acc = {};
#pragma unroll
        for (int kk = 0; kk < 8; ++kk) {
            const int ko = (128 * wave + 16 * kk + 8 * hi) * 2;
            const h8 xh_ = *(const LAS h8*)(lds + RT_XHI + r32 * RT_XROW + ko), xl_ = *(const LAS h8*)(lds + RT_XLO + r32 * RT_XROW + ko);
            acc = __builtin_amdgcn_mfma_f32_32x32x16_f16(whi[kk], xh_, acc, 0, 0, 0);
            acc = __builtin_amdgcn_mfma_f32_32x32x16_f16(wlo[kk], xh_, acc, 0, 0, 0);
            acc = __builtin_amdgcn_mfma_f32_32x32x16_f16(whi[kk], xl_, acc, 0, 0, 0);
        }
        __syncthreads();
#pragma unroll
        for (int g = 0; g < 4; ++g) { f32x4 o; o[0] = acc[4 * g]; o[1] = acc[4 * g + 1]; o[2] = acc[4 * g + 2]; o[3] = acc[4 * g + 3];
            *(LAS f32x4*)(lds + RT_PART + (((wave * 32 + r32) * 32) + 8 * g + 4 * hi) * 4) = o; }
        __syncthreads();
        { const int row = tid >> 4, e0 = 2 * (tid & 15); float a0 = A.in[I_BR][e0], a1 = A.in[I_BR][e0 + 1];
#pragma unroll
          for (int w = 0; w < 8; ++w) { a0 += *(const LAS float*)(lds + RT_PART + (((w * 32 + row) * 32) + e0) * 4); a1 += *(const LAS float*)(lds + RT_PART + (((w * 32 + row) * 32) + e0 + 1) * 4); }
          *(LAS float*)(lds + RT_FIN + (row * 33 + e0) * 4) = a0; *(LAS float*)(lds + RT_FIN + (row * 33 + e0 + 1) * 4) = a1; }
        __syncthreads();
        if (tid < 32) {
            const LAS float* lg = (const LAS float*)(lds + RT_FIN + tid * 33 * 4);
            float tv[4]; int te[4];
#pragma unroll
            for (int k = 0; k < 4; ++k) { tv[k] = -INFINITY; te[k] = 0; }
#pragma unroll 1
            for (int e = 0; e < 32; ++e) { const float x = lg[e];
                if (x > tv[3]) {
                    if (x > tv[0]) { tv[3] = tv[2]; te[3] = te[2]; tv[2] = tv[1]; te[2] = te[1]; tv[1] = tv[0]; te[1] = te[0]; tv[0] = x; te[0] = e; }
                    else if (x > tv[1]) { tv[3] = tv[2]; te[3] = te[2]; tv[2] = tv[1]; te[2] = te[1]; tv[1] = x; te[1] = e; }
                    else if (x > tv[2]) { tv[3] = tv[2]; te[3] = te[2]; tv[2] = x; te[2] = e; }
                    else { tv[3] = x; te[3] = e; } } }
            const float e1 = __expf(tv[1] - tv[0]), e2 = __expf(tv[2] - tv[0]), e3 = __expf(tv[3] - tv[0]); const float inv = 1.0f / (1.0f + e1 + e2 + e3);
            const int row = row0 + tid; f32x4 gk; gk[0] = inv; gk[1] = e1 * inv; gk[2] = e2 * inv; gk[3] = e3 * inv;
            *(f32x4*)(gates + (size_t)row * 4) = gk;
#pragma unroll
            for (int k = 0; k < 4; ++k) { const unsigned rk = atomicAdd((unsigned*)&lcnt[te[k]], 1u); asg[(bt * 32 + tid) * 4 + k] = (unsigned)te[k] | (rk << 8); }
        }
        __syncthreads();
    }
    if (F.tid < 32) lbase[F.tid] = __hip_atomic_fetch_add(F.ctl + CW_CNT + 2048 * pass + 64 * F.tid, lcnt[F.tid], RLX_AGENT);
    __syncthreads();
    int* list = (int*)(F.ws + WS_LIST + (size_t)pass * 4 * MiB);
    { const unsigned a = asg[F.tid]; const int e = a & 255, rk = a >> 8; const int row = blockIdx.x * rows_per_blk + (F.tid >> 2);
      list[(size_t)e * ECAP + lbase[e] + rk] = row * 4 + (F.tid & 3); }
    __syncthreads();
}

template <int WHICH> __device__ __forceinline__ void p67_moe(Frame& F) {
    const Args& A = *F.a;
    LAS int* tab = (LAS int*)(F.lds + pg8::STAGE_BYTES + 2048);
    if (F.tid < 32) tab[F.tid] = (int)__hip_atomic_load(F.ctl + CW_CNT + 64 * F.tid, RLX_AGENT);
    __syncthreads();
    if (F.tid == 0) { int sacc = 0; for (int e = 0; e < 32; ++e) { tab[32 + e] = sacc; sacc += (tab[e] + 255) >> 8; } tab[64] = sacc; }
    __syncthreads();
    const int* list = (const int*)(F.ws + WS_LIST);
    if (WHICH == 0) {
        ProbMoeUp P{(const char*)(F.ws + WS_X1Q), (const char*)(F.ws + WS_WGU), list, A.in[I_BGU], (unsigned char*)(F.ws + WS_ACT)};
        pg8::MoeOrder S{tab, 8, F.G, F.vcu}; pg8::gemm_phase(F.lds, P, S);
    } else {
        ProbMoeDn P{(const char*)(F.ws + WS_ACT), (const char*)(F.ws + WS_WDN), list, A.in[I_BDN], (const float*)(F.ws + WS_GATES), (unsigned char*)(F.ws + WS_SLAB)};
        pg8::MoeOrder S{tab, 4, F.G, F.vcu}; pg8::gemm_phase(F.lds, P, S);
    }
    __syncthreads();
}

__device__ __forceinline__ void p8_combine(Frame& F) {
    const int lane = F.lane;
    typedef int i32x2 __attribute__((ext_vector_type(2))); typedef float f32x2 __attribute__((ext_vector_type(2)));
    const f16* x1h = (const f16*)(F.ws + WS_X1H); const unsigned char* slab = (const unsigned char*)(F.ws + WS_SLAB); f16* rh = (f16*)(F.ws + WS_RH); unsigned char* rq = (unsigned char*)(F.ws + WS_RQ);
    for (int row = F.gw; row < T; row += F.NGW) {
#pragma unroll
        for (int j = 0; j < 2; ++j) {
            const size_t o = (size_t)row * 1024 + 512 * j + 8 * lane;
            const h8 xv = *(const h8*)(x1h + o); float v[8], acc[8];
#pragma unroll
            for (int e = 0; e < 8; ++e) { v[e] = ALPHA * (float)xv[e]; acc[e] = 0.f; }
#pragma unroll
            for (int k = 0; k < 4; ++k) { const i32x2 sv = *(const i32x2*)(slab + ((size_t)row * 4 + k) * 1024 + 512 * j + 8 * lane);
#pragma unroll
                for (int q = 0; q < 2; ++q) { const f32x2 lo = __builtin_amdgcn_cvt_pk_f32_fp8(sv[q], false), hi = __builtin_amdgcn_cvt_pk_f32_fp8(sv[q], true);
                    acc[4 * q] += lo[0]; acc[4 * q + 1] += lo[1]; acc[4 * q + 2] += hi[0]; acc[4 * q + 3] += hi[1]; } }
            h8 hh;
#pragma unroll
            for (int e = 0; e < 8; ++e) { v[e] += acc[e] * (1.0f / SLAB_SCALE); hh[e] = (f16)v[e]; v[e] = fminf(fmaxf(v[e] * RQ_SCALE, -448.f), 448.f); }
            *(h8*)(rh + o) = hh;
            i32x2 qq = {pack_fp8x4(v[0], v[1], v[2], v[3]), pack_fp8x4(v[4], v[5], v[6], v[7])}; *(i32x2*)(rq + o) = qq;
        }
    }
}

__device__ __forceinline__ void p9_ple(Frame& F) {
    ProbPleGate P{(const char*)(F.ws + WS_RQ), (const char*)(F.ws + WS_WPG), (f16*)(F.ws + WS_GATEH)};
    pg8::DenseOrder S; S.init(T, DM, F.G, (int)blockIdx.x); pg8::gemm_phase(F.lds, P, S);
}

__device__ __forceinline__ void p10_ln2(Frame& F) {
    const Args& A = *F.a; const int lane = F.lane; float* out = A.out; const f16* rh = (const f16*)(F.ws + WS_RH); const f16* gateh = (const f16*)(F.ws + WS_GATEH); const f16* pe = (const f16*)(F.ws + WS_PE);
    f32x4 gv[4], bv[4];
#pragma unroll
    for (int j = 0; j < 2; ++j)
#pragma unroll
        for (int q = 0; q < 2; ++q) { gv[2 * j + q] = *(const f32x4*)(A.in[I_LN2G] + 512 * j + 8 * lane + 4 * q); bv[2 * j + q] = *(const f32x4*)(A.in[I_LN2B] + 512 * j + 8 * lane + 4 * q); }
    for (int row = F.gw; row < T; row += F.NGW) {
        f32x4 v[4]; float s = 0.f;
#pragma unroll
        for (int j = 0; j < 2; ++j) { const size_t o_ = (size_t)row * 1024 + 512 * j + 8 * lane; const h8 r8 = *(const h8*)(rh + o_), g8 = *(const h8*)(gateh + o_), p8 = *(const h8*)(pe + o_);
#pragma unroll
            for (int q = 0; q < 2; ++q) { f32x4 t;
#pragma unroll
                for (int e = 0; e < 4; ++e) t[e] = (float)r8[4 * q + e] + (float)g8[4 * q + e] * (float)p8[4 * q + e];
                v[2 * j + q] = t; s += (t[0] + t[1]) + (t[2] + t[3]); } }
        const float mean = wave_sum(s) * (1.0f / 1024.0f); float s2 = 0.f;
#pragma unroll
        for (int j = 0; j < 4; ++j) { v[j] = v[j] - mean; s2 += (v[j][0] * v[j][0] + v[j][1] * v[j][1]) + (v[j][2] * v[j][2] + v[j][3] * v[j][3]); }
        const float rstd = rsqrtf(wave_sum(s2) * (1.0f / 1024.0f) + LN_EPS);
#pragma unroll
        for (int j = 0; j < 2; ++j)
#pragma unroll
            for (int q = 0; q < 2; ++q) *(f32x4*)(out + (size_t)row * 1024 + 512 * j + 8 * lane + 4 * q) = v[2 * j + q] * rstd * gv[2 * j + q] + bv[2 * j + q];
    }
}

__global__ void __launch_bounds__(NTHREADS, 2) fwd_kernel(Args args) {
    extern __shared__ __attribute__((aligned(16))) unsigned char lds_raw[];
    Frame F;
    F.lds = (LAS unsigned char*)lds_raw; F.a = &args; F.ws = args.ws; F.ctl = (gu32*)(args.ws + WS_CTL);
    F.tid = threadIdx.x; F.lane = F.tid & 63; F.wave = __builtin_amdgcn_readfirstlane(F.tid >> 6);
    F.G = gridDim.x; F.gw = blockIdx.x * NWAVES + F.wave; F.NGW = F.G * NWAVES;
    { const int bx = blockIdx.x; F.vcu = (F.G % 8 == 0) ? (bx % 8) * (F.G / 8) + bx / 8 : bx; }
    volatile LAS unsigned* barst = (volatile LAS unsigned*)(F.lds + LDS_BARST);
    if (F.tid < 16) barst[F.tid] = 0u;
    __syncthreads();
    XcdBarrier bar; bar.bar = (unsigned*)(F.ctl + CW_BAR); bar.x = 0; bar.st = nullptr;
    if (MK_N_LAUNCHES == 1) bar = xcd_barrier_post((unsigned*)(F.ctl + CW_BAR), barst);
    const int lo = args.ph_lo, hi = args.ph_hi;
#define IN(k) (lo <= (k) && (k) < hi)
#define SEAM(k) do { if (IN(k) && IN((k) + 1)) xcd_barrier(bar); } while (0)
#define REP(k, body) do { if (IN(k)) { body; if ((PROBE_MASK >> (k)) & 1) { xcd_barrier(bar); body; } } } while (0)
    REP(0, p0_prologue(F)); SEAM(0);
    REP(1, p1_inproj(F)); SEAM(1);
    if (IN(2)) { p2_mixers(F, args.pass); if ((PROBE_MASK >> 2) & 1) { xcd_barrier(bar); p2_mixers(F, 1); } } SEAM(2);
    REP(3, p3_glu(F)); SEAM(3);
    REP(4, p4_outproj(F)); SEAM(4);
    if (IN(5)) { p5_router(F, args.pass); } SEAM(5);
    REP(6, p67_moe<0>(F)); SEAM(6);
    REP(7, p67_moe<1>(F)); SEAM(7);
    REP(8, p8_combine(F)); SEAM(8);
    REP(9, p9_ple(F)); SEAM(9);
    if (IN(10)) { p10_ln2(F); }
#undef REP
#undef IN
#undef SEAM
}
}

extern "C" void kernel_launch(void* const* d_in, const int* in_sizes, int n_in, void* d_out, int out_size, void* d_ws, size_t ws_size, hipStream_t stream) {
    static int grid = 0;
    if (grid == 0) {
        if (n_in != 31 || out_size != T * DM || ws_size < WS_END) { fprintf(stderr, "kernel_launch: unexpected problem (n_in %d, out %d, ws %zu)\n", n_in, out_size, ws_size); grid = -1; return; }
        int dev = 0, cus = 0;
        if (hipGetDevice(&dev) != hipSuccess || hipDeviceGetAttribute(&cus, hipDeviceAttributeMultiprocessorCount, dev) != hipSuccess) { grid = -1; return; }
        if (hipFuncSetAttribute((const void*)fwd_kernel, hipFuncAttributeMaxDynamicSharedMemorySize, LDS_BYTES) != hipSuccess) { fprintf(stderr, "kernel_launch: hipFuncSetAttribute failed\n"); grid = -1; return; }
        int per_cu = 0;
        if (hipOccupancyMaxActiveBlocksPerMultiprocessor(&per_cu, (const void*)fwd_kernel, NTHREADS, LDS_BYTES) != hipSuccess || per_cu < 1) { fprintf(stderr, "kernel_launch: occupancy query says %d\n", per_cu); }
        (void)hipGetLastError();
        grid = cus;
    }
    if (grid < 0) return;
    (void)hipMemsetAsync((char*)d_ws + WS_CTL, 0, CTL_ZERO_BYTES, stream);
    Args a{};
    for (int i = 0; i < 31; ++i) a.in[i] = (const float*)d_in[i];
    a.out = (float*)d_out; a.ws = (unsigned char*)d_ws;
    if (MK_N_LAUNCHES == 1) { a.ph_lo = 0; a.ph_hi = NPHASE; hipLaunchKernelGGL(fwd_kernel, dim3(grid), dim3(NTHREADS), LDS_BYTES, stream, a); }
    else { for (int p = 0; p < NPHASE; ++p) { a.ph_lo = p; a.ph_hi = p + 1; a.pass = 0; hipLaunchKernelGGL(fwd_kernel, dim3(grid), dim3(NTHREADS), LDS_BYTES, stream, a);
             if (p == PROBE_DUP) { a.pass = 1; hipLaunchKernelGGL(fwd_kernel, dim3(grid), dim3(NTHREADS), LDS_BYTES, stream, a); } } }
}
```

```cpp
#include <hip/hip_runtime.h>
#include <cstdio>
#include <cstdint>

#ifndef PROBE_MASK
#define PROBE_MASK 0
#endif
#ifndef PROBE_SEL
#define PROBE_SEL 0
#endif
#ifndef PROBE_DUP
#define PROBE_DUP -1
#endif
#ifndef MK_N_LAUNCHES
#define MK_N_LAUNCHES 1
#endif

namespace {
constexpr int BATCH = 4, SEQ = 8192, DM = 1024, T = BATCH * SEQ;
constexpr int NH = 8, NG = 32, NS = 64, DIN = 2048;
constexpr int NE = 32, PLE = 256;
constexpr int ECAP = T;
constexpr float LN_EPS = 1e-5f, RMS_EPS = 1e-5f;
constexpr float ALPHA = 1.189207115002721f;
constexpr float QSCALE = 0.17677669529663687f * 1.4426950408889634f;
constexpr float LOG2E = 1.4426950408889634f;
constexpr int NPHASE = 11;
constexpr int NWAVES = 8, NTHREADS = 512;

typedef _Float16 f16;
typedef f16 h8 __attribute__((ext_vector_type(8)));
typedef f16 h4 __attribute__((ext_vector_type(4)));
typedef f16 h2 __attribute__((ext_vector_type(2)));
typedef float f32x4 __attribute__((ext_vector_type(4)));
typedef float f32x16 __attribute__((ext_vector_type(16)));
typedef int i32x4 __attribute__((ext_vector_type(4)));
typedef int i32x8 __attribute__((ext_vector_type(8)));
#define LAS __attribute__((address_space(3)))
#define GAS __attribute__((address_space(1)))
typedef GAS unsigned gu32;
#define RLX_AGENT __ATOMIC_RELAXED, __HIP_MEMORY_SCOPE_AGENT

constexpr size_t MiB = 1u << 20;
constexpr size_t WS_CTL = 0, CTL_ZERO_BYTES = 1 * MiB;
constexpr size_t WS_STATS = 3 * MiB;
constexpr size_t WS_GATES = 5 * MiB;
constexpr size_t WS_LIST = 6 * MiB;
constexpr size_t WS_WIN = 16 * MiB;
constexpr size_t WS_WGLU = 20 * MiB;
constexpr size_t WS_WOUT = 21 * MiB;
constexpr size_t WS_WPG = 23 * MiB;
constexpr size_t WS_WPP = 25 * MiB;
constexpr size_t WS_WGU = 32 * MiB;
constexpr size_t WS_WDN = 160 * MiB;
constexpr size_t WS_PE = 224 * MiB;
constexpr size_t WS_V1 = 288 * MiB;
constexpr size_t WS_A = 416 * MiB;
constexpr size_t WS_XH = WS_A;
constexpr size_t WS_PH = WS_A + 64 * MiB;
constexpr size_t WS_QH = WS_A + 80 * MiB;
constexpr size_t WS_KT = WS_A + 112 * MiB;
constexpr size_t WS_VT = WS_A + 144 * MiB;
constexpr size_t WS_UG = WS_A + 176 * MiB;
constexpr size_t WS_ACT = WS_A;
constexpr size_t WS_X1Q = WS_A + 128 * MiB;
constexpr size_t WS_R = WS_A;
constexpr size_t WS_RH = WS_A + 128 * MiB;
constexpr size_t WS_RQ = WS_A + 192 * MiB;
constexpr size_t WS_B = 672 * MiB;
constexpr size_t WS_YH = WS_B;
constexpr size_t WS_MIX = WS_B + 32 * MiB;
constexpr size_t WS_X1H = 940 * MiB;
constexpr size_t WS_SLAB = WS_B;
constexpr size_t WS_SSMOP = 928 * MiB;
constexpr size_t WS_A16 = 936 * MiB;
constexpr size_t WS_GATEH = WS_V1;
constexpr size_t WS_MIXO = WS_XH;
constexpr size_t WS_END = 1004 * MiB;

constexpr int CW_BAR = 4096;
constexpr int CW_CNT = 8192;
constexpr int CW_QUEUE = 12288;
constexpr int CW_KMAX = 16384;

constexpr int LDS_BYTES = 147456;
constexpr int LDS_BARST = LDS_BYTES - 64;

__device__ __forceinline__ float wave_sum(float v) {
#pragma unroll
    for (int o = 1; o < 64; o <<= 1) v += __shfl_xor(v, o);
    return v;
}
__device__ __forceinline__ float sigmoidf_(float x) { return __builtin_amdgcn_rcpf(1.0f + __builtin_amdgcn_exp2f(-LOG2E * x)); }
__device__ __forceinline__ float gelu_tanh(float x) {
    const float z = 0.7978845608028654f * (x + 0.044715f * x * x * x);
    const float e = __builtin_amdgcn_exp2f(fminf(2.0f * LOG2E * z, 80.0f));
    const float t = 1.0f - 2.0f * __builtin_amdgcn_rcpf(e + 1.0f);
    return 0.5f * x * (1.0f + t);
}
__device__ __forceinline__ int crow(int r, int hi) { return (r & 3) + 8 * (r >> 2) + 4 * hi; }
__device__ __forceinline__ float swap_add(float v) { return v + __shfl_xor(v, 32); }
__device__ __forceinline__ float swap_max(float v) { return fmaxf(v, __shfl_xor(v, 32)); }

#define XB_TMO      128
#define XB_XCNT(j)  (256  + 64 * (j))
#define XB_XSUB(j)  (1280 + 64 * (j))
#define XB_XGEN(j)  (2304 + 64 * (j))
#define XB_TOP      3328
#define XB_TOPGEN   3392
#define XCD_BAR_WORDS 3456
#define XB_SPIN_CAP (1u << 20)
__device__ __forceinline__ unsigned xb_ld(unsigned* p)              { return __hip_atomic_load(p, __ATOMIC_RELAXED, __HIP_MEMORY_SCOPE_AGENT); }
__device__ __forceinline__ unsigned xb_add(unsigned* p, unsigned v) { return __hip_atomic_fetch_add(p, v, __ATOMIC_RELAXED, __HIP_MEMORY_SCOPE_AGENT); }
__device__ __forceinline__ unsigned xb_xcc_id() { return (unsigned)__builtin_amdgcn_s_getreg((3 << 11) | 20) & 0xFu; }
#define XB_SPIN(cond, bar) do { unsigned _sp = 0; while (cond) { __builtin_amdgcn_s_sleep(1); \
    if ((++_sp & 255u) == 0u) { if (xb_ld(&(bar)[XB_TMO])) break; if (_sp > XB_SPIN_CAP) { atomicAdd(&(bar)[XB_TMO], 1u); break; } } } } while (0)
struct XcdBarrier { unsigned* bar; unsigned x; volatile LAS unsigned* st; };
__device__ __forceinline__ XcdBarrier xcd_barrier_post(unsigned* bar, volatile LAS unsigned* st) {
    XcdBarrier b; b.bar = bar; b.x = xb_xcc_id(); b.st = st;
    if (threadIdx.x == 0) (void)xb_add(&bar[XB_XCNT(b.x)], 1u);
    return b;
}
__device__ __forceinline__ void xcd_barrier_complete(unsigned* bar, unsigned x, unsigned& nloc, unsigned& nx) {
    const unsigned G = gridDim.x * gridDim.y * gridDim.z;
    unsigned sum, cnt, mine, sp = 0u;
    for (;;) {
        sum = 0u; cnt = 0u; mine = 0u;
#pragma unroll
        for (unsigned j = 0; j < 16; ++j) { const unsigned c = xb_ld(&bar[XB_XCNT(j)]); sum += c; cnt += (c > 0u) ? 1u : 0u; mine = (j == x) ? c : mine; }
        if (sum == G) break;
        __builtin_amdgcn_s_sleep(1);
        if ((++sp & 255u) == 0u) { if (xb_ld(&bar[XB_TMO])) break; if (sp > XB_SPIN_CAP) { atomicAdd(&bar[XB_TMO], 1u); break; } }
    }
    nloc = mine > 0u ? mine : 1u; nx = cnt > 0u ? cnt : 1u;
}
__device__ __forceinline__ void xcd_barrier(const XcdBarrier& b) {
    asm volatile("s_waitcnt vmcnt(0)" ::: "memory");
    __syncthreads();
    if (threadIdx.x == 0) {
        unsigned* bar = b.bar;
        __builtin_amdgcn_s_waitcnt(0);
        unsigned nloc = b.st[0], nx = b.st[1];
        if (nloc == 0u) { xcd_barrier_complete(bar, b.x, nloc, nx); b.st[0] = nloc; b.st[1] = nx; }
        const unsigned old = xb_add(&bar[XB_XSUB(b.x)], 1u);
        const unsigned gen = old / nloc;
        if (old + 1u == (gen + 1u) * nloc) {
            __builtin_amdgcn_fence(__ATOMIC_RELEASE, "agent");
            asm volatile("s_waitcnt vmcnt(0)" ::: "memory");
            const unsigned og = xb_add(&bar[XB_TOP], 1u);
            const unsigned tg = og / nx;
            if (og + 1u == (tg + 1u) * nx) xb_add(&bar[XB_TOPGEN], 1u);
            else XB_SPIN(xb_ld(&bar[XB_TOPGEN]) == tg, bar);
            __builtin_amdgcn_fence(__ATOMIC_ACQUIRE, "agent");
            xb_add(&bar[XB_XGEN(b.x)], 1u);
            asm volatile("s_waitcnt vmcnt(0)" ::: "memory");
        } else {
            XB_SPIN(xb_ld(&bar[XB_XGEN(b.x)]) == gen, bar);
            __builtin_amdgcn_fence(__ATOMIC_ACQUIRE, "agent");
            asm volatile("s_waitcnt vmcnt(0)" ::: "memory");
        }
    }
    __syncthreads();
}

struct Args { const float* in[31]; float* out; unsigned char* ws; int ph_lo, ph_hi, pass, pad; };
enum { I_X = 0, I_P, I_WIN, I_LQ1, I_LK1, I_LQ2, I_LK2, I_SUBLN, I_ARE, I_AIM, I_LOGDT, I_BRE, I_BIM, I_CRE, I_CIM, I_SSMD, I_WGLU, I_SSMG, I_WOUT,
       I_LN1G, I_LN1B, I_WR, I_BR, I_WGU, I_BGU, I_WDN, I_BDN, I_WPG, I_WPP, I_LN2G, I_LN2B };

struct Frame {
    LAS unsigned char* lds;
    const Args* a;
    unsigned char* ws;
    gu32* ctl;
    int tid, lane, wave, gw, NGW, G, vcu;
};

namespace pg8 {
constexpr int BM = 256, BK = 64, HALF = 128, HTB = HALF * BK * 2, STAGE_BYTES = 8 * HTB, NXCD = 8, WGM = 8;
__device__ __forceinline__ int lds_byte(int r, int c) { const int st = (r >> 4) * 2 + (c >> 5), rr = r & 15, cc = c & 31, ob = rr * 64 + cc * 2; return st * 1024 + (ob ^ (((ob >> 9) & 1) << 5)); }
__device__ __forceinline__ void stage_rc(int b, int& R, int& C) { const int st = b / 1024, sb = b % 1024, swz = sb ^ (((sb >> 9) & 1) << 5); R = (st >> 1) * 16 + swz / 64; C = (st & 1) * 32 + (swz % 64) / 2; }
struct Unit { int pm, pn, e, cnt; };
struct DenseOrder {
    int nM, nN, nwg, G, c;
    __device__ __forceinline__ void init(int M, int N, int G_, int c_) { nM = M / BM; nN = N / BM; nwg = nM * nN; G = G_; c = c_; }
    __device__ __forceinline__ bool next(int i, Unit& u) const {
        const long L = (long)i * G + c; if (L >= nwg) return false;
        int wgid = (int)L; { const int q = nwg / NXCD, r = nwg % NXCD, xcd = wgid % NXCD, off = wgid / NXCD; wgid = (xcd < r ? xcd * (q + 1) : r * (q + 1) + (xcd - r) * q) + off; }
        const int nig = WGM * nN, gid = wgid / nig, fm = gid * WGM, gsz = (nM - fm) < WGM ? (nM - fm) : WGM;
        u.pm = fm + ((wgid % nig) % gsz); u.pn = (wgid % nig) / gsz; u.e = 0; u.cnt = 0; return true;
    }
};
struct OneOrder { Unit u; __device__ __forceinline__ bool next(int i, Unit& o) const { if (i != 0) return false; o = u; return true; } };
struct MoeOrder {
    const LAS int* tab; int ntn, G, c;
    __device__ __forceinline__ bool next(int i, Unit& u) const {
        const int L = i * G + c; if (L >= tab[64] * ntn) return false;
        int e = 0;
#pragma unroll 1
        for (int q = 1; q < 32; ++q) if (L >= tab[32 + q] * ntn) e = q;
        const int cnt = tab[e], lu = L - tab[32 + e] * ntn;
        u.e = e; u.cnt = cnt; u.pn = lu % ntn; u.pm = lu / ntn; return true;
    }
};

template <class P, class Sched>
__device__ __forceinline__ void gemm_phase(LAS unsigned char* lds, const P& p, const Sched& S) {
    const int tid = threadIdx.x, wid = __builtin_amdgcn_readfirstlane(tid >> 6), lane = tid & 63, wr = wid >> 2, wc = wid & 3, fr = lane & 15, fq = lane >> 4;
    constexpr int K = P::K, PB = P::FP8 ? K : 2 * K  , nt = PB / 128;
    int RA[2]; unsigned CB[2], voffB[2];
#pragma unroll
    for (int i = 0; i < 2; ++i) { int R, C; stage_rc(tid * 16 + i * 8192, R, C); RA[i] = R; CB[i] = (unsigned)C * 2u; voffB[i] = (unsigned)(R * PB + C * 2); }
    constexpr size_t kstep = 128, hstep = (size_t)HALF * PB, tstep = 2 * hstep;
    const unsigned ldsw = (unsigned)wid * 1024u;
    const int aoff = lds_byte(wr * 64 + fr, fq * 8), boff = lds_byte(wc * 32 + fr, fq * 8);
    LAS float* rsl = (LAS float*)(lds + STAGE_BYTES);
    const char* abase = p.abase();
#define PG8_SA(b, h) (((b) * 2 + (h)) * HTB)
#define PG8_SB(b, h) ((4 + (b) * 2 + (h)) * HTB)
#define PG8_STAGE(bufoff, gbase, voff) do { _Pragma("unroll") for (int _i = 0; _i < 2; ++_i) \
        __builtin_amdgcn_global_load_lds((const unsigned*)((const char*)(gbase) + (voff)[_i]), (LAS unsigned*)(lds + (bufoff) + ldsw + _i * 8192), 16, 0, 0); } while (0)
#define PG8_LDA(dst, b, h) do { _Pragma("unroll") for (int m = 0; m < 4; ++m) { \
        if constexpr (P::FP8) { const i32x4 lo_ = *(const LAS i32x4*)(lds + PG8_SA(b, h) + aoff + m * 2048), hi_ = *(const LAS i32x4*)(lds + PG8_SA(b, h) + aoff + m * 2048 + 1024); dst##8[m] = __builtin_shufflevector(lo_, hi_, 0, 1, 2, 3, 4, 5, 6, 7); } \
        else { _Pragma("unroll") for (int k = 0; k < 2; ++k) dst[m][k] = *(const LAS h8*)(lds + PG8_SA(b, h) + aoff + m * 2048 + k * 1024); } } } while (0)
#define PG8_LDB(dst, b, h) do { _Pragma("unroll") for (int n = 0; n < 2; ++n) { \
        if constexpr (P::FP8) { const i32x4 lo_ = *(const LAS i32x4*)(lds + PG8_SB(b, h) + boff + n * 2048), hi_ = *(const LAS i32x4*)(lds + PG8_SB(b, h) + boff + n * 2048 + 1024); dst##8[n] = __builtin_shufflevector(lo_, hi_, 0, 1, 2, 3, 4, 5, 6, 7); } \
        else { _Pragma("unroll") for (int k = 0; k < 2; ++k) dst[n][k] = *(const LAS h8*)(lds + PG8_SB(b, h) + boff + n * 2048 + k * 1024); } } } while (0)
#define PG8_MMA(ai, bj, At, Bt) do { __builtin_amdgcn_s_setprio(1); _Pragma("unroll") for (int m = 0; m < 4; ++m) _Pragma("unroll") for (int n = 0; n < 2; ++n) { \
        if constexpr (P::FP8) asm volatile("v_mfma_scale_f32_16x16x128_f8f6f4 %0, %1, %2, %0, %3, %3 op_sel_hi:[0,0,0]" : "+v"(acc[ai][bj][m][n]) : "v"(Bt##8[n]), "v"(At##8[m]), "v"(one_scale)); \
        else { _Pragma("unroll") for (int k = 0; k < 2; ++k) acc[ai][bj][m][n] = __builtin_amdgcn_mfma_f32_16x16x32_f16(Bt[n][k], At[m][k], acc[ai][bj][m][n], 0, 0, 0); } } \
        __builtin_amdgcn_s_setprio(0); } while (0)
#define PG8_WAIT_V(n) asm volatile("s_waitcnt vmcnt(" #n ")" ::: "memory")
#define PG8_WAIT_L(n) asm volatile("s_waitcnt lgkmcnt(" #n ")" ::: "memory")
#define PG8_BAR __builtin_amdgcn_s_barrier()
#define PG8_SCHED __builtin_amdgcn_sched_barrier(0)
    Unit cur, nxt; int ui = 0;
    if (!S.next(0, cur)) return;
    f32x4 acc[2][2][4][2];
#pragma unroll
    for (int a = 0; a < 2; ++a)
#pragma unroll
        for (int b = 0; b < 2; ++b)
#pragma unroll
            for (int m = 0; m < 4; ++m)
#pragma unroll
                for (int n = 0; n < 2; ++n) acc[a][b][m][n] = (f32x4){0.f, 0.f, 0.f, 0.f};
    h8 At[4][2], B0[2][2], B1[2][2]; i32x8 At8[4], B08[2], B18[2];
    int one_scale = 0x7f7f7f7f; asm volatile("" : "+v"(one_scale));
    LAS int* ginfo = (LAS int*)(lds + STAGE_BYTES + 4096);
    unsigned voffA[2];
    const char* cA = abase; const char* nA = abase;
#pragma unroll
    for (int i = 0; i < 2; ++i) voffA[i] = P::GATHER ? CB[i] : (unsigned)(RA[i] * PB) + CB[i];
    if constexpr (P::GATHER) {
        if (tid < 256) p.fill_rows(cur, ginfo, tid);
        asm volatile("s_waitcnt lgkmcnt(0)" ::: "memory"); PG8_BAR; asm volatile("" ::: "memory");
    } else cA = abase + (size_t)cur.pm * tstep;
    constexpr size_t hA = P::GATHER ? 0 : hstep;
#define PG8_STAGE_A(bufoff, gbase, par, half) do { if constexpr (P::GATHER) { _Pragma("unroll") for (int _i = 0; _i < 2; ++_i) { \
            const unsigned ro_ = p.rowbytes(ginfo[(par) * 512 + (half) * 128 + RA[_i]] & 0x7fffffff) + voffA[_i]; \
            __builtin_amdgcn_global_load_lds((const unsigned*)((const char*)(gbase) + ro_), (LAS unsigned*)(lds + (bufoff) + ldsw + _i * 8192), 16, 0, 0); } } \
        else PG8_STAGE(bufoff, (const char*)(gbase) + (half) * hA, voffA); } while (0)
    const char* cB = p.bptr(cur);
    if constexpr (P::MID) p.mid_prepare(cur, rsl, tid);
    PG8_STAGE(PG8_SB(0, 0), cB, voffB); PG8_STAGE(PG8_SB(0, 1), cB + hstep, voffB); PG8_STAGE_A(PG8_SA(0, 0), cA, 0, 0); PG8_STAGE_A(PG8_SA(0, 1), cA, 0, 1);
    if (wr == 1) PG8_BAR;
    PG8_WAIT_V(2); PG8_BAR;
    PG8_STAGE(PG8_SB(1, 0), cB + kstep, voffB); PG8_STAGE_A(PG8_SA(1, 0), cA + kstep, 0, 0); PG8_STAGE(PG8_SB(1, 1), cB + hstep + kstep, voffB);
    PG8_WAIT_V(6); PG8_BAR;
    for (;;) {
        const bool has_next = S.next(ui + 1, nxt);
        const char* nB = cB; nA = cA;
        const int cpar = ui & 1; int npar = cpar;
        if (has_next) {
            nB = p.bptr(nxt); npar = cpar ^ 1;
            if constexpr (P::GATHER) { if (tid < 256) p.fill_rows(nxt, ginfo + npar * 512, tid); }
            else nA = abase + (size_t)nxt.pm * tstep;
            if constexpr (P::MID) p.mid_prepare(nxt, rsl + 256 * ((ui + 1) & 1), tid);
        }
#pragma unroll 1
        for (int t = 0; t < nt; t += 2) {
            const bool last = (t == nt - 2);
            if constexpr (P::MID) {
                if (t == nt / 2) {
                    const LAS float* rs = rsl + 256 * (ui & 1);
#pragma unroll
                    for (int a = 0; a < 2; ++a)
#pragma unroll
                        for (int m = 0; m < 4; ++m) { const float sc = rs[a * 128 + wr * 64 + m * 16 + fr];
#pragma unroll
                            for (int b = 0; b < 2; ++b)
#pragma unroll
                                for (int n = 0; n < 2; ++n) acc[a][b][m][n] *= sc; }
                }
            }
            const char* a1 = cA + (size_t)(t + 1) * kstep;
            const char* a2 = last ? nA : cA + (size_t)(t + 2) * kstep; const char* b2 = last ? nB : cB + (size_t)(t + 2) * kstep;
            const char* a3 = a2 + kstep; const char* b3 = b2 + kstep;
            const int par2 = last ? npar : cpar;
            PG8_LDB(B0, 0, 0); PG8_LDB(B1, 0, 1); PG8_SCHED; PG8_LDA(At, 0, 0); PG8_STAGE_A(PG8_SA(1, 1), a1, cpar, 1);
            PG8_WAIT_V(8); PG8_WAIT_L(0); PG8_BAR; PG8_MMA(0, 0, At, B0); PG8_MMA(0, 1, At, B1); PG8_BAR; PG8_SCHED;
            PG8_LDA(At, 0, 1); PG8_STAGE(PG8_SB(0, 0), b2, voffB); PG8_STAGE(PG8_SB(0, 1), b2 + hstep, voffB); PG8_STAGE_A(PG8_SA(0, 0), a2, par2, 0);
            PG8_WAIT_V(8); PG8_WAIT_L(0); PG8_BAR; PG8_MMA(1, 0, At, B0); PG8_MMA(1, 1, At, B1); PG8_BAR; PG8_SCHED;
            PG8_LDB(B0, 1, 0); PG8_LDB(B1, 1, 1); PG8_SCHED; PG8_LDA(At, 1, 0); PG8_STAGE_A(PG8_SA(0, 1), a2, par2, 1);
            PG8_WAIT_V(8); PG8_WAIT_L(0); PG8_BAR; PG8_MMA(0, 0, At, B0); PG8_MMA(0, 1, At, B1); PG8_BAR; PG8_SCHED;
            PG8_LDA(At, 1, 1); PG8_STAGE(PG8_SB(1, 0), b3, voffB); PG8_STAGE(PG8_SB(1, 1), b3 + hstep, voffB); PG8_STAGE_A(PG8_SA(1, 0), a3, par2, 0);
            PG8_WAIT_V(8); PG8_WAIT_L(0); PG8_BAR; PG8_MMA(1, 0, At, B0); PG8_MMA(1, 1, At, B1); PG8_BAR; PG8_SCHED;
        }
        if (wr == 0) PG8_BAR;
        if constexpr (P::FP8) asm volatile("s_nop 15\n\ts_nop 7" ::: "memory");
        {
            const int cb = wc * 32 + fq * 8;
#define PG8_EPI_LOOP(RI, CALL) do { const auto pre = p.pre(cur, cb); (void)pre; \
                _Pragma("unroll") for (int a = 0; a < 2; ++a) { \
                    int lrow = a * 128 + wr * 64 + fr; decltype(RI) ris[4]; \
                    _Pragma("unroll") for (int m = 0; m < 4; ++m) { lrow = a * 128 + wr * 64 + m * 16 + fr; ris[m] = RI; } \
                    _Pragma("unroll") for (int m = 0; m < 4; ++m) { lrow = a * 128 + wr * 64 + m * 16 + fr; const auto ri = ris[m]; CALL; } } } while (0)
            if constexpr (P::KINDS) {
                const int kd = __builtin_amdgcn_readfirstlane(p.kind(cur));
                if (kd == 1) p.knorm(cur, acc, wc, lane);
                if (kd == 0) PG8_EPI_LOOP(p.template rowpart<0>(cur, lrow), p.template epik<0>(cur, ri, cb, acc[a][0][m][0], acc[a][0][m][1], acc[a][1][m][0], acc[a][1][m][1]));
                else if (kd == 1) PG8_EPI_LOOP(p.template rowpart<1>(cur, lrow), p.template epik<1>(cur, ri, cb, acc[a][0][m][0], acc[a][0][m][1], acc[a][1][m][0], acc[a][1][m][1]));
                else if (kd == 2) PG8_EPI_LOOP(p.template rowpart<2>(cur, lrow), p.template epik<2>(cur, ri, cb, acc[a][0][m][0], acc[a][0][m][1], acc[a][1][m][0], acc[a][1][m][1]));
                else PG8_EPI_LOOP(p.template rowpart<3>(cur, lrow), p.template epik<3>(cur, ri, cb, acc[a][0][m][0], acc[a][0][m][1], acc[a][1][m][0], acc[a][1][m][1]));
            } else {
                if constexpr (P::GATHER) {
                    const LAS int* gi_ = ginfo + (ui & 1) * 512; const auto pre = p.pre(cur, cb); const bool odd = (fq & 1) != 0; const int cbs = cb - (odd ? 8 : 0);
                    decltype(p.rowinfo_lds(gi_, 0)) rA[2][2], rB[2][2]; int rS[2][2];
#pragma unroll
                    for (int a = 0; a < 2; ++a)
#pragma unroll
                        for (int mp = 0; mp < 2; ++mp) { const int lr0 = a * 128 + wr * 64 + mp * 32 + fr; rA[a][mp] = p.rowinfo_lds(gi_, lr0); rB[a][mp] = p.rowinfo_lds(gi_, lr0 + 16); rS[a][mp] = p.rowidx(p.rowinfo_lds(gi_, lr0 + (odd ? 16 : 0))); }
                    asm volatile("s_waitcnt lgkmcnt(0)" ::: "memory");
#pragma unroll
                    for (int a = 0; a < 2; ++a) {
#pragma unroll
                        for (int mp = 0; mp < 2; ++mp) {
                            const auto ri0 = rA[a][mp], ri1 = rB[a][mp];
                            const i32x4 x0 = p.val(cur, pre, ri0, acc[a][0][2 * mp][0], acc[a][0][2 * mp][1], acc[a][1][2 * mp][0], acc[a][1][2 * mp][1]);
                            const i32x4 x1 = p.val(cur, pre, ri1, acc[a][0][2 * mp + 1][0], acc[a][0][2 * mp + 1][1], acc[a][1][2 * mp + 1][0], acc[a][1][2 * mp + 1][1]);
                            const int asel = rS[a][mp];
#pragma unroll
                            for (int q = 0; q < P::NW; ++q) {
                                const auto lo = __builtin_amdgcn_permlane16_swap((unsigned)x0[2 * q], (unsigned)x1[2 * q], false, false), hi = __builtin_amdgcn_permlane16_swap((unsigned)x0[2 * q + 1], (unsigned)x1[2 * q + 1], false, false);
                                i32x4 w; w[0] = (int)lo[0]; w[1] = (int)hi[0]; w[2] = (int)lo[1]; w[3] = (int)hi[1];
                                p.store16(cur, asel, cbs, q, w);
                            }
                        }
                    }
                }
                else PG8_EPI_LOOP(p.rowinfo(cur, lrow), p.epi(cur, pre, ri, lrow, cb, acc[a][0][m][0], acc[a][0][m][1], acc[a][1][m][0], acc[a][1][m][1]));
            }
#undef PG8_EPI_LOOP
        }
        if (!has_next) break;
#pragma unroll
        for (int a = 0; a < 2; ++a)
#pragma unroll
            for (int b = 0; b < 2; ++b)
#pragma unroll
                for (int m = 0; m < 4; ++m)
#pragma unroll
                    for (int n = 0; n < 2; ++n) acc[a][b][m][n] = (f32x4){0.f, 0.f, 0.f, 0.f};
        cur = nxt; cB = nB; cA = nA; ++ui;
        if (wr == 1) PG8_BAR;
    }
    PG8_WAIT_V(0);
    PG8_BAR;
#undef PG8_SA
#undef PG8_SB
#undef PG8_STAGE
#undef PG8_STAGE_A
#undef PG8_LDA
#undef PG8_LDB
#undef PG8_MMA
#undef PG8_WAIT_V
#undef PG8_WAIT_L
#undef PG8_BAR
#undef PG8_SCHED
}
}

struct NoPre {};
__device__ __forceinline__ int pack_fp8x4(float a, float b, float c, float d) { int w = 0; w = __builtin_amdgcn_cvt_pk_fp8_f32(a, b, w, false); w = __builtin_amdgcn_cvt_pk_fp8_f32(c, d, w, true); return w; }
constexpr float WGU_SCALE = 32.0f, WDN_SCALE = 64.0f, ACT_SCALE = 4.0f, SLAB_SCALE = 16.0f, RQ_SCALE = 8.0f;
__device__ __forceinline__ h8 pack8(f32x4 lo, f32x4 hi) { h8 o; o[0] = (f16)lo[0]; o[1] = (f16)lo[1]; o[2] = (f16)lo[2]; o[3] = (f16)lo[3]; o[4] = (f16)hi[0]; o[5] = (f16)hi[1]; o[6] = (f16)hi[2]; o[7] = (f16)hi[3]; return o; }
struct ProbInproj {
    static constexpr int K = 1024; static constexpr bool KINDS = true; static constexpr bool GATHER = false; static constexpr bool FP8 = false; static constexpr bool MID = false;
    const char* xh; const char* win; f16 *qh, *kt, *vt, *ug; gu32* kmax;
    __device__ __forceinline__ const char* abase() const { return xh; }
    __device__ __forceinline__ unsigned rowoff(const pg8::Unit& u, int r) const { return (unsigned)(u.pm * 256 + r) * (unsigned)(K * 2); }
    __device__ __forceinline__ const char* bptr(const pg8::Unit& u) const { return win + (size_t)u.pn * 256 * K * 2; }
    __device__ __forceinline__ NoPre pre(const pg8::Unit&, int) const { return NoPre{}; }
    __device__ __forceinline__ int kind(const pg8::Unit& u) const { return u.pn >> 1; }
    __device__ __forceinline__ void knorm(const pg8::Unit& u, const f32x4 (&acc)[2][2][4][2], int wc, int lane) const {
#pragma unroll
        for (int b = 0; b < 2; ++b) {
            float mx = 0.f;
#pragma unroll
            for (int a = 0; a < 2; ++a)
#pragma unroll
                for (int m = 0; m < 4; ++m) { const f32x4 x = acc[a][b][m][0], y = acc[a][b][m][1];
                    float q = (x[0] * x[0] + x[1] * x[1]) + (x[2] * x[2] + x[3] * x[3]) + (y[0] * y[0] + y[1] * y[1]) + (y[2] * y[2] + y[3] * y[3]);
                    q += __shfl_xor(q, 16); q += __shfl_xor(q, 32); mx = fmaxf(mx, q); }
            mx = fmaxf(mx, __shfl_xor(mx, 1)); mx = fmaxf(mx, __shfl_xor(mx, 2)); mx = fmaxf(mx, __shfl_xor(mx, 4)); mx = fmaxf(mx, __shfl_xor(mx, 8));
            if (lane == 0) { const int bt = (u.pm * 256) >> 13, hd = (u.pn & 1) * 4 + 2 * b + (wc >> 1), mp = wc & 1;
                __hip_atomic_fetch_max(kmax + (bt * 8 + hd) * 2 + mp, __float_as_uint(sqrtf(mx)), RLX_AGENT); }
        }
    }
    template <int KIND> __device__ __forceinline__ unsigned rowpart(const pg8::Unit& u, int lr) const {
        const int row = u.pm * 256 + lr, b = row >> 13, tt = row & 8191, tile = tt >> 6, key = tt & 63;
        if (KIND == 0) return (unsigned)row * 512u;
        if (KIND == 1) return (unsigned)((b * 8 * 128 + tile) * 4096 + key * 8);
        if (KIND == 2) { const int sx = key >> 4, w = key & 15, hh = (w >> 2) & 1, j = (w & 3) + 4 * (w >> 3); return (unsigned)((b * 8 * 128 + tile) * 4096 + (2 * sx + hh) * 512 + j); }
        return (unsigned)((b * 32 * 8192 + tt) * 16);
    }
    template <int KIND> __device__ __forceinline__ void epik(const pg8::Unit& u, unsigned rp, int cb, f32x4 v00, f32x4 v01, f32x4 v10, f32x4 v11) const {
#pragma unroll
        for (int b = 0; b < 2; ++b) {
            const int col = (u.pn & 1) * 256 + b * 128 + cb; const f32x4 lo = b ? v10 : v00, hi = b ? v11 : v01;
            if (KIND == 0) { *(h8*)(qh + rp + col) = pack8(lo * QSCALE, hi * QSCALE); }
            else if (KIND == 1) { const int hd = col >> 6, d = col & 63; *(h8*)(kt + rp + (unsigned)(hd * 128 * 4096 + (d >> 3) * 512)) = pack8(lo, hi); }
            else if (KIND == 2) { const int hd = col >> 6, dv = col & 63; f16* q = vt + rp + (unsigned)(hd * 128 * 4096 + dv * 8);
                q[0] = (f16)lo[0]; q[8] = (f16)lo[1]; q[16] = (f16)lo[2]; q[24] = (f16)lo[3]; q[32] = (f16)hi[0]; q[40] = (f16)hi[1]; q[48] = (f16)hi[2]; q[56] = (f16)hi[3]; }
            else { const int g = col >> 4, c0 = col & 15; *(h8*)(ug + rp + (unsigned)(g * 8192 * 16 + c0)) = pack8(lo, hi); }
        }
    }
};
struct ProbPleProj {
    static constexpr int K = 256; static constexpr bool KINDS = false; static constexpr bool GATHER = false; static constexpr bool FP8 = false; static constexpr bool MID = false;
    const char* ph; const char* wpp; f16* pe;
    __device__ __forceinline__ const char* abase() const { return ph; }
    __device__ __forceinline__ unsigned rowoff(const pg8::Unit& u, int r) const { return (unsigned)(u.pm * 256 + r) * (unsigned)(K * 2); }
    __device__ __forceinline__ const char* bptr(const pg8::Unit& u) const { return wpp + (size_t)u.pn * 256 * K * 2; }
    __device__ __forceinline__ NoPre pre(const pg8::Unit&, int) const { return NoPre{}; }
    __device__ __forceinline__ int rowinfo(const pg8::Unit&, int) const { return 0; }
    __device__ __forceinline__ void epi(const pg8::Unit& u, NoPre, int, int lr, int cb, f32x4 v00, f32x4 v01, f32x4 v10, f32x4 v11) const {
        f16* o = pe + (size_t)(u.pm * 256 + lr) * 1024 + u.pn * 256 + cb; *(h8*)o = pack8(v00, v01); *(h8*)(o + 128) = pack8(v10, v11); }
};
struct ProbGlu {
    static constexpr int K = 512; static constexpr bool KINDS = false; static constexpr bool GATHER = false; static constexpr bool FP8 = false; static constexpr bool MID = false;
    const char* yh; const char* wg; f16* mix;
    __device__ __forceinline__ const char* abase() const { return yh; }
    __device__ __forceinline__ unsigned rowoff(const pg8::Unit& u, int r) const { return (unsigned)(u.pm * 256 + r) * (unsigned)(K * 2); }
    __device__ __forceinline__ const char* bptr(const pg8::Unit& u) const { return wg + (size_t)u.pn * 256 * K * 2; }
    __device__ __forceinline__ NoPre pre(const pg8::Unit&, int) const { return NoPre{}; }
    __device__ __forceinline__ int rowinfo(const pg8::Unit&, int) const { return 0; }
    __device__ __forceinline__ void epi(const pg8::Unit& u, NoPre, int, int lr, int cb, f32x4 v00, f32x4 v01, f32x4 v10, f32x4 v11) const {
        h8 o;
#pragma unroll
        for (int e = 0; e < 4; ++e) { o[e] = (f16)(v00[e] * sigmoidf_(v10[e])); o[4 + e] = (f16)(v01[e] * sigmoidf_(v11[e])); }
        *(h8*)(mix + (size_t)(u.pm * 256 + lr) * 1024 + u.pn * 128 + cb) = o; }
};
struct ProbOut {
    static constexpr int K = 1024; static constexpr bool KINDS = false; static constexpr bool GATHER = false; static constexpr bool FP8 = false; static constexpr bool MID = true;
    const char* mixb; const char* wo; f16* mixo;
    __device__ __forceinline__ const char* abase() const { return mixb; }
    __device__ __forceinline__ unsigned rowoff(const pg8::Unit& u, int r) const { return (unsigned)(u.pm * 256 + r) * (unsigned)(K * 2); }
    __device__ __forceinline__ const char* bptr(const pg8::Unit& u) const { return wo + (size_t)u.pn * 256 * K * 2; }
    __device__ __forceinline__ NoPre pre(const pg8::Unit&, int) const { return NoPre{}; }
    __device__ __forceinline__ int rowinfo(const pg8::Unit&, int) const { return 0; }
    __device__ __forceinline__ void mid_prepare(const pg8::Unit& u, LAS float* slot, int tid) const {
        const int row = tid >> 1; const h8* q = (const h8*)(mixb + (size_t)(u.pm * 256 + row) * 2048 + (tid & 1) * 512); float sacc = 0.f;
#pragma unroll 4
        for (int j = 0; j < 32; ++j) { const h8 v = q[j];
#pragma unroll
            for (int e = 0; e < 8; ++e) { const float f = (float)v[e]; sacc += f * f; } }
        sacc += __shfl_xor(sacc, 1);
        if (!(tid & 1)) slot[row] = rsqrtf(sacc * (1.0f / 512.0f) + RMS_EPS);
    }
    __device__ __forceinline__ void epi(const pg8::Unit& u, NoPre, int, int lr, int cb, f32x4 v00, f32x4 v01, f32x4 v10, f32x4 v11) const {
        f16* o = mixo + (size_t)(u.pm * 256 + lr) * 1024 + u.pn * 256 + cb; *(h8*)o = pack8(v00, v01); *(h8*)(o + 128) = pack8(v10, v11); }
};
struct Pre16 { f32x4 a, b, c, d; };
struct ProbMoeUp {
    static constexpr int K = 1024; static constexpr bool KINDS = false; static constexpr bool GATHER = true; static constexpr bool FP8 = true; static constexpr bool MID = false;
    const char* x1q; const char* wgu; const int* list; const float* bias; unsigned char* act;
    __device__ __forceinline__ const char* abase() const { return x1q; }
    __device__ __forceinline__ unsigned rowoff(const pg8::Unit&, int) const { return 0u; }
    __device__ __forceinline__ void fill_rows(const pg8::Unit& u, LAS int* tabp, int r) const { const int i = u.pm * 256 + r; const bool ok = i < u.cnt; const int a = list[(size_t)u.e * ECAP + (ok ? i : 0)]; tabp[r] = ok ? a : (a | (int)0x80000000); }
    __device__ __forceinline__ unsigned rowbytes(int a) const { return (unsigned)(a >> 2) * (unsigned)K; }
    __device__ __forceinline__ int rowinfo_lds(const LAS int* tabp, int lr) const { return tabp[lr]; }
    __device__ __forceinline__ const char* bptr(const pg8::Unit& u) const { return wgu + ((size_t)u.e * 2048 + (size_t)u.pn * 256) * K; }
    __device__ __forceinline__ Pre16 pre(const pg8::Unit& u, int cb) const {
        const float* bp = bias + u.e * 2048 + 2 * (u.pn * 128 + cb); Pre16 r; r.a = *(const f32x4*)bp; r.b = *(const f32x4*)(bp + 4); r.c = *(const f32x4*)(bp + 8); r.d = *(const f32x4*)(bp + 12); return r; }
    __device__ __forceinline__ int rowinfo(const pg8::Unit& u, int lr) const { const int i = u.pm * 256 + lr; return i < u.cnt ? list[(size_t)u.e * ECAP + i] : -1; }
    static constexpr int NW = 1;
    __device__ __forceinline__ int rowidx(int a) const { return a; }
    __device__ __forceinline__ i32x4 val(const pg8::Unit&, const Pre16& pb, int, f32x4 v00, f32x4 v01, f32x4 v10, f32x4 v11) const {
        const float bg[8] = {pb.a[0], pb.a[2], pb.b[0], pb.b[2], pb.c[0], pb.c[2], pb.d[0], pb.d[2]}, bl[8] = {pb.a[1], pb.a[3], pb.b[1], pb.b[3], pb.c[1], pb.c[3], pb.d[1], pb.d[3]};
        float o[8];
#pragma unroll
        for (int e = 0; e < 8; ++e) { const float g = fminf((e < 4 ? v00[e] : v01[e - 4]) * (1.0f / WGU_SCALE) + bg[e], 7.0f), l = fminf(fmaxf((e < 4 ? v10[e] : v11[e - 4]) * (1.0f / WGU_SCALE) + bl[e], -7.0f), 7.0f);
            o[e] = g * sigmoidf_(1.702f * g) * (l + 1.0f) * ACT_SCALE; }
        i32x4 w; w[0] = pack_fp8x4(o[0], o[1], o[2], o[3]); w[1] = pack_fp8x4(o[4], o[5], o[6], o[7]); w[2] = 0; w[3] = 0; return w; }
    __device__ __forceinline__ void store16(const pg8::Unit& u, int a, int cbs, int, i32x4 w) const { if (a < 0) return; *(i32x4*)(act + (size_t)a * 1024 + u.pn * 128 + cbs) = w; }
};
struct RowAG { int a; float g; };
struct ProbMoeDn {
    static constexpr int K = 1024; static constexpr bool KINDS = false; static constexpr bool GATHER = true; static constexpr bool FP8 = true; static constexpr bool MID = false;
    const char* actb; const char* wdn; const int* list; const float* bias; const float* gates; unsigned char* slab;
    __device__ __forceinline__ const char* abase() const { return actb; }
    __device__ __forceinline__ unsigned rowoff(const pg8::Unit&, int) const { return 0u; }
    __device__ __forceinline__ void fill_rows(const pg8::Unit& u, LAS int* tabp, int r) const { const int i = u.pm * 256 + r; const bool ok = i < u.cnt; const int a = list[(size_t)u.e * ECAP + (ok ? i : 0)];
        tabp[r] = ok ? a : (a | (int)0x80000000); tabp[256 + r] = __float_as_int(ok ? gates[a] : 0.f); }
    __device__ __forceinline__ unsigned rowbytes(int a) const { return (unsigned)a * (unsigned)K; }
    __device__ __forceinline__ RowAG rowinfo_lds(const LAS int* tabp, int lr) const { RowAG r; r.a = tabp[lr]; r.g = __int_as_float(tabp[256 + lr]); return r; }
    __device__ __forceinline__ const char* bptr(const pg8::Unit& u) const { return wdn + ((size_t)u.e * 1024 + (size_t)u.pn * 256) * K; }
    __device__ __forceinline__ Pre16 pre(const pg8::Unit& u, int cb) const {
        const float* bp = bias + u.e * 1024 + u.pn * 256 + cb; Pre16 r; r.a = *(const f32x4*)bp; r.b = *(const f32x4*)(bp + 4); r.c = *(const f32x4*)(bp + 128); r.d = *(const f32x4*)(bp + 132); return r; }
    __device__ __forceinline__ RowAG rowinfo(const pg8::Unit& u, int lr) const { const int i = u.pm * 256 + lr; RowAG r; r.a = i < u.cnt ? list[(size_t)u.e * ECAP + i] : -1; r.g = r.a >= 0 ? gates[r.a] : 0.f; return r; }
    static constexpr int NW = 2;
    __device__ __forceinline__ int rowidx(const RowAG& r) const { return r.a; }
    __device__ __forceinline__ i32x4 val(const pg8::Unit&, const Pre16& pb, const RowAG& ri, f32x4 v00, f32x4 v01, f32x4 v10, f32x4 v11) const {
        constexpr float S = 1.0f / (WDN_SCALE * ACT_SCALE);
        const float g = ri.g * SLAB_SCALE;
        f32x4 a = (v00 * S + pb.a) * g, b = (v01 * S + pb.b) * g, c = (v10 * S + pb.c) * g, d = (v11 * S + pb.d) * g;
#pragma unroll
        for (int e = 0; e < 4; ++e) { a[e] = fminf(fmaxf(a[e], -448.f), 448.f); b[e] = fminf(fmaxf(b[e], -448.f), 448.f); c[e] = fminf(fmaxf(c[e], -448.f), 448.f); d[e] = fminf(fmaxf(d[e], -448.f), 448.f); }
        i32x4 w; w[0] = pack_fp8x4(a[0], a[1], a[2], a[3]); w[1] = pack_fp8x4(b[0], b[1], b[2], b[3]); w[2] = pack_fp8x4(c[0], c[1], c[2], c[3]); w[3] = pack_fp8x4(d[0], d[1], d[2], d[3]); return w; }
    __device__ __forceinline__ void store16(const pg8::Unit& u, int a_, int cbs, int q, i32x4 w) const { if (a_ < 0) return; *(i32x4*)(slab + (size_t)a_ * 1024 + u.pn * 256 + q * 128 + cbs) = w; }
};
struct ProbPleGate {
    static constexpr int K = 1024; static constexpr bool KINDS = false; static constexpr bool GATHER = false; static constexpr bool FP8 = true; static constexpr bool MID = false;
    const char* rq; const char* wpg; f16* gateh;
    __device__ __forceinline__ const char* abase() const { return rq; }
    __device__ __forceinline__ unsigned rowoff(const pg8::Unit& u, int r) const { return (unsigned)(u.pm * 256 + r) * (unsigned)K; }
    __device__ __forceinline__ const char* bptr(const pg8::Unit& u) const { return wpg + (size_t)u.pn * 256 * K; }
    __device__ __forceinline__ NoPre pre(const pg8::Unit&, int) const { return NoPre{}; }
    __device__ __forceinline__ int rowinfo(const pg8::Unit&, int) const { return 0; }
    __device__ __forceinline__ void epi(const pg8::Unit& u, NoPre, int, int lr, int cb, f32x4 v00, f32x4 v01, f32x4 v10, f32x4 v11) const {
        f16* o = gateh + (size_t)(u.pm * 256 + lr) * 1024 + u.pn * 256 + cb;
        constexpr float S = 1.0f / (WDN_SCALE * RQ_SCALE);
        f32x4 a, b, c, d;
#pragma unroll
        for (int e = 0; e < 4; ++e) { a[e] = sigmoidf_(v00[e] * S); b[e] = sigmoidf_(v01[e] * S); c[e] = sigmoidf_(v10[e] * S); d[e] = sigmoidf_(v11[e] * S); }
        *(h8*)o = pack8(a, b); *(h8*)(o + 128) = pack8(c, d); }
};

__device__ __forceinline__ int invperm32(int c) { return 16 * ((c >> 2) & 1) + 4 * (c >> 3) + (c & 3); }
__device__ __forceinline__ void tr_item(const float* W, int K, int N, f16* WT, int item, int mode, const float* gsc, LAS float* scr, int lane) {
    const int nblk = N / 32, kb = item / nblk, nb = item % nblk, k0 = 64 * kb, n0 = 32 * nb;
#pragma unroll 8
    for (int i = 0; i < 32; ++i) {
        const int kk = 2 * i + (lane >> 5);
        float v = W[(size_t)(k0 + kk) * N + n0 + (lane & 31)];
        if (mode == 2 && k0 + kk >= 512) v *= gsc[k0 + kk - 512];
        scr[kk * 33 + (lane & 31)] = v;
    }
    asm volatile("s_waitcnt lgkmcnt(0)" ::: "memory");
    const int c = lane & 7;
#pragma unroll
    for (int j = 0; j < 4; ++j) {
        const int n = (lane >> 3) + 8 * j; const LAS float* s = scr + (8 * c) * 33 + n;
        const int ns = n0 + n; int nd;
        if (mode == 1 || mode == 3) { const int ja = mode == 1 ? (ns & 511) : (ns >> 1), bj = mode == 1 ? (ns >> 9) : (ns & 1), jl = ja & 127;
            nd = 256 * (ja >> 7) + 128 * bj + (jl & ~31) + invperm32(jl & 31); }
        else nd = (ns & ~31) + invperm32(ns & 31);
        int kd = k0 + 8 * c; if (mode == 2) kd = (kd + 512) & 1023;
        if (mode >= 3) {
            const float sc = mode == 3 ? WGU_SCALE : WDN_SCALE;
            typedef int i32x2 __attribute__((ext_vector_type(2)));
            i32x2 o; o[0] = pack_fp8x4(s[0] * sc, s[33] * sc, s[66] * sc, s[99] * sc); o[1] = pack_fp8x4(s[132] * sc, s[165] * sc, s[198] * sc, s[231] * sc);
            *(i32x2*)((unsigned char*)WT + (size_t)nd * K + kd) = o;
        } else {
            h8 o; o[0] = (f16)s[0]; o[1] = (f16)s[33]; o[2] = (f16)s[66]; o[3] = (f16)s[99]; o[4] = (f16)s[132]; o[5] = (f16)s[165]; o[6] = (f16)s[198]; o[7] = (f16)s[231];
            *(h8*)(WT + (size_t)nd * K + kd) = o;
        }
    }
    asm volatile("s_waitcnt lgkmcnt(0)" ::: "memory");
}

__device__ __forceinline__ void ssm_precompute(Frame& F, int g) {
    const Args& A = *F.a; const int tid = F.tid;
    LAS float* pwr = (LAS float*)F.lds;
    LAS float* pwi = pwr + 17 * 64;
    LAS float* Bbr = pwi + 17 * 64;
    LAS float* Bbi = Bbr + 1024;
    LAS float* Cr = Bbi + 1024;
    LAS float* Ci = Cr + 1024;
    LAS float* Kd = Ci + 1024;
    if (tid < 64) {
        const int p = tid;
        const float are = A.in[I_ARE][g * 64 + p], aim = A.in[I_AIM][g * 64 + p], dt = __expf(A.in[I_LOGDT][g]);
        for (int d = 0; d <= 16; ++d) { const float mag = __expf(are * dt * (float)d); float sn, cs; sincosf(aim * dt * (float)d, &sn, &cs); pwr[d * 64 + p] = mag * cs; pwi[d * 64 + p] = mag * sn; }
        const float abr = pwr[64 + p], abi = pwi[64 + p];
        const float nr = abr - 1.0f, ni = abi, den = 1.0f / (are * are + aim * aim);
        const float fr_ = (nr * are + ni * aim) * den, fi_ = (ni * are - nr * aim) * den;
        for (int c = 0; c < 16; ++c) { const float br = A.in[I_BRE][(g * 64 + p) * 16 + c], bi = A.in[I_BIM][(g * 64 + p) * 16 + c]; Bbr[p * 16 + c] = fr_ * br - fi_ * bi; Bbi[p * 16 + c] = fr_ * bi + fi_ * br; }
        float* a16 = (float*)(F.ws + WS_A16) + (g * 64 + p) * 2; a16[0] = pwr[16 * 64 + p]; a16[1] = pwi[16 * 64 + p];
    }
    for (int i = tid; i < 1024; i += NTHREADS) { Cr[i] = A.in[I_CRE][g * 1024 + i]; Ci[i] = A.in[I_CIM][g * 1024 + i]; }
    __syncthreads();
    for (int q = 0; q < 8; ++q) {
        const int idx = tid * 8 + q, d = idx >> 8, cp = (idx >> 4) & 15, c = idx & 15; float acc = 0.f;
        for (int p = 0; p < 64; ++p) { const float cr = Cr[cp * 64 + p], ci = Ci[cp * 64 + p], pr = pwr[d * 64 + p], pi = pwi[d * 64 + p];
            const float zr = cr * pr - ci * pi, zi = cr * pi + ci * pr; acc += zr * Bbr[p * 16 + c] - zi * Bbi[p * 16 + c]; }
        Kd[idx] = acc;
    }
    __syncthreads();
    f16* ops = (f16*)(F.ws + WS_SSMOP) + (size_t)g * 131072;
    f16* Top = ops; f16* We = ops + 65536; f16* Wc = ops + 65536 + 32768;
    for (int v = tid; v < 8192; v += NTHREADS) {
        const int row = v >> 5, kv = v & 31, j = kv >> 1, half = kv & 1, i = row >> 4, cp = row & 15; h8 o;
#pragma unroll
        for (int e = 0; e < 8; ++e) o[e] = (j <= i) ? (f16)Kd[((i - j) * 16 + cp) * 16 + 8 * half + e] : (f16)0.f;
        *(h8*)(Top + row * 256 + kv * 8) = o;
    }
    for (int v = tid; v < 4096; v += NTHREADS) {
        const int sx = v >> 5, kv = v & 31, j = kv >> 1, half = kv & 1, p = sx & 63; const float pr = pwr[(15 - j) * 64 + p], pi = pwi[(15 - j) * 64 + p]; h8 o;
#pragma unroll
        for (int e = 0; e < 8; ++e) { const float br = Bbr[p * 16 + 8 * half + e], bi = Bbi[p * 16 + 8 * half + e]; o[e] = (f16)(sx < 64 ? pr * br - pi * bi : pr * bi + pi * br); }
        *(h8*)(We + sx * 256 + kv * 8) = o;
    }
    for (int v = tid; v < 4096; v += NTHREADS) {
        const int row = v >> 4, kv = v & 15, i = row >> 4, cp = row & 15; h8 o;
#pragma unroll
        for (int e = 0; e < 8; ++e) { const int sx = 8 * kv + e, p = sx & 63; const float cr = Cr[cp * 64 + p], ci = Ci[cp * 64 + p], pr = pwr[(i + 1) * 64 + p], pi = pwi[(i + 1) * 64 + p];
            o[e] = (f16)(sx < 64 ? cr * pr - ci * pi : -(cr * pi + ci * pr)); }
        *(h8*)(Wc + row * 128 + kv * 8) = o;
    }
    __syncthreads();
}

__device__ __forceinline__ void p0_prologue(Frame& F) {
    const Args& A = *F.a;
    if (blockIdx.x < NG) ssm_precompute(F, (int)blockIdx.x);
    LAS float* scr = (LAS float*)(F.lds + F.wave * 16384);
    constexpr int I0 = 16 * 64, I1 = 8 * 32, I2 = 16 * 32, I3 = 16 * 32, I4 = 4 * 32, I5 = NE * 16 * 64, I6 = NE * 16 * 32;
    constexpr int NIT = I0 + I1 + I2 + I3 + I4 + I5;
    for (int it = F.gw; it < NIT; it += F.NGW) {
        int r = it;
        if (r < I0) { tr_item(A.in[I_WIN], 1024, 2048, (f16*)(F.ws + WS_WIN), r, 0, nullptr, scr, F.lane); continue; } r -= I0;
        if (r < I1) { tr_item(A.in[I_WGLU], 512, 1024, (f16*)(F.ws + WS_WGLU), r, 1, nullptr, scr, F.lane); continue; } r -= I1;
        if (r < I2) { tr_item(A.in[I_WOUT], 1024, 1024, (f16*)(F.ws + WS_WOUT), r, 2, A.in[I_SSMG], scr, F.lane); continue; } r -= I2;
        if (r < I3) { tr_item(A.in[I_WPG], 1024, 1024, (f16*)(F.ws + WS_WPG), r, 4, nullptr, scr, F.lane); continue; } r -= I3;
        if (r < I4) { tr_item(A.in[I_WPP], 256, 1024, (f16*)(F.ws + WS_WPP), r, 0, nullptr, scr, F.lane); continue; } r -= I4;
        if (r < I5) { const int e = r / (16 * 64), ii = r % (16 * 64);
            tr_item(A.in[I_WGU] + (size_t)e * 1024 * 2048, 1024, 2048, (f16*)(F.ws + WS_WGU + (size_t)e * 2048 * 1024), ii, 3, nullptr, scr, F.lane); continue; }
    }
    const size_t gt = (size_t)blockIdx.x * NTHREADS + F.tid, NT = (size_t)F.G * NTHREADS;
    { const f32x4* s = (const f32x4*)A.in[I_X]; h8* d = (h8*)(F.ws + WS_XH);
      for (size_t i = gt; i < (size_t)T * DM / 8; i += NT) { const f32x4 a = s[2 * i], b = s[2 * i + 1]; h8 o; o[0] = (f16)a[0]; o[1] = (f16)a[1]; o[2] = (f16)a[2]; o[3] = (f16)a[3]; o[4] = (f16)b[0]; o[5] = (f16)b[1]; o[6] = (f16)b[2]; o[7] = (f16)b[3]; d[i] = o; } }
    { const f32x4* s = (const f32x4*)A.in[I_P]; h8* d = (h8*)(F.ws + WS_PH);
      for (size_t i = gt; i < (size_t)T * PLE / 8; i += NT) { const f32x4 a = s[2 * i], b = s[2 * i + 1]; h8 o; o[0] = (f16)a[0]; o[1] = (f16)a[1]; o[2] = (f16)a[2]; o[3] = (f16)a[3]; o[4] = (f16)b[0]; o[5] = (f16)b[1]; o[6] = (f16)b[2]; o[7] = (f16)b[3]; d[i] = o; } }
}

__device__ __forceinline__ void p1_inproj(Frame& F) {
    { ProbInproj P{(const char*)(F.ws + WS_XH), (const char*)(F.ws + WS_WIN), (f16*)(F.ws + WS_QH), (f16*)(F.ws + WS_KT), (f16*)(F.ws + WS_VT), (f16*)(F.ws + WS_UG), F.ctl + CW_KMAX};
      pg8::DenseOrder S; S.init(T, DIN, F.G, (int)blockIdx.x); pg8::gemm_phase(F.lds, P, S); }
}

constexpr int ATT_SLOT = 32768, ATT_FLAGS = 3 * ATT_SLOT;
constexpr float ATT_SKIP = -40.0f;
constexpr int ATT_SG = 143360;
__device__ __forceinline__ int attn_unit(Frame& F, int b, int hd, int qb, float lam, gu32* qc, volatile LAS int* slot) {
    const int lane = F.lane, wave = F.wave, r32 = lane & 31, hi = lane >> 5;
    LAS unsigned char* lds = F.lds;
    const f16* qh = (const f16*)(F.ws + WS_QH);
    const f16* ktb = (const f16*)(F.ws + WS_KT) + (size_t)((b * 8 + hd) * 128) * 4096;
    const f16* vtb = (const f16*)(F.ws + WS_VT) + (size_t)((b * 8 + hd) * 128) * 4096;
    f16* mix = (f16*)(F.ws + WS_MIX);
    const int q0 = qb * 256, q0w = q0 + 32 * wave, NT = 4 * (qb + 1), NI = NT / 2; const size_t rowbase = (size_t)b * SEQ;
    volatile LAS int* flags = (volatile LAS int*)(lds + ATT_FLAGS);
#define ATT_ISSUE(ii) do { const int t0_ = NT - 1 - 2 * (ii); const unsigned so_ = (unsigned)(((ii) % 3) * ATT_SLOT + wave * 1024); \
        __builtin_amdgcn_global_load_lds((const unsigned*)(ktb + (size_t)t0_ * 4096 + wave * 512 + lane * 8), (LAS unsigned*)(lds + so_), 16, 0, 0); \
        __builtin_amdgcn_global_load_lds((const unsigned*)(vtb + (size_t)t0_ * 4096 + wave * 512 + lane * 8), (LAS unsigned*)(lds + so_ + 8192), 16, 0, 0); \
        __builtin_amdgcn_global_load_lds((const unsigned*)(ktb + (size_t)(t0_ - 1) * 4096 + wave * 512 + lane * 8), (LAS unsigned*)(lds + so_ + 16384), 16, 0, 0); \
        __builtin_amdgcn_global_load_lds((const unsigned*)(vtb + (size_t)(t0_ - 1) * 4096 + wave * 512 + lane * 8), (LAS unsigned*)(lds + so_ + 24576), 16, 0, 0); } while (0)
    ATT_ISSUE(0); ATT_ISSUE(1);
    if (lane == 0) { flags[wave] = 1; flags[8 + wave] = 1; }
    h8 qf[2][2];
#pragma unroll
    for (int mp = 0; mp < 2; ++mp)
#pragma unroll
        for (int kk = 0; kk < 2; ++kk) qf[mp][kk] = *(const h8*)(qh + (rowbase + q0w + r32) * 512 + hd * 64 + mp * 32 + kk * 16 + hi * 8);
    float sb1, sb2;
    { float n1 = 0.f, n2 = 0.f;
#pragma unroll
      for (int kk = 0; kk < 2; ++kk)
#pragma unroll
          for (int e = 0; e < 8; ++e) { const float a = (float)qf[0][kk][e], c = (float)qf[1][kk][e]; n1 += a * a; n2 += c * c; }
      n1 = swap_add(n1); n2 = swap_add(n2);
      const float k1 = __uint_as_float(__hip_atomic_load(F.ctl + CW_KMAX + (b * 8 + hd) * 2, RLX_AGENT)), k2 = __uint_as_float(__hip_atomic_load(F.ctl + CW_KMAX + (b * 8 + hd) * 2 + 1, RLX_AGENT));
      sb1 = sqrtf(n1) * k1 * 1.01f; sb2 = sqrtf(n2) * k2 * 1.01f; }
    const float slope2 = exp2f(-(float)(hd + 1)) * LOG2E;
    const int td = q0w >> 6, wo = q0w & 63;
    const f16 s_hi = (f16)slope2, s_lo = (f16)(slope2 - (float)s_hi);
    float mr1 = 0.f, mr2 = 0.f, l1 = 0.f, l2 = 0.f;
    h8 qx1, qx2;
    { h8 z; z[0] = (f16)(64.0f * (float)s_hi); z[1] = s_hi; z[2] = (f16)(64.0f * (float)s_lo); z[3] = s_lo; z[4] = (f16)0.f; z[5] = (f16)0.f; z[6] = (f16)0.f; z[7] = (f16)0.f;
      if (hi) { z[0] = (f16)0.f; z[1] = (f16)0.f; z[2] = (f16)0.f; z[3] = (f16)0.f; }
      qx1 = z; qx2 = z; }
    f32x16 o1[2], o2[2];
#pragma unroll
    for (int i = 0; i < 2; ++i) { o1[i] = (f32x16){}; o2[i] = (f32x16){}; }
    bool wdone = false, started = false;
    h2 ones; ones[0] = (f16)1.f; ones[1] = (f16)1.f;
#pragma unroll 1
    for (int ii = 0; ii < NI; ++ii) {
        if (ii + 1 < NI) asm volatile("s_waitcnt vmcnt(4) lgkmcnt(0)" ::: "memory"); else asm volatile("s_waitcnt vmcnt(0) lgkmcnt(0)" ::: "memory");
        __builtin_amdgcn_s_barrier();
        asm volatile("" ::: "memory");
        { const volatile LAS int* fl = flags + 8 * (ii & 1); const int any = fl[0] | fl[1] | fl[2] | fl[3] | fl[4] | fl[5] | fl[6] | fl[7];
          if (__builtin_amdgcn_readfirstlane(any) == 0) break; }
        if (ii + 2 < NI) ATT_ISSUE(ii + 2);
        bool need = !wdone;
        const int T0 = NT - 1 - 2 * ii, T1 = T0 - 1;
        if (T1 <= td && !wdone) {
            const bool first = !started; started = true;
            const LAS unsigned char* kp = lds + (ii % 3) * ATT_SLOT;
            const LAS unsigned char* kbase = kp + (hi * 512 + r32 * 8) * 2;
            const LAS unsigned char* vbase = kp + 8192 + (hi * 512 + r32 * 8) * 2;
            const float bmax = slope2 * (float)(64 * (T0 - td) + 63 - wo);
            const bool gen = first || T0 >= td || (__any(fmaxf(sb1 - mr1, sb2 - mr2) + bmax > 12.0f) != 0);
            const bool tlo = T0 > td;
            f32x16 s0[2], s1[2]; h8 kfr[4], vfr[6], pf[4], kxa, kxb; float ls;
#define ATT_SB __builtin_amdgcn_sched_barrier(0)
#define ATT_KX(tl) do { const f16 tr_ = (f16)(float)(T0 - (tl) - td); const f16 wa_ = (f16)(float)(r32 - wo), wb_ = (f16)(float)(32 + r32 - wo); h8 za, zb; \
                za[0] = tr_; za[1] = wa_; za[2] = tr_; za[3] = wa_; za[4] = (f16)1.f; za[5] = (f16)0.f; za[6] = (f16)0.f; za[7] = (f16)0.f; \
                zb[0] = tr_; zb[1] = wb_; zb[2] = tr_; zb[3] = wb_; zb[4] = (f16)1.f; zb[5] = (f16)0.f; zb[6] = (f16)0.f; zb[7] = (f16)0.f; \
                if (hi) { za[0] = (f16)0.f; za[1] = (f16)0.f; za[2] = (f16)0.f; za[3] = (f16)0.f; za[4] = (f16)0.f; zb[0] = (f16)0.f; zb[1] = (f16)0.f; zb[2] = (f16)0.f; zb[3] = (f16)0.f; zb[4] = (f16)0.f; } \
                kxa = za; kxb = zb; } while (0)
#define ATT_KLD(mp, tl) do { _Pragma("unroll") for (int kb = 0; kb < 2; ++kb) _Pragma("unroll") for (int j = 0; j < 2; ++j) \
                kfr[kb * 2 + j] = *(const LAS h8*)(kbase + (tl) * 16384 + ((mp) * 4 + j * 2) * 1024 + kb * 512); } while (0)
#define ATT_VLD(d, tl, sx, dh) vfr[d] = *(const LAS h8*)(vbase + (tl) * 16384 + (sx) * 2048 + (dh) * 512)
#define ATT_QKM(sn, mpn, qxn, j) do { if ((j) == 0) sn[0] = __builtin_amdgcn_mfma_f32_32x32x16_f16(kxa, qxn, (f32x16){}, 0, 0, 0); \
                else if ((j) == 1) sn[1] = __builtin_amdgcn_mfma_f32_32x32x16_f16(kxb, qxn, (f32x16){}, 0, 0, 0); \
                else if ((j) == 2) sn[0] = __builtin_amdgcn_mfma_f32_32x32x16_f16(kfr[0], qf[mpn][0], sn[0], 0, 0, 0); \
                else if ((j) == 3) sn[1] = __builtin_amdgcn_mfma_f32_32x32x16_f16(kfr[2], qf[mpn][0], sn[1], 0, 0, 0); \
                else if ((j) == 4) sn[0] = __builtin_amdgcn_mfma_f32_32x32x16_f16(kfr[1], qf[mpn][1], sn[0], 0, 0, 0); \
                else sn[1] = __builtin_amdgcn_mfma_f32_32x32x16_f16(kfr[3], qf[mpn][1], sn[1], 0, 0, 0); } while (0)
#define ATT_EXPH(sc, h) do { const float a0_ = __builtin_amdgcn_exp2f(sc[(h) >> 3][2 * ((h) & 7)]), a1_ = __builtin_amdgcn_exp2f(sc[(h) >> 3][2 * ((h) & 7) + 1]); \
                h2 p_; p_[0] = (f16)a0_; p_[1] = (f16)a1_; pf[(h) >> 2][2 * ((h) & 3)] = p_[0]; pf[(h) >> 2][2 * ((h) & 3) + 1] = p_[1]; \
                if (((h) & 1) == 0) hacc = p_; else { hacc = hacc + p_; asm volatile("v_dot2c_f32_f16 %0, %1, %2" : "+v"(ls) : "v"(hacc), "v"(ones)); } } while (0)
#define ATT_PLAINQK(sn, mpn, qxn) do { ATT_QKM(sn, mpn, qxn, 0); ATT_QKM(sn, mpn, qxn, 1); ATT_QKM(sn, mpn, qxn, 2); ATT_QKM(sn, mpn, qxn, 3); ATT_QKM(sn, mpn, qxn, 4); ATT_QKM(sn, mpn, qxn, 5); } while (0)
#define ATT_GENI(sc, mr, l, o, qx, tile, FIRST) do { \
                if ((tile) >= td) { _Pragma("unroll") for (int kb = 0; kb < 2; ++kb) _Pragma("unroll") for (int r = 0; r < 16; ++r) { const int kpos = 64 * (tile) + 32 * kb + crow(r, hi); if (kpos > q0w + r32) sc[kb][r] = -1e30f; } } \
                float rm = sc[0][0]; \
                _Pragma("unroll") for (int kb = 0; kb < 2; ++kb) _Pragma("unroll") for (int r = 0; r < 16; ++r) rm = fmaxf(rm, sc[kb][r]); \
                rm = swap_max(rm); \
                if ((FIRST) || __any(rm > 4.0f) != 0) { const float d = (FIRST) ? rm : fmaxf(rm, 0.f); const float f = __builtin_amdgcn_exp2f(-d); \
                    _Pragma("unroll") for (int kb = 0; kb < 2; ++kb) _Pragma("unroll") for (int r = 0; r < 16; ++r) sc[kb][r] -= d; \
                    mr += d; l *= f; o[0] *= f; o[1] *= f; if (!hi) qx[4] = (f16)(-mr); } } while (0)
#define ATT_BLOCK(sc, l, o, tlc, HASN, sn, mpn, qxn, NKLD) do { ls = 0.f; h2 hacc; \
                if (HASN) ATT_QKM(sn, mpn, qxn, 0); ATT_EXPH(sc, 0); ATT_SB; \
                if (HASN) ATT_QKM(sn, mpn, qxn, 1); ATT_EXPH(sc, 1); ATT_SB; \
                if (HASN) ATT_QKM(sn, mpn, qxn, 2); ATT_EXPH(sc, 2); ATT_VLD(0, tlc, 0, 0); ATT_VLD(1, tlc, 0, 1); ATT_SB; \
                if (HASN) ATT_QKM(sn, mpn, qxn, 3); ATT_EXPH(sc, 3); ATT_VLD(2, tlc, 1, 0); ATT_VLD(3, tlc, 1, 1); ATT_SB; \
                if (HASN) ATT_QKM(sn, mpn, qxn, 4); ATT_EXPH(sc, 4); ATT_VLD(4, tlc, 2, 0); ATT_VLD(5, tlc, 2, 1); ATT_SB; \
                if (HASN) ATT_QKM(sn, mpn, qxn, 5); ATT_EXPH(sc, 5); ATT_SB; \
                o[0] = __builtin_amdgcn_mfma_f32_32x32x16_f16(vfr[0], pf[0], o[0], 0, 0, 0); ATT_EXPH(sc, 6); ATT_EXPH(sc, 7); ATT_SB; \
                o[1] = __builtin_amdgcn_mfma_f32_32x32x16_f16(vfr[1], pf[0], o[1], 0, 0, 0); ATT_EXPH(sc, 8); NKLD; ATT_SB; \
                o[0] = __builtin_amdgcn_mfma_f32_32x32x16_f16(vfr[2], pf[1], o[0], 0, 0, 0); ATT_EXPH(sc, 9); ATT_EXPH(sc, 10); ATT_VLD(0, tlc, 3, 0); ATT_VLD(1, tlc, 3, 1); ATT_SB; \
                o[1] = __builtin_amdgcn_mfma_f32_32x32x16_f16(vfr[3], pf[1], o[1], 0, 0, 0); ATT_EXPH(sc, 11); ATT_SB; \
                o[0] = __builtin_amdgcn_mfma_f32_32x32x16_f16(vfr[4], pf[2], o[0], 0, 0, 0); ATT_EXPH(sc, 12); ATT_EXPH(sc, 13); ATT_SB; \
                o[1] = __builtin_amdgcn_mfma_f32_32x32x16_f16(vfr[5], pf[2], o[1], 0, 0, 0); ATT_EXPH(sc, 14); ATT_EXPH(sc, 15); ATT_SB; \
                o[0] = __builtin_amdgcn_mfma_f32_32x32x16_f16(vfr[0], pf[3], o[0], 0, 0, 0); ATT_SB; \
                o[1] = __builtin_amdgcn_mfma_f32_32x32x16_f16(vfr[1], pf[3], o[1], 0, 0, 0); ATT_SB; \
                l += ls; } while (0)
            if (!tlo) {
                ATT_KX(0); ATT_KLD(0, 0); ATT_PLAINQK(s0, 0, qx1); ATT_SB; ATT_KLD(1, 0); ATT_SB;
                if (gen) ATT_GENI(s0, mr1, l1, o1, qx1, T0, first);
                ATT_BLOCK(s0, l1, o1, 0, true, s1, 1, qx2, ATT_KLD(0, 1));
                ATT_KX(1);
                if (gen) ATT_GENI(s1, mr2, l2, o2, qx2, T0, first);
                ATT_BLOCK(s1, l2, o2, 0, true, s0, 0, qx1, ATT_KLD(1, 1));
            } else {
                ATT_KX(1); ATT_KLD(0, 1); ATT_PLAINQK(s0, 0, qx1); ATT_SB; ATT_KLD(1, 1); ATT_SB;
            }
            { const bool f2 = first && tlo;
              if (gen) ATT_GENI(s0, mr1, l1, o1, qx1, T1, f2);
              ATT_BLOCK(s0, l1, o1, 1, true, s1, 1, qx2, (void)0);
              if (gen) ATT_GENI(s1, mr2, l2, o2, qx2, T1, f2);
              ATT_BLOCK(s1, l2, o2, 1, false, s0, 0, qx1, (void)0); }
#undef ATT_SB
#undef ATT_KX
#undef ATT_KLD
#undef ATT_VLD
#undef ATT_QKM
#undef ATT_EXPH
#undef ATT_PLAINQK
#undef ATT_GENI
#undef ATT_BLOCK
            const float far = fmaxf(sb1 - mr1, sb2 - mr2) + slope2 * (float)(64 * T1 - 1 - q0w);
            need = (T1 >= 1) && (__any(far >= ATT_SKIP) != 0);
            if (!need) wdone = true;
        }
        if (lane == 0) flags[8 * ((ii + 1) & 1) + wave] = need ? 1 : 0;
    }
    asm volatile("s_waitcnt vmcnt(0) lgkmcnt(0)" ::: "memory");
    __builtin_amdgcn_s_barrier();
    asm volatile("" ::: "memory");
#undef ATT_ISSUE
    unsigned nxt = 0;
    if (F.tid == 0) nxt = __hip_atomic_fetch_add(qc, 1u, RLX_AGENT);
    l1 = swap_add(l1); l2 = swap_add(l2);
    const float i1 = 1.0f / l1, i2 = lam / l2;
    float ss = 0.f;
#pragma unroll
    for (int dh = 0; dh < 2; ++dh)
#pragma unroll
        for (int r = 0; r < 16; ++r) { const float v = o1[dh][r] * i1 - o2[dh][r] * i2; o1[dh][r] = v; ss += v * v; }
    ss = swap_add(ss);
    const float rs = rsqrtf(ss * (1.0f / 64.0f) + RMS_EPS) * 0.8f;
    const LAS float* sg = (const LAS float*)(lds + ATT_SG);
    f16* orow = mix + (rowbase + q0w + r32) * 1024 + 512 + hd * 64;
#pragma unroll
    for (int dh = 0; dh < 2; ++dh)
#pragma unroll
        for (int gq = 0; gq < 4; ++gq) {
            const int dv = 32 * dh + 8 * gq + 4 * hi; const f32x4 gg = *(const LAS f32x4*)(sg + dv);
            h4 o; o[0] = (f16)(o1[dh][4 * gq] * rs * gg[0]); o[1] = (f16)(o1[dh][4 * gq + 1] * rs * gg[1]); o[2] = (f16)(o1[dh][4 * gq + 2] * rs * gg[2]); o[3] = (f16)(o1[dh][4 * gq + 3] * rs * gg[3]);
            *(h4*)(orow + dv) = o;
        }
    if (F.tid == 0) slot[0] = (int)nxt;
    __syncthreads();
    const int nit = __builtin_amdgcn_readfirstlane(slot[0]);
    __syncthreads();
    return nit;
}

constexpr int SSM_UROW = 528, SSM_EROW = 528, SSM_XROW = 272;
constexpr int SSM_U0 = 0, SSM_U1 = 64 * SSM_UROW, SSM_E = 2 * 64 * SSM_UROW, SSM_XP = SSM_E + 64 * SSM_EROW;
typedef float f32x4_t __attribute__((ext_vector_type(4)));
__device__ __forceinline__ void ssm_unit(Frame& F, int b, int g) {
    const Args& A = *F.a; const int tid = F.tid, wave = F.wave, lane = F.lane, fr = lane & 15, fq = lane >> 4;
    const f16* ops = (const f16*)(F.ws + WS_SSMOP) + (size_t)g * 131072;
    const f16* Top = ops; const f16* We = ops + 65536; const f16* Wc = ops + 65536 + 32768;
    const char* ugb = (const char*)((const f16*)(F.ws + WS_UG) + (size_t)((b * 32 + g) * 8192) * 16);
    f16* yh = (f16*)(F.ws + WS_YH) + (size_t)b * SEQ * 512 + g * 16;
    LAS unsigned char* lds = F.lds;
    h8 BY[2][12];
#pragma unroll
    for (int n2 = 0; n2 < 2; ++n2) {
        const int nrow = 16 * (2 * wave + n2) + fr;
#pragma unroll
        for (int kk = 0; kk < 8; ++kk) BY[n2][kk] = *(const h8*)(Top + nrow * 256 + 32 * kk + 8 * fq);
#pragma unroll
        for (int kk = 0; kk < 4; ++kk) BY[n2][8 + kk] = *(const h8*)(Wc + nrow * 128 + 32 * kk + 8 * fq);
    }
    const float* a16 = (const float*)(F.ws + WS_A16) + (g * 64 + lane) * 2;
    const float a16r = a16[0], a16i = a16[1];
    const f32x4 dsk = *(const f32x4*)(A.in[I_SSMD] + g * 16 + 4 * fq);
    float xr = 0.f, xi = 0.f;
#pragma unroll
    for (int q = 0; q < 4; ++q) { const int o = (q * NTHREADS + tid) * 16; const h8 v = *(const h8*)(ugb + o); *(LAS h8*)(lds + SSM_U0 + (o >> 9) * SSM_UROW + (o & 511)) = v; }
    __syncthreads();
#pragma unroll 1
    for (int seg = 0; seg < 8; ++seg) {
        LAS unsigned char* Uc = lds + ((seg & 1) ? SSM_U1 : SSM_U0);
        LAS unsigned char* Un = lds + ((seg & 1) ? SSM_U0 : SSM_U1);
        {
            f32x4 ea[4]; h8 BE[8];
#pragma unroll
            for (int kk = 0; kk < 8; ++kk) BE[kk] = *(const h8*)(We + (16 * wave + fr) * 256 + 32 * kk + 8 * fq);
#pragma unroll
            for (int mt = 0; mt < 4; ++mt) ea[mt] = (f32x4){0.f, 0.f, 0.f, 0.f};
#pragma unroll
            for (int kk = 0; kk < 8; ++kk)
#pragma unroll
                for (int mt = 0; mt < 4; ++mt) { const h8 a = *(const LAS h8*)(Uc + (16 * mt + fr) * SSM_UROW + (32 * kk + 8 * fq) * 2); ea[mt] = __builtin_amdgcn_mfma_f32_16x16x32_f16(BE[kk], a, ea[mt], 0, 0, 0); }
#pragma unroll
            for (int mt = 0; mt < 4; ++mt) *(LAS f32x4*)(lds + SSM_E + (16 * mt + fr) * SSM_EROW + (16 * wave + 4 * fq) * 4) = ea[mt];
        }
        __syncthreads();
        if (wave == 0) {
#pragma unroll 8
            for (int n = 0; n < 64; ++n) {
                const float er = *(const LAS float*)(lds + SSM_E + n * SSM_EROW + lane * 4), ei = *(const LAS float*)(lds + SSM_E + n * SSM_EROW + (64 + lane) * 4);
                *(LAS f16*)(lds + SSM_XP + n * SSM_XROW + lane * 2) = (f16)xr; *(LAS f16*)(lds + SSM_XP + n * SSM_XROW + (64 + lane) * 2) = (f16)xi;
                const float nr = a16r * xr - a16i * xi + er, ni = a16r * xi + a16i * xr + ei; xr = nr; xi = ni;
            }
        } else if (seg < 7) {
            const char* src = ugb + (size_t)(seg + 1) * 32768;
            for (int v = tid - 64; v < 2048; v += NTHREADS - 64) { const int o = v * 16; const h8 x = *(const h8*)(src + o); *(LAS h8*)(Un + (o >> 9) * SSM_UROW + (o & 511)) = x; }
        }
        __syncthreads();
        {
            f32x4 ya[4][2];
#pragma unroll
            for (int mt = 0; mt < 4; ++mt) { ya[mt][0] = (f32x4){0.f, 0.f, 0.f, 0.f}; ya[mt][1] = (f32x4){0.f, 0.f, 0.f, 0.f}; }
#pragma unroll
            for (int kk = 0; kk < 12; ++kk)
#pragma unroll
                for (int mt = 0; mt < 4; ++mt) {
                    const h8 a = kk < 8 ? *(const LAS h8*)(Uc + (16 * mt + fr) * SSM_UROW + (32 * kk + 8 * fq) * 2) : *(const LAS h8*)(lds + SSM_XP + (16 * mt + fr) * SSM_XROW + (32 * (kk - 8) + 8 * fq) * 2);
                    ya[mt][0] = __builtin_amdgcn_mfma_f32_16x16x32_f16(BY[0][kk], a, ya[mt][0], 0, 0, 0);
                    ya[mt][1] = __builtin_amdgcn_mfma_f32_16x16x32_f16(BY[1][kk], a, ya[mt][1], 0, 0, 0);
                }
#pragma unroll
            for (int mt = 0; mt < 4; ++mt)
#pragma unroll
                for (int n2 = 0; n2 < 2; ++n2) {
                    const int ch = 16 * mt + fr, ti = 2 * wave + n2; const size_t tok = (size_t)(seg * 64 + ch) * 16 + ti;
                    const h4 u4 = *(const LAS h4*)(Uc + ch * SSM_UROW + (ti * 16 + 4 * fq) * 2);
                    h4 o;
#pragma unroll
                    for (int e = 0; e < 4; ++e) o[e] = (f16)gelu_tanh(ya[mt][n2][e] + dsk[e] * (float)u4[e]);
                    *(h4*)(yh + tok * 512 + 4 * fq) = o;
                }
        }
    }
    __syncthreads();
}

__device__ __forceinline__ void p2_mixers(Frame& F, int pass) {
    const Args& A = *F.a;
    gu32* qctr = F.ctl + CW_QUEUE + 128 * pass;
    constexpr int NSSM = BATCH * NG, NATT = BATCH * NH * 32;
    volatile LAS int* slot = (volatile LAS int*)(F.lds + LDS_BARST + 16);
    for (;;) {
        if (F.tid == 0) slot[0] = (int)__hip_atomic_fetch_add(qctr, 1u, RLX_AGENT);
        __syncthreads();
        const int it = __builtin_amdgcn_readfirstlane(slot[0]);
        __syncthreads();
        if (it >= NSSM) break;
        if (pass == 1 && PROBE_SEL != 0 && PROBE_SEL != 1) continue;
        ssm_unit(F, it / NG, it % NG);
    }
    asm volatile("" ::: "memory");
    float lam;
    { float d1 = 0.f, d2 = 0.f;
#pragma unroll 1
      for (int i = 0; i < 32; ++i) { d1 += A.in[I_LQ1][i] * A.in[I_LK1][i]; d2 += A.in[I_LQ2][i] * A.in[I_LK2][i]; }
      lam = __expf(d1) - __expf(d2) + 0.2f; }
    asm volatile("" : "+v"(lam));
    if (F.tid < 64) *(LAS float*)(F.lds + ATT_SG + F.tid * 4) = A.in[I_SUBLN][F.tid];
    int ait;
    { if (F.tid == 0) slot[0] = (int)__hip_atomic_fetch_add(qctr + 64, 1u, RLX_AGENT);
      __syncthreads();
      ait = __builtin_amdgcn_readfirstlane(slot[0]);
      __syncthreads(); }
    while (ait < NATT) {
        const int qb = 31 - ait / 32, bh = ait % 32;
        if (pass == 1 && PROBE_SEL != 0) { const int hd_ = bh & 7; const bool sel = PROBE_SEL == 2 ? hd_ >= 6 : PROBE_SEL == 3 ? hd_ <= 3 : PROBE_SEL == 4 ? (hd_ == 7 && qb == 31) : PROBE_SEL == 5 ? (hd_ == 4 || hd_ == 5) : false;
            if (!sel) { if (F.tid == 0) slot[0] = (int)__hip_atomic_fetch_add(qctr + 64, 1u, RLX_AGENT); __syncthreads(); ait = __builtin_amdgcn_readfirstlane(slot[0]); __syncthreads(); continue; } }
        ait = attn_unit(F, bh >> 3, bh & 7, qb, lam, qctr + 64, slot);
    }
    constexpr int NPLE = (T / 256) * 4, WDN_ITEMS = NE * 16 * 32, WDN_CHUNK = 32, NWDN = WDN_ITEMS / WDN_CHUNK;
    gu32* fctr = F.ctl + CW_QUEUE + 256 + 64 * pass;
    for (;;) {
        if (F.tid == 0) slot[0] = (int)__hip_atomic_fetch_add(fctr, 1u, RLX_AGENT);
        __syncthreads();
        const int it = __builtin_amdgcn_readfirstlane(slot[0]);
        __syncthreads();
        if (it >= NPLE + NWDN) break;
        if (it < NPLE) {
            ProbPleProj P{(const char*)(F.ws + WS_PH), (const char*)(F.ws + WS_WPP), (f16*)(F.ws + WS_PE)};
            pg8::OneOrder S; S.u.pm = it >> 2; S.u.pn = it & 3; S.u.e = 0; S.u.cnt = 0; pg8::gemm_phase(F.lds, P, S);
        } else {
            LAS float* scr = (LAS float*)(F.lds + F.wave * 16384);
#pragma unroll 1
            for (int j = 0; j < WDN_CHUNK / 8; ++j) { const int r = (it - NPLE) * WDN_CHUNK + j * 8 + F.wave; const int e = r / (16 * 32), ii = r % (16 * 32);
                tr_item(A.in[I_WDN] + (size_t)e * 1024 * 1024, 1024, 1024, (f16*)(F.ws + WS_WDN + (size_t)e * 1024 * 1024), ii, 4, nullptr, scr, F.lane); }
        }
        __syncthreads();
    }
}

__device__ __forceinline__ void p3_glu(Frame& F) {
    ProbGlu P{(const char*)(F.ws + WS_YH), (const char*)(F.ws + WS_WGLU), (f16*)(F.ws + WS_MIX)};
    pg8::DenseOrder S; S.init(T, 1024, F.G, (int)blockIdx.x); pg8::gemm_phase(F.lds, P, S);
}

__device__ __forceinline__ void p4_outproj(Frame& F) {
    ProbOut P{(const char*)(F.ws + WS_MIX), (const char*)(F.ws + WS_WOUT), (f16*)(F.ws + WS_MIXO)};
    pg8::DenseOrder S; S.init(T, DM, F.G, (int)blockIdx.x); pg8::gemm_phase(F.lds, P, S);
}

constexpr int RT_XROW = 2064;
constexpr int RT_XHI = 0, RT_XLO = 32 * RT_XROW;
constexpr int RT_PART = 0;
constexpr int RT_FIN = 2 * 32 * RT_XROW;
constexpr int RT_CNT = RT_FIN + 32 * 33 * 4;
__device__ __forceinline__ void p5_router(Frame& F, int pass) {
    const Args& A = *F.a; const int tid = F.tid, lane = F.lane, wave = F.wave, r32 = lane & 31, hi = lane >> 5;
    LAS unsigned char* lds = F.lds;
    LAS unsigned* lcnt = (LAS unsigned*)(lds + RT_CNT); LAS unsigned* lbase = lcnt + 32; LAS unsigned* asg = lcnt + 64;
    if (tid < 32) lcnt[tid] = 0u;
    const float* xin = A.in[I_X]; const f16* mixo = (const f16*)(F.ws + WS_MIXO); f16* x1h = (f16*)(F.ws + WS_X1H); unsigned char* x1q = (unsigned char*)(F.ws + WS_X1Q); float* gates = (float*)(F.ws + WS_GATES);
    h8 whi[8], wlo[8];
#pragma unroll
    for (int kk = 0; kk < 8; ++kk)
#pragma unroll
        for (int e = 0; e < 8; ++e) { const float w = A.in[I_WR][(128 * wave + 16 * kk + 8 * hi + e) * 32 + r32]; const f16 h = (f16)w; whi[kk][e] = h; wlo[kk][e] = (f16)(w - (float)h); }
    f32x4 gv[4], bv[4];
#pragma unroll
    for (int jx = 0; jx < 4; ++jx) { gv[jx] = *(const f32x4*)(A.in[I_LN1G] + 256 * jx + 4 * lane); bv[jx] = *(const f32x4*)(A.in[I_LN1B] + 256 * jx + 4 * lane); }
    const int rows_per_blk = T / F.G;
#pragma unroll 1
    for (int bt = 0; bt < rows_per_blk / 32; ++bt) {
        const int row0 = blockIdx.x * rows_per_blk + bt * 32;
#pragma unroll 1
        for (int rr = 0; rr < 4; ++rr) {
            const int lr = wave * 4 + rr; const size_t ro = (size_t)(row0 + lr) * 1024;
            f32x4 v[4]; float s1 = 0.f, s2 = 0.f;
#pragma unroll
            for (int jx = 0; jx < 4; ++jx) { const f32x4 xv = *(const f32x4*)(xin + ro + 256 * jx + 4 * lane); const h4 mv = *(const h4*)(mixo + ro + 256 * jx + 4 * lane);
#pragma unroll
                for (int e = 0; e < 4; ++e) { const float t = ALPHA * xv[e] + (float)mv[e]; v[jx][e] = t; s1 += t; } }
            const float mean = wave_sum(s1) * (1.0f / 1024.0f);
#pragma unroll
            for (int jx = 0; jx < 4; ++jx) { v[jx] = v[jx] - mean; s2 += (v[jx][0] * v[jx][0] + v[jx][1] * v[jx][1]) + (v[jx][2] * v[jx][2] + v[jx][3] * v[jx][3]); }
            const float rstd = rsqrtf(wave_sum(s2) * (1.0f / 1024.0f) + LN_EPS);
#pragma unroll
            for (int jx = 0; jx < 4; ++jx) {
                const f32x4 y = v[jx] * rstd * gv[jx] + bv[jx];
                h4 yh_, yl_;
#pragma unroll
                for (int e = 0; e < 4; ++e) { const f16 h = (f16)y[e]; yh_[e] = h; yl_[e] = (f16)(y[e] - (float)h); }
                *(h4*)(x1h + ro + 256 * jx + 4 * lane) = yh_;
                *(int*)(x1q + ro + 256 * jx + 4 * lane) = pack_fp8x4(y[0], y[1], y[2], y[3]);
                *(LAS h4*)(lds + RT_XHI + lr * RT_XROW + (256 * jx + 4 * lane) * 2) = yh_;
                *(LAS h4*)(lds + RT_XLO + lr * RT_XROW + (256 * jx + 4 * lane) * 2) = yl_;
            }
        }
        __syncthreads();
        f32x16 acc = {};
#pragma unroll
        for (int kk = 0; kk < 8; ++kk) {
            const int ko = (128 * wave + 16 * kk + 8 * hi) * 2;
            const h8 xh_ = *(const LAS h8*)(lds + RT_XHI + r32 * RT_XROW + ko), xl_ = *(const LAS h8*)(lds + RT_XLO + r32 * RT_XROW + ko);
            acc = __builtin_amdgcn_mfma_f32_32x32x16_f16(whi[kk], xh_, acc, 0, 0, 0);
            acc = __builtin_amdgcn_mfma_f32_32x32x16_f16(wlo[kk], xh_, acc, 0, 0, 0);
            acc = __builtin_amdgcn_mfma_f32_32x32x16_f16(whi[kk], xl_, acc, 0, 0, 0);
        }
        __syncthreads();
#pragma unroll
        for (int g = 0; g < 4; ++g) { f32x4 o; o[0] = acc[4 * g]; o[1] = acc[4 * g + 1]; o[2] = acc[4 * g + 2]; o[3] = acc[4 * g + 3];
            *(LAS f32x4*)(lds + RT_PART + (((wave * 32 + r32) * 32) + 8 * g + 4 * hi) * 4) = o; }
        __syncthreads();
        { const int row = tid >> 4, e0 = 2 * (tid & 15); float a0 = A.in[I_BR][e0], a1 = A.in[I_BR][e0 + 1];
#pragma unroll
          for (int w = 0; w < 8; ++w) { a0 += *(const LAS float*)(lds + RT_PART + (((w * 32 + row) * 32) + e0) * 4); a1 += *(const LAS float*)(lds + RT_PART + (((w * 32 + row) * 32) + e0 + 1) * 4); }
          *(LAS float*)(lds + RT_FIN + (row * 33 + e0) * 4) = a0; *(LAS float*)(lds + RT_FIN + (row * 33 + e0 + 1) * 4) = a1; }
        __syncthreads();
        if (tid < 32) {
            const LAS float* lg = (const LAS float*)(lds + RT_FIN + tid * 33 * 4);
            float tv[4]; int te[4];
#pragma unroll
            for (int k = 0; k < 4; ++k) { tv[k] = -INFINITY; te[k] = 0; }
#pragma unroll 1
            for (int e = 0; e < 32; ++e) { const float x = lg[e];
                if (x > tv[3]) {
                    if (x > tv[0]) { tv[3] = tv[2]; te[3] = te[2]; tv[2] = tv[1]; te[2] = te[1]; tv[1] = tv[0]; te[1] = te[0]; tv[0] = x; te[0] = e; }
                    else if (x > tv[1]) { tv[3] = tv[2]; te[3] = te[2]; tv[2] = tv[1]; te[2] = te[1]; tv[1] = x; te[1] = e; }
                    else if (x > tv[2]) { tv[3] = tv[2]; te[3] = te[2]; tv[2] = x; te[2] = e; }
                    else { tv[3] = x; te[3] = e; } } }
            const float e1 = __expf(tv[1] - tv[0]), e2 = __expf(tv[2] - tv[0]), e3 = __expf(tv[3] - tv[0]); const float inv = 1.0f / (1.0f + e1 + e2 + e3);
            const int row = row0 + tid; f32x4 gk; gk[0] = inv; gk[1] = e1 * inv; gk[2] = e2 * inv; gk[3] = e3 * inv;
            *(f32x4*)(gates + (size_t)row * 4) = gk;
#pragma unroll
            for (int k = 0; k < 4; ++k) { const unsigned rk = atomicAdd((unsigned*)&lcnt[te[k]], 1u); asg[(bt * 32 + tid) * 4 + k] = (unsigned)te[k] | (rk << 8); }
        }
        __syncthreads();
    }
    if (F.tid < 32) lbase[F.tid] = __hip_atomic_fetch_add(F.ctl + CW_CNT + 2048 * pass + 64 * F.tid, lcnt[F.tid], RLX_AGENT);
    __syncthreads();
    int* list = (int*)(F.ws + WS_LIST + (size_t)pass * 4 * MiB);
    { const unsigned a = asg[F.tid]; const int e = a & 255, rk = a >> 8; const int row = blockIdx.x * rows_per_blk + (F.tid >> 2);
      list[(size_t)e * ECAP + lbase[e] + rk] = row * 4 + (F.tid & 3); }
    __syncthreads();
}

template <int WHICH> __device__ __forceinline__ void p67_moe(Frame& F) {
    const Args& A = *F.a;
    LAS int* tab = (LAS int*)(F.lds + pg8::STAGE_BYTES + 2048);
    if (F.tid < 32) tab[F.tid] = (int)__hip_atomic_load(F.ctl + CW_CNT + 64 * F.tid, RLX_AGENT);
    __syncthreads();
    if (F.tid == 0) { int sacc = 0; for (int e = 0; e < 32; ++e) { tab[32 + e] = sacc; sacc += (tab[e] + 255) >> 8; } tab[64] = sacc; }
    __syncthreads();
    const int* list = (const int*)(F.ws + WS_LIST);
    if (WHICH == 0) {
        ProbMoeUp P{(const char*)(F.ws + WS_X1Q), (const char*)(F.ws + WS_WGU), list, A.in[I_BGU], (unsigned char*)(F.ws + WS_ACT)};
        pg8::MoeOrder S{tab, 8, F.G, F.vcu}; pg8::gemm_phase(F.lds, P, S);
    } else {
        ProbMoeDn P{(const char*)(F.ws + WS_ACT), (const char*)(F.ws + WS_WDN), list, A.in[I_BDN], (const float*)(F.ws + WS_GATES), (unsigned char*)(F.ws + WS_SLAB)};
        pg8::MoeOrder S{tab, 4, F.G, F.vcu}; pg8::gemm_phase(F.lds, P, S);
    }
    __syncthreads();
}

__device__ __forceinline__ void p8_combine(Frame& F) {
    const int lane = F.lane;
    typedef int i32x2 __attribute__((ext_vector_type(2))); typedef float f32x2 __attribute__((ext_vector_type(2)));
    const f16* x1h = (const f16*)(F.ws + WS_X1H); const unsigned char* slab = (const unsigned char*)(F.ws + WS_SLAB); f16* rh = (f16*)(F.ws + WS_RH); unsigned char* rq = (unsigned char*)(F.ws + WS_RQ);
    for (int row = F.gw; row < T; row += F.NGW) {
#pragma unroll
        for (int j = 0; j < 2; ++j) {
            const size_t o = (size_t)row * 1024 + 512 * j + 8 * lane;
            const h8 xv = *(const h8*)(x1h + o); float v[8], acc[8];
#pragma unroll
            for (int e = 0; e < 8; ++e) { v[e] = ALPHA * (float)xv[e]; acc[e] = 0.f; }
#pragma unroll
            for (int k = 0; k < 4; ++k) { const i32x2 sv = *(const i32x2*)(slab + ((size_t)row * 4 + k) * 1024 + 512 * j + 8 * lane);
#pragma unroll
                for (int q = 0; q < 2; ++q) { const f32x2 lo = __builtin_amdgcn_cvt_pk_f32_fp8(sv[q], false), hi = __builtin_amdgcn_cvt_pk_f32_fp8(sv[q], true);
                    acc[4 * q] += lo[0]; acc[4 * q + 1] += lo[1]; acc[4 * q + 2] += hi[0]; acc[4 * q + 3] += hi[1]; } }
            h8 hh;
#pragma unroll
            for (int e = 0; e < 8; ++e) { v[e] += acc[e] * (1.0f / SLAB_SCALE); hh[e] = (f16)v[e]; v[e] = fminf(fmaxf(v[e] * RQ_SCALE, -448.f), 448.f); }
            *(h8*)(rh + o) = hh;
            i32x2 qq = {pack_fp8x4(v[0], v[1], v[2], v[3]), pack_fp8x4(v[4], v[5], v[6], v[7])}; *(i32x2*)(rq + o) = qq;
        }
    }
}

__device__ __forceinline__ void p9_ple(Frame& F) {
    ProbPleGate P{(const char*)(F.ws + WS_RQ), (const char*)(F.ws + WS_WPG), (f16*)(F.ws + WS_GATEH)};
    pg8::DenseOrder S; S.init(T, DM, F.G, (int)blockIdx.x); pg8::gemm_phase(F.lds, P, S);
}

__device__ __forceinline__ void p10_ln2(Frame& F) {
    const Args& A = *F.a; const int lane = F.lane; float* out = A.out; const f16* rh = (const f16*)(F.ws + WS_RH); const f16* gateh = (const f16*)(F.ws + WS_GATEH); const f16* pe = (const f16*)(F.ws + WS_PE);
    f32x4 gv[4], bv[4];
#pragma unroll
    for (int j = 0; j < 2; ++j)
#pragma unroll
        for (int q = 0; q < 2; ++q) { gv[2 * j + q] = *(const f32x4*)(A.in[I_LN2G] + 512 * j + 8 * lane + 4 * q); bv[2 * j + q] = *(const f32x4*)(A.in[I_LN2B] + 512 * j + 8 * lane + 4 * q); }
    for (int row = F.gw; row < T; row += F.NGW) {
        f32x4 v[4]; float s = 0.f;
#pragma unroll
        for (int j = 0; j < 2; ++j) { const size_t o_ = (size_t)row * 1024 + 512 * j + 8 * lane; const h8 r8 = *(const h8*)(rh + o_), g8 = *(const h8*)(gateh + o_), p8 = *(const h8*)(pe + o_);
#pragma unroll
            for (int q = 0; q < 2; ++q) { f32x4 t;
#pragma unroll
                for (int e = 0; e < 4; ++e) t[e] = (float)r8[4 * q + e] + (float)g8[4 * q + e] * (float)p8[4 * q + e];
                v[2 * j + q] = t; s += (t[0] + t[1]) + (t[2] + t[3]); } }
        const float mean = wave_sum(s) * (1.0f / 1024.0f); float s2 = 0.f;
#pragma unroll
        for (int j = 0; j < 4; ++j) { v[j] = v[j] - mean; s2 += (v[j][0] * v[j][0] + v[j][1] * v[j][1]) + (v[j][2] * v[j][2] + v[j][3] * v[j][3]); }
        const float rstd = rsqrtf(wave_sum(s2) * (1.0f / 1024.0f) + LN_EPS);
#pragma unroll
        for (int j = 0; j < 2; ++j)
#pragma unroll
            for (int q = 0; q < 2; ++q) *(f32x4*)(out + (size_t)row * 1024 + 512 * j + 8 * lane + 4 * q) = v[2 * j + q] * rstd * gv[2 * j + q] + bv[2 * j + q];
    }
}

__global__ void __launch_bounds__(NTHREADS, 2) fwd_kernel(Args args) {
    extern __shared__ __attribute__((aligned(16))) unsigned char lds_raw[];
    Frame F;
    F.lds = (LAS unsigned char*)lds_raw; F.a = &args; F.ws = args.ws; F.ctl = (gu32*)(args.ws + WS_CTL);
    F.tid = threadIdx.x; F.lane = F.tid & 63; F.wave = __builtin_amdgcn_readfirstlane(F.tid >> 6);
    F.G = gridDim.x; F.gw = blockIdx.x * NWAVES + F.wave; F.NGW = F.G * NWAVES;
    { const int bx = blockIdx.x; F.vcu = (F.G % 8 == 0) ? (bx % 8) * (F.G / 8) + bx / 8 : bx; }
    volatile LAS unsigned* barst = (volatile LAS unsigned*)(F.lds + LDS_BARST);
    if (F.tid < 16) barst[F.tid] = 0u;
    __syncthreads();
    XcdBarrier bar; bar.bar = (unsigned*)(F.ctl + CW_BAR); bar.x = 0; bar.st = nullptr;
    if (MK_N_LAUNCHES == 1) bar = xcd_barrier_post((unsigned*)(F.ctl + CW_BAR), barst);
    const int lo = args.ph_lo, hi = args.ph_hi;
#define IN(k) (lo <= (k) && (k) < hi)
#define SEAM(k) do { if (IN(k) && IN((k) + 1)) xcd_barrier(bar); } while (0)
#define REP(k, body) do { if (IN(k)) { body; if ((PROBE_MASK >> (k)) & 1) { xcd_barrier(bar); body; } } } while (0)
    REP(0, p0_prologue(F)); SEAM(0);
    REP(1, p1_inproj(F)); SEAM(1);
    if (IN(2)) { p2_mixers(F, args.pass); if ((PROBE_MASK >> 2) & 1) { xcd_barrier(bar); p2_mixers(F, 1); } } SEAM(2);
    REP(3, p3_glu(F)); SEAM(3);
    REP(4, p4_outproj(F)); SEAM(4);
    if (IN(5)) { p5_router(F, args.pass); } SEAM(5);
    REP(6, p67_moe<0>(F)); SEAM(6);
    REP(7, p67_moe<1>(F)); SEAM(7);
    REP(8, p8_combine(F)); SEAM(8);
    REP(9, p9_ple(F)); SEAM(9);
    if (IN(10)) { p10_ln2(F); }
#undef REP
#undef IN
#undef SEAM
}
}

extern "C" void kernel_launch(void* const* d_in, const int* in_sizes, int n_in, void* d_out, int out_size, void* d_ws, size_t ws_size, hipStream_t stream) {
    static int grid = 0;
    if (grid == 0) {
        if (n_in != 31 || out_size != T * DM || ws_size < WS_END) { fprintf(stderr, "kernel_launch: unexpected problem (n_in %d, out %d, ws %zu)\n", n_in, out_size, ws_size); grid = -1; return; }
        int dev = 0, cus = 0;
        if (hipGetDevice(&dev) != hipSuccess || hipDeviceGetAttribute(&cus, hipDeviceAttributeMultiprocessorCount, dev) != hipSuccess) { grid = -1; return; }
        if (hipFuncSetAttribute((const void*)fwd_kernel, hipFuncAttributeMaxDynamicSharedMemorySize, LDS_BYTES) != hipSuccess) { fprintf(stderr, "kernel_launch: hipFuncSetAttribute failed\n"); grid = -1; return; }
        int per_cu = 0;
        if (hipOccupancyMaxActiveBlocksPerMultiprocessor(&per_cu, (const void*)fwd_kernel, NTHREADS, LDS_BYTES) != hipSuccess || per_cu < 1) { fprintf(stderr, "kernel_launch: occupancy query says %d\n", per_cu); }
        (void)hipGetLastError();
        grid = cus;
    }
    if (grid < 0) return;
    (void)hipMemsetAsync((char*)d_ws + WS_CTL, 0, CTL_ZERO_BYTES, stream);
    Args a{};
    for (int i = 0; i < 31; ++i) a.in[i] = (const float*)d_in[i];
    a.out = (float*)d_out; a.ws = (unsigned char*)d_ws;
    if (MK_N_LAUNCHES == 1) { a.ph_lo = 0; a.ph_hi = NPHASE; hipLaunchKernelGGL(fwd_kernel, dim3(grid), dim3(NTHREADS), LDS_BYTES, stream, a); }
    else { for (int p = 0; p < NPHASE; ++p) { a.ph_lo = p; a.ph_hi = p + 1; a.pass = 0; hipLaunchKernelGGL(fwd_kernel, dim3(grid), dim3(NTHREADS), LDS_BYTES, stream, a);
             if (p == PROBE_DUP) { a.pass = 1; hipLaunchKernelGGL(fwd_kernel, dim3(grid), dim3(NTHREADS), LDS_BYTES, stream, a); } } }
}
```

```cpp
#include <hip/hip_runtime.h>
#include <cstdio>
#include <cstdint>

#ifndef PROBE_MASK
#define PROBE_MASK 0
#endif
#ifndef PROBE_SEL
#define PROBE_SEL 0
#endif
#ifndef PROBE_DUP
#define PROBE_DUP -1
#endif
#ifndef MK_N_LAUNCHES
#define MK_N_LAUNCHES 1
#endif

namespace {
constexpr int BATCH = 4, SEQ = 8192, DM = 1024, T = BATCH * SEQ;
constexpr int NH = 8, NG = 32, NS = 64, DIN = 2048;
constexpr int NE = 32, PLE = 256;
constexpr int ECAP = T;
constexpr float LN_EPS = 1e-5f, RMS_EPS = 1e-5f;
constexpr float ALPHA = 1.189207115002721f;
constexpr float QSCALE = 0.17677669529663687f * 1.4426950408889634f;
constexpr float LOG2E = 1.4426950408889634f;
constexpr int NPHASE = 11;
constexpr int NWAVES = 8, NTHREADS = 512;

typedef _Float16 f16;
typedef f16 h8 __attribute__((ext_vector_type(8)));
typedef f16 h4 __attribute__((ext_vector_type(4)));
typedef f16 h2 __attribute__((ext_vector_type(2)));
typedef float f32x4 __attribute__((ext_vector_type(4)));
typedef float f32x16 __attribute__((ext_vector_type(16)));
typedef int i32x4 __attribute__((ext_vector_type(4)));
typedef int i32x8 __attribute__((ext_vector_type(8)));
#define LAS __attribute__((address_space(3)))
#define GAS __attribute__((address_space(1)))
typedef GAS unsigned gu32;
#define RLX_AGENT __ATOMIC_RELAXED, __HIP_MEMORY_SCOPE_AGENT

constexpr size_t MiB = 1u << 20;
constexpr size_t WS_CTL = 0, CTL_ZERO_BYTES = 1 * MiB;
constexpr size_t WS_STATS = 3 * MiB;
constexpr size_t WS_GATES = 5 * MiB;
constexpr size_t WS_LIST = 6 * MiB;
constexpr size_t WS_WIN = 16 * MiB;
constexpr size_t WS_WGLU = 20 * MiB;
constexpr size_t WS_WOUT = 21 * MiB;
constexpr size_t WS_WPG = 23 * MiB;
constexpr size_t WS_WPP = 25 * MiB;
constexpr size_t WS_WGU = 32 * MiB;
constexpr size_t WS_WDN = 160 * MiB;
constexpr size_t WS_PE = 224 * MiB;
constexpr size_t WS_V1 = 288 * MiB;
constexpr size_t WS_A = 416 * MiB;
constexpr size_t WS_XH = WS_A;
constexpr size_t WS_PH = WS_A + 64 * MiB;
constexpr size_t WS_QH = WS_A + 80 * MiB;
constexpr size_t WS_KT = WS_A + 112 * MiB;
constexpr size_t WS_VT = WS_A + 144 * MiB;
constexpr size_t WS_UG = WS_A + 176 * MiB;
constexpr size_t WS_ACT = WS_A;
constexpr size_t WS_X1Q = WS_A + 128 * MiB;
constexpr size_t WS_R = WS_A;
constexpr size_t WS_RH = WS_A + 128 * MiB;
constexpr size_t WS_RQ = WS_A + 192 * MiB;
constexpr size_t WS_B = 672 * MiB;
constexpr size_t WS_YH = WS_B;
constexpr size_t WS_MIX = WS_B + 32 * MiB;
constexpr size_t WS_X1H = 940 * MiB;
constexpr size_t WS_SLAB = WS_B;
constexpr size_t WS_SSMOP = 928 * MiB;
constexpr size_t WS_A16 = 936 * MiB;
constexpr size_t WS_GATEH = WS_V1;
constexpr size_t WS_MIXO = WS_XH;
constexpr size_t WS_END = 1004 * MiB;

constexpr int CW_BAR = 4096;
constexpr int CW_CNT = 8192;
constexpr int CW_QUEUE = 12288;
constexpr int CW_KMAX = 16384;

constexpr int LDS_BYTES = 147456;
constexpr int LDS_BARST = LDS_BYTES - 64;

__device__ __forceinline__ float wave_sum(float v) {
#pragma unroll
    for (int o = 1; o < 64; o <<= 1) v += __shfl_xor(v, o);
    return v;
}
__device__ __forceinline__ float sigmoidf_(float x) { return __builtin_amdgcn_rcpf(1.0f + __builtin_amdgcn_exp2f(-LOG2E * x)); }
__device__ __forceinline__ float gelu_tanh(float x) {
    const float z = 0.7978845608028654f * (x + 0.044715f * x * x * x);
    const float e = __builtin_amdgcn_exp2f(fminf(2.0f * LOG2E * z, 80.0f));
    const float t = 1.0f - 2.0f * __builtin_amdgcn_rcpf(e + 1.0f);
    return 0.5f * x * (1.0f + t);
}
__device__ __forceinline__ int crow(int r, int hi) { return (r & 3) + 8 * (r >> 2) + 4 * hi; }
__device__ __forceinline__ float swap_add(float v) { return v + __shfl_xor(v, 32); }
__device__ __forceinline__ float swap_max(float v) { return fmaxf(v, __shfl_xor(v, 32)); }

#define XB_TMO      128
#define XB_XCNT(j)  (256  + 64 * (j))
#define XB_XSUB(j)  (1280 + 64 * (j))
#define XB_XGEN(j)  (2304 + 64 * (j))
#define XB_TOP      3328
#define XB_TOPGEN   3392
#define XCD_BAR_WORDS 3456
#define XB_SPIN_CAP (1u << 20)
__device__ __forceinline__ unsigned xb_ld(unsigned* p)              { return __hip_atomic_load(p, __ATOMIC_RELAXED, __HIP_MEMORY_SCOPE_AGENT); }
__device__ __forceinline__ unsigned xb_add(unsigned* p, unsigned v) { return __hip_atomic_fetch_add(p, v, __ATOMIC_RELAXED, __HIP_MEMORY_SCOPE_AGENT); }
__device__ __forceinline__ unsigned xb_xcc_id() { return (unsigned)__builtin_amdgcn_s_getreg((3 << 11) | 20) & 0xFu; }
#define XB_SPIN(cond, bar) do { unsigned _sp = 0; while (cond) { __builtin_amdgcn_s_sleep(1); \
    if ((++_sp & 255u) == 0u) { if (xb_ld(&(bar)[XB_TMO])) break; if (_sp > XB_SPIN_CAP) { atomicAdd(&(bar)[XB_TMO], 1u); break; } } } } while (0)
struct XcdBarrier { unsigned* bar; unsigned x; volatile LAS unsigned* st; };
__device__ __forceinline__ XcdBarrier xcd_barrier_post(unsigned* bar, volatile LAS unsigned* st) {
    XcdBarrier b; b.bar = bar; b.x = xb_xcc_id(); b.st = st;
    if (threadIdx.x == 0) (void)xb_add(&bar[XB_XCNT(b.x)], 1u);
    return b;
}
__device__ __forceinline__ void xcd_barrier_complete(unsigned* bar, unsigned x, unsigned& nloc, unsigned& nx) {
    const unsigned G = gridDim.x * gridDim.y * gridDim.z;
    unsigned sum, cnt, mine, sp = 0u;
    for (;;) {
        sum = 0u; cnt = 0u; mine = 0u;
#pragma unroll
        for (unsigned j = 0; j < 16; ++j) { const unsigned c = xb_ld(&bar[XB_XCNT(j)]); sum += c; cnt += (c > 0u) ? 1u : 0u; mine = (j == x) ? c : mine; }
        if (sum == G) break;
        __builtin_amdgcn_s_sleep(1);
        if ((++sp & 255u) == 0u) { if (xb_ld(&bar[XB_TMO])) break; if (sp > XB_SPIN_CAP) { atomicAdd(&bar[XB_TMO], 1u); break; } }
    }
    nloc = mine > 0u ? mine : 1u; nx = cnt > 0u ? cnt : 1u;
}
__device__ __forceinline__ void xcd_barrier(const XcdBarrier& b) {
    asm volatile("s_waitcnt vmcnt(0)" ::: "memory");
    __syncthreads();
    if (threadIdx.x == 0) {
        unsigned* bar = b.bar;
        __builtin_amdgcn_s_waitcnt(0);
        unsigned nloc = b.st[0], nx = b.st[1];
        if (nloc == 0u) { xcd_barrier_complete(bar, b.x, nloc, nx); b.st[0] = nloc; b.st[1] = nx; }
        const unsigned old = xb_add(&bar[XB_XSUB(b.x)], 1u);
        const unsigned gen = old / nloc;
        if (old + 1u == (gen + 1u) * nloc) {
            __builtin_amdgcn_fence(__ATOMIC_RELEASE, "agent");
            asm volatile("s_waitcnt vmcnt(0)" ::: "memory");
            const unsigned og = xb_add(&bar[XB_TOP], 1u);
            const unsigned tg = og / nx;
            if (og + 1u == (tg + 1u) * nx) xb_add(&bar[XB_TOPGEN], 1u);
            else XB_SPIN(xb_ld(&bar[XB_TOPGEN]) == tg, bar);
            __builtin_amdgcn_fence(__ATOMIC_ACQUIRE, "agent");
            xb_add(&bar[XB_XGEN(b.x)], 1u);
            asm volatile("s_waitcnt vmcnt(0)" ::: "memory");
        } else {
            XB_SPIN(xb_ld(&bar[XB_XGEN(b.x)]) == gen, bar);
            __builtin_amdgcn_fence(__ATOMIC_ACQUIRE, "agent");
            asm volatile("s_waitcnt vmcnt(0)" ::: "memory");
        }
    }
    __syncthreads();
}

struct Args { const float* in[31]; float* out; unsigned char* ws; int ph_lo, ph_hi, pass, pad; };
enum { I_X = 0, I_P, I_WIN, I_LQ1, I_LK1, I_LQ2, I_LK2, I_SUBLN, I_ARE, I_AIM, I_LOGDT, I_BRE, I_BIM, I_CRE, I_CIM, I_SSMD, I_WGLU, I_SSMG, I_WOUT,
       I_LN1G, I_LN1B, I_WR, I_BR, I_WGU, I_BGU, I_WDN, I_BDN, I_WPG, I_WPP, I_LN2G, I_LN2B };

struct Frame {
    LAS unsigned char* lds;
    const Args* a;
    unsigned char* ws;
    gu32* ctl;
    int tid, lane, wave, gw, NGW, G, vcu;
};

namespace pg8 {
constexpr int BM = 256, BK = 64, HALF = 128, HTB = HALF * BK * 2, STAGE_BYTES = 8 * HTB, NXCD = 8, WGM = 8;
__device__ __forceinline__ int lds_byte(int r, int c) { const int st = (r >> 4) * 2 + (c >> 5), rr = r & 15, cc = c & 31, ob = rr * 64 + cc * 2; return st * 1024 + (ob ^ (((ob >> 9) & 1) << 5)); }
__device__ __forceinline__ void stage_rc(int b, int& R, int& C) { const int st = b / 1024, sb = b % 1024, swz = sb ^ (((sb >> 9) & 1) << 5); R = (st >> 1) * 16 + swz / 64; C = (st & 1) * 32 + (swz % 64) / 2; }
struct Unit { int pm, pn, e, cnt; };
struct DenseOrder {
    int nM, nN, nwg, G, c;
    __device__ __forceinline__ void init(int M, int N, int G_, int c_) { nM = M / BM; nN = N / BM; nwg = nM * nN; G = G_; c = c_; }
    __device__ __forceinline__ bool next(int i, Unit& u) const {
        const long L = (long)i * G + c; if (L >= nwg) return false;
        int wgid = (int)L; { const int q = nwg / NXCD, r = nwg % NXCD, xcd = wgid % NXCD, off = wgid / NXCD; wgid = (xcd < r ? xcd * (q + 1) : r * (q + 1) + (xcd - r) * q) + off; }
        const int nig = WGM * nN, gid = wgid / nig, fm = gid * WGM, gsz = (nM - fm) < WGM ? (nM - fm) : WGM;
        u.pm = fm + ((wgid % nig) % gsz); u.pn = (wgid % nig) / gsz; u.e = 0; u.cnt = 0; return true;
    }
};
struct OneOrder { Unit u; __device__ __forceinline__ bool next(int i, Unit& o) const { if (i != 0) return false; o = u; return true; } };
struct MoeOrder {
    const LAS int* tab; int ntn, G, c;
    __device__ __forceinline__ bool next(int i, Unit& u) const {
        const int L = i * G + c; if (L >= tab[64] * ntn) return false;
        int e = 0;
#pragma unroll 1
        for (int q = 1; q < 32; ++q) if (L >= tab[32 + q] * ntn) e = q;
        const int cnt = tab[e], lu = L - tab[32 + e] * ntn;
        u.e = e; u.cnt = cnt; u.pn = lu % ntn; u.pm = lu / ntn; return true;
    }
};

template <class P, class Sched>
__device__ __forceinline__ void gemm_phase(LAS unsigned char* lds, const P& p, const Sched& S) {
    const int tid = threadIdx.x, wid = __builtin_amdgcn_readfirstlane(tid >> 6), lane = tid & 63, wr = wid >> 2, wc = wid & 3, fr = lane & 15, fq = lane >> 4;
    constexpr int K = P::K, PB = P::FP8 ? K : 2 * K  , nt = PB / 128;
    int RA[2]; unsigned CB[2], voffB[2];
#pragma unroll
    for (int i = 0; i < 2; ++i) { int R, C; stage_rc(tid * 16 + i * 8192, R, C); RA[i] = R; CB[i] = (unsigned)C * 2u; voffB[i] = (unsigned)(R * PB + C * 2); }
    constexpr size_t kstep = 128, hstep = (size_t)HALF * PB, tstep = 2 * hstep;
    const unsigned ldsw = (unsigned)wid * 1024u;
    const int aoff = lds_byte(wr * 64 + fr, fq * 8), boff = lds_byte(wc * 32 + fr, fq * 8);
    LAS float* rsl = (LAS float*)(lds + STAGE_BYTES);
    const char* abase = p.abase();
#define PG8_SA(b, h) (((b) * 2 + (h)) * HTB)
#define PG8_SB(b, h) ((4 + (b) * 2 + (h)) * HTB)
#define PG8_STAGE(bufoff, gbase, voff) do { _Pragma("unroll") for (int _i = 0; _i < 2; ++_i) \
        __builtin_amdgcn_global_load_lds((const unsigned*)((const char*)(gbase) + (voff)[_i]), (LAS unsigned*)(lds + (bufoff) + ldsw + _i * 8192), 16, 0, 0); } while (0)
#define PG8_LDA(dst, b, h) do { _Pragma("unroll") for (int m = 0; m < 4; ++m) { \
        if constexpr (P::FP8) { const i32x4 lo_ = *(const LAS i32x4*)(lds + PG8_SA(b, h) + aoff + m * 2048), hi_ = *(const LAS i32x4*)(lds + PG8_SA(b, h) + aoff + m * 2048 + 1024); dst##8[m] = __builtin_shufflevector(lo_, hi_, 0, 1, 2, 3, 4, 5, 6, 7); } \
        else { _Pragma("unroll") for (int k = 0; k < 2; ++k) dst[m][k] = *(const LAS h8*)(lds + PG8_SA(b, h) + aoff + m * 2048 + k * 1024); } } } while (0)
#define PG8_LDB(dst, b, h) do { _Pragma("unroll") for (int n = 0; n < 2; ++n) { \
        if constexpr (P::FP8) { const i32x4 lo_ = *(const LAS i32x4*)(lds + PG8_SB(b, h) + boff + n * 2048), hi_ = *(const LAS i32x4*)(lds + PG8_SB(b, h) + boff + n * 2048 + 1024); dst##8[n] = __builtin_shufflevector(lo_, hi_, 0, 1, 2, 3, 4, 5, 6, 7); } \
        else { _Pragma("unroll") for (int k = 0; k < 2; ++k) dst[n][k] = *(const LAS h8*)(lds + PG8_SB(b, h) + boff + n * 2048 + k * 1024); } } } while (0)
#define PG8_MMA(ai, bj, At, Bt) do { __builtin_amdgcn_s_setprio(1); _Pragma("unroll") for (int m = 0; m < 4; ++m) _Pragma("unroll") for (int n = 0; n < 2; ++n) { \
        if constexpr (P::FP8) asm volatile("v_mfma_scale_f32_16x16x128_f8f6f4 %0, %1, %2, %0, %3, %3 op_sel_hi:[0,0,0]" : "+v"(acc[ai][bj][m][n]) : "v"(Bt##8[n]), "v"(At##8[m]), "v"(one_scale)); \
        else { _Pragma("unroll") for (int k = 0; k < 2; ++k) acc[ai][bj][m][n] = __builtin_amdgcn_mfma_f32_16x16x32_f16(Bt[n][k], At[m][k], acc[ai][bj][m][n], 0, 0, 0); } } \
        __builtin_amdgcn_s_setprio(0); } while (0)
#define PG8_WAIT_V(n) asm volatile("s_waitcnt vmcnt(" #n ")" ::: "memory")
#define PG8_WAIT_L(n) asm volatile("s_waitcnt lgkmcnt(" #n ")" ::: "memory")
#define PG8_BAR __builtin_amdgcn_s_barrier()
#define PG8_SCHED __builtin_amdgcn_sched_barrier(0)
    Unit cur, nxt; int ui = 0;
    if (!S.next(0, cur)) return;
    f32x4 acc[2][2][4][2];
#pragma unroll
    for (int a = 0; a < 2; ++a)
#pragma unroll
        for (int b = 0; b < 2; ++b)
#pragma unroll
            for (int m = 0; m < 4; ++m)
#pragma unroll
                for (int n = 0; n < 2; ++n) acc[a][b][m][n] = (f32x4){0.f, 0.f, 0.f, 0.f};
    h8 At[4][2], B0[2][2], B1[2][2]; i32x8 At8[4], B08[2], B18[2];
    int one_scale = 0x7f7f7f7f; asm volatile("" : "+v"(one_scale));
    LAS int* ginfo = (LAS int*)(lds + STAGE_BYTES + 4096);
    unsigned voffA[2];
    const char* cA = abase; const char* nA = abase;
#pragma unroll
    for (int i = 0; i < 2; ++i) voffA[i] = P::GATHER ? CB[i] : (unsigned)(RA[i] * PB) + CB[i];
    if constexpr (P::GATHER) {
        if (tid < 256) p.fill_rows(cur, ginfo, tid);
        asm volatile("s_waitcnt lgkmcnt(0)" ::: "memory"); PG8_BAR; asm volatile("" ::: "memory");
    } else cA = abase + (size_t)cur.pm * tstep;
    constexpr size_t hA = P::GATHER ? 0 : hstep;
#define PG8_STAGE_A(bufoff, gbase, par, half) do { if constexpr (P::GATHER) { _Pragma("unroll") for (int _i = 0; _i < 2; ++_i) { \
            const unsigned ro_ = p.rowbytes(ginfo[(par) * 512 + (half) * 128 + RA[_i]] & 0x7fffffff) + voffA[_i]; \
            __builtin_amdgcn_global_load_lds((const unsigned*)((const char*)(gbase) + ro_), (LAS unsigned*)(lds + (bufoff) + ldsw + _i * 8192), 16, 0, 0); } } \
        else PG8_STAGE(bufoff, (const char*)(gbase) + (half) * hA, voffA); } while (0)
    const char* cB = p.bptr(cur);
    if constexpr (P::MID) p.mid_prepare(cur, rsl, tid);
    PG8_STAGE(PG8_SB(0, 0), cB, voffB); PG8_STAGE(PG8_SB(0, 1), cB + hstep, voffB); PG8_STAGE_A(PG8_SA(0, 0), cA, 0, 0); PG8_STAGE_A(PG8_SA(0, 1), cA, 0, 1);
    if (wr == 1) PG8_BAR;
    PG8_WAIT_V(2); PG8_BAR;
    PG8_STAGE(PG8_SB(1, 0), cB + kstep, voffB); PG8_STAGE_A(PG8_SA(1, 0), cA + kstep, 0, 0); PG8_STAGE(PG8_SB(1, 1), cB + hstep + kstep, voffB);
    PG8_WAIT_V(6); PG8_BAR;
    for (;;) {
        const bool has_next = S.next(ui + 1, nxt);
        const char* nB = cB; nA = cA;
        const int cpar = ui & 1; int npar = cpar;
        if (has_next) {
            nB = p.bptr(nxt); npar = cpar ^ 1;
            if constexpr (P::GATHER) { if (tid < 256) p.fill_rows(nxt, ginfo + npar * 512, tid); }
            else nA = abase + (size_t)nxt.pm * tstep;
            if constexpr (P::MID) p.mid_prepare(nxt, rsl + 256 * ((ui + 1) & 1), tid);
        }
#pragma unroll 1
        for (int t = 0; t < nt; t += 2) {
            const bool last = (t == nt - 2);
            if constexpr (P::MID) {
                if (t == nt / 2) {
                    const LAS float* rs = rsl + 256 * (ui & 1);
#pragma unroll
                    for (int a = 0; a < 2; ++a)
#pragma unroll
                        for (int m = 0; m < 4; ++m) { const float sc = rs[a * 128 + wr * 64 + m * 16 + fr];
#pragma unroll
                            for (int b = 0; b < 2; ++b)
#pragma unroll
                                for (int n = 0; n < 2; ++n) acc[a][b][m][n] *= sc; }
                }
            }
            const char* a1 = cA + (size_t)(t + 1) * kstep;
            const char* a2 = last ? nA : cA + (size_t)(t + 2) * kstep; const char* b2 = last ? nB : cB + (size_t)(t + 2) * kstep;
            const char* a3 = a2 + kstep; const char* b3 = b2 + kstep;
            const int par2 = last ? npar : cpar;
            PG8_LDB(B0, 0, 0); PG8_LDB(B1, 0, 1); PG8_SCHED; PG8_LDA(At, 0, 0); PG8_STAGE_A(PG8_SA(1, 1), a1, cpar, 1);
            PG8_WAIT_V(8); PG8_WAIT_L(0); PG8_BAR; PG8_MMA(0, 0, At, B0); PG8_MMA(0, 1, At, B1); PG8_BAR; PG8_SCHED;
            PG8_LDA(At, 0, 1); PG8_STAGE(PG8_SB(0, 0), b2, voffB); PG8_STAGE(PG8_SB(0, 1), b2 + hstep, voffB); PG8_STAGE_A(PG8_SA(0, 0), a2, par2, 0);
            PG8_WAIT_V(8); PG8_WAIT_L(0); PG8_BAR; PG8_MMA(1, 0, At, B0); PG8_MMA(1, 1, At, B1); PG8_BAR; PG8_SCHED;
            PG8_LDB(B0, 1, 0); PG8_LDB(B1, 1, 1); PG8_SCHED; PG8_LDA(At, 1, 0); PG8_STAGE_A(PG8_SA(0, 1), a2, par2, 1);
            PG8_WAIT_V(8); PG8_WAIT_L(0); PG8_BAR; PG8_MMA(0, 0, At, B0); PG8_MMA(0, 1, At, B1); PG8_BAR; PG8_SCHED;
            PG8_LDA(At, 1, 1); PG8_STAGE(PG8_SB(1, 0), b3, voffB); PG8_STAGE(PG8_SB(1, 1), b3 + hstep, voffB); PG8_STAGE_A(PG8_SA(1, 0), a3, par2, 0);
            PG8_WAIT_V(8); PG8_WAIT_L(0); PG8_BAR; PG8_MMA(1, 0, At, B0); PG8_MMA(1, 1, At, B1); PG8_BAR; PG8_SCHED;
        }
        if (wr == 0) PG8_BAR;
        if constexpr (P::FP8) asm volatile("s_nop 15\n\ts_nop 7" ::: "memory");
        {
            const int cb = wc * 32 + fq * 8;
#define PG8_EPI_LOOP(RI, CALL) do { const auto pre = p.pre(cur, cb); (void)pre; \
                _Pragma("unroll") for (int a = 0; a < 2; ++a) { \
                    int lrow = a * 128 + wr * 64 + fr; decltype(RI) ris[4]; \
                    _Pragma("unroll") for (int m = 0; m < 4; ++m) { lrow = a * 128 + wr * 64 + m * 16 + fr; ris[m] = RI; } \
                    _Pragma("unroll") for (int m = 0; m < 4; ++m) { lrow = a * 128 + wr * 64 + m * 16 + fr; const auto ri = ris[m]; CALL; } } } while (0)
            if constexpr (P::KINDS) {
                const int kd = __builtin_amdgcn_readfirstlane(p.kind(cur));
                if (kd == 1) p.knorm(cur, acc, wc, lane);
                if (kd == 0) PG8_EPI_LOOP(p.template rowpart<0>(cur, lrow), p.template epik<0>(cur, ri, cb, acc[a][0][m][0], acc[a][0][m][1], acc[a][1][m][0], acc[a][1][m][1]));
                else if (kd == 1) PG8_EPI_LOOP(p.template rowpart<1>(cur, lrow), p.template epik<1>(cur, ri, cb, acc[a][0][m][0], acc[a][0][m][1], acc[a][1][m][0], acc[a][1][m][1]));
                else if (kd == 2) PG8_EPI_LOOP(p.template rowpart<2>(cur, lrow), p.template epik<2>(cur, ri, cb, acc[a][0][m][0], acc[a][0][m][1], acc[a][1][m][0], acc[a][1][m][1]));
                else PG8_EPI_LOOP(p.template rowpart<3>(cur, lrow), p.template epik<3>(cur, ri, cb, acc[a][0][m][0], acc[a][0][m][1], acc[a][1][m][0], acc[a][1][m][1]));
            } else {
                if constexpr (P::GATHER) {
                    const LAS int* gi_ = ginfo + (ui & 1) * 512; const auto pre = p.pre(cur, cb); const bool odd = (fq & 1) != 0; const int cbs = cb - (odd ? 8 : 0);
                    decltype(p.rowinfo_lds(gi_, 0)) rA[2][2], rB[2][2]; int rS[2][2];
#pragma unroll
                    for (int a = 0; a < 2; ++a)
#pragma unroll
                        for (int mp = 0; mp < 2; ++mp) { const int lr0 = a * 128 + wr * 64 + mp * 32 + fr; rA[a][mp] = p.rowinfo_lds(gi_, lr0); rB[a][mp] = p.rowinfo_lds(gi_, lr0 + 16); rS[a][mp] = p.rowidx(p.rowinfo_lds(gi_, lr0 + (odd ? 16 : 0))); }
                    asm volatile("s_waitcnt lgkmcnt(0)" ::: "memory");
#pragma unroll
                    for (int a = 0; a < 2; ++a) {
#pragma unroll
                        for (int mp = 0; mp < 2; ++mp) {
                            const auto ri0 = rA[a][mp], ri1 = rB[a][mp];
                            const i32x4 x0 = p.val(cur, pre, ri0, acc[a][0][2 * mp][0], acc[a][0][2 * mp][1], acc[a][1][2 * mp][0], acc[a][1][2 * mp][1]);
                            const i32x4 x1 = p.val(cur, pre, ri1, acc[a][0][2 * mp + 1][0], acc[a][0][2 * mp + 1][1], acc[a][1][2 * mp + 1][0], acc[a][1][2 * mp + 1][1]);
                            const int asel = rS[a][mp];
#pragma unroll
                            for (int q = 0; q < P::NW; ++q) {
                                const auto lo = __builtin_amdgcn_permlane16_swap((unsigned)x0[2 * q], (unsigned)x1[2 * q], false, false), hi = __builtin_amdgcn_permlane16_swap((unsigned)x0[2 * q + 1], (unsigned)x1[2 * q + 1], false, false);
                                i32x4 w; w[0] = (int)lo[0]; w[1] = (int)hi[0]; w[2] = (int)lo[1]; w[3] = (int)hi[1];
                                p.store16(cur, asel, cbs, q, w);
                            }
                        }
                    }
                }
                else PG8_EPI_LOOP(p.rowinfo(cur, lrow), p.epi(cur, pre, ri, lrow, cb, acc[a][0][m][0], acc[a][0][m][1], acc[a][1][m][0], acc[a][1][m][1]));
            }
#undef PG8_EPI_LOOP
        }
        if (!has_next) break;
#pragma unroll
        for (int a = 0; a < 2; ++a)
#pragma unroll
            for (int b = 0; b < 2; ++b)
#pragma unroll
                for (int m = 0; m < 4; ++m)
#pragma unroll
                    for (int n = 0; n < 2; ++n) acc[a][b][m][n] = (f32x4){0.f, 0.f, 0.f, 0.f};
        cur = nxt; cB = nB; cA = nA; ++ui;
        if (wr == 1) PG8_BAR;
    }
    PG8_WAIT_V(0);
    PG8_BAR;
#undef PG8_SA
#undef PG8_SB
#undef PG8_STAGE
#undef PG8_STAGE_A
#undef PG8_LDA
#undef PG8_LDB
#undef PG8_MMA
#undef PG8_WAIT_V
#undef PG8_WAIT_L
#undef PG8_BAR
#undef PG8_SCHED
}
}

struct NoPre {};
__device__ __forceinline__ int pack_fp8x4(float a, float b, float c, float d) { int w = 0; w = __builtin_amdgcn_cvt_pk_fp8_f32(a, b, w, false); w = __builtin_amdgcn_cvt_pk_fp8_f32(c, d, w, true); return w; }
constexpr float WGU_SCALE = 32.0f, WDN_SCALE = 64.0f, ACT_SCALE = 4.0f, SLAB_SCALE = 16.0f, RQ_SCALE = 8.0f;
__device__ __forceinline__ h8 pack8(f32x4 lo, f32x4 hi) { h8 o; o[0] = (f16)lo[0]; o[1] = (f16)lo[1]; o[2] = (f16)lo[2]; o[3] = (f16)lo[3]; o[4] = (f16)hi[0]; o[5] = (f16)hi[1]; o[6] = (f16)hi[2]; o[7] = (f16)hi[3]; return o; }
struct ProbInproj {
    static constexpr int K = 1024; static constexpr bool KINDS = true; static constexpr bool GATHER = false; static constexpr bool FP8 = false; static constexpr bool MID = false;
    const char* xh; const char* win; f16 *qh, *kt, *vt, *ug; gu32* kmax;
    __device__ __forceinline__ const char* abase() const { return xh; }
    __device__ __forceinline__ unsigned rowoff(const pg8::Unit& u, int r) const { return (unsigned)(u.pm * 256 + r) * (unsigned)(K * 2); }
    __device__ __forceinline__ const char* bptr(const pg8::Unit& u) const { return win + (size_t)u.pn * 256 * K * 2; }
    __device__ __forceinline__ NoPre pre(const pg8::Unit&, int) const { return NoPre{}; }
    __device__ __forceinline__ int kind(const pg8::Unit& u) const { return u.pn >> 1; }
    __device__ __forceinline__ void knorm(const pg8::Unit& u, const f32x4 (&acc)[2][2][4][2], int wc, int lane) const {
#pragma unroll
        for (int b = 0; b < 2; ++b) {
            float mx = 0.f;
#pragma unroll
            for (int a = 0; a < 2; ++a)
#pragma unroll
                for (int m = 0; m < 4; ++m) { const f32x4 x = acc[a][b][m][0], y = acc[a][b][m][1];
                    float q = (x[0] * x[0] + x[1] * x[1]) + (x[2] * x[2] + x[3] * x[3]) + (y[0] * y[0] + y[1] * y[1]) + (y[2] * y[2] + y[3] * y[3]);
                    q += __shfl_xor(q, 16); q += __shfl_xor(q, 32); mx = fmaxf(mx, q); }
            mx = fmaxf(mx, __shfl_xor(mx, 1)); mx = fmaxf(mx, __shfl_xor(mx, 2)); mx = fmaxf(mx, __shfl_xor(mx, 4)); mx = fmaxf(mx, __shfl_xor(mx, 8));
            if (lane == 0) { const int bt = (u.pm * 256) >> 13, hd = (u.pn & 1) * 4 + 2 * b + (wc >> 1), mp = wc & 1;
                __hip_atomic_fetch_max(kmax + (bt * 8 + hd) * 2 + mp, __float_as_uint(sqrtf(mx)), RLX_AGENT); }
        }
    }
    template <int KIND> __device__ __forceinline__ unsigned rowpart(const pg8::Unit& u, int lr) const {
        const int row = u.pm * 256 + lr, b = row >> 13, tt = row & 8191, tile = tt >> 6, key = tt & 63;
        if (KIND == 0) return (unsigned)row * 512u;
        if (KIND == 1) return (unsigned)((b * 8 * 128 + tile) * 4096 + key * 8);
        if (KIND == 2) { const int sx = key >> 4, w = key & 15, hh = (w >> 2) & 1, j = (w & 3) + 4 * (w >> 3); return (unsigned)((b * 8 * 128 + tile) * 4096 + (2 * sx + hh) * 512 + j); }
        return (unsigned)((b * 32 * 8192 + tt) * 16);
    }
    template <int KIND> __device__ __forceinline__ void epik(const pg8::Unit& u, unsigned rp, int cb, f32x4 v00, f32x4 v01, f32x4 v10, f32x4 v11) const {
#pragma unroll
        for (int b = 0; b < 2; ++b) {
            const int col = (u.pn & 1) * 256 + b * 128 + cb; const f32x4 lo = b ? v10 : v00, hi = b ? v11 : v01;
            if (KIND == 0) { *(h8*)(qh + rp + col) = pack8(lo * QSCALE, hi * QSCALE); }
            else if (KIND == 1) { const int hd = col >> 6, d = col & 63; *(h8*)(kt + rp + (unsigned)(hd * 128 * 4096 + (d >> 3) * 512)) = pack8(lo, hi); }
            else if (KIND == 2) { const int hd = col >> 6, dv = col & 63; f16* q = vt + rp + (unsigned)(hd * 128 * 4096 + dv * 8);
                q[0] = (f16)lo[0]; q[8] = (f16)lo[1]; q[16] = (f16)lo[2]; q[24] = (f16)lo[3]; q[32] = (f16)hi[0]; q[40] = (f16)hi[1]; q[48] = (f16)hi[2]; q[56] = (f16)hi[3]; }
            else { const int g = col >> 4, c0 = col & 15; *(h8*)(ug + rp + (unsigned)(g * 8192 * 16 + c0)) = pack8(lo, hi); }
        }
    }
};
struct ProbPleProj {
    static constexpr int K = 256; static constexpr bool KINDS = false; static constexpr bool GATHER = false; static constexpr bool FP8 = false; static constexpr bool MID = false;
    const char* ph; const char* wpp; f16* pe;
    __device__ __forceinline__ const char* abase() const { return ph; }
    __device__ __forceinline__ unsigned rowoff(const pg8::Unit& u, int r) const { return (unsigned)(u.pm * 256 + r) * (unsigned)(K * 2); }
    __device__ __forceinline__ const char* bptr(const pg8::Unit& u) const { return wpp + (size_t)u.pn * 256 * K * 2; }
    __device__ __forceinline__ NoPre pre(const pg8::Unit&, int) const { return NoPre{}; }
    __device__ __forceinline__ int rowinfo(const pg8::Unit&, int) const { return 0; }
    __device__ __forceinline__ void epi(const pg8::Unit& u, NoPre, int, int lr, int cb, f32x4 v00, f32x4 v01, f32x4 v10, f32x4 v11) const {
        f16* o = pe + (size_t)(u.pm * 256 + lr) * 1024 + u.pn * 256 + cb; *(h8*)o = pack8(v00, v01); *(h8*)(o + 128) = pack8(v10, v11); }
};
struct ProbGlu {
    static constexpr int K = 512; static constexpr bool KINDS = false; static constexpr bool GATHER = false; static constexpr bool FP8 = false; static constexpr bool MID = false;
    const char* yh; const char* wg; f16* mix;
    __device__ __forceinline__ const char* abase() const { return yh; }
    __device__ __forceinline__ unsigned rowoff(const pg8::Unit& u, int r) const { return (unsigned)(u.pm * 256 + r) * (unsigned)(K * 2); }
    __device__ __forceinline__ const char* bptr(const pg8::Unit& u) const { return wg + (size_t)u.pn * 256 * K * 2; }
    __device__ __forceinline__ NoPre pre(const pg8::Unit&, int) const { return NoPre{}; }
    __device__ __forceinline__ int rowinfo(const pg8::Unit&, int) const { return 0; }
    __device__ __forceinline__ void epi(const pg8::Unit& u, NoPre, int, int lr, int cb, f32x4 v00, f32x4 v01, f32x4 v10, f32x4 v11) const {
        h8 o;
#pragma unroll
        for (int e = 0; e < 4; ++e) { o[e] = (f16)(v00[e] * sigmoidf_(v10[e])); o[4 + e] = (f16)(v01[e] * sigmoidf_(v11[e])); }
        *(h8*)(mix + (size_t)(u.pm * 256 + lr) * 1024 + u.pn * 128 + cb) = o; }
};
struct ProbOut {
    static constexpr int K = 1024; static constexpr bool KINDS = false; static constexpr bool GATHER = false; static constexpr bool FP8 = false; static constexpr bool MID = true;
    const char* mixb; const char* wo; f16* mixo;
    __device__ __forceinline__ const char* abase() const { return mixb; }
    __device__ __forceinline__ unsigned rowoff(const pg8::Unit& u, int r) const { return (unsigned)(u.pm * 256 + r) * (unsigned)(K * 2); }
    __device__ __forceinline__ const char* bptr(const pg8::Unit& u) const { return wo + (size_t)u.pn * 256 * K * 2; }
    __device__ __forceinline__ NoPre pre(const pg8::Unit&, int) const { return NoPre{}; }
    __device__ __forceinline__ int rowinfo(const pg8::Unit&, int) const { return 0; }
    __device__ __forceinline__ void mid_prepare(const pg8::Unit& u, LAS float* slot, int tid) const {
        const int row = tid >> 1; const h8* q = (const h8*)(mixb + (size_t)(u.pm * 256 + row) * 2048 + (tid & 1) * 512); float sacc = 0.f;
#pragma unroll 4
        for (int j = 0; j < 32; ++j) { const h8 v = q[j];
#pragma unroll
            for (int e = 0; e < 8; ++e) { const float f = (float)v[e]; sacc += f * f; } }
        sacc += __shfl_xor(sacc, 1);
        if (!(tid & 1)) slot[row] = rsqrtf(sacc * (1.0f / 512.0f) + RMS_EPS);
    }
    __device__ __forceinline__ void epi(const pg8::Unit& u, NoPre, int, int lr, int cb, f32x4 v00, f32x4 v01, f32x4 v10, f32x4 v11) const {
        f16* o = mixo + (size_t)(u.pm * 256 + lr) * 1024 + u.pn * 256 + cb; *(h8*)o = pack8(v00, v01); *(h8*)(o + 128) = pack8(v10, v11); }
};
struct Pre16 { f32x4 a, b, c, d; };
struct ProbMoeUp {
    static constexpr int K = 1024; static constexpr bool KINDS = false; static constexpr bool GATHER = true; static constexpr bool FP8 = true; static constexpr bool MID = false;
    const char* x1q; const char* wgu; const int* list; const float* bias; unsigned char* act;
    __device__ __forceinline__ const char* abase() const { return x1q; }
    __device__ __forceinline__ unsigned rowoff(const pg8::Unit&, int) const { return 0u; }
    __device__ __forceinline__ void fill_rows(const pg8::Unit& u, LAS int* tabp, int r) const { const int i = u.pm * 256 + r; const bool ok = i < u.cnt; const int a = list[(size_t)u.e * ECAP + (ok ? i : 0)]; tabp[r] = ok ? a : (a | (int)0x80000000); }
    __device__ __forceinline__ unsigned rowbytes(int a) const { return (unsigned)(a >> 2) * (unsigned)K; }
    __device__ __forceinline__ int rowinfo_lds(const LAS int* tabp, int lr) const { return tabp[lr]; }
    __device__ __forceinline__ const char* bptr(const pg8::Unit& u) const { return wgu + ((size_t)u.e * 2048 + (size_t)u.pn * 256) * K; }
    __device__ __forceinline__ Pre16 pre(const pg8::Unit& u, int cb) const {
        const float* bp = bias + u.e * 2048 + 2 * (u.pn * 128 + cb); Pre16 r; r.a = *(const f32x4*)bp; r.b = *(const f32x4*)(bp + 4); r.c = *(const f32x4*)(bp + 8); r.d = *(const f32x4*)(bp + 12); return r; }
    __device__ __forceinline__ int rowinfo(const pg8::Unit& u, int lr) const { const int i = u.pm * 256 + lr; return i < u.cnt ? list[(size_t)u.e * ECAP + i] : -1; }
    static constexpr int NW = 1;
    __device__ __forceinline__ int rowidx(int a) const { return a; }
    __device__ __forceinline__ i32x4 val(const pg8::Unit&, const Pre16& pb, int, f32x4 v00, f32x4 v01, f32x4 v10, f32x4 v11) const {
        const float bg[8] = {pb.a[0], pb.a[2], pb.b[0], pb.b[2], pb.c[0], pb.c[2], pb.d[0], pb.d[2]}, bl[8] = {pb.a[1], pb.a[3], pb.b[1], pb.b[3], pb.c[1], pb.c[3], pb.d[1], pb.d[3]};
        float o[8];
#pragma unroll
        for (int e = 0; e < 8; ++e) { const float g = fminf((e < 4 ? v00[e] : v01[e - 4]) * (1.0f / WGU_SCALE) + bg[e], 7.0f), l = fminf(fmaxf((e < 4 ? v10[e] : v11[e - 4]) * (1.0f / WGU_SCALE) + bl[e], -7.0f), 7.0f);
            o[e] = g * sigmoidf_(1.702f * g) * (l + 1.0f) * ACT_SCALE; }
        i32x4 w; w[0] = pack_fp8x4(o[0], o[1], o[2], o[3]); w[1] = pack_fp8x4(o[4], o[5], o[6], o[7]); w[2] = 0; w[3] = 0; return w; }
    __device__ __forceinline__ void store16(const pg8::Unit& u, int a, int cbs, int, i32x4 w) const { if (a < 0) return; *(i32x4*)(act + (size_t)a * 1024 + u.pn * 128 + cbs) = w; }
};
struct RowAG { int a; float g; };
struct ProbMoeDn {
    static constexpr int K = 1024; static constexpr bool KINDS = false; static constexpr bool GATHER = true; static constexpr bool FP8 = true; static constexpr bool MID = false;
    const char* actb; const char* wdn; const int* list; const float* bias; const float* gates; unsigned char* slab;
    __device__ __forceinline__ const char* abase() const { return actb; }
    __device__ __forceinline__ unsigned rowoff(const pg8::Unit&, int) const { return 0u; }
    __device__ __forceinline__ void fill_rows(const pg8::Unit& u, LAS int* tabp, int r) const { const int i = u.pm * 256 + r; const bool ok = i < u.cnt; const int a = list[(size_t)u.e * ECAP + (ok ? i : 0)];
        tabp[r] = ok ? a : (a | (int)0x80000000); tabp[256 + r] = __float_as_int(ok ? gates[a] : 0.f); }
    __device__ __forceinline__ unsigned rowbytes(int a) const { return (unsigned)a * (unsigned)K; }
    __device__ __forceinline__ RowAG rowinfo_lds(const LAS int* tabp, int lr) const { RowAG r; r.a = tabp[lr]; r.g = __int_as_float(tabp[256 + lr]); return r; }
    __device__ __forceinline__ const char* bptr(const pg8::Unit& u) const { return wdn + ((size_t)u.e * 1024 + (size_t)u.pn * 256) * K; }
    __device__ __forceinline__ Pre16 pre(const pg8::Unit& u, int cb) const {
        const float* bp = bias + u.e * 1024 + u.pn * 256 + cb; Pre16 r; r.a = *(const f32x4*)bp; r.b = *(const f32x4*)(bp + 4); r.c = *(const f32x4*)(bp + 128); r.d = *(const f32x4*)(bp + 132); return r; }
    __device__ __forceinline__ RowAG rowinfo(const pg8::Unit& u, int lr) const { const int i = u.pm * 256 + lr; RowAG r; r.a = i < u.cnt ? list[(size_t)u.e * ECAP + i] : -1; r.g = r.a >= 0 ? gates[r.a] : 0.f; return r; }
    static constexpr int NW = 2;
    __device__ __forceinline__ int rowidx(const RowAG& r) const { return r.a; }
    __device__ __forceinline__ i32x4 val(const pg8::Unit&, const Pre16& pb, const RowAG& ri, f32x4 v00, f32x4 v01, f32x4 v10, f32x4 v11) const {
        constexpr float S = 1.0f / (WDN_SCALE * ACT_SCALE);
        const float g = ri.g * SLAB_SCALE;
        f32x4 a = (v00 * S + pb.a) * g, b = (v01 * S + pb.b) * g, c = (v10 * S + pb.c) * g, d = (v11 * S + pb.d) * g;
#pragma unroll
        for (int e = 0; e < 4; ++e) { a[e] = fminf(fmaxf(a[e], -448.f), 448.f); b[e] = fminf(fmaxf(b[e], -448.f), 448.f); c[e] = fminf(fmaxf(c[e], -448.f), 448.f); d[e] = fminf(fmaxf(d[e], -448.f), 448.f); }
        i32x4 w; w[0] = pack_fp8x4(a[0], a[1], a[2], a[3]); w[1] = pack_fp8x4(b[0], b[1], b[2], b[3]); w[2] = pack_fp8x4(c[0], c[1], c[2], c[3]); w[3] = pack_fp8x4(d[0], d[1], d[2], d[3]); return w; }
    __device__ __forceinline__ void store16(const pg8::Unit& u, int a_, int cbs, int q, i32x4 w) const { if (a_ < 0) return; *(i32x4*)(slab + (size_t)a_ * 1024 + u.pn * 256 + q * 128 + cbs) = w; }
};
struct ProbPleGate {
    static constexpr int K = 1024; static constexpr bool KINDS = false; static constexpr bool GATHER = false; static constexpr bool FP8 = true; static constexpr bool MID = false;
    const char* rq; const char* wpg; f16* gateh;
    __device__ __forceinline__ const char* abase() const { return rq; }
    __device__ __forceinline__ unsigned rowoff(const pg8::Unit& u, int r) const { return (unsigned)(u.pm * 256 + r) * (unsigned)K; }
    __device__ __forceinline__ const char* bptr(const pg8::Unit& u) const { return wpg + (size_t)u.pn * 256 * K; }
    __device__ __forceinline__ NoPre pre(const pg8::Unit&, int) const { return NoPre{}; }
    __device__ __forceinline__ int rowinfo(const pg8::Unit&, int) const { return 0; }
    __device__ __forceinline__ void epi(const pg8::Unit& u, NoPre, int, int lr, int cb, f32x4 v00, f32x4 v01, f32x4 v10, f32x4 v11) const {
        f16* o = gateh + (size_t)(u.pm * 256 + lr) * 1024 + u.pn * 256 + cb;
        constexpr float S = 1.0f / (WDN_SCALE * RQ_SCALE);
        f32x4 a, b, c, d;
#pragma unroll
        for (int e = 0; e < 4; ++e) { a[e] = sigmoidf_(v00[e] * S); b[e] = sigmoidf_(v01[e] * S); c[e] = sigmoidf_(v10[e] * S); d[e] = sigmoidf_(v11[e] * S); }
        *(h8*)o = pack8(a, b); *(h8*)(o + 128) = pack8(c, d); }
};

__device__ __forceinline__ int invperm32(int c) { return 16 * ((c >> 2) & 1) + 4 * (c >> 3) + (c & 3); }
__device__ __forceinline__ void tr_item(const float* W, int K, int N, f16* WT, int item, int mode, const float* gsc, LAS float* scr, int lane) {
    const int nblk = N / 32, kb = item / nblk, nb = item % nblk, k0 = 64 * kb, n0 = 32 * nb;
#pragma unroll 8
    for (int i = 0; i < 32; ++i) {
        const int kk = 2 * i + (lane >> 5);
        float v = W[(size_t)(k0 + kk) * N + n0 + (lane & 31)];
        if (mode == 2 && k0 + kk >= 512) v *= gsc[k0 + kk - 512];
        scr[kk * 33 + (lane & 31)] = v;
    }
    asm volatile("s_waitcnt lgkmcnt(0)" ::: "memory");
    const int c = lane & 7;
#pragma unroll
    for (int j = 0; j < 4; ++j) {
        const int n = (lane >> 3) + 8 * j; const LAS float* s = scr + (8 * c) * 33 + n;
        const int ns = n0 + n; int nd;
        if (mode == 1 || mode == 3) { const int ja = mode == 1 ? (ns & 511) : (ns >> 1), bj = mode == 1 ? (ns >> 9) : (ns & 1), jl = ja & 127;
            nd = 256 * (ja >> 7) + 128 * bj + (jl & ~31) + invperm32(jl & 31); }
        else nd = (ns & ~31) + invperm32(ns & 31);
        int kd = k0 + 8 * c; if (mode == 2) kd = (kd + 512) & 1023;
        if (mode >= 3) {
            const float sc = mode == 3 ? WGU_SCALE : WDN_SCALE;
            typedef int i32x2 __attribute__((ext_vector_type(2)));
            i32x2 o; o[0] = pack_fp8x4(s[0] * sc, s[33] * sc, s[66] * sc, s[99] * sc); o[1] = pack_fp8x4(s[132] * sc, s[165] * sc, s[198] * sc, s[231] * sc);
            *(i32x2*)((unsigned char*)WT + (size_t)nd * K + kd) = o;
        } else {
            h8 o; o[0] = (f16)s[0]; o[1] = (f16)s[33]; o[2] = (f16)s[66]; o[3] = (f16)s[99]; o[4] = (f16)s[132]; o[5] = (f16)s[165]; o[6] = (f16)s[198]; o[7] = (f16)s[231];
            *(h8*)(WT + (size_t)nd * K + kd) = o;
        }
    }
    asm volatile("s_waitcnt lgkmcnt(0)" ::: "memory");
}

__device__ __forceinline__ void ssm_precompute(Frame& F, int g) {
    const Args& A = *F.a; const int tid = F.tid;
    LAS float* pwr = (LAS float*)F.lds;
    LAS float* pwi = pwr + 17 * 64;
    LAS float* Bbr = pwi + 17 * 64;
    LAS float* Bbi = Bbr + 1024;
    LAS float* Cr = Bbi + 1024;
    LAS float* Ci = Cr + 1024;
    LAS float* Kd = Ci + 1024;
    if (tid < 64) {
        const int p = tid;
        const float are = A.in[I_ARE][g * 64 + p], aim = A.in[I_AIM][g * 64 + p], dt = __expf(A.in[I_LOGDT][g]);
        for (int d = 0; d <= 16; ++d) { const float mag = __expf(are * dt * (float)d); float sn, cs; sincosf(aim * dt * (float)d, &sn, &cs); pwr[d * 64 + p] = mag * cs; pwi[d * 64 + p] = mag * sn; }
        const float abr = pwr[64 + p], abi = pwi[64 + p];
        const float nr = abr - 1.0f, ni = abi, den = 1.0f / (are * are + aim * aim);
        const float fr_ = (nr * are + ni * aim) * den, fi_ = (ni * are - nr * aim) * den;
        for (int c = 0; c < 16; ++c) { const float br = A.in[I_BRE][(g * 64 + p) * 16 + c], bi = A.in[I_BIM][(g * 64 + p) * 16 + c]; Bbr[p * 16 + c] = fr_ * br - fi_ * bi; Bbi[p * 16 + c] = fr_ * bi + fi_ * br; }
        float* a16 = (float*)(F.ws + WS_A16) + (g * 64 + p) * 2; a16[0] = pwr[16 * 64 + p]; a16[1] = pwi[16 * 64 + p];
    }
    for (int i = tid; i < 1024; i += NTHREADS) { Cr[i] = A.in[I_CRE][g * 1024 + i]; Ci[i] = A.in[I_CIM][g * 1024 + i]; }
    __syncthreads();
    for (int q = 0; q < 8; ++q) {
        const int idx = tid * 8 + q, d = idx >> 8, cp = (idx >> 4) & 15, c = idx & 15; float acc = 0.f;
        for (int p = 0; p < 64; ++p) { const float cr = Cr[cp * 64 + p], ci = Ci[cp * 64 + p], pr = pwr[d * 64 + p], pi = pwi[d * 64 + p];
            const float zr = cr * pr - ci * pi, zi = cr * pi + ci * pr; acc += zr * Bbr[p * 16 + c] - zi * Bbi[p * 16 + c]; }
        Kd[idx] = acc;
    }
    __syncthreads();
    f16* ops = (f16*)(F.ws + WS_SSMOP) + (size_t)g * 131072;
    f16* Top = ops; f16* We = ops + 65536; f16* Wc = ops + 65536 + 32768;
    for (int v = tid; v < 8192; v += NTHREADS) {
        const int row = v >> 5, kv = v & 31, j = kv >> 1, half = kv & 1, i = row >> 4, cp = row & 15; h8 o;
#pragma unroll
        for (int e = 0; e < 8; ++e) o[e] = (j <= i) ? (f16)Kd[((i - j) * 16 + cp) * 16 + 8 * half + e] : (f16)0.f;
        *(h8*)(Top + row * 256 + kv * 8) = o;
    }
    for (int v = tid; v < 4096; v += NTHREADS) {
        const int sx = v >> 5, kv = v & 31, j = kv >> 1, half = kv & 1, p = sx & 63; const float pr = pwr[(15 - j) * 64 + p], pi = pwi[(15 - j) * 64 + p]; h8 o;
#pragma unroll
        for (int e = 0; e < 8; ++e) { const float br = Bbr[p * 16 + 8 * half + e], bi = Bbi[p * 16 + 8 * half + e]; o[e] = (f16)(sx < 64 ? pr * br - pi * bi : pr * bi + pi * br); }
        *(h8*)(We + sx * 256 + kv * 8) = o;
    }
    for (int v = tid; v < 4096; v += NTHREADS) {
        const int row = v >> 4, kv = v & 15, i = row >> 4, cp = row & 15; h8 o;
#pragma unroll
        for (int e = 0; e < 8; ++e) { const int sx = 8 * kv + e, p = sx & 63; const float cr = Cr[cp * 64 + p], ci = Ci[cp * 64 + p], pr = pwr[(i + 1) * 64 + p], pi = pwi[(i + 1) * 64 + p];
            o[e] = (f16)(sx < 64 ? cr * pr - ci * pi : -(cr * pi + ci * pr)); }
        *(h8*)(Wc + row * 128 + kv * 8) = o;
    }
    __syncthreads();
}

__device__ __forceinline__ void p0_prologue(Frame& F) {
    const Args& A = *F.a;
    if (blockIdx.x < NG) ssm_precompute(F, (int)blockIdx.x);
    LAS float* scr = (LAS float*)(F.lds + F.wave * 16384);
    constexpr int I0 = 16 * 64, I1 = 8 * 32, I2 = 16 * 32, I3 = 16 * 32, I4 = 4 * 32, I5 = NE * 16 * 64, I6 = NE * 16 * 32;
    constexpr int NIT = I0 + I1 + I2 + I3 + I4 + I5;
    for (int it = F.gw; it < NIT; it += F.NGW) {
        int r = it;
        if (r < I0) { tr_item(A.in[I_WIN], 1024, 2048, (f16*)(F.ws + WS_WIN), r, 0, nullptr, scr, F.lane); continue; } r -= I0;
        if (r < I1) { tr_item(A.in[I_WGLU], 512, 1024, (f16*)(F.ws + WS_WGLU), r, 1, nullptr, scr, F.lane); continue; } r -= I1;
        if (r < I2) { tr_item(A.in[I_WOUT], 1024, 1024, (f16*)(F.ws + WS_WOUT), r, 2, A.in[I_SSMG], scr, F.lane); continue; } r -= I2;
        if (r < I3) { tr_item(A.in[I_WPG], 1024, 1024, (f16*)(F.ws + WS_WPG), r, 4, nullptr, scr, F.lane); continue; } r -= I3;
        if (r < I4) { tr_item(A.in[I_WPP], 256, 1024, (f16*)(F.ws + WS_WPP), r, 0, nullptr, scr, F.lane); continue; } r -= I4;
        if (r < I5) { const int e = r / (16 * 64), ii = r % (16 * 64);
            tr_item(A.in[I_WGU] + (size_t)e * 1024 * 2048, 1024, 2048, (f16*)(F.ws + WS_WGU + (size_t)e * 2048 * 1024), ii, 3, nullptr, scr, F.lane); continue; }
    }
    const size_t gt = (size_t)blockIdx.x * NTHREADS + F.tid, NT = (size_t)F.G * NTHREADS;
    { const f32x4* s = (const f32x4*)A.in[I_X]; h8* d = (h8*)(F.ws + WS_XH);
      for (size_t i = gt; i < (size_t)T * DM / 8; i += NT) { const f32x4 a = s[2 * i], b = s[2 * i + 1]; h8 o; o[0] = (f16)a[0]; o[1] = (f16)a[1]; o[2] = (f16)a[2]; o[3] = (f16)a[3]; o[4] = (f16)b[0]; o[5] = (f16)b[1]; o[6] = (f16)b[2]; o[7] = (f16)b[3]; d[i] = o; } }
    { const f32x4* s = (const f32x4*)A.in[I_P]; h8* d = (h8*)(F.ws + WS_PH);
      for (size_t i = gt; i < (size_t)T * PLE / 8; i += NT) { const f32x4 a = s[2 * i], b = s[2 * i + 1]; h8 o; o[0] = (f16)a[0]; o[1] = (f16)a[1]; o[2] = (f16)a[2]; o[3] = (f16)a[3]; o[4] = (f16)b[0]; o[5] = (f16)b[1]; o[6] = (f16)b[2]; o[7] = (f16)b[3]; d[i] = o; } }
}

__device__ __forceinline__ void p1_inproj(Frame& F) {
    { ProbInproj P{(const char*)(F.ws + WS_XH), (const char*)(F.ws + WS_WIN), (f16*)(F.ws + WS_QH), (f16*)(F.ws + WS_KT), (f16*)(F.ws + WS_VT), (f16*)(F.ws + WS_UG), F.ctl + CW_KMAX};
      pg8::DenseOrder S; S.init(T, DIN, F.G, (int)blockIdx.x); pg8::gemm_phase(F.lds, P, S); }
}

constexpr int ATT_SLOT = 32768, ATT_FLAGS = 3 * ATT_SLOT;
constexpr float ATT_SKIP = -40.0f;
constexpr int ATT_SG = 143360;
__device__ __forceinline__ int attn_unit(Frame& F, int b, int hd, int qb, float lam, gu32* qc, volatile LAS int* slot) {
    const int lane = F.lane, wave = F.wave, r32 = lane & 31, hi = lane >> 5;
    LAS unsigned char* lds = F.lds;
    const f16* qh = (const f16*)(F.ws + WS_QH);
    const f16* ktb = (const f16*)(F.ws + WS_KT) + (size_t)((b * 8 + hd) * 128) * 4096;
    const f16* vtb = (const f16*)(F.ws + WS_VT) + (size_t)((b * 8 + hd) * 128) * 4096;
    f16* mix = (f16*)(F.ws + WS_MIX);
    const int q0 = qb * 256, q0w = q0 + 32 * wave, NT = 4 * (qb + 1), NI = NT / 2; const size_t rowbase = (size_t)b * SEQ;
    volatile LAS int* flags = (volatile LAS int*)(lds + ATT_FLAGS);
#define ATT_ISSUE(ii) do { const int t0_ = NT - 1 - 2 * (ii); const unsigned so_ = (unsigned)(((ii) % 3) * ATT_SLOT + wave * 1024); \
        __builtin_amdgcn_global_load_lds((const unsigned*)(ktb + (size_t)t0_ * 4096 + wave * 512 + lane * 8), (LAS unsigned*)(lds + so_), 16, 0, 0); \
        __builtin_amdgcn_global_load_lds((const unsigned*)(vtb + (size_t)t0_ * 4096 + wave * 512 + lane * 8), (LAS unsigned*)(lds + so_ + 8192), 16, 0, 0); \
        __builtin_amdgcn_global_load_lds((const unsigned*)(ktb + (size_t)(t0_ - 1) * 4096 + wave * 512 + lane * 8), (LAS unsigned*)(lds + so_ + 16384), 16, 0, 0); \
        __builtin_amdgcn_global_load_lds((const unsigned*)(vtb + (size_t)(t0_ - 1) * 4096 + wave * 512 + lane * 8), (LAS unsigned*)(lds + so_ + 24576), 16, 0, 0); } while (0)
    ATT_ISSUE(0); ATT_ISSUE(1);
    if (lane == 0) { flags[wave] = 1; flags[8 + wave] = 1; }
    h8 qf[2][2];
#pragma unroll
    for (int mp = 0; mp < 2; ++mp)
#pragma unroll
        for (int kk = 0; kk < 2; ++kk) qf[mp][kk] = *(const h8*)(qh + (rowbase + q0w + r32) * 512 + hd * 64 + mp * 32 + kk * 16 + hi * 8);
    float sb1, sb2;
    { float n1 = 0.f, n2 = 0.f;
#pragma unroll
      for (int kk = 0; kk < 2; ++kk)
#pragma unroll
          for (int e = 0; e < 8; ++e) { const float a = (float)qf[0][kk][e], c = (float)qf[1][kk][e]; n1 += a * a; n2 += c * c; }
      n1 = swap_add(n1); n2 = swap_add(n2);
      const float k1 = __uint_as_float(__hip_atomic_load(F.ctl + CW_KMAX + (b * 8 + hd) * 2, RLX_AGENT)), k2 = __uint_as_float(__hip_atomic_load(F.ctl + CW_KMAX + (b * 8 + hd) * 2 + 1, RLX_AGENT));
      sb1 = sqrtf(n1) * k1 * 1.01f; sb2 = sqrtf(n2) * k2 * 1.01f; }
    const float slope2 = exp2f(-(float)(hd + 1)) * LOG2E;
    const int td = q0w >> 6, wo = q0w & 63;
    const f16 s_hi = (f16)slope2, s_lo = (f16)(slope2 - (float)s_hi);
    float mr1 = 0.f, mr2 = 0.f, l1 = 0.f, l2 = 0.f;
    h8 qx1, qx2;
    { h8 z; z[0] = (f16)(64.0f * (float)s_hi); z[1] = s_hi; z[2] = (f16)(64.0f * (float)s_lo); z[3] = s_lo; z[4] = (f16)0.f; z[5] = (f16)0.f; z[6] = (f16)0.f; z[7] = (f16)0.f;
      if (hi) { z[0] = (f16)0.f; z[1] = (f16)0.f; z[2] = (f16)0.f; z[3] = (f16)0.f; }
      qx1 = z; qx2 = z; }
    f32x16 o1[2], o2[2];
#pragma unroll
    for (int i = 0; i < 2; ++i) { o1[i] = (f32x16){}; o2[i] = (f32x16){}; }
    bool wdone = false, started = false;
    h2 ones; ones[0] = (f16)1.f; ones[1] = (f16)1.f;
#pragma unroll 1
    for (int ii = 0; ii < NI; ++ii) {
        if (ii + 1 < NI) asm volatile("s_waitcnt vmcnt(4) lgkmcnt(0)" ::: "memory"); else asm volatile("s_waitcnt vmcnt(0) lgkmcnt(0)" ::: "memory");
        __builtin_amdgcn_s_barrier();
        asm volatile("" ::: "memory");
        { const volatile LAS int* fl = flags + 8 * (ii & 1); const int any = fl[0] | fl[1] | fl[2] | fl[3] | fl[4] | fl[5] | fl[6] | fl[7];
          if (__builtin_amdgcn_readfirstlane(any) == 0) break; }
        if (ii + 2 < NI) ATT_ISSUE(ii + 2);
        bool need = !wdone;
        const int T0 = NT - 1 - 2 * ii, T1 = T0 - 1;
        if (T1 <= td && !wdone) {
            const bool first = !started; started = true;
            const LAS unsigned char* kp = lds + (ii % 3) * ATT_SLOT;
            const LAS unsigned char* kbase = kp + (hi * 512 + r32 * 8) * 2;
            const LAS unsigned char* vbase = kp + 8192 + (hi * 512 + r32 * 8) * 2;
            const float bmax = slope2 * (float)(64 * (T0 - td) + 63 - wo);
            const bool gen = first || T0 >= td || (__any(fmaxf(sb1 - mr1, sb2 - mr2) + bmax > 12.0f) != 0);
            const bool tlo = T0 > td;
            f32x16 s0[2], s1[2]; h8 kfr[4], vfr[6], pf[4], kxa, kxb; float ls;
#define ATT_SB __builtin_amdgcn_sched_barrier(0)
#define ATT_KX(tl) do { const f16 tr_ = (f16)(float)(T0 - (tl) - td); const f16 wa_ = (f16)(float)(r32 - wo), wb_ = (f16)(float)(32 + r32 - wo); h8 za, zb; \
                za[0] = tr_; za[1] = wa_; za[2] = tr_; za[3] = wa_; za[4] = (f16)1.f; za[5] = (f16)0.f; za[6] = (f16)0.f; za[7] = (f16)0.f; \
                zb[0] = tr_; zb[1] = wb_; zb[2] = tr_; zb[3] = wb_; zb[4] = (f16)1.f; zb[5] = (f16)0.f; zb[6] = (f16)0.f; zb[7] = (f16)0.f; \
                if (hi) { za[0] = (f16)0.f; za[1] = (f16)0.f; za[2] = (f16)0.f; za[3] = (f16)0.f; za[4] = (f16)0.f; zb[0] = (f16)0.f; zb[1] = (f16)0.f; zb[2] = (f16)0.f; zb[3] = (f16)0.f; zb[4] = (f16)0.f; } \
                kxa = za; kxb = zb; } while (0)
#define ATT_KLD(mp, tl) do { _Pragma("unroll") for (int kb = 0; kb < 2; ++kb) _Pragma("unroll") for (int j = 0; j < 2; ++j) \
                kfr[kb * 2 + j] = *(const LAS h8*)(kbase + (tl) * 16384 + ((mp) * 4 + j * 2) * 1024 + kb * 512); } while (0)
#define ATT_VLD(d, tl, sx, dh) vfr[d] = *(const LAS h8*)(vbase + (tl) * 16384 + (sx) * 2048 + (dh) * 512)
#define ATT_QKM(sn, mpn, qxn, j) do { if ((j) == 0) sn[0] = __builtin_amdgcn_mfma_f32_32x32x16_f16(kxa, qxn, (f32x16){}, 0, 0, 0); \
                else if ((j) == 1) sn[1] = __builtin_amdgcn_mfma_f32_32x32x16_f16(kxb, qxn, (f32x16){}, 0, 0, 0); \
                else if ((j) == 2) sn[0] = __builtin_amdgcn_mfma_f32_32x32x16_f16(kfr[0], qf[mpn][0], sn[0], 0, 0, 0); \
                else if ((j) == 3) sn[1] = __builtin_amdgcn_mfma_f32_32x32x16_f16(kfr[2], qf[mpn][0], sn[1], 0, 0, 0); \
                else if ((j) == 4) sn[0] = __builtin_amdgcn_mfma_f32_32x32x16_f16(kfr[1], qf[mpn][1], sn[0], 0, 0, 0); \
                else sn[1] = __builtin_amdgcn_mfma_f32_32x32x16_f16(kfr[3], qf[mpn][1], sn[1], 0, 0, 0); } while (0)
#define ATT_EXPH(sc, h) do { const float a0_ = __builtin_amdgcn_exp2f(sc[(h) >> 3][2 * ((h) & 7)]), a1_ = __builtin_amdgcn_exp2f(sc[(h) >> 3][2 * ((h) & 7) + 1]); \
                h2 p_; p_[0] = (f16)a0_; p_[1] = (f16)a1_; pf[(h) >> 2][2 * ((h) & 3)] = p_[0]; pf[(h) >> 2][2 * ((h) & 3) + 1] = p_[1]; \
                if (((h) & 1) == 0) hacc = p_; else { hacc = hacc + p_; asm volatile("v_dot2c_f32_f16 %0, %1, %2" : "+v"(ls) : "v"(hacc), "v"(ones)); } } while (0)
#define ATT_PLAINQK(sn, mpn, qxn) do { ATT_QKM(sn, mpn, qxn, 0); ATT_QKM(sn, mpn, qxn, 1); ATT_QKM(sn, mpn, qxn, 2); ATT_QKM(sn, mpn, qxn, 3); ATT_QKM(sn, mpn, qxn, 4); ATT_QKM(sn, mpn, qxn, 5); } while (0)
#define ATT_GENI(sc, mr, l, o, qx, tile, FIRST) do { \
                if ((tile) >= td) { _Pragma("unroll") for (int kb = 0; kb < 2; ++kb) _Pragma("unroll") for (int r = 0; r < 16; ++r) { const int kpos = 64 * (tile) + 32 * kb + crow(r, hi); if (kpos > q0w + r32) sc[kb][r] = -1e30f; } } \
                float rm = sc[0][0]; \
                _Pragma("unroll") for (int kb = 0; kb < 2; ++kb) _Pragma("unroll") for (int r = 0; r < 16; ++r) rm = fmaxf(rm, sc[kb][r]); \
                rm = swap_max(rm); \
                if ((FIRST) || __any(rm > 4.0f) != 0) { const float d = (FIRST) ? rm : fmaxf(rm, 0.f); const float f = __builtin_amdgcn_exp2f(-d); \
                    _Pragma("unroll") for (int kb = 0; kb < 2; ++kb) _Pragma("unroll") for (int r = 0; r < 16; ++r) sc[kb][r] -= d; \
                    mr += d; l *= f; o[0] *= f; o[1] *= f; if (!hi) qx[4] = (f16)(-mr); } } while (0)
#define ATT_BLOCK(sc, l, o, tlc, HASN, sn, mpn, qxn, NKLD) do { ls = 0.f; h2 hacc; \
                if (HASN) ATT_QKM(sn, mpn, qxn, 0); ATT_EXPH(sc, 0); ATT_SB; \
                if (HASN) ATT_QKM(sn, mpn, qxn, 1); ATT_EXPH(sc, 1); ATT_SB; \
                if (HASN) ATT_QKM(sn, mpn, qxn, 2); ATT_EXPH(sc, 2); ATT_VLD(0, tlc, 0, 0); ATT_VLD(1, tlc, 0, 1); ATT_SB; \
                if (HASN) ATT_QKM(sn, mpn, qxn, 3); ATT_EXPH(sc, 3); ATT_VLD(2, tlc, 1, 0); ATT_VLD(3, tlc, 1, 1); ATT_SB; \
                if (HASN) ATT_QKM(sn, mpn, qxn, 4); ATT_EXPH(sc, 4); ATT_VLD(4, tlc, 2, 0); ATT_VLD(5, tlc, 2, 1); ATT_SB; \
                if (HASN) ATT_QKM(sn, mpn, qxn, 5); ATT_EXPH(sc, 5); ATT_SB; \
                o[0] = __builtin_amdgcn_mfma_f32_32x32x16_f16(vfr[0], pf[0], o[0], 0, 0, 0); ATT_EXPH(sc, 6); ATT_EXPH(sc, 7); ATT_SB; \
                o[1] = __builtin_amdgcn_mfma_f32_32x32x16_f16(vfr[1], pf[0], o[1], 0, 0, 0); ATT_EXPH(sc, 8); NKLD; ATT_SB; \
                o[0] = __builtin_amdgcn_mfma_f32_32x32x16_f16(vfr[2], pf[1], o[0], 0, 0, 0); ATT_EXPH(sc, 9); ATT_EXPH(sc, 10); ATT_VLD(0, tlc, 3, 0); ATT_VLD(1, tlc, 3, 1); ATT_SB; \
                o[1] = __builtin_amdgcn_mfma_f32_32x32x16_f16(vfr[3], pf[1], o[1], 0, 0, 0); ATT_EXPH(sc, 11); ATT_SB; \
                o[0] = __builtin_amdgcn_mfma_f32_32x32x16_f16(vfr[4], pf[2], o[0], 0, 0, 0); ATT_EXPH(sc, 12); ATT_EXPH(sc, 13); ATT_SB; \
                o[1] = __builtin_amdgcn_mfma_f32_32x32x16_f16(vfr[5], pf[2], o[1], 0, 0, 0); ATT_EXPH(sc, 14); ATT_EXPH(sc, 15); ATT_SB; \
                o[0] = __builtin_amdgcn_mfma_f32_32x32x16_f16(vfr[0], pf[3], o[0], 0, 0, 0); ATT_SB; \
                o[1] = __builtin_amdgcn_mfma_f32_32x32x16_f16(vfr[1], pf[3], o[1], 0, 0, 0); ATT_SB; \
                l += ls; } while (0)
            if (!tlo) {
                ATT_KX(0); ATT_KLD(0, 0); ATT_PLAINQK(s0, 0, qx1); ATT_SB; ATT_KLD(1, 0); ATT_SB;
                if (gen) ATT_GENI(s0, mr1, l1, o1, qx1, T0, first);
                ATT_BLOCK(s0, l1, o1, 0, true, s1, 1, qx2, ATT_KLD(0, 1));
                ATT_KX(1);
                if (gen) ATT_GENI(s1, mr2, l2, o2, qx2, T0, first);
                ATT_BLOCK(s1, l2, o2, 0, true, s0, 0, qx1, ATT_KLD(1, 1));
            } else {
                ATT_KX(1); ATT_KLD(0, 1); ATT_PLAINQK(s0, 0, qx1); ATT_SB; ATT_KLD(1, 1); ATT_SB;
            }
            { const bool f2 = first && tlo;
              if (gen) ATT_GENI(s0, mr1, l1, o1, qx1, T1, f2);
              ATT_BLOCK(s0, l1, o1, 1, true, s1, 1, qx2, (void)0);
              if (gen) ATT_GENI(s1, mr2, l2, o2, qx2, T1, f2);
              ATT_BLOCK(s1, l2, o2, 1, false, s0, 0, qx1, (void)0); }
#undef ATT_SB
#undef ATT_KX
#undef ATT_KLD
#undef ATT_VLD
#undef ATT_QKM
#undef ATT_EXPH
#undef ATT_PLAINQK
#undef ATT_GENI
#undef ATT_BLOCK
            const float far = fmaxf(sb1 - mr1, sb2 - mr2) + slope2 * (float)(64 * T1 - 1 - q0w);
            need = (T1 >= 1) && (__any(far >= ATT_SKIP) != 0);
            if (!need) wdone = true;
        }
        if (lane == 0) flags[8 * ((ii + 1) & 1) + wave] = need ? 1 : 0;
    }
    asm volatile("s_waitcnt vmcnt(0) lgkmcnt(0)" ::: "memory");
    __builtin_amdgcn_s_barrier();
    asm volatile("" ::: "memory");
#undef ATT_ISSUE
    unsigned nxt = 0;
    if (F.tid == 0) nxt = __hip_atomic_fetch_add(qc, 1u, RLX_AGENT);
    l1 = swap_add(l1); l2 = swap_add(l2);
    const float i1 = 1.0f / l1, i2 = lam / l2;
    float ss = 0.f;
#pragma unroll
    for (int dh = 0; dh < 2; ++dh)
#pragma unroll
        for (int r = 0; r < 16; ++r) { const float v = o1[dh][r] * i1 - o2[dh][r] * i2; o1[dh][r] = v; ss += v * v; }
    ss = swap_add(ss);
    const float rs = rsqrtf(ss * (1.0f / 64.0f) + RMS_EPS) * 0.8f;
    const LAS float* sg = (const LAS float*)(lds + ATT_SG);
    f16* orow = mix + (rowbase + q0w + r32) * 1024 + 512 + hd * 64;
#pragma unroll
    for (int dh = 0; dh < 2; ++dh)
#pragma unroll
        for (int gp = 0; gp < 2; ++gp) {
            typedef unsigned u32x2 __attribute__((ext_vector_type(2))); typedef unsigned u32x4 __attribute__((ext_vector_type(4)));
            u32x2 pk[2];
#pragma unroll
            for (int j = 0; j < 2; ++j) { const int gq = 2 * gp + j; const int dv = 32 * dh + 8 * gq + 4 * hi; const f32x4 gg = *(const LAS f32x4*)(sg + dv);
                h4 o; o[0] = (f16)(o1[dh][4 * gq] * rs * gg[0]); o[1] = (f16)(o1[dh][4 * gq + 1] * rs * gg[1]); o[2] = (f16)(o1[dh][4 * gq + 2] * rs * gg[2]); o[3] = (f16)(o1[dh][4 * gq + 3] * rs * gg[3]);
                pk[j] = __builtin_bit_cast(u32x2, o); }
            const auto s0 = __builtin_amdgcn_permlane32_swap(pk[0][0], pk[1][0], false, false), s1 = __builtin_amdgcn_permlane32_swap(pk[0][1], pk[1][1], false, false);
            u32x4 w; w[0] = s0[0]; w[1] = s1[0]; w[2] = s0[1]; w[3] = s1[1];
            *(u32x4*)(orow + 32 * dh + 16 * gp + 8 * hi) = w;
        }
    if (F.tid == 0) slot[0] = (int)nxt;
    __syncthreads();
    const int nit = __builtin_amdgcn_readfirstlane(slot[0]);
    __syncthreads();
    return nit;
}

constexpr int SSM_UROW = 528, SSM_EROW = 528, SSM_XROW = 272;
constexpr int SSM_U0 = 0, SSM_U1 = 64 * SSM_UROW, SSM_E = 2 * 64 * SSM_UROW, SSM_XP = SSM_E + 64 * SSM_EROW;
typedef float f32x4_t __attribute__((ext_vector_type(4)));
__device__ __forceinline__ void ssm_unit(Frame& F, int b, int g) {
    const Args& A = *F.a; const int tid = F.tid, wave = F.wave, lane = F.lane, fr = lane & 15, fq = lane >> 4;
    const f16* ops = (const f16*)(F.ws + WS_SSMOP) + (size_t)g * 131072;
    const f16* Top = ops; const f16* We = ops + 65536; const f16* Wc = ops + 65536 + 32768;
    const char* ugb = (const char*)((const f16*)(F.ws + WS_UG) + (size_t)((b * 32 + g) * 8192) * 16);
    f16* yh = (f16*)(F.ws + WS_YH) + (size_t)b * SEQ * 512 + g * 16;
    LAS unsigned char* lds = F.lds;
    h8 BY[2][12];
#pragma unroll
    for (int n2 = 0; n2 < 2; ++n2) {
        const int nrow = 16 * (2 * wave + n2) + fr;
#pragma unroll
        for (int kk = 0; kk < 8; ++kk) BY[n2][kk] = *(const h8*)(Top + nrow * 256 + 32 * kk + 8 * fq);
#pragma unroll
        for (int kk = 0; kk < 4; ++kk) BY[n2][8 + kk] = *(const h8*)(Wc + nrow * 128 + 32 * kk + 8 * fq);
    }
    const float* a16 = (const float*)(F.ws + WS_A16) + (g * 64 + lane) * 2;
    const float a16r = a16[0], a16i = a16[1];
    const f32x4 dsk = *(const f32x4*)(A.in[I_SSMD] + g * 16 + 4 * fq);
    float xr = 0.f, xi = 0.f;
#pragma unroll
    for (int q = 0; q < 4; ++q) { const int o = (q * NTHREADS + tid) * 16; const h8 v = *(const h8*)(ugb + o); *(LAS h8*)(lds + SSM_U0 + (o >> 9) * SSM_UROW + (o & 511)) = v; }
    __syncthreads();
#pragma unroll 1
    for (int seg = 0; seg < 8; ++seg) {
        LAS unsigned char* Uc = lds + ((seg & 1) ? SSM_U1 : SSM_U0);
        LAS unsigned char* Un = lds + ((seg & 1) ? SSM_U0 : SSM_U1);
        {
            f32x4 ea[4]; h8 BE[8];
#pragma unroll
            for (int kk = 0; kk < 8; ++kk) BE[kk] = *(const h8*)(We + (16 * wave + fr) * 256 + 32 * kk + 8 * fq);
#pragma unroll
            for (int mt = 0; mt < 4; ++mt) ea[mt] = (f32x4){0.f, 0.f, 0.f, 0.f};
#pragma unroll
            for (int kk = 0; kk < 8; ++kk)
#pragma unroll
                for (int mt = 0; mt < 4; ++mt) { const h8 a = *(const LAS h8*)(Uc + (16 * mt + fr) * SSM_UROW + (32 * kk + 8 * fq) * 2); ea[mt] = __builtin_amdgcn_mfma_f32_16x16x32_f16(BE[kk], a, ea[mt], 0, 0, 0); }
#pragma unroll
            for (int mt = 0; mt < 4; ++mt) *(LAS f32x4*)(lds + SSM_E + (16 * mt + fr) * SSM_EROW + (16 * wave + 4 * fq) * 4) = ea[mt];
        }
        __syncthreads();
        if (wave == 0) {
#pragma unroll 8
            for (int n = 0; n < 64; ++n) {
                const float er = *(const LAS float*)(lds + SSM_E + n * SSM_EROW + lane * 4), ei = *(const LAS float*)(lds + SSM_E + n * SSM_EROW + (64 + lane) * 4);
                *(LAS f16*)(lds + SSM_XP + n * SSM_XROW + lane * 2) = (f16)xr; *(LAS f16*)(lds + SSM_XP + n * SSM_XROW + (64 + lane) * 2) = (f16)xi;
                const float nr = a16r * xr - a16i * xi + er, ni = a16r * xi + a16i * xr + ei; xr = nr; xi = ni;
            }
        } else if (seg < 7) {
            const char* src = ugb + (size_t)(seg + 1) * 32768;
            for (int v = tid - 64; v < 2048; v += NTHREADS - 64) { const int o = v * 16; const h8 x = *(const h8*)(src + o); *(LAS h8*)(Un + (o >> 9) * SSM_UROW + (o & 511)) = x; }
        }
        __syncthreads();
        {
            f32x4 ya[4][2];
#pragma unroll
            for (int mt = 0; mt < 4; ++mt) { ya[mt][0] = (f32x4){0.f, 0.f, 0.f, 0.f}; ya[mt][1] = (f32x4){0.f, 0.f, 0.f, 0.f}; }
#pragma unroll
            for (int kk = 0; kk < 12; ++kk)
#pragma unroll
                for (int mt = 0; mt < 4; ++mt) {
                    const h8 a = kk < 8 ? *(const LAS h8*)(Uc + (16 * mt + fr) * SSM_UROW + (32 * kk + 8 * fq) * 2) : *(const LAS h8*)(lds + SSM_XP + (16 * mt + fr) * SSM_XROW + (32 * (kk - 8) + 8 * fq) * 2);
                    ya[mt][0] = __builtin_amdgcn_mfma_f32_16x16x32_f16(BY[0][kk], a, ya[mt][0], 0, 0, 0);
                    ya[mt][1] = __builtin_amdgcn_mfma_f32_16x16x32_f16(BY[1][kk], a, ya[mt][1], 0, 0, 0);
                }
#pragma unroll
            for (int mt = 0; mt < 4; ++mt)
#pragma unroll
                for (int n2 = 0; n2 < 2; ++n2) {
                    const int ch = 16 * mt + fr, ti = 2 * wave + n2; const size_t tok = (size_t)(seg * 64 + ch) * 16 + ti;
                    const h4 u4 = *(const LAS h4*)(Uc + ch * SSM_UROW + (ti * 16 + 4 * fq) * 2);
                    h4 o;
#pragma unroll
                    for (int e = 0; e < 4; ++e) o[e] = (f16)gelu_tanh(ya[mt][n2][e] + dsk[e] * (float)u4[e]);
                    *(h4*)(yh + tok * 512 + 4 * fq) = o;
                }
        }
    }
    __syncthreads();
}

__device__ __forceinline__ void p2_mixers(Frame& F, int pass) {
    const Args& A = *F.a;
    gu32* qctr = F.ctl + CW_QUEUE + 128 * pass;
    constexpr int NSSM = BATCH * NG, NATT = BATCH * NH * 32;
    volatile LAS int* slot = (volatile LAS int*)(F.lds + LDS_BARST + 16);
    for (;;) {
        if (F.tid == 0) slot[0] = (int)__hip_atomic_fetch_add(qctr, 1u, RLX_AGENT);
        __syncthreads();
        const int it = __builtin_amdgcn_readfirstlane(slot[0]);
        __syncthreads();
        if (it >= NSSM) break;
        if (pass == 1 && PROBE_SEL != 0 && PROBE_SEL != 1) continue;
        ssm_unit(F, it / NG, it % NG);
    }
    asm volatile("" ::: "memory");
    float lam;
    { float d1 = 0.f, d2 = 0.f;
#pragma unroll 1
      for (int i = 0; i < 32; ++i) { d1 += A.in[I_LQ1][i] * A.in[I_LK1][i]; d2 += A.in[I_LQ2][i] * A.in[I_LK2][i]; }
      lam = __expf(d1) - __expf(d2) + 0.2f; }
    asm volatile("" : "+v"(lam));
    if (F.tid < 64) *(LAS float*)(F.lds + ATT_SG + F.tid * 4) = A.in[I_SUBLN][F.tid];
    int ait;
    { if (F.tid == 0) slot[0] = (int)__hip_atomic_fetch_add(qctr + 64, 1u, RLX_AGENT);
      __syncthreads();
      ait = __builtin_amdgcn_readfirstlane(slot[0]);
      __syncthreads(); }
    while (ait < NATT) {
        const int qb = 31 - ait / 32, bh = ait % 32;
        if (pass == 1 && PROBE_SEL != 0) { const int hd_ = bh & 7; const bool sel = PROBE_SEL == 2 ? hd_ >= 6 : PROBE_SEL == 3 ? hd_ <= 3 : PROBE_SEL == 4 ? (hd_ == 7 && qb == 31) : PROBE_SEL == 5 ? (hd_ == 4 || hd_ == 5) : false;
            if (!sel) { if (F.tid == 0) slot[0] = (int)__hip_atomic_fetch_add(qctr + 64, 1u, RLX_AGENT); __syncthreads(); ait = __builtin_amdgcn_readfirstlane(slot[0]); __syncthreads(); continue; } }
        ait = attn_unit(F, bh >> 3, bh & 7, qb, lam, qctr + 64, slot);
    }
    constexpr int NPLE = (T / 256) * 4, WDN_ITEMS = NE * 16 * 32, WDN_CHUNK = 32, NWDN = WDN_ITEMS / WDN_CHUNK;
    gu32* fctr = F.ctl + CW_QUEUE + 256 + 64 * pass;
    for (;;) {
        if (F.tid == 0) slot[0] = (int)__hip_atomic_fetch_add(fctr, 1u, RLX_AGENT);
        __syncthreads();
        const int it = __builtin_amdgcn_readfirstlane(slot[0]);
        __syncthreads();
        if (it >= NPLE + NWDN) break;
        if (it < NPLE) {
            ProbPleProj P{(const char*)(F.ws + WS_PH), (const char*)(F.ws + WS_WPP), (f16*)(F.ws + WS_PE)};
            pg8::OneOrder S; S.u.pm = it >> 2; S.u.pn = it & 3; S.u.e = 0; S.u.cnt = 0; pg8::gemm_phase(F.lds, P, S);
        } else {
            LAS float* scr = (LAS float*)(F.lds + F.wave * 16384);
#pragma unroll 1
            for (int j = 0; j < WDN_CHUNK / 8; ++j) { const int r = (it - NPLE) * WDN_CHUNK + j * 8 + F.wave; const int e = r / (16 * 32), ii = r % (16 * 32);
                tr_item(A.in[I_WDN] + (size_t)e * 1024 * 1024, 1024, 1024, (f16*)(F.ws + WS_WDN + (size_t)e * 1024 * 1024), ii, 4, nullptr, scr, F.lane); }
        }
        __syncthreads();
    }
}

__device__ __forceinline__ void p3_glu(Frame& F) {
    ProbGlu P{(const char*)(F.ws + WS_YH), (const char*)(F.ws + WS_WGLU), (f16*)(F.ws + WS_MIX)};
    pg8::DenseOrder S; S.init(T, 1024, F.G, (int)blockIdx.x); pg8::gemm_phase(F.lds, P, S);
}

__device__ __forceinline__ void p4_outproj(Frame& F) {
    ProbOut P{(const char*)(F.ws + WS_MIX), (const char*)(F.ws + WS_WOUT), (f16*)(F.ws + WS_MIXO)};
    pg8::DenseOrder S; S.init(T, DM, F.G, (int)blockIdx.x); pg8::gemm_phase(F.lds, P, S);
}

constexpr int RT_XROW = 2064;
constexpr int RT_XHI = 0, RT_XLO = 32 * RT_XROW;
constexpr int RT_PART = 0;
constexpr int RT_FIN = 2 * 32 * RT_XROW;
constexpr int RT_CNT = RT_FIN + 32 * 33 * 4;
__device__ __forceinline__ void p5_router(Frame& F, int pass) {
    const Args& A = *F.a; const int tid = F.tid, lane = F.lane, wave = F.wave, r32 = lane & 31, hi = lane >> 5;
    LAS unsigned char* lds = F.lds;
    LAS unsigned* lcnt = (LAS unsigned*)(lds + RT_CNT); LAS unsigned* lbase = lcnt + 32; LAS unsigned* asg = lcnt + 64;
    if (tid < 32) lcnt[tid] = 0u;
    const float* xin = A.in[I_X]; const f16* mixo = (const f16*)(F.ws + WS_MIXO); f16* x1h = (f16*)(F.ws + WS_X1H); unsigned char* x1q = (unsigned char*)(F.ws + WS_X1Q); float* gates = (float*)(F.ws + WS_GATES);
    h8 whi[8], wlo[8];
#pragma unroll
    for (int kk = 0; kk < 8; ++kk)
#pragma unroll
        for (int e = 0; e < 8; ++e) { const float w = A.in[I_WR][(128 * wave + 16 * kk + 8 * hi + e) * 32 + r32]; const f16 h = (f16)w; whi[kk][e] = h; wlo[kk][e] = (f16)(w - (float)h); }
    f32x4 gv[4], bv[4];
#pragma unroll
    for (int jx = 0; jx < 4; ++jx) { gv[jx] = *(const f32x4*)(A.in[I_LN1G] + 256 * jx + 4 * lane); bv[jx] = *(const f32x4*)(A.in[I_LN1B] + 256 * jx + 4 * lane); }
    const int rows_per_blk = T / F.G;
#pragma unroll 1
    for (int bt = 0; bt < rows_per_blk / 32; ++bt) {
        const int row0 = blockIdx.x * rows_per_blk + bt * 32;
#pragma unroll 1
        for (int rr = 0; rr < 4; ++rr) {
            const int lr = wave * 4 + rr; const size_t ro = (size_t)(row0 + lr) * 1024;
            f32x4 v[4]; float s1 = 0.f, s2 = 0.f;
#pragma unroll
            for (int jx = 0; jx < 4; ++jx) { const f32x4 xv = *(const f32x4*)(xin + ro + 256 * jx + 4 * lane); const h4 mv = *(const h4*)(mixo + ro + 256 * jx + 4 * lane);
#pragma unroll
                for (int e = 0; e < 4; ++e) { const float t = ALPHA * xv[e] + (float)mv[e]; v[jx][e] = t; s1 += t; } }
            const float mean = wave_sum(s1) * (1.0f / 1024.0f);
#pragma unroll
            for (int jx = 0; jx < 4; ++jx) { v[jx] = v[jx] - mean; s2 += (v[jx][0] * v[jx][0] + v[jx][1] * v[jx][1]) + (v[jx][2] * v[jx][2] + v[jx][3] * v[jx][3]); }
            const float rstd = rsqrtf(wave_sum(s2) * (1.0f / 1024.0f) + LN_EPS);
#pragma unroll
            for (int jx = 0; jx < 4; ++jx) {
                const f32x4 y = v[jx] * rstd * gv[jx] + bv[jx];
                h4 yh_, yl_;
#pragma unroll
                for (int e = 0; e < 4; ++e) { const f16 h = (f16)y[e]; yh_[e] = h; yl_[e] = (f16)(y[e] - (float)h); }
                *(h4*)(x1h + ro + 256 * jx + 4 * lane) = yh_;
                *(int*)(x1q + ro + 256 * jx + 4 * lane) = pack_fp8x4(y[0], y[1], y[2], y[3]);
                *(LAS h4*)(lds + RT_XHI + lr * RT_XROW + (256 * jx + 4 * lane) * 2) = yh_;
                *(LAS h4*)(lds + RT_XLO + lr * RT_XROW + (256 * jx + 4 * lane) * 2) = yl_;
            }
        }
        __syncthreads();
        f32x16 acc = {};
#pragma unroll
        for (int kk = 0; kk < 8; ++kk) {
            const int ko = (128 * wave + 16 * kk + 8 * hi) * 2;
            const h8 xh_ = *(const LAS h8*)(lds + RT_XHI + r32 * RT_XROW + ko), xl_ = *(const LAS h8*)(lds + RT_XLO + r32 * RT_XROW + ko);
            acc = __builtin_amdgcn_mfma_f32_32x32x16_f16(whi[kk], xh_, acc, 0, 0, 0);
            acc = __builtin_amdgcn_mfma_f32_32x32x16_f16(wlo[kk], xh_, acc, 0, 0, 0);
            acc = __builtin_amdgcn_mfma_f32_32x32x16_f16(whi[kk], xl_, acc, 0, 0, 0);
        }
        __syncthreads();
#pragma unroll
        for (int g = 0; g < 4; ++g) { f32x4 o; o[0] = acc[4 * g]; o[1] = acc[4 * g + 1]; o[2] = acc[4 * g + 2]; o[3] = acc[4 * g + 3];
            *(LAS f32x4*)(lds + RT_PART + (((wave * 32 + r32) * 32) + 8 * g + 4 * hi) * 4) = o; }
        __syncthreads();
        { const int row = tid >> 4, e0 = 2 * (tid & 15); float a0 = A.in[I_BR][e0], a1 = A.in[I_BR][e0 + 1];
#pragma unroll
          for (int w = 0; w < 8; ++w) { a0 += *(const LAS float*)(lds + RT_PART + (((w * 32 + row) * 32) + e0) * 4); a1 += *(const LAS float*)(lds + RT_PART + (((w * 32 + row) * 32) + e0 + 1) * 4); }
          *(LAS float*)(lds + RT_FIN + (row * 33 + e0) * 4) = a0; *(LAS float*)(lds + RT_FIN + (row * 33 + e0 + 1) * 4) = a1; }
        __syncthreads();
        if (tid < 32) {
            const LAS float* lg = (const LAS float*)(lds + RT_FIN + tid * 33 * 4);
            float tv[4]; int te[4];
#pragma unroll
            for (int k = 0; k < 4; ++k) { tv[k] = -INFINITY; te[k] = 0; }
#pragma unroll 1
            for (int e = 0; e < 32; ++e) { const float x = lg[e];
                if (x > tv[3]) {
                    if (x > tv[0]) { tv[3] = tv[2]; te[3] = te[2]; tv[2] = tv[1]; te[2] = te[1]; tv[1] = tv[0]; te[1] = te[0]; tv[0] = x; te[0] = e; }
                    else if (x > tv[1]) { tv[3] = tv[2]; te[3] = te[2]; tv[2] = tv[1]; te[2] = te[1]; tv[1] = x; te[1] = e; }
                    else if (x > tv[2]) { tv[3] = tv[2]; te[3] = te[2]; tv[2] = x; te[2] = e; }
                    else { tv[3] = x; te[3] = e; } } }
            const float e1 = __expf(tv[1] - tv[0]), e2 = __expf(tv[2] - tv[0]), e3 = __expf(tv[3] - tv[0]); const float inv = 1.0f / (1.0f + e1 + e2 + e3);
            const int row = row0 + tid; f32x4 gk; gk[0] = inv; gk[1] = e1 * inv; gk[2] = e2 * inv; gk[3] = e3 * inv;
            *(f32x4*)(gates + (size_t)row * 4) = gk;
#pragma unroll
            for (int k = 0; k < 4; ++k) { const unsigned rk = atomicAdd((unsigned*)&lcnt[te[k]], 1u); asg[(bt * 32 + tid) * 4 + k] = (unsigned)te[k] | (rk << 8); }
        }
        __syncthreads();
    }
    if (F.tid < 32) lbase[F.tid] = __hip_atomic_fetch_add(F.ctl + CW_CNT + 2048 * pass + 64 * F.tid, lcnt[F.tid], RLX_AGENT);
    __syncthreads();
    int* list = (int*)(F.ws + WS_LIST + (size_t)pass * 4 * MiB);
    { const unsigned a = asg[F.tid]; const int e = a & 255, rk = a >> 8; const int row = blockIdx.x * rows_per_blk + (F.tid >> 2);
      list[(size_t)e * ECAP + lbase[e] + rk] = row * 4 + (F.tid & 3); }
    __syncthreads();
}

template <int WHICH> __device__ __forceinline__ void p67_moe(Frame& F) {
    const Args& A = *F.a;
    LAS int* tab = (LAS int*)(F.lds + pg8::STAGE_BYTES + 2048);
    if (F.tid < 32) tab[F.tid] = (int)__hip_atomic_load(F.ctl + CW_CNT + 64 * F.tid, RLX_AGENT);
    __syncthreads();
    if (F.tid == 0) { int sacc = 0; for (int e = 0; e < 32; ++e) { tab[32 + e] = sacc; sacc += (tab[e] + 255) >> 8; } tab[64] = sacc; }
    __syncthreads();
    const int* list = (const int*)(F.ws + WS_LIST);
    if (WHICH == 0) {
        ProbMoeUp P{(const char*)(F.ws + WS_X1Q), (const char*)(F.ws + WS_WGU), list, A.in[I_BGU], (unsigned char*)(F.ws + WS_ACT)};
        pg8::MoeOrder S{tab, 8, F.G, F.vcu}; pg8::gemm_phase(F.lds, P, S);
    } else {
        ProbMoeDn P{(const char*)(F.ws + WS_ACT), (const char*)(F.ws + WS_WDN), list, A.in[I_BDN], (const float*)(F.ws + WS_GATES), (unsigned char*)(F.ws + WS_SLAB)};
        pg8::MoeOrder S{tab, 4, F.G, F.vcu}; pg8::gemm_phase(F.lds, P, S);
    }
    __syncthreads();
}

__device__ __forceinline__ void p8_combine(Frame& F) {
    const int lane = F.lane;
    typedef int i32x2 __attribute__((ext_vector_type(2))); typedef float f32x2 __attribute__((ext_vector_type(2)));
    const f16* x1h = (const f16*)(F.ws + WS_X1H); const unsigned char* slab = (const unsigned char*)(F.ws + WS_SLAB); f16* rh = (f16*)(F.ws + WS_RH); unsigned char* rq = (unsigned char*)(F.ws + WS_RQ);
    for (int row = F.gw; row < T; row += F.NGW) {
#pragma unroll
        for (int j = 0; j < 2; ++j) {
            const size_t o = (size_t)row * 1024 + 512 * j + 8 * lane;
            const h8 xv = *(const h8*)(x1h + o); float v[8], acc[8];
#pragma unroll
            for (int e = 0; e < 8; ++e) { v[e] = ALPHA * (float)xv[e]; acc[e] = 0.f; }
#pragma unroll
            for (int k = 0; k < 4; ++k) { const i32x2 sv = *(const i32x2*)(slab + ((size_t)row * 4 + k) * 1024 + 512 * j + 8 * lane);
#pragma unroll
                for (int q = 0; q < 2; ++q) { const f32x2 lo = __builtin_amdgcn_cvt_pk_f32_fp8(sv[q], false), hi = __builtin_amdgcn_cvt_pk_f32_fp8(sv[q], true);
                    acc[4 * q] += lo[0]; acc[4 * q + 1] += lo[1]; acc[4 * q + 2] += hi[0]; acc[4 * q + 3] += hi[1]; } }
            h8 hh;
#pragma unroll
            for (int e = 0; e < 8; ++e) { v[e] += acc[e] * (1.0f / SLAB_SCALE); hh[e] = (f16)v[e]; v[e] = fminf(fmaxf(v[e] * RQ_SCALE, -448.f), 448.f); }
            *(h8*)(rh + o) = hh;
            i32x2 qq = {pack_fp8x4(v[0], v[1], v[2], v[3]), pack_fp8x4(v[4], v[5], v[6], v[7])}; *(i32x2*)(rq + o) = qq;
        }
    }
}

__device__ __forceinline__ void p9_ple(Frame& F) {
    ProbPleGate P{(const char*)(F.ws + WS_RQ), (const char*)(F.ws + WS_WPG), (f16*)(F.ws + WS_GATEH)};
    pg8::DenseOrder S; S.init(T, DM, F.G, (int)blockIdx.x); pg8::gemm_phase(F.lds, P, S);
}

__device__ __forceinline__ void p10_ln2(Frame& F) {
    const Args& A = *F.a; const int lane = F.lane; float* out = A.out; const f16* rh = (const f16*)(F.ws + WS_RH); const f16* gateh = (const f16*)(F.ws + WS_GATEH); const f16* pe = (const f16*)(F.ws + WS_PE);
    f32x4 gv[4], bv[4];
#pragma unroll
    for (int j = 0; j < 2; ++j)
#pragma unroll
        for (int q = 0; q < 2; ++q) { gv[2 * j + q] = *(const f32x4*)(A.in[I_LN2G] + 512 * j + 8 * lane + 4 * q); bv[2 * j + q] = *(const f32x4*)(A.in[I_LN2B] + 512 * j + 8 * lane + 4 * q); }
    for (int row = F.gw; row < T; row += F.NGW) {
        f32x4 v[4]; float s = 0.f;
#pragma unroll
        for (int j = 0; j < 2; ++j) { const size_t o_ = (size_t)row * 1024 + 512 * j + 8 * lane; const h8 r8 = *(const h8*)(rh + o_), g8 = *(const h8*)(gateh + o_), p8 = *(const h8*)(pe + o_);
#pragma unroll
            for (int q = 0; q < 2; ++q) { f32x4 t;
#pragma unroll
                for (int e = 0; e < 4; ++e) t[e] = (float)r8[4 * q + e] + (float)g8[4 * q + e] * (float)p8[4 * q + e];
                v[2 * j + q] = t; s += (t[0] + t[1]) + (t[2] + t[3]); } }
        const float mean = wave_sum(s) * (1.0f / 1024.0f); float s2 = 0.f;
#pragma unroll
        for (int j = 0; j < 4; ++j) { v[j] = v[j] - mean; s2 += (v[j][0] * v[j][0] + v[j][1] * v[j][1]) + (v[j][2] * v[j][2] + v[j][3] * v[j][3]); }
        const float rstd = rsqrtf(wave_sum(s2) * (1.0f / 1024.0f) + LN_EPS);
#pragma unroll
        for (int j = 0; j < 2; ++j)
#pragma unroll
            for (int q = 0; q < 2; ++q) *(f32x4*)(out + (size_t)row * 1024 + 512 * j + 8 * lane + 4 * q) = v[2 * j + q] * rstd * gv[2 * j + q] + bv[2 * j + q];
    }
}

__global__ void __launch_bounds__(NTHREADS, 2) fwd_kernel(Args args) {
    extern __shared__ __attribute__((aligned(16))) unsigned char lds_raw[];
    Frame F;
    F.lds = (LAS unsigned char*)lds_raw; F.a = &args; F.ws = args.ws; F.ctl = (gu32*)(args.ws + WS_CTL);
    F.tid = threadIdx.x; F.lane = F.tid & 63; F.wave = __builtin_amdgcn_readfirstlane(F.tid >> 6);
    F.G = gridDim.x; F.gw = blockIdx.x * NWAVES + F.wave; F.NGW = F.G * NWAVES;
    { const int bx = blockIdx.x; F.vcu = (F.G % 8 == 0) ? (bx % 8) * (F.G / 8) + bx / 8 : bx; }
    volatile LAS unsigned* barst = (volatile LAS unsigned*)(F.lds + LDS_BARST);
    if (F.tid < 16) barst[F.tid] = 0u;
    __syncthreads();
    XcdBarrier bar; bar.bar = (unsigned*)(F.ctl + CW_BAR); bar.x = 0; bar.st = nullptr;
    if (MK_N_LAUNCHES == 1) bar = xcd_barrier_post((unsigned*)(F.ctl + CW_BAR), barst);
    const int lo = args.ph_lo, hi = args.ph_hi;
#define IN(k) (lo <= (k) && (k) < hi)
#define SEAM(k) do { if (IN(k) && IN((k) + 1)) xcd_barrier(bar); } while (0)
#define REP(k, body) do { if (IN(k)) { body; if ((PROBE_MASK >> (k)) & 1) { xcd_barrier(bar); body; } } } while (0)
    REP(0, p0_prologue(F)); SEAM(0);
    REP(1, p1_inproj(F)); SEAM(1);
    if (IN(2)) { p2_mixers(F, args.pass); if ((PROBE_MASK >> 2) & 1) { xcd_barrier(bar); p2_mixers(F, 1); } } SEAM(2);
    REP(3, p3_glu(F)); SEAM(3);
    REP(4, p4_outproj(F)); SEAM(4);
    if (IN(5)) { p5_router(F, args.pass); } SEAM(5);
    REP(6, p67_moe<0>(F)); SEAM(6);
    REP(7, p67_moe<1>(F)); SEAM(7);
    REP(8, p8_combine(F)); SEAM(8);
    REP(9, p9_ple(F)); SEAM(9);
    if (IN(10)) { p10_ln2(F); }
#undef REP
#undef IN
#undef SEAM
}
}

extern "C" void kernel_launch(void* const* d_in, const int* in_sizes, int n_in, void* d_out, int out_size, void* d_ws, size_t ws_size, hipStream_t stream) {
    static int grid = 0;
    if (grid == 0) {
        if (n_in != 31 || out_size != T * DM || ws_size < WS_END) { fprintf(stderr, "kernel_launch: unexpected problem (n_in %d, out %d, ws %zu)\n", n_in, out_size, ws_size); grid = -1; return; }
        int dev = 0, cus = 0;
        if (hipGetDevice(&dev) != hipSuccess || hipDeviceGetAttribute(&cus, hipDeviceAttributeMultiprocessorCount, dev) != hipSuccess) { grid = -1; return; }
        if (hipFuncSetAttribute((const void*)fwd_kernel, hipFuncAttributeMaxDynamicSharedMemorySize, LDS_BYTES) != hipSuccess) { fprintf(stderr, "kernel_launch: hipFuncSetAttribute failed\n"); grid = -1; return; }
        int per_cu = 0;
        if (hipOccupancyMaxActiveBlocksPerMultiprocessor(&per_cu, (const void*)fwd_kernel, NTHREADS, LDS_BYTES) != hipSuccess || per_cu < 1) { fprintf(stderr, "kernel_launch: occupancy query says %d\n", per_cu); }
        (void)hipGetLastError();
        grid = cus;
    }
    if (grid < 0) return;
    (void)hipMemsetAsync((char*)d_ws + WS_CTL, 0, CTL_ZERO_BYTES, stream);
    Args a{};
    for (int i = 0; i < 31; ++i) a.in[i] = (const float*)d_in[i];
    a.out = (float*)d_out; a.ws = (unsigned char*)d_ws;
    if (MK_N_LAUNCHES == 1) { a.ph_lo = 0; a.ph_hi = NPHASE; hipLaunchKernelGGL(fwd_kernel, dim3(grid), dim3(NTHREADS), LDS_BYTES, stream, a); }
    else { for (int p = 0; p < NPHASE; ++p) { a.ph_lo = p; a.ph_hi = p + 1; a.pass = 0; hipLaunchKernelGGL(fwd_kernel, dim3(grid), dim3(NTHREADS), LDS_BYTES, stream, a);
             if (p == PROBE_DUP) { a.pass = 1; hipLaunchKernelGGL(fwd_kernel, dim3(grid), dim3(NTHREADS), LDS_BYTES, stream, a); } } }
}
```

```cpp
#include <hip/hip_runtime.h>
#include <cstdio>
#include <cstdint>

#ifndef PROBE_MASK
#define PROBE_MASK 0
#endif
#ifndef PROBE_SEL
#define PROBE_SEL 0
#endif
#ifndef PROBE_DUP
#define PROBE_DUP -1
#endif
#ifndef MK_N_LAUNCHES
#define MK_N_LAUNCHES 1
#endif

namespace {
constexpr int BATCH = 4, SEQ = 8192, DM = 1024, T = BATCH * SEQ;
constexpr int NH = 8, NG = 32, NS = 64, DIN = 2048;
constexpr int NE = 32, PLE = 256;
constexpr int ECAP = T;
constexpr float LN_EPS = 1e-5f, RMS_EPS = 1e-5f;
constexpr float ALPHA = 1.189207115002721f;
constexpr float QSCALE = 0.17677669529663687f * 1.4426950408889634f;
constexpr float LOG2E = 1.4426950408889634f;
constexpr int NPHASE = 11;
constexpr int NWAVES = 8, NTHREADS = 512;

typedef _Float16 f16;
typedef f16 h8 __attribute__((ext_vector_type(8)));
typedef f16 h4 __attribute__((ext_vector_type(4)));
typedef f16 h2 __attribute__((ext_vector_type(2)));
typedef float f32x4 __attribute__((ext_vector_type(4)));
typedef float f32x16 __attribute__((ext_vector_type(16)));
typedef int i32x4 __attribute__((ext_vector_type(4)));
typedef int i32x8 __attribute__((ext_vector_type(8)));
#define LAS __attribute__((address_space(3)))
#define GAS __attribute__((address_space(1)))
typedef GAS unsigned gu32;
#define RLX_AGENT __ATOMIC_RELAXED, __HIP_MEMORY_SCOPE_AGENT

constexpr size_t MiB = 1u << 20;
constexpr size_t WS_CTL = 0, CTL_ZERO_BYTES = 1 * MiB;
constexpr size_t WS_STATS = 3 * MiB;
constexpr size_t WS_GATES = 5 * MiB;
constexpr size_t WS_LIST = 6 * MiB;
constexpr size_t WS_WIN = 16 * MiB;
constexpr size_t WS_WGLU = 20 * MiB;
constexpr size_t WS_WOUT = 21 * MiB;
constexpr size_t WS_WPG = 23 * MiB;
constexpr size_t WS_WPP = 25 * MiB;
constexpr size_t WS_WGU = 32 * MiB;
constexpr size_t WS_WDN = 160 * MiB;
constexpr size_t WS_PE = 224 * MiB;
constexpr size_t WS_V1 = 288 * MiB;
constexpr size_t WS_A = 416 * MiB;
constexpr size_t WS_XH = WS_A;
constexpr size_t WS_PH = WS_A + 64 * MiB;
constexpr size_t WS_QH = WS_A + 80 * MiB;
constexpr size_t WS_KT = WS_A + 112 * MiB;
constexpr size_t WS_VT = WS_A + 144 * MiB;
constexpr size_t WS_UG = WS_A + 176 * MiB;
constexpr size_t WS_ACT = WS_A;
constexpr size_t WS_X1Q = WS_A + 128 * MiB;
constexpr size_t WS_R = WS_A;
constexpr size_t WS_RH = WS_A + 128 * MiB;
constexpr size_t WS_RQ = WS_A + 192 * MiB;
constexpr size_t WS_B = 672 * MiB;
constexpr size_t WS_YH = WS_B;
constexpr size_t WS_MIX = WS_B + 32 * MiB;
constexpr size_t WS_X1H = 940 * MiB;
constexpr size_t WS_SLAB = WS_B;
constexpr size_t WS_SSMOP = 928 * MiB;
constexpr size_t WS_A16 = 936 * MiB;
constexpr size_t WS_GATEH = WS_V1;
constexpr size_t WS_MIXO = WS_XH;
constexpr size_t WS_END = 1004 * MiB;

constexpr int CW_BAR = 4096;
constexpr int CW_CNT = 8192;
constexpr int CW_QUEUE = 12288;
constexpr int CW_KMAX = 16384;

constexpr int LDS_BYTES = 147456;
constexpr int LDS_BARST = LDS_BYTES - 64;

__device__ __forceinline__ float wave_sum(float v) {
#pragma unroll
    for (int o = 1; o < 64; o <<= 1) v += __shfl_xor(v, o);
    return v;
}
__device__ __forceinline__ float sigmoidf_(float x) { return __builtin_amdgcn_rcpf(1.0f + __builtin_amdgcn_exp2f(-LOG2E * x)); }
__device__ __forceinline__ float gelu_tanh(float x) {
    const float z = 0.7978845608028654f * (x + 0.044715f * x * x * x);
    const float e = __builtin_amdgcn_exp2f(fminf(2.0f * LOG2E * z, 80.0f));
    const float t = 1.0f - 2.0f * __builtin_amdgcn_rcpf(e + 1.0f);
    return 0.5f * x * (1.0f + t);
}
__device__ __forceinline__ int crow(int r, int hi) { return (r & 3) + 8 * (r >> 2) + 4 * hi; }
__device__ __forceinline__ float swap_add(float v) { return v + __shfl_xor(v, 32); }
__device__ __forceinline__ float swap_max(float v) { return fmaxf(v, __shfl_xor(v, 32)); }

#define XB_TMO      128
#define XB_XCNT(j)  (256  + 64 * (j))
#define XB_XSUB(j)  (1280 + 64 * (j))
#define XB_XGEN(j)  (2304 + 64 * (j))
#define XB_TOP      3328
#define XB_TOPGEN   3392
#define XCD_BAR_WORDS 3456
#define XB_SPIN_CAP (1u << 20)
__device__ __forceinline__ unsigned xb_ld(unsigned* p)              { return __hip_atomic_load(p, __ATOMIC_RELAXED, __HIP_MEMORY_SCOPE_AGENT); }
__device__ __forceinline__ unsigned xb_add(unsigned* p, unsigned v) { return __hip_atomic_fetch_add(p, v, __ATOMIC_RELAXED, __HIP_MEMORY_SCOPE_AGENT); }
__device__ __forceinline__ unsigned xb_xcc_id() { return (unsigned)__builtin_amdgcn_s_getreg((3 << 11) | 20) & 0xFu; }
#define XB_SPIN(cond, bar) do { unsigned _sp = 0; while (cond) { __builtin_amdgcn_s_sleep(1); \
    if ((++_sp & 255u) == 0u) { if (xb_ld(&(bar)[XB_TMO])) break; if (_sp > XB_SPIN_CAP) { atomicAdd(&(bar)[XB_TMO], 1u); break; } } } } while (0)
struct XcdBarrier { unsigned* bar; unsigned x; volatile LAS unsigned* st; };
__device__ __forceinline__ XcdBarrier xcd_barrier_post(unsigned* bar, volatile LAS unsigned* st) {
    XcdBarrier b; b.bar = bar; b.x = xb_xcc_id(); b.st = st;
    if (threadIdx.x == 0) (void)xb_add(&bar[XB_XCNT(b.x)], 1u);
    return b;
}
__device__ __forceinline__ void xcd_barrier_complete(unsigned* bar, unsigned x, unsigned& nloc, unsigned& nx) {
    const unsigned G = gridDim.x * gridDim.y * gridDim.z;
    unsigned sum, cnt, mine, sp = 0u;
    for (;;) {
        sum = 0u; cnt = 0u; mine = 0u;
#pragma unroll
        for (unsigned j = 0; j < 16; ++j) { const unsigned c = xb_ld(&bar[XB_XCNT(j)]); sum += c; cnt += (c > 0u) ? 1u : 0u; mine = (j == x) ? c : mine; }
        if (sum == G) break;
        __builtin_amdgcn_s_sleep(1);
        if ((++sp & 255u) == 0u) { if (xb_ld(&bar[XB_TMO])) break; if (sp > XB_SPIN_CAP) { atomicAdd(&bar[XB_TMO], 1u); break; } }
    }
    nloc = mine > 0u ? mine : 1u; nx = cnt > 0u ? cnt : 1u;
}
__device__ __forceinline__ void xcd_barrier(const XcdBarrier& b) {
    asm volatile("s_waitcnt vmcnt(0)" ::: "memory");
    __syncthreads();
    if (threadIdx.x == 0) {
        unsigned* bar = b.bar;
        __builtin_amdgcn_s_waitcnt(0);
        unsigned nloc = b.st[0], nx = b.st[1];
        if (nloc == 0u) { xcd_barrier_complete(bar, b.x, nloc, nx); b.st[0] = nloc; b.st[1] = nx; }
        const unsigned old = xb_add(&bar[XB_XSUB(b.x)], 1u);
        const unsigned gen = old / nloc;
        if (old + 1u == (gen + 1u) * nloc) {
            __builtin_amdgcn_fence(__ATOMIC_RELEASE, "agent");
            asm volatile("s_waitcnt vmcnt(0)" ::: "memory");
            const unsigned og = xb_add(&bar[XB_TOP], 1u);
            const unsigned tg = og / nx;
            if (og + 1u == (tg + 1u) * nx) xb_add(&bar[XB_TOPGEN], 1u);
            else XB_SPIN(xb_ld(&bar[XB_TOPGEN]) == tg, bar);
            __builtin_amdgcn_fence(__ATOMIC_ACQUIRE, "agent");
            xb_add(&bar[XB_XGEN(b.x)], 1u);
            asm volatile("s_waitcnt vmcnt(0)" ::: "memory");
        } else {
            XB_SPIN(xb_ld(&bar[XB_XGEN(b.x)]) == gen, bar);
            __builtin_amdgcn_fence(__ATOMIC_ACQUIRE, "agent");
            asm volatile("s_waitcnt vmcnt(0)" ::: "memory");
        }
    }
    __syncthreads();
}

struct Args { const float* in[31]; float* out; unsigned char* ws; int ph_lo, ph_hi, pass, pad; };
enum { I_X = 0, I_P, I_WIN, I_LQ1, I_LK1, I_LQ2, I_LK2, I_SUBLN, I_ARE, I_AIM, I_LOGDT, I_BRE, I_BIM, I_CRE, I_CIM, I_SSMD, I_WGLU, I_SSMG, I_WOUT,
       I_LN1G, I_LN1B, I_WR, I_BR, I_WGU, I_BGU, I_WDN, I_BDN, I_WPG, I_WPP, I_LN2G, I_LN2B };

struct Frame {
    LAS unsigned char* lds;
    const Args* a;
    unsigned char* ws;
    gu32* ctl;
    int tid, lane, wave, gw, NGW, G, vcu;
};

namespace pg8 {
constexpr int BM = 256, BK = 64, HALF = 128, HTB = HALF * BK * 2, STAGE_BYTES = 8 * HTB, NXCD = 8, WGM = 8;
__device__ __forceinline__ int lds_byte(int r, int c) { const int st = (r >> 4) * 2 + (c >> 5), rr = r & 15, cc = c & 31, ob = rr * 64 + cc * 2; return st * 1024 + (ob ^ (((ob >> 9) & 1) << 5)); }
__device__ __forceinline__ void stage_rc(int b, int& R, int& C) { const int st = b / 1024, sb = b % 1024, swz = sb ^ (((sb >> 9) & 1) << 5); R = (st >> 1) * 16 + swz / 64; C = (st & 1) * 32 + (swz % 64) / 2; }
struct Unit { int pm, pn, e, cnt; };
struct DenseOrder {
    int nM, nN, nwg, G, c;
    __device__ __forceinline__ void init(int M, int N, int G_, int c_) { nM = M / BM; nN = N / BM; nwg = nM * nN; G = G_; c = c_; }
    __device__ __forceinline__ bool next(int i, Unit& u) const {
        const long L = (long)i * G + c; if (L >= nwg) return false;
        int wgid = (int)L; { const int q = nwg / NXCD, r = nwg % NXCD, xcd = wgid % NXCD, off = wgid / NXCD; wgid = (xcd < r ? xcd * (q + 1) : r * (q + 1) + (xcd - r) * q) + off; }
        const int nig = WGM * nN, gid = wgid / nig, fm = gid * WGM, gsz = (nM - fm) < WGM ? (nM - fm) : WGM;
        u.pm = fm + ((wgid % nig) % gsz); u.pn = (wgid % nig) / gsz; u.e = 0; u.cnt = 0; return true;
    }
};
struct OneOrder { Unit u; __device__ __forceinline__ bool next(int i, Unit& o) const { if (i != 0) return false; o = u; return true; } };
struct MoeOrder {
    const LAS int* tab; int ntn, G, c;
    __device__ __forceinline__ bool next(int i, Unit& u) const {
        const int L = i * G + c; if (L >= tab[64] * ntn) return false;
        int e = 0;
#pragma unroll 1
        for (int q = 1; q < 32; ++q) if (L >= tab[32 + q] * ntn) e = q;
        const int cnt = tab[e], lu = L - tab[32 + e] * ntn;
        u.e = e; u.cnt = cnt; u.pn = lu % ntn; u.pm = lu / ntn; return true;
    }
};

template <class P, class Sched>
__device__ __forceinline__ void gemm_phase(LAS unsigned char* lds, const P& p, const Sched& S) {
    const int tid = threadIdx.x, wid = __builtin_amdgcn_readfirstlane(tid >> 6), lane = tid & 63, wr = wid >> 2, wc = wid & 3, fr = lane & 15, fq = lane >> 4;
    constexpr int K = P::K, PB = P::FP8 ? K : 2 * K  , nt = PB / 128;
    int RA[2]; unsigned CB[2], voffB[2];
#pragma unroll
    for (int i = 0; i < 2; ++i) { int R, C; stage_rc(tid * 16 + i * 8192, R, C); RA[i] = R; CB[i] = (unsigned)C * 2u; voffB[i] = (unsigned)(R * PB + C * 2); }
    constexpr size_t kstep = 128, hstep = (size_t)HALF * PB, tstep = 2 * hstep;
    const unsigned ldsw = (unsigned)wid * 1024u;
    const int aoff = lds_byte(wr * 64 + fr, fq * 8), boff = lds_byte(wc * 32 + fr, fq * 8);
    LAS float* rsl = (LAS float*)(lds + STAGE_BYTES);
    const char* abase = p.abase();
#define PG8_SA(b, h) (((b) * 2 + (h)) * HTB)
#define PG8_SB(b, h) ((4 + (b) * 2 + (h)) * HTB)
#define PG8_STAGE(bufoff, gbase, voff) do { _Pragma("unroll") for (int _i = 0; _i < 2; ++_i) \
        __builtin_amdgcn_global_load_lds((const unsigned*)((const char*)(gbase) + (voff)[_i]), (LAS unsigned*)(lds + (bufoff) + ldsw + _i * 8192), 16, 0, 0); } while (0)
#define PG8_LDA(dst, b, h) do { _Pragma("unroll") for (int m = 0; m < 4; ++m) { \
        if constexpr (P::FP8) { const i32x4 lo_ = *(const LAS i32x4*)(lds + PG8_SA(b, h) + aoff + m * 2048), hi_ = *(const LAS i32x4*)(lds + PG8_SA(b, h) + aoff + m * 2048 + 1024); dst##8[m] = __builtin_shufflevector(lo_, hi_, 0, 1, 2, 3, 4, 5, 6, 7); } \
        else { _Pragma("unroll") for (int k = 0; k < 2; ++k) dst[m][k] = *(const LAS h8*)(lds + PG8_SA(b, h) + aoff + m * 2048 + k * 1024); } } } while (0)
#define PG8_LDB(dst, b, h) do { _Pragma("unroll") for (int n = 0; n < 2; ++n) { \
        if constexpr (P::FP8) { const i32x4 lo_ = *(const LAS i32x4*)(lds + PG8_SB(b, h) + boff + n * 2048), hi_ = *(const LAS i32x4*)(lds + PG8_SB(b, h) + boff + n * 2048 + 1024); dst##8[n] = __builtin_shufflevector(lo_, hi_, 0, 1, 2, 3, 4, 5, 6, 7); } \
        else { _Pragma("unroll") for (int k = 0; k < 2; ++k) dst[n][k] = *(const LAS h8*)(lds + PG8_SB(b, h) + boff + n * 2048 + k * 1024); } } } while (0)
#define PG8_MMA(ai, bj, At, Bt) do { __builtin_amdgcn_s_setprio(1); _Pragma("unroll") for (int m = 0; m < 4; ++m) _Pragma("unroll") for (int n = 0; n < 2; ++n) { \
        if constexpr (P::FP8) asm volatile("v_mfma_scale_f32_16x16x128_f8f6f4 %0, %1, %2, %0, %3, %3 op_sel_hi:[0,0,0]" : "+v"(acc[ai][bj][m][n]) : "v"(Bt##8[n]), "v"(At##8[m]), "v"(one_scale)); \
        else { _Pragma("unroll") for (int k = 0; k < 2; ++k) acc[ai][bj][m][n] = __builtin_amdgcn_mfma_f32_16x16x32_f16(Bt[n][k], At[m][k], acc[ai][bj][m][n], 0, 0, 0); } } \
        __builtin_amdgcn_s_setprio(0); } while (0)
#define PG8_WAIT_V(n) asm volatile("s_waitcnt vmcnt(" #n ")" ::: "memory")
#define PG8_WAIT_L(n) asm volatile("s_waitcnt lgkmcnt(" #n ")" ::: "memory")
#define PG8_BAR __builtin_amdgcn_s_barrier()
#define PG8_SCHED __builtin_amdgcn_sched_barrier(0)
    Unit cur, nxt; int ui = 0;
    if (!S.next(0, cur)) return;
    f32x4 acc[2][2][4][2];
#pragma unroll
    for (int a = 0; a < 2; ++a)
#pragma unroll
        for (int b = 0; b < 2; ++b)
#pragma unroll
            for (int m = 0; m < 4; ++m)
#pragma unroll
                for (int n = 0; n < 2; ++n) acc[a][b][m][n] = (f32x4){0.f, 0.f, 0.f, 0.f};
    h8 At[4][2], B0[2][2], B1[2][2]; i32x8 At8[4], B08[2], B18[2];
    int one_scale = 0x7f7f7f7f; asm volatile("" : "+v"(one_scale));
    LAS int* ginfo = (LAS int*)(lds + STAGE_BYTES + 4096);
    unsigned voffA[2];
    const char* cA = abase; const char* nA = abase;
#pragma unroll
    for (int i = 0; i < 2; ++i) voffA[i] = P::GATHER ? CB[i] : (unsigned)(RA[i] * PB) + CB[i];
    if constexpr (P::GATHER) {
        if (tid < 256) p.fill_rows(cur, ginfo, tid);
        asm volatile("s_waitcnt lgkmcnt(0)" ::: "memory"); PG8_BAR; asm volatile("" ::: "memory");
    } else cA = abase + (size_t)cur.pm * tstep;
    constexpr size_t hA = P::GATHER ? 0 : hstep;
#define PG8_STAGE_A(bufoff, gbase, par, half) do { if constexpr (P::GATHER) { _Pragma("unroll") for (int _i = 0; _i < 2; ++_i) { \
            const unsigned ro_ = p.rowbytes(ginfo[(par) * 512 + (half) * 128 + RA[_i]] & 0x7fffffff) + voffA[_i]; \
            __builtin_amdgcn_global_load_lds((const unsigned*)((const char*)(gbase) + ro_), (LAS unsigned*)(lds + (bufoff) + ldsw + _i * 8192), 16, 0, 0); } } \
        else PG8_STAGE(bufoff, (const char*)(gbase) + (half) * hA, voffA); } while (0)
    const char* cB = p.bptr(cur);
    if constexpr (P::MID) p.mid_prepare(cur, rsl, tid);
    PG8_STAGE(PG8_SB(0, 0), cB, voffB); PG8_STAGE(PG8_SB(0, 1), cB + hstep, voffB); PG8_STAGE_A(PG8_SA(0, 0), cA, 0, 0); PG8_STAGE_A(PG8_SA(0, 1), cA, 0, 1);
    if (wr == 1) PG8_BAR;
    PG8_WAIT_V(2); PG8_BAR;
    PG8_STAGE(PG8_SB(1, 0), cB + kstep, voffB); PG8_STAGE_A(PG8_SA(1, 0), cA + kstep, 0, 0); PG8_STAGE(PG8_SB(1, 1), cB + hstep + kstep, voffB);
    PG8_WAIT_V(6); PG8_BAR;
    for (;;) {
        const bool has_next = S.next(ui + 1, nxt);
        const char* nB = cB; nA = cA;
        const int cpar = ui & 1; int npar = cpar;
        if (has_next) {
            nB = p.bptr(nxt); npar = cpar ^ 1;
            if constexpr (P::GATHER) { if (tid < 256) p.fill_rows(nxt, ginfo + npar * 512, tid); }
            else nA = abase + (size_t)nxt.pm * tstep;
            if constexpr (P::MID) p.mid_prepare(nxt, rsl + 256 * ((ui + 1) & 1), tid);
        }
#pragma unroll 1
        for (int t = 0; t < nt; t += 2) {
            const bool last = (t == nt - 2);
            if constexpr (P::MID) {
                if (t == nt / 2) {
                    const LAS float* rs = rsl + 256 * (ui & 1);
#pragma unroll
                    for (int a = 0; a < 2; ++a)
#pragma unroll
                        for (int m = 0; m < 4; ++m) { const float sc = rs[a * 128 + wr * 64 + m * 16 + fr];
#pragma unroll
                            for (int b = 0; b < 2; ++b)
#pragma unroll
                                for (int n = 0; n < 2; ++n) acc[a][b][m][n] *= sc; }
                }
            }
            const char* a1 = cA + (size_t)(t + 1) * kstep;
            const char* a2 = last ? nA : cA + (size_t)(t + 2) * kstep; const char* b2 = last ? nB : cB + (size_t)(t + 2) * kstep;
            const char* a3 = a2 + kstep; const char* b3 = b2 + kstep;
            const int par2 = last ? npar : cpar;
            PG8_LDB(B0, 0, 0); PG8_LDB(B1, 0, 1); PG8_SCHED; PG8_LDA(At, 0, 0); PG8_STAGE_A(PG8_SA(1, 1), a1, cpar, 1);
            PG8_WAIT_V(8); PG8_WAIT_L(0); PG8_BAR; PG8_MMA(0, 0, At, B0); PG8_MMA(0, 1, At, B1); PG8_BAR; PG8_SCHED;
            PG8_LDA(At, 0, 1); PG8_STAGE(PG8_SB(0, 0), b2, voffB); PG8_STAGE(PG8_SB(0, 1), b2 + hstep, voffB); PG8_STAGE_A(PG8_SA(0, 0), a2, par2, 0);
            PG8_WAIT_V(8); PG8_WAIT_L(0); PG8_BAR; PG8_MMA(1, 0, At, B0); PG8_MMA(1, 1, At, B1); PG8_BAR; PG8_SCHED;
            PG8_LDB(B0, 1, 0); PG8_LDB(B1, 1, 1); PG8_SCHED; PG8_LDA(At, 1, 0); PG8_STAGE_A(PG8_SA(0, 1), a2, par2, 1);
            PG8_WAIT_V(8); PG8_WAIT_L(0); PG8_BAR; PG8_MMA(0, 0, At, B0); PG8_MMA(0, 1, At, B1); PG8_BAR; PG8_SCHED;
            PG8_LDA(At, 1, 1); PG8_STAGE(PG8_SB(1, 0), b3, voffB); PG8_STAGE(PG8_SB(1, 1), b3 + hstep, voffB); PG8_STAGE_A(PG8_SA(1, 0), a3, par2, 0);
            PG8_WAIT_V(8); PG8_WAIT_L(0); PG8_BAR; PG8_MMA(1, 0, At, B0); PG8_MMA(1, 1, At, B1); PG8_BAR; PG8_SCHED;
        }
        if (wr == 0) PG8_BAR;
        if constexpr (P::FP8) asm volatile("s_nop 15\n\ts_nop 7" ::: "memory");
        {
            const int cb = wc * 32 + fq * 8;
#define PG8_EPI_LOOP(RI, CALL) do { const auto pre = p.pre(cur, cb); (void)pre; \
                _Pragma("unroll") for (int a = 0; a < 2; ++a) { \
                    int lrow = a * 128 + wr * 64 + fr; decltype(RI) ris[4]; \
                    _Pragma("unroll") for (int m = 0; m < 4; ++m) { lrow = a * 128 + wr * 64 + m * 16 + fr; ris[m] = RI; } \
                    _Pragma("unroll") for (int m = 0; m < 4; ++m) { lrow = a * 128 + wr * 64 + m * 16 + fr; const auto ri = ris[m]; CALL; } } } while (0)
            if constexpr (P::KINDS) {
                const int kd = __builtin_amdgcn_readfirstlane(p.kind(cur));
                if (kd == 1) p.knorm(cur, acc, wc, lane);
                if (kd == 0) PG8_EPI_LOOP(p.template rowpart<0>(cur, lrow), p.template epik<0>(cur, ri, cb, acc[a][0][m][0], acc[a][0][m][1], acc[a][1][m][0], acc[a][1][m][1]));
                else if (kd == 1) PG8_EPI_LOOP(p.template rowpart<1>(cur, lrow), p.template epik<1>(cur, ri, cb, acc[a][0][m][0], acc[a][0][m][1], acc[a][1][m][0], acc[a][1][m][1]));
                else if (kd == 2) PG8_EPI_LOOP(p.template rowpart<2>(cur, lrow), p.template epik<2>(cur, ri, cb, acc[a][0][m][0], acc[a][0][m][1], acc[a][1][m][0], acc[a][1][m][1]));
                else PG8_EPI_LOOP(p.template rowpart<3>(cur, lrow), p.template epik<3>(cur, ri, cb, acc[a][0][m][0], acc[a][0][m][1], acc[a][1][m][0], acc[a][1][m][1]));
            } else {
                if constexpr (P::GATHER) {
                    const LAS int* gi_ = ginfo + (ui & 1) * 512; const auto pre = p.pre(cur, cb); const bool odd = (fq & 1) != 0; const int cbs = cb - (odd ? 8 : 0);
                    decltype(p.rowinfo_lds(gi_, 0)) rA[2][2], rB[2][2]; int rS[2][2];
#pragma unroll
                    for (int a = 0; a < 2; ++a)
#pragma unroll
                        for (int mp = 0; mp < 2; ++mp) { const int lr0 = a * 128 + wr * 64 + mp * 32 + fr; rA[a][mp] = p.rowinfo_lds(gi_, lr0); rB[a][mp] = p.rowinfo_lds(gi_, lr0 + 16); rS[a][mp] = p.rowidx(p.rowinfo_lds(gi_, lr0 + (odd ? 16 : 0))); }
                    asm volatile("s_waitcnt lgkmcnt(0)" ::: "memory");
#pragma unroll
                    for (int a = 0; a < 2; ++a) {
#pragma unroll
                        for (int mp = 0; mp < 2; ++mp) {
                            const auto ri0 = rA[a][mp], ri1 = rB[a][mp];
                            const i32x4 x0 = p.val(cur, pre, ri0, acc[a][0][2 * mp][0], acc[a][0][2 * mp][1], acc[a][1][2 * mp][0], acc[a][1][2 * mp][1]);
                            const i32x4 x1 = p.val(cur, pre, ri1, acc[a][0][2 * mp + 1][0], acc[a][0][2 * mp + 1][1], acc[a][1][2 * mp + 1][0], acc[a][1][2 * mp + 1][1]);
                            const int asel = rS[a][mp];
#pragma unroll
                            for (int q = 0; q < P::NW; ++q) {
                                const auto lo = __builtin_amdgcn_permlane16_swap((unsigned)x0[2 * q], (unsigned)x1[2 * q], false, false), hi = __builtin_amdgcn_permlane16_swap((unsigned)x0[2 * q + 1], (unsigned)x1[2 * q + 1], false, false);
                                i32x4 w; w[0] = (int)lo[0]; w[1] = (int)hi[0]; w[2] = (int)lo[1]; w[3] = (int)hi[1];
                                p.store16(cur, asel, cbs, q, w);
                            }
                        }
                    }
                }
                else PG8_EPI_LOOP(p.rowinfo(cur, lrow), p.epi(cur, pre, ri, lrow, cb, acc[a][0][m][0], acc[a][0][m][1], acc[a][1][m][0], acc[a][1][m][1]));
            }
#undef PG8_EPI_LOOP
        }
        if (!has_next) break;
#pragma unroll
        for (int a = 0; a < 2; ++a)
#pragma unroll
            for (int b = 0; b < 2; ++b)
#pragma unroll
                for (int m = 0; m < 4; ++m)
#pragma unroll
                    for (int n = 0; n < 2; ++n) acc[a][b][m][n] = (f32x4){0.f, 0.f, 0.f, 0.f};
        cur = nxt; cB = nB; cA = nA; ++ui;
        if (wr == 1) PG8_BAR;
    }
    PG8_WAIT_V(0);
    PG8_BAR;
#undef PG8_SA
#undef PG8_SB
#undef PG8_STAGE
#undef PG8_STAGE_A
#undef PG8_LDA
#undef PG8_LDB
#undef PG8_MMA
#undef PG8_WAIT_V
#undef PG8_WAIT_L
#undef PG8_BAR
#undef PG8_SCHED
}
}

struct NoPre {};
__device__ __forceinline__ int pack_fp8x4(float a, float b, float c, float d) { int w = 0; w = __builtin_amdgcn_cvt_pk_fp8_f32(a, b, w, false); w = __builtin_amdgcn_cvt_pk_fp8_f32(c, d, w, true); return w; }
constexpr float WGU_SCALE = 32.0f, WDN_SCALE = 64.0f, ACT_SCALE = 4.0f, SLAB_SCALE = 16.0f, RQ_SCALE = 8.0f;
__device__ __forceinline__ h8 pack8(f32x4 lo, f32x4 hi) { h8 o; o[0] = (f16)lo[0]; o[1] = (f16)lo[1]; o[2] = (f16)lo[2]; o[3] = (f16)lo[3]; o[4] = (f16)hi[0]; o[5] = (f16)hi[1]; o[6] = (f16)hi[2]; o[7] = (f16)hi[3]; return o; }
struct ProbInproj {
    static constexpr int K = 1024; static constexpr bool KINDS = true; static constexpr bool GATHER = false; static constexpr bool FP8 = false; static constexpr bool MID = false;
    const char* xh; const char* win; f16 *qh, *kt, *vt, *ug; gu32* kmax;
    __device__ __forceinline__ const char* abase() const { return xh; }
    __device__ __forceinline__ unsigned rowoff(const pg8::Unit& u, int r) const { return (unsigned)(u.pm * 256 + r) * (unsigned)(K * 2); }
    __device__ __forceinline__ const char* bptr(const pg8::Unit& u) const { return win + (size_t)u.pn * 256 * K * 2; }
    __device__ __forceinline__ NoPre pre(const pg8::Unit&, int) const { return NoPre{}; }
    __device__ __forceinline__ int kind(const pg8::Unit& u) const { return u.pn >> 1; }
    __device__ __forceinline__ void knorm(const pg8::Unit& u, const f32x4 (&acc)[2][2][4][2], int wc, int lane) const {
#pragma unroll
        for (int b = 0; b < 2; ++b) {
            float mx = 0.f;
#pragma unroll
            for (int a = 0; a < 2; ++a)
#pragma unroll
                for (int m = 0; m < 4; ++m) { const f32x4 x = acc[a][b][m][0], y = acc[a][b][m][1];
                    float q = (x[0] * x[0] + x[1] * x[1]) + (x[2] * x[2] + x[3] * x[3]) + (y[0] * y[0] + y[1] * y[1]) + (y[2] * y[2] + y[3] * y[3]);
                    q += __shfl_xor(q, 16); q += __shfl_xor(q, 32); mx = fmaxf(mx, q); }
            mx = fmaxf(mx, __shfl_xor(mx, 1)); mx = fmaxf(mx, __shfl_xor(mx, 2)); mx = fmaxf(mx, __shfl_xor(mx, 4)); mx = fmaxf(mx, __shfl_xor(mx, 8));
            if (lane == 0) { const int bt = (u.pm * 256) >> 13, hd = (u.pn & 1) * 4 + 2 * b + (wc >> 1), mp = wc & 1;
                __hip_atomic_fetch_max(kmax + (bt * 8 + hd) * 2 + mp, __float_as_uint(sqrtf(mx)), RLX_AGENT); }
        }
    }
    template <int KIND> __device__ __forceinline__ unsigned rowpart(const pg8::Unit& u, int lr) const {
        const int row = u.pm * 256 + lr, b = row >> 13, tt = row & 8191, tile = tt >> 6, key = tt & 63;
        if (KIND == 0) return (unsigned)row * 512u;
        if (KIND == 1) return (unsigned)((b * 8 * 128 + tile) * 4096 + key * 8);
        if (KIND == 2) { const int sx = key >> 4, w = key & 15, hh = (w >> 2) & 1, j = (w & 3) + 4 * (w >> 3); return (unsigned)((b * 8 * 128 + tile) * 4096 + (2 * sx + hh) * 512 + j); }
        return (unsigned)((b * 32 * 8192 + tt) * 16);
    }
    template <int KIND> __device__ __forceinline__ void epik(const pg8::Unit& u, unsigned rp, int cb, f32x4 v00, f32x4 v01, f32x4 v10, f32x4 v11) const {
#pragma unroll
        for (int b = 0; b < 2; ++b) {
            const int col = (u.pn & 1) * 256 + b * 128 + cb; const f32x4 lo = b ? v10 : v00, hi = b ? v11 : v01;
            if (KIND == 0) { *(h8*)(qh + rp + col) = pack8(lo * QSCALE, hi * QSCALE); }
            else if (KIND == 1) { const int hd = col >> 6, d = col & 63; *(h8*)(kt + rp + (unsigned)(hd * 128 * 4096 + (d >> 3) * 512)) = pack8(lo, hi); }
            else if (KIND == 2) { const int hd = col >> 6, dv = col & 63; f16* q = vt + rp + (unsigned)(hd * 128 * 4096 + dv * 8);
                q[0] = (f16)lo[0]; q[8] = (f16)lo[1]; q[16] = (f16)lo[2]; q[24] = (f16)lo[3]; q[32] = (f16)hi[0]; q[40] = (f16)hi[1]; q[48] = (f16)hi[2]; q[56] = (f16)hi[3]; }
            else { const int g = col >> 4, c0 = col & 15; *(h8*)(ug + rp + (unsigned)(g * 8192 * 16 + c0)) = pack8(lo, hi); }
        }
    }
};
struct ProbPleProj {
    static constexpr int K = 256; static constexpr bool KINDS = false; static constexpr bool GATHER = false; static constexpr bool FP8 = false; static constexpr bool MID = false;
    const char* ph; const char* wpp; f16* pe;
    __device__ __forceinline__ const char* abase() const { return ph; }
    __device__ __forceinline__ unsigned rowoff(const pg8::Unit& u, int r) const { return (unsigned)(u.pm * 256 + r) * (unsigned)(K * 2); }
    __device__ __forceinline__ const char* bptr(const pg8::Unit& u) const { return wpp + (size_t)u.pn * 256 * K * 2; }
    __device__ __forceinline__ NoPre pre(const pg8::Unit&, int) const { return NoPre{}; }
    __device__ __forceinline__ int rowinfo(const pg8::Unit&, int) const { return 0; }
    __device__ __forceinline__ void epi(const pg8::Unit& u, NoPre, int, int lr, int cb, f32x4 v00, f32x4 v01, f32x4 v10, f32x4 v11) const {
        f16* o = pe + (size_t)(u.pm * 256 + lr) * 1024 + u.pn * 256 + cb; *(h8*)o = pack8(v00, v01); *(h8*)(o + 128) = pack8(v10, v11); }
};
struct ProbGlu {
    static constexpr int K = 512; static constexpr bool KINDS = false; static constexpr bool GATHER = false; static constexpr bool FP8 = false; static constexpr bool MID = false;
    const char* yh; const char* wg; f16* mix;
    __device__ __forceinline__ const char* abase() const { return yh; }
    __device__ __forceinline__ unsigned rowoff(const pg8::Unit& u, int r) const { return (unsigned)(u.pm * 256 + r) * (unsigned)(K * 2); }
    __device__ __forceinline__ const char* bptr(const pg8::Unit& u) const { return wg + (size_t)u.pn * 256 * K * 2; }
    __device__ __forceinline__ NoPre pre(const pg8::Unit&, int) const { return NoPre{}; }
    __device__ __forceinline__ int rowinfo(const pg8::Unit&, int) const { return 0; }
    __device__ __forceinline__ void epi(const pg8::Unit& u, NoPre, int, int lr, int cb, f32x4 v00, f32x4 v01, f32x4 v10, f32x4 v11) const {
        h8 o;
#pragma unroll
        for (int e = 0; e < 4; ++e) { o[e] = (f16)(v00[e] * sigmoidf_(v10[e])); o[4 + e] = (f16)(v01[e] * sigmoidf_(v11[e])); }
        *(h8*)(mix + (size_t)(u.pm * 256 + lr) * 1024 + u.pn * 128 + cb) = o; }
};
struct ProbOut {
    static constexpr int K = 1024; static constexpr bool KINDS = false; static constexpr bool GATHER = false; static constexpr bool FP8 = false; static constexpr bool MID = true;
    const char* mixb; const char* wo; f16* mixo;
    __device__ __forceinline__ const char* abase() const { return mixb; }
    __device__ __forceinline__ unsigned rowoff(const pg8::Unit& u, int r) const { return (unsigned)(u.pm * 256 + r) * (unsigned)(K * 2); }
    __device__ __forceinline__ const char* bptr(const pg8::Unit& u) const { return wo + (size_t)u.pn * 256 * K * 2; }
    __device__ __forceinline__ NoPre pre(const pg8::Unit&, int) const { return NoPre{}; }
    __device__ __forceinline__ int rowinfo(const pg8::Unit&, int) const { return 0; }
    __device__ __forceinline__ void mid_prepare(const pg8::Unit& u, LAS float* slot, int tid) const {
        const int row = tid >> 1; const h8* q = (const h8*)(mixb + (size_t)(u.pm * 256 + row) * 2048 + (tid & 1) * 512); float sacc = 0.f;
#pragma unroll 4
        for (int j = 0; j < 32; ++j) { const h8 v = q[j];
#pragma unroll
            for (int e = 0; e < 8; ++e) { const float f = (float)v[e]; sacc += f * f; } }
        sacc += __shfl_xor(sacc, 1);
        if (!(tid & 1)) slot[row] = rsqrtf(sacc * (1.0f / 512.0f) + RMS_EPS);
    }
    __device__ __forceinline__ void epi(const pg8::Unit& u, NoPre, int, int lr, int cb, f32x4 v00, f32x4 v01, f32x4 v10, f32x4 v11) const {
        f16* o = mixo + (size_t)(u.pm * 256 + lr) * 1024 + u.pn * 256 + cb; *(h8*)o = pack8(v00, v01); *(h8*)(o + 128) = pack8(v10, v11); }
};
struct Pre16 { f32x4 a, b, c, d; };
struct ProbMoeUp {
    static constexpr int K = 1024; static constexpr bool KINDS = false; static constexpr bool GATHER = true; static constexpr bool FP8 = true; static constexpr bool MID = false;
    const char* x1q; const char* wgu; const int* list; const float* bias; unsigned char* act;
    __device__ __forceinline__ const char* abase() const { return x1q; }
    __device__ __forceinline__ unsigned rowoff(const pg8::Unit&, int) const { return 0u; }
    __device__ __forceinline__ void fill_rows(const pg8::Unit& u, LAS int* tabp, int r) const { const int i = u.pm * 256 + r; const bool ok = i < u.cnt; const int a = list[(size_t)u.e * ECAP + (ok ? i : 0)]; tabp[r] = ok ? a : (a | (int)0x80000000); }
    __device__ __forceinline__ unsigned rowbytes(int a) const { return (unsigned)(a >> 2) * (unsigned)K; }
    __device__ __forceinline__ int rowinfo_lds(const LAS int* tabp, int lr) const { return tabp[lr]; }
    __device__ __forceinline__ const char* bptr(const pg8::Unit& u) const { return wgu + ((size_t)u.e * 2048 + (size_t)u.pn * 256) * K; }
    __device__ __forceinline__ Pre16 pre(const pg8::Unit& u, int cb) const {
        const float* bp = bias + u.e * 2048 + 2 * (u.pn * 128 + cb); Pre16 r; r.a = *(const f32x4*)bp; r.b = *(const f32x4*)(bp + 4); r.c = *(const f32x4*)(bp + 8); r.d = *(const f32x4*)(bp + 12); return r; }
    __device__ __forceinline__ int rowinfo(const pg8::Unit& u, int lr) const { const int i = u.pm * 256 + lr; return i < u.cnt ? list[(size_t)u.e * ECAP + i] : -1; }
    static constexpr int NW = 1;
    __device__ __forceinline__ int rowidx(int a) const { return a; }
    __device__ __forceinline__ i32x4 val(const pg8::Unit&, const Pre16& pb, int, f32x4 v00, f32x4 v01, f32x4 v10, f32x4 v11) const {
        const float bg[8] = {pb.a[0], pb.a[2], pb.b[0], pb.b[2], pb.c[0], pb.c[2], pb.d[0], pb.d[2]}, bl[8] = {pb.a[1], pb.a[3], pb.b[1], pb.b[3], pb.c[1], pb.c[3], pb.d[1], pb.d[3]};
        float o[8];
#pragma unroll
        for (int e = 0; e < 8; ++e) { const float g = fminf((e < 4 ? v00[e] : v01[e - 4]) * (1.0f / WGU_SCALE) + bg[e], 7.0f), l = fminf(fmaxf((e < 4 ? v10[e] : v11[e - 4]) * (1.0f / WGU_SCALE) + bl[e], -7.0f), 7.0f);
            o[e] = g * sigmoidf_(1.702f * g) * (l + 1.0f) * ACT_SCALE; }
        i32x4 w; w[0] = pack_fp8x4(o[0], o[1], o[2], o[3]); w[1] = pack_fp8x4(o[4], o[5], o[6], o[7]); w[2] = 0; w[3] = 0; return w; }
    __device__ __forceinline__ void store16(const pg8::Unit& u, int a, int cbs, int, i32x4 w) const { if (a < 0) return; *(i32x4*)(act + (size_t)a * 1024 + u.pn * 128 + cbs) = w; }
};
struct RowAG { int a; float g; };
struct ProbMoeDn {
    static constexpr int K = 1024; static constexpr bool KINDS = false; static constexpr bool GATHER = true; static constexpr bool FP8 = true; static constexpr bool MID = false;
    const char* actb; const char* wdn; const int* list; const float* bias; const float* gates; unsigned char* slab;
    __device__ __forceinline__ const char* abase() const { return actb; }
    __device__ __forceinline__ unsigned rowoff(const pg8::Unit&, int) const { return 0u; }
    __device__ __forceinline__ void fill_rows(const pg8::Unit& u, LAS int* tabp, int r) const { const int i = u.pm * 256 + r; const bool ok = i < u.cnt; const int a = list[(size_t)u.e * ECAP + (ok ? i : 0)];
        tabp[r] = ok ? a : (a | (int)0x80000000); tabp[256 + r] = __float_as_int(ok ? gates[a] : 0.f); }
    __device__ __forceinline__ unsigned rowbytes(int a) const { return (unsigned)a * (unsigned)K; }
    __device__ __forceinline__ RowAG rowinfo_lds(const LAS int* tabp, int lr) const { RowAG r; r.a = tabp[lr]; r.g = __int_as_float(tabp[256 + lr]); return r; }
    __device__ __forceinline__ const char* bptr(const pg8::Unit& u) const { return wdn + ((size_t)u.e * 1024 + (size_t)u.pn * 256) * K; }
    __device__ __forceinline__ Pre16 pre(const pg8::Unit& u, int cb) const {
        const float* bp = bias + u.e * 1024 + u.pn * 256 + cb; Pre16 r; r.a = *(const f32x4*)bp; r.b = *(const f32x4*)(bp + 4); r.c = *(const f32x4*)(bp + 128); r.d = *(const f32x4*)(bp + 132); return r; }
    __device__ __forceinline__ RowAG rowinfo(const pg8::Unit& u, int lr) const { const int i = u.pm * 256 + lr; RowAG r; r.a = i < u.cnt ? list[(size_t)u.e * ECAP + i] : -1; r.g = r.a >= 0 ? gates[r.a] : 0.f; return r; }
    static constexpr int NW = 2;
    __device__ __forceinline__ int rowidx(const RowAG& r) const { return r.a; }
    __device__ __forceinline__ i32x4 val(const pg8::Unit&, const Pre16& pb, const RowAG& ri, f32x4 v00, f32x4 v01, f32x4 v10, f32x4 v11) const {
        constexpr float S = 1.0f / (WDN_SCALE * ACT_SCALE);
        const float g = ri.g * SLAB_SCALE;
        f32x4 a = (v00 * S + pb.a) * g, b = (v01 * S + pb.b) * g, c = (v10 * S + pb.c) * g, d = (v11 * S + pb.d) * g;
#pragma unroll
        for (int e = 0; e < 4; ++e) { a[e] = fminf(fmaxf(a[e], -448.f), 448.f); b[e] = fminf(fmaxf(b[e], -448.f), 448.f); c[e] = fminf(fmaxf(c[e], -448.f), 448.f); d[e] = fminf(fmaxf(d[e], -448.f), 448.f); }
        i32x4 w; w[0] = pack_fp8x4(a[0], a[1], a[2], a[3]); w[1] = pack_fp8x4(b[0], b[1], b[2], b[3]); w[2] = pack_fp8x4(c[0], c[1], c[2], c[3]); w[3] = pack_fp8x4(d[0], d[1], d[2], d[3]); return w; }
    __device__ __forceinline__ void store16(const pg8::Unit& u, int a_, int cbs, int q, i32x4 w) const { if (a_ < 0) return; *(i32x4*)(slab + (size_t)a_ * 1024 + u.pn * 256 + q * 128 + cbs) = w; }
};
struct ProbPleGate {
    static constexpr int K = 1024; static constexpr bool KINDS = false; static constexpr bool GATHER = false; static constexpr bool FP8 = true; static constexpr bool MID = false;
    const char* rq; const char* wpg; f16* gateh;
    __device__ __forceinline__ const char* abase() const { return rq; }
    __device__ __forceinline__ unsigned rowoff(const pg8::Unit& u, int r) const { return (unsigned)(u.pm * 256 + r) * (unsigned)K; }
    __device__ __forceinline__ const char* bptr(const pg8::Unit& u) const { return wpg + (size_t)u.pn * 256 * K; }
    __device__ __forceinline__ NoPre pre(const pg8::Unit&, int) const { return NoPre{}; }
    __device__ __forceinline__ int rowinfo(const pg8::Unit&, int) const { return 0; }
    __device__ __forceinline__ void epi(const pg8::Unit& u, NoPre, int, int lr, int cb, f32x4 v00, f32x4 v01, f32x4 v10, f32x4 v11) const {
        f16* o = gateh + (size_t)(u.pm * 256 + lr) * 1024 + u.pn * 256 + cb;
        constexpr float S = 1.0f / (WDN_SCALE * RQ_SCALE);
        f32x4 a, b, c, d;
#pragma unroll
        for (int e = 0; e < 4; ++e) { a[e] = sigmoidf_(v00[e] * S); b[e] = sigmoidf_(v01[e] * S); c[e] = sigmoidf_(v10[e] * S); d[e] = sigmoidf_(v11[e] * S); }
        *(h8*)o = pack8(a, b); *(h8*)(o + 128) = pack8(c, d); }
};

__device__ __forceinline__ int invperm32(int c) { return 16 * ((c >> 2) & 1) + 4 * (c >> 3) + (c & 3); }
__device__ __forceinline__ void tr_item(const float* W, int K, int N, f16* WT, int item, int mode, const float* gsc, LAS float* scr, int lane) {
    const int nblk = N / 32, kb = item / nblk, nb = item % nblk, k0 = 64 * kb, n0 = 32 * nb;
#pragma unroll 8
    for (int i = 0; i < 32; ++i) {
        const int kk = 2 * i + (lane >> 5);
        float v = W[(size_t)(k0 + kk) * N + n0 + (lane & 31)];
        if (mode == 2 && k0 + kk >= 512) v *= gsc[k0 + kk - 512];
        scr[kk * 33 + (lane & 31)] = v;
    }
    asm volatile("s_waitcnt lgkmcnt(0)" ::: "memory");
    const int c = lane & 7;
#pragma unroll
    for (int j = 0; j < 4; ++j) {
        const int n = (lane >> 3) + 8 * j; const LAS float* s = scr + (8 * c) * 33 + n;
        const int ns = n0 + n; int nd;
        if (mode == 1 || mode == 3) { const int ja = mode == 1 ? (ns & 511) : (ns >> 1), bj = mode == 1 ? (ns >> 9) : (ns & 1), jl = ja & 127;
            nd = 256 * (ja >> 7) + 128 * bj + (jl & ~31) + invperm32(jl & 31); }
        else nd = (ns & ~31) + invperm32(ns & 31);
        int kd = k0 + 8 * c; if (mode == 2) kd = (kd + 512) & 1023;
        if (mode >= 3) {
            const float sc = mode == 3 ? WGU_SCALE : WDN_SCALE;
            typedef int i32x2 __attribute__((ext_vector_type(2)));
            i32x2 o; o[0] = pack_fp8x4(s[0] * sc, s[33] * sc, s[66] * sc, s[99] * sc); o[1] = pack_fp8x4(s[132] * sc, s[165] * sc, s[198] * sc, s[231] * sc);
            *(i32x2*)((unsigned char*)WT + (size_t)nd * K + kd) = o;
        } else {
            h8 o; o[0] = (f16)s[0]; o[1] = (f16)s[33]; o[2] = (f16)s[66]; o[3] = (f16)s[99]; o[4] = (f16)s[132]; o[5] = (f16)s[165]; o[6] = (f16)s[198]; o[7] = (f16)s[231];
            *(h8*)(WT + (size_t)nd * K + kd) = o;
        }
    }
    asm volatile("s_waitcnt lgkmcnt(0)" ::: "memory");
}

__device__ __forceinline__ void ssm_precompute(Frame& F, int g) {
    const Args& A = *F.a; const int tid = F.tid;
    LAS float* pwr = (LAS float*)F.lds;
    LAS float* pwi = pwr + 17 * 64;
    LAS float* Bbr = pwi + 17 * 64;
    LAS float* Bbi = Bbr + 1024;
    LAS float* Cr = Bbi + 1024;
    LAS float* Ci = Cr + 1024;
    LAS float* Kd = Ci + 1024;
    if (tid < 64) {
        const int p = tid;
        const float are = A.in[I_ARE][g * 64 + p], aim = A.in[I_AIM][g * 64 + p], dt = __expf(A.in[I_LOGDT][g]);
        for (int d = 0; d <= 16; ++d) { const float mag = __expf(are * dt * (float)d); float sn, cs; sincosf(aim * dt * (float)d, &sn, &cs); pwr[d * 64 + p] = mag * cs; pwi[d * 64 + p] = mag * sn; }
        const float abr = pwr[64 + p], abi = pwi[64 + p];
        const float nr = abr - 1.0f, ni = abi, den = 1.0f / (are * are + aim * aim);
        const float fr_ = (nr * are + ni * aim) * den, fi_ = (ni * are - nr * aim) * den;
        for (int c = 0; c < 16; ++c) { const float br = A.in[I_BRE][(g * 64 + p) * 16 + c], bi = A.in[I_BIM][(g * 64 + p) * 16 + c]; Bbr[p * 16 + c] = fr_ * br - fi_ * bi; Bbi[p * 16 + c] = fr_ * bi + fi_ * br; }
        float* a16 = (float*)(F.ws + WS_A16) + (g * 64 + p) * 2; a16[0] = pwr[16 * 64 + p]; a16[1] = pwi[16 * 64 + p];
    }
    for (int i = tid; i < 1024; i += NTHREADS) { Cr[i] = A.in[I_CRE][g * 1024 + i]; Ci[i] = A.in[I_CIM][g * 1024 + i]; }
    __syncthreads();
    for (int q = 0; q < 8; ++q) {
        const int idx = tid * 8 + q, d = idx >> 8, cp = (idx >> 4) & 15, c = idx & 15; float acc = 0.f;
        for (int p = 0; p < 64; ++p) { const float cr = Cr[cp * 64 + p], ci = Ci[cp * 64 + p], pr = pwr[d * 64 + p], pi = pwi[d * 64 + p];
            const float zr = cr * pr - ci * pi, zi = cr * pi + ci * pr; acc += zr * Bbr[p * 16 + c] - zi * Bbi[p * 16 + c]; }
        Kd[idx] = acc;
    }
    __syncthreads();
    f16* ops = (f16*)(F.ws + WS_SSMOP) + (size_t)g * 131072;
    f16* Top = ops; f16* We = ops + 65536; f16* Wc = ops + 65536 + 32768;
    for (int v = tid; v < 8192; v += NTHREADS) {
        const int row = v >> 5, kv = v & 31, j = kv >> 1, half = kv & 1, i = row >> 4, cp = row & 15; h8 o;
#pragma unroll
        for (int e = 0; e < 8; ++e) o[e] = (j <= i) ? (f16)Kd[((i - j) * 16 + cp) * 16 + 8 * half + e] : (f16)0.f;
        *(h8*)(Top + row * 256 + kv * 8) = o;
    }
    for (int v = tid; v < 4096; v += NTHREADS) {
        const int sx = v >> 5, kv = v & 31, j = kv >> 1, half = kv & 1, p = sx & 63; const float pr = pwr[(15 - j) * 64 + p], pi = pwi[(15 - j) * 64 + p]; h8 o;
#pragma unroll
        for (int e = 0; e < 8; ++e) { const float br = Bbr[p * 16 + 8 * half + e], bi = Bbi[p * 16 + 8 * half + e]; o[e] = (f16)(sx < 64 ? pr * br - pi * bi : pr * bi + pi * br); }
        *(h8*)(We + sx * 256 + kv * 8) = o;
    }
    for (int v = tid; v < 4096; v += NTHREADS) {
        const int row = v >> 4, kv = v & 15, i = row >> 4, cp = row & 15; h8 o;
#pragma unroll
        for (int e = 0; e < 8; ++e) { const int sx = 8 * kv + e, p = sx & 63; const float cr = Cr[cp * 64 + p], ci = Ci[cp * 64 + p], pr = pwr[(i + 1) * 64 + p], pi = pwi[(i + 1) * 64 + p];
            o[e] = (f16)(sx < 64 ? cr * pr - ci * pi : -(cr * pi + ci * pr)); }
        *(h8*)(Wc + row * 128 + kv * 8) = o;
    }
    __syncthreads();
}

__device__ __forceinline__ void p0_prologue(Frame& F) {
    const Args& A = *F.a;
    if (blockIdx.x < NG) ssm_precompute(F, (int)blockIdx.x);
    LAS float* scr = (LAS float*)(F.lds + F.wave * 16384);
    constexpr int I0 = 16 * 64, I1 = 8 * 32, I2 = 16 * 32, I3 = 16 * 32, I4 = 4 * 32, I5 = NE * 16 * 64, I6 = NE * 16 * 32;
    constexpr int NIT = I0 + I1 + I2 + I3 + I4 + I5;
    for (int it = F.gw; it < NIT; it += F.NGW) {
        int r = it;
        if (r < I0) { tr_item(A.in[I_WIN], 1024, 2048, (f16*)(F.ws + WS_WIN), r, 0, nullptr, scr, F.lane); continue; } r -= I0;
        if (r < I1) { tr_item(A.in[I_WGLU], 512, 1024, (f16*)(F.ws + WS_WGLU), r, 1, nullptr, scr, F.lane); continue; } r -= I1;
        if (r < I2) { tr_item(A.in[I_WOUT], 1024, 1024, (f16*)(F.ws + WS_WOUT), r, 2, A.in[I_SSMG], scr, F.lane); continue; } r -= I2;
        if (r < I3) { tr_item(A.in[I_WPG], 1024, 1024, (f16*)(F.ws + WS_WPG), r, 4, nullptr, scr, F.lane); continue; } r -= I3;
        if (r < I4) { tr_item(A.in[I_WPP], 256, 1024, (f16*)(F.ws + WS_WPP), r, 0, nullptr, scr, F.lane); continue; } r -= I4;
        if (r < I5) { const int e = r / (16 * 64), ii = r % (16 * 64);
            tr_item(A.in[I_WGU] + (size_t)e * 1024 * 2048, 1024, 2048, (f16*)(F.ws + WS_WGU + (size_t)e * 2048 * 1024), ii, 3, nullptr, scr, F.lane); continue; }
    }
    const size_t gt = (size_t)blockIdx.x * NTHREADS + F.tid, NT = (size_t)F.G * NTHREADS;
    { const f32x4* s = (const f32x4*)A.in[I_X]; h8* d = (h8*)(F.ws + WS_XH);
      for (size_t i = gt; i < (size_t)T * DM / 8; i += NT) { const f32x4 a = s[2 * i], b = s[2 * i + 1]; h8 o; o[0] = (f16)a[0]; o[1] = (f16)a[1]; o[2] = (f16)a[2]; o[3] = (f16)a[3]; o[4] = (f16)b[0]; o[5] = (f16)b[1]; o[6] = (f16)b[2]; o[7] = (f16)b[3]; d[i] = o; } }
    { const f32x4* s = (const f32x4*)A.in[I_P]; h8* d = (h8*)(F.ws + WS_PH);
      for (size_t i = gt; i < (size_t)T * PLE / 8; i += NT) { const f32x4 a = s[2 * i], b = s[2 * i + 1]; h8 o; o[0] = (f16)a[0]; o[1] = (f16)a[1]; o[2] = (f16)a[2]; o[3] = (f16)a[3]; o[4] = (f16)b[0]; o[5] = (f16)b[1]; o[6] = (f16)b[2]; o[7] = (f16)b[3]; d[i] = o; } }
}

__device__ __forceinline__ void p1_inproj(Frame& F) {
    { ProbInproj P{(const char*)(F.ws + WS_XH), (const char*)(F.ws + WS_WIN), (f16*)(F.ws + WS_QH), (f16*)(F.ws + WS_KT), (f16*)(F.ws + WS_VT), (f16*)(F.ws + WS_UG), F.ctl + CW_KMAX};
      pg8::DenseOrder S; S.init(T, DIN, F.G, (int)blockIdx.x); pg8::gemm_phase(F.lds, P, S); }
}

constexpr int ATT_SLOT = 32768, ATT_FLAGS = 3 * ATT_SLOT;
constexpr float ATT_SKIP = -40.0f;
constexpr int ATT_SG = 143360;
__device__ __forceinline__ int attn_unit(Frame& F, int b, int hd, int qb, float lam, gu32* qc, volatile LAS int* slot) {
    const int lane = F.lane, wave = F.wave, r32 = lane & 31, hi = lane >> 5;
    LAS unsigned char* lds = F.lds;
    const f16* qh = (const f16*)(F.ws + WS_QH);
    const f16* ktb = (const f16*)(F.ws + WS_KT) + (size_t)((b * 8 + hd) * 128) * 4096;
    const f16* vtb = (const f16*)(F.ws + WS_VT) + (size_t)((b * 8 + hd) * 128) * 4096;
    f16* mix = (f16*)(F.ws + WS_MIX);
    const int q0 = qb * 256, q0w = q0 + 32 * wave, NT = 4 * (qb + 1), NI = NT / 2; const size_t rowbase = (size_t)b * SEQ;
    volatile LAS int* flags = (volatile LAS int*)(lds + ATT_FLAGS);
#define ATT_ISSUE(ii) do { const int t0_ = NT - 1 - 2 * (ii); const unsigned so_ = (unsigned)(((ii) % 3) * ATT_SLOT + wave * 1024); \
        __builtin_amdgcn_global_load_lds((const unsigned*)(ktb + (size_t)t0_ * 4096 + wave * 512 + lane * 8), (LAS unsigned*)(lds + so_), 16, 0, 0); \
        __builtin_amdgcn_global_load_lds((const unsigned*)(vtb + (size_t)t0_ * 4096 + wave * 512 + lane * 8), (LAS unsigned*)(lds + so_ + 8192), 16, 0, 0); \
        __builtin_amdgcn_global_load_lds((const unsigned*)(ktb + (size_t)(t0_ - 1) * 4096 + wave * 512 + lane * 8), (LAS unsigned*)(lds + so_ + 16384), 16, 0, 0); \
        __builtin_amdgcn_global_load_lds((const unsigned*)(vtb + (size_t)(t0_ - 1) * 4096 + wave * 512 + lane * 8), (LAS unsigned*)(lds + so_ + 24576), 16, 0, 0); } while (0)
    ATT_ISSUE(0); ATT_ISSUE(1);
    if (lane == 0) { flags[wave] = 1; flags[8 + wave] = 1; }
    h8 qf[2][2];
#pragma unroll
    for (int mp = 0; mp < 2; ++mp)
#pragma unroll
        for (int kk = 0; kk < 2; ++kk) qf[mp][kk] = *(const h8*)(qh + (rowbase + q0w + r32) * 512 + hd * 64 + mp * 32 + kk * 16 + hi * 8);
    float sb1, sb2;
    { float n1 = 0.f, n2 = 0.f;
#pragma unroll
      for (int kk = 0; kk < 2; ++kk)
#pragma unroll
          for (int e = 0; e < 8; ++e) { const float a = (float)qf[0][kk][e], c = (float)qf[1][kk][e]; n1 += a * a; n2 += c * c; }
      n1 = swap_add(n1); n2 = swap_add(n2);
      const float k1 = __uint_as_float(__hip_atomic_load(F.ctl + CW_KMAX + (b * 8 + hd) * 2, RLX_AGENT)), k2 = __uint_as_float(__hip_atomic_load(F.ctl + CW_KMAX + (b * 8 + hd) * 2 + 1, RLX_AGENT));
      sb1 = sqrtf(n1) * k1 * 1.01f; sb2 = sqrtf(n2) * k2 * 1.01f; }
    const float slope2 = exp2f(-(float)(hd + 1)) * LOG2E;
    const int td = q0w >> 6, wo = q0w & 63;
    const f16 s_hi = (f16)slope2, s_lo = (f16)(slope2 - (float)s_hi);
    float mr1 = 0.f, mr2 = 0.f, l1 = 0.f, l2 = 0.f;
    h8 qx1, qx2;
    { h8 z; z[0] = (f16)(64.0f * (float)s_hi); z[1] = s_hi; z[2] = (f16)(64.0f * (float)s_lo); z[3] = s_lo; z[4] = (f16)0.f; z[5] = (f16)0.f; z[6] = (f16)0.f; z[7] = (f16)0.f;
      if (hi) { z[0] = (f16)0.f; z[1] = (f16)0.f; z[2] = (f16)0.f; z[3] = (f16)0.f; }
      qx1 = z; qx2 = z; }
    f32x16 o1[2], o2[2];
#pragma unroll
    for (int i = 0; i < 2; ++i) { o1[i] = (f32x16){}; o2[i] = (f32x16){}; }
    bool wdone = false, started = false;
    h2 ones; ones[0] = (f16)1.f; ones[1] = (f16)1.f;
#pragma unroll 1
    for (int ii = 0; ii < NI; ++ii) {
        if (ii + 1 < NI) asm volatile("s_waitcnt vmcnt(4) lgkmcnt(0)" ::: "memory"); else asm volatile("s_waitcnt vmcnt(0) lgkmcnt(0)" ::: "memory");
        __builtin_amdgcn_s_barrier();
        asm volatile("" ::: "memory");
        { const volatile LAS int* fl = flags + 8 * (ii & 1); const int any = fl[0] | fl[1] | fl[2] | fl[3] | fl[4] | fl[5] | fl[6] | fl[7];
          if (__builtin_amdgcn_readfirstlane(any) == 0) break; }
        if (ii + 2 < NI) ATT_ISSUE(ii + 2);
        bool need = !wdone;
        const int T0 = NT - 1 - 2 * ii, T1 = T0 - 1;
        if (T1 <= td && !wdone) {
            const bool first = !started; started = true;
            const LAS unsigned char* kp = lds + (ii % 3) * ATT_SLOT;
            const LAS unsigned char* kbase = kp + (hi * 512 + r32 * 8) * 2;
            const LAS unsigned char* vbase = kp + 8192 + (hi * 512 + r32 * 8) * 2;
            const float bmax = slope2 * (float)(64 * (T0 - td) + 63 - wo);
            const bool gen = first || T0 >= td || (__any(fmaxf(sb1 - mr1, sb2 - mr2) + bmax > 12.0f) != 0);
            const bool tlo = T0 > td;
            f32x16 s0[2], s1[2]; h8 kfr[4], vfr[6], pf[4], kxa, kxb; float ls;
#define ATT_SB __builtin_amdgcn_sched_barrier(0)
#define ATT_KX(tl) do { const f16 tr_ = (f16)(float)(T0 - (tl) - td); const f16 wa_ = (f16)(float)(r32 - wo), wb_ = (f16)(float)(32 + r32 - wo); h8 za, zb; \
                za[0] = tr_; za[1] = wa_; za[2] = tr_; za[3] = wa_; za[4] = (f16)1.f; za[5] = (f16)0.f; za[6] = (f16)0.f; za[7] = (f16)0.f; \
                zb[0] = tr_; zb[1] = wb_; zb[2] = tr_; zb[3] = wb_; zb[4] = (f16)1.f; zb[5] = (f16)0.f; zb[6] = (f16)0.f; zb[7] = (f16)0.f; \
                if (hi) { za[0] = (f16)0.f; za[1] = (f16)0.f; za[2] = (f16)0.f; za[3] = (f16)0.f; za[4] = (f16)0.f; zb[0] = (f16)0.f; zb[1] = (f16)0.f; zb[2] = (f16)0.f; zb[3] = (f16)0.f; zb[4] = (f16)0.f; } \
                kxa = za; kxb = zb; } while (0)
#define ATT_KLD(mp, tl) do { _Pragma("unroll") for (int kb = 0; kb < 2; ++kb) _Pragma("unroll") for (int j = 0; j < 2; ++j) \
                kfr[kb * 2 + j] = *(const LAS h8*)(kbase + (tl) * 16384 + ((mp) * 4 + j * 2) * 1024 + kb * 512); } while (0)
#define ATT_VLD(d, tl, sx, dh) vfr[d] = *(const LAS h8*)(vbase + (tl) * 16384 + (sx) * 2048 + (dh) * 512)
#define ATT_QKM(sn, mpn, qxn, j) do { if ((j) == 0) sn[0] = __builtin_amdgcn_mfma_f32_32x32x16_f16(kxa, qxn, (f32x16){}, 0, 0, 0); \
                else if ((j) == 1) sn[1] = __builtin_amdgcn_mfma_f32_32x32x16_f16(kxb, qxn, (f32x16){}, 0, 0, 0); \
                else if ((j) == 2) sn[0] = __builtin_amdgcn_mfma_f32_32x32x16_f16(kfr[0], qf[mpn][0], sn[0], 0, 0, 0); \
                else if ((j) == 3) sn[1] = __builtin_amdgcn_mfma_f32_32x32x16_f16(kfr[2], qf[mpn][0], sn[1], 0, 0, 0); \
                else if ((j) == 4) sn[0] = __builtin_amdgcn_mfma_f32_32x32x16_f16(kfr[1], qf[mpn][1], sn[0], 0, 0, 0); \
                else sn[1] = __builtin_amdgcn_mfma_f32_32x32x16_f16(kfr[3], qf[mpn][1], sn[1], 0, 0, 0); } while (0)
#define ATT_EXPH(sc, h) do { const float a0_ = __builtin_amdgcn_exp2f(sc[(h) >> 3][2 * ((h) & 7)]), a1_ = __builtin_amdgcn_exp2f(sc[(h) >> 3][2 * ((h) & 7) + 1]); \
                h2 p_; p_[0] = (f16)a0_; p_[1] = (f16)a1_; pf[(h) >> 2][2 * ((h) & 3)] = p_[0]; pf[(h) >> 2][2 * ((h) & 3) + 1] = p_[1]; \
                if (((h) & 1) == 0) hacc = p_; else { hacc = hacc + p_; asm volatile("v_dot2c_f32_f16 %0, %1, %2" : "+v"(ls) : "v"(hacc), "v"(ones)); } } while (0)
#define ATT_PLAINQK(sn, mpn, qxn) do { ATT_QKM(sn, mpn, qxn, 0); ATT_QKM(sn, mpn, qxn, 1); ATT_QKM(sn, mpn, qxn, 2); ATT_QKM(sn, mpn, qxn, 3); ATT_QKM(sn, mpn, qxn, 4); ATT_QKM(sn, mpn, qxn, 5); } while (0)
#define ATT_GENI(sc, mr, l, o, qx, tile, FIRST) do { \
                if ((tile) >= td) { _Pragma("unroll") for (int kb = 0; kb < 2; ++kb) _Pragma("unroll") for (int r = 0; r < 16; ++r) { const int kpos = 64 * (tile) + 32 * kb + crow(r, hi); if (kpos > q0w + r32) sc[kb][r] = -1e30f; } } \
                float rm = sc[0][0]; \
                _Pragma("unroll") for (int kb = 0; kb < 2; ++kb) _Pragma("unroll") for (int r = 0; r < 16; ++r) rm = fmaxf(rm, sc[kb][r]); \
                rm = swap_max(rm); \
                if ((FIRST) || __any(rm > 4.0f) != 0) { const float d = (FIRST) ? rm : fmaxf(rm, 0.f); const float f = __builtin_amdgcn_exp2f(-d); \
                    _Pragma("unroll") for (int kb = 0; kb < 2; ++kb) _Pragma("unroll") for (int r = 0; r < 16; ++r) sc[kb][r] -= d; \
                    mr += d; l *= f; o[0] *= f; o[1] *= f; if (!hi) qx[4] = (f16)(-mr); } } while (0)
#define ATT_BLOCK(sc, l, o, tlc, HASN, sn, mpn, qxn, NKLD) do { ls = 0.f; h2 hacc; \
                if (HASN) ATT_QKM(sn, mpn, qxn, 0); ATT_EXPH(sc, 0); ATT_SB; \
                if (HASN) ATT_QKM(sn, mpn, qxn, 1); ATT_EXPH(sc, 1); ATT_SB; \
                if (HASN) ATT_QKM(sn, mpn, qxn, 2); ATT_EXPH(sc, 2); ATT_VLD(0, tlc, 0, 0); ATT_VLD(1, tlc, 0, 1); ATT_SB; \
                if (HASN) ATT_QKM(sn, mpn, qxn, 3); ATT_EXPH(sc, 3); ATT_VLD(2, tlc, 1, 0); ATT_VLD(3, tlc, 1, 1); ATT_SB; \
                if (HASN) ATT_QKM(sn, mpn, qxn, 4); ATT_EXPH(sc, 4); ATT_VLD(4, tlc, 2, 0); ATT_VLD(5, tlc, 2, 1); ATT_SB; \
                if (HASN) ATT_QKM(sn, mpn, qxn, 5); ATT_EXPH(sc, 5); ATT_SB; \
                o[0] = __builtin_amdgcn_mfma_f32_32x32x16_f16(vfr[0], pf[0], o[0], 0, 0, 0); ATT_EXPH(sc, 6); ATT_EXPH(sc, 7); ATT_SB; \
                o[1] = __builtin_amdgcn_mfma_f32_32x32x16_f16(vfr[1], pf[0], o[1], 0, 0, 0); ATT_EXPH(sc, 8); NKLD; ATT_SB; \
                o[0] = __builtin_amdgcn_mfma_f32_32x32x16_f16(vfr[2], pf[1], o[0], 0, 0, 0); ATT_EXPH(sc, 9); ATT_EXPH(sc, 10); ATT_VLD(0, tlc, 3, 0); ATT_VLD(1, tlc, 3, 1); ATT_SB; \
                o[1] = __builtin_amdgcn_mfma_f32_32x32x16_f16(vfr[3], pf[1], o[1], 0, 0, 0); ATT_EXPH(sc, 11); ATT_SB; \
                o[0] = __builtin_amdgcn_mfma_f32_32x32x16_f16(vfr[4], pf[2], o[0], 0, 0, 0); ATT_EXPH(sc, 12); ATT_EXPH(sc, 13); ATT_SB; \
                o[1] = __builtin_amdgcn_mfma_f32_32x32x16_f16(vfr[5], pf[2], o[1], 0, 0, 0); ATT_EXPH(sc, 14); ATT_EXPH(sc, 15); ATT_SB; \
                o[0] = __builtin_amdgcn_mfma_f32_32x32x16_f16(vfr[0], pf[3], o[0], 0, 0, 0); ATT_SB; \
                o[1] = __builtin_amdgcn_mfma_f32_32x32x16_f16(vfr[1], pf[3], o[1], 0, 0, 0); ATT_SB; \
                l += ls; } while (0)
            if (!tlo) {
                ATT_KX(0); ATT_KLD(0, 0); ATT_PLAINQK(s0, 0, qx1); ATT_SB; ATT_KLD(1, 0); ATT_SB;
                if (gen) ATT_GENI(s0, mr1, l1, o1, qx1, T0, first);
                ATT_BLOCK(s0, l1, o1, 0, true, s1, 1, qx2, ATT_KLD(0, 1));
                ATT_KX(1);
                if (gen) ATT_GENI(s1, mr2, l2, o2, qx2, T0, first);
                ATT_BLOCK(s1, l2, o2, 0, true, s0, 0, qx1, ATT_KLD(1, 1));
            } else {
                ATT_KX(1); ATT_KLD(0, 1); ATT_PLAINQK(s0, 0, qx1); ATT_SB; ATT_KLD(1, 1); ATT_SB;
            }
            { const bool f2 = first && tlo;
              if (gen) ATT_GENI(s0, mr1, l1, o1, qx1, T1, f2);
              ATT_BLOCK(s0, l1, o1, 1, true, s1, 1, qx2, (void)0);
              if (gen) ATT_GENI(s1, mr2, l2, o2, qx2, T1, f2);
              ATT_BLOCK(s1, l2, o2, 1, false, s0, 0, qx1, (void)0); }
#undef ATT_SB
#undef ATT_KX
#undef ATT_KLD
#undef ATT_VLD
#undef ATT_QKM
#undef ATT_EXPH
#undef ATT_PLAINQK
#undef ATT_GENI
#undef ATT_BLOCK
            const float far = fmaxf(sb1 - mr1, sb2 - mr2) + slope2 * (float)(64 * T1 - 1 - q0w);
            need = (T1 >= 1) && (__any(far >= ATT_SKIP) != 0);
            if (!need) wdone = true;
        }
        if (lane == 0) flags[8 * ((ii + 1) & 1) + wave] = need ? 1 : 0;
    }
    asm volatile("s_waitcnt vmcnt(0) lgkmcnt(0)" ::: "memory");
    __builtin_amdgcn_s_barrier();
    asm volatile("" ::: "memory");
#undef ATT_ISSUE
    unsigned nxt = 0;
    if (F.tid == 0) nxt = __hip_atomic_fetch_add(qc, 1u, RLX_AGENT);
    l1 = swap_add(l1); l2 = swap_add(l2);
    const float i1 = 1.0f / l1, i2 = lam / l2;
    float ss = 0.f;
#pragma unroll
    for (int dh = 0; dh < 2; ++dh)
#pragma unroll
        for (int r = 0; r < 16; ++r) { const float v = o1[dh][r] * i1 - o2[dh][r] * i2; o1[dh][r] = v; ss += v * v; }
    ss = swap_add(ss);
    const float rs = rsqrtf(ss * (1.0f / 64.0f) + RMS_EPS) * 0.8f;
    const LAS float* sg = (const LAS float*)(lds + ATT_SG);
    f16* orow = mix + (rowbase + q0w + r32) * 1024 + 512 + hd * 64;
#pragma unroll
    for (int dh = 0; dh < 2; ++dh)
#pragma unroll
        for (int gp = 0; gp < 2; ++gp) {
            typedef unsigned u32x2 __attribute__((ext_vector_type(2))); typedef unsigned u32x4 __attribute__((ext_vector_type(4)));
            u32x2 pk[2];
#pragma unroll
            for (int j = 0; j < 2; ++j) { const int gq = 2 * gp + j; const int dv = 32 * dh + 8 * gq + 4 * hi; const f32x4 gg = *(const LAS f32x4*)(sg + dv);
                h4 o; o[0] = (f16)(o1[dh][4 * gq] * rs * gg[0]); o[1] = (f16)(o1[dh][4 * gq + 1] * rs * gg[1]); o[2] = (f16)(o1[dh][4 * gq + 2] * rs * gg[2]); o[3] = (f16)(o1[dh][4 * gq + 3] * rs * gg[3]);
                pk[j] = __builtin_bit_cast(u32x2, o); }
            const auto s0 = __builtin_amdgcn_permlane32_swap(pk[0][0], pk[1][0], false, false), s1 = __builtin_amdgcn_permlane32_swap(pk[0][1], pk[1][1], false, false);
            u32x4 w; w[0] = s0[0]; w[1] = s1[0]; w[2] = s0[1]; w[3] = s1[1];
            *(u32x4*)(orow + 32 * dh + 16 * gp + 8 * hi) = w;
        }
    if (F.tid == 0) slot[0] = (int)nxt;
    __syncthreads();
    const int nit = __builtin_amdgcn_readfirstlane(slot[0]);
    __syncthreads();
    return nit;
}

constexpr int SSM_UROW = 528, SSM_EROW = 528, SSM_XROW = 272;
constexpr int SSM_U0 = 0, SSM_U1 = 64 * SSM_UROW, SSM_E = 2 * 64 * SSM_UROW, SSM_XP = SSM_E + 64 * SSM_EROW;
typedef float f32x4_t __attribute__((ext_vector_type(4)));
__device__ __forceinline__ void ssm_unit(Frame& F, int b, int g) {
    const Args& A = *F.a; const int tid = F.tid, wave = F.wave, lane = F.lane, fr = lane & 15, fq = lane >> 4;
    const f16* ops = (const f16*)(F.ws + WS_SSMOP) + (size_t)g * 131072;
    const f16* Top = ops; const f16* We = ops + 65536; const f16* Wc = ops + 65536 + 32768;
    const char* ugb = (const char*)((const f16*)(F.ws + WS_UG) + (size_t)((b * 32 + g) * 8192) * 16);
    f16* yh = (f16*)(F.ws + WS_YH) + (size_t)b * SEQ * 512 + g * 16;
    LAS unsigned char* lds = F.lds;
    h8 BY[2][12];
#pragma unroll
    for (int n2 = 0; n2 < 2; ++n2) {
        const int nrow = 16 * (2 * wave + n2) + fr;
#pragma unroll
        for (int kk = 0; kk < 8; ++kk) BY[n2][kk] = *(const h8*)(Top + nrow * 256 + 32 * kk + 8 * fq);
#pragma unroll
        for (int kk = 0; kk < 4; ++kk) BY[n2][8 + kk] = *(const h8*)(Wc + nrow * 128 + 32 * kk + 8 * fq);
    }
    const float* a16 = (const float*)(F.ws + WS_A16) + (g * 64 + lane) * 2;
    const float a16r = a16[0], a16i = a16[1];
    const f32x4 dsk = *(const f32x4*)(A.in[I_SSMD] + g * 16 + 4 * fq);
    float xr = 0.f, xi = 0.f;
#pragma unroll
    for (int q = 0; q < 4; ++q) { const int o = (q * NTHREADS + tid) * 16; const h8 v = *(const h8*)(ugb + o); *(LAS h8*)(lds + SSM_U0 + (o >> 9) * SSM_UROW + (o & 511)) = v; }
    __syncthreads();
#pragma unroll 1
    for (int seg = 0; seg < 8; ++seg) {
        LAS unsigned char* Uc = lds + ((seg & 1) ? SSM_U1 : SSM_U0);
        LAS unsigned char* Un = lds + ((seg & 1) ? SSM_U0 : SSM_U1);
        {
            f32x4 ea[4]; h8 BE[8];
#pragma unroll
            for (int kk = 0; kk < 8; ++kk) BE[kk] = *(const h8*)(We + (16 * wave + fr) * 256 + 32 * kk + 8 * fq);
#pragma unroll
            for (int mt = 0; mt < 4; ++mt) ea[mt] = (f32x4){0.f, 0.f, 0.f, 0.f};
#pragma unroll
            for (int kk = 0; kk < 8; ++kk)
#pragma unroll
                for (int mt = 0; mt < 4; ++mt) { const h8 a = *(const LAS h8*)(Uc + (16 * mt + fr) * SSM_UROW + (32 * kk + 8 * fq) * 2); ea[mt] = __builtin_amdgcn_mfma_f32_16x16x32_f16(BE[kk], a, ea[mt], 0, 0, 0); }
#pragma unroll
            for (int mt = 0; mt < 4; ++mt) *(LAS f32x4*)(lds + SSM_E + (16 * mt + fr) * SSM_EROW + (16 * wave + 4 * fq) * 4) = ea[mt];
        }
        __syncthreads();
        if (wave == 0) {
#pragma unroll 8
            for (int n = 0; n < 64; ++n) {
                const float er = *(const LAS float*)(lds + SSM_E + n * SSM_EROW + lane * 4), ei = *(const LAS float*)(lds + SSM_E + n * SSM_EROW + (64 + lane) * 4);
                *(LAS f16*)(lds + SSM_XP + n * SSM_XROW + lane * 2) = (f16)xr; *(LAS f16*)(lds + SSM_XP + n * SSM_XROW + (64 + lane) * 2) = (f16)xi;
                const float nr = a16r * xr - a16i * xi + er, ni = a16r * xi + a16i * xr + ei; xr = nr; xi = ni;
            }
        } else if (seg < 7) {
            const char* src = ugb + (size_t)(seg + 1) * 32768;
            for (int v = tid - 64; v < 2048; v += NTHREADS - 64) { const int o = v * 16; const h8 x = *(const h8*)(src + o); *(LAS h8*)(Un + (o >> 9) * SSM_UROW + (o & 511)) = x; }
        }
        __syncthreads();
        {
            f32x4 ya[4][2];
#pragma unroll
            for (int mt = 0; mt < 4; ++mt) { ya[mt][0] = (f32x4){0.f, 0.f, 0.f, 0.f}; ya[mt][1] = (f32x4){0.f, 0.f, 0.f, 0.f}; }
#pragma unroll
            for (int kk = 0; kk < 12; ++kk)
#pragma unroll
                for (int mt = 0; mt < 4; ++mt) {
                    const h8 a = kk < 8 ? *(const LAS h8*)(Uc + (16 * mt + fr) * SSM_UROW + (32 * kk + 8 * fq) * 2) : *(const LAS h8*)(lds + SSM_XP + (16 * mt + fr) * SSM_XROW + (32 * (kk - 8) + 8 * fq) * 2);
                    ya[mt][0] = __builtin_amdgcn_mfma_f32_16x16x32_f16(BY[0][kk], a, ya[mt][0], 0, 0, 0);
                    ya[mt][1] = __builtin_amdgcn_mfma_f32_16x16x32_f16(BY[1][kk], a, ya[mt][1], 0, 0, 0);
                }
#pragma unroll
            for (int mt = 0; mt < 4; ++mt)
#pragma unroll
                for (int n2 = 0; n2 < 2; ++n2) {
                    const int ch = 16 * mt + fr, ti = 2 * wave + n2; const size_t tok = (size_t)(seg * 64 + ch) * 16 + ti;
                    const h4 u4 = *(const LAS h4*)(Uc + ch * SSM_UROW + (ti * 16 + 4 * fq) * 2);
                    h4 o;
#pragma unroll
                    for (int e = 0; e < 4; ++e) o[e] = (f16)gelu_tanh(ya[mt][n2][e] + dsk[e] * (float)u4[e]);
                    *(h4*)(yh + tok * 512 + 4 * fq) = o;
                }
        }
    }
    __syncthreads();
}

__device__ __forceinline__ void p2_mixers(Frame& F, int pass) {
    const Args& A = *F.a;
    gu32* qctr = F.ctl + CW_QUEUE + 128 * pass;
    constexpr int NSSM = BATCH * NG, NATT = BATCH * NH * 32;
    volatile LAS int* slot = (volatile LAS int*)(F.lds + LDS_BARST + 16);
    for (;;) {
        if (F.tid == 0) slot[0] = (int)__hip_atomic_fetch_add(qctr, 1u, RLX_AGENT);
        __syncthreads();
        const int it = __builtin_amdgcn_readfirstlane(slot[0]);
        __syncthreads();
        if (it >= NSSM) break;
        if (pass == 1 && PROBE_SEL != 0 && PROBE_SEL != 1) continue;
        ssm_unit(F, it / NG, it % NG);
    }
    asm volatile("" ::: "memory");
    float lam;
    { float d1 = 0.f, d2 = 0.f;
#pragma unroll 1
      for (int i = 0; i < 32; ++i) { d1 += A.in[I_LQ1][i] * A.in[I_LK1][i]; d2 += A.in[I_LQ2][i] * A.in[I_LK2][i]; }
      lam = __expf(d1) - __expf(d2) + 0.2f; }
    asm volatile("" : "+v"(lam));
    if (F.tid < 64) *(LAS float*)(F.lds + ATT_SG + F.tid * 4) = A.in[I_SUBLN][F.tid];
    int ait;
    { if (F.tid == 0) slot[0] = (int)__hip_atomic_fetch_add(qctr + 64, 1u, RLX_AGENT);
      __syncthreads();
      ait = __builtin_amdgcn_readfirstlane(slot[0]);
      __syncthreads(); }
    while (ait < NATT) {
        const int qb = 31 - ait / 32, bh = ait % 32;
        if (pass == 1 && PROBE_SEL != 0) { const int hd_ = bh & 7; const bool sel = PROBE_SEL == 2 ? hd_ >= 6 : PROBE_SEL == 3 ? hd_ <= 3 : PROBE_SEL == 4 ? (hd_ == 7 && qb == 31) : PROBE_SEL == 5 ? (hd_ == 4 || hd_ == 5) : false;
            if (!sel) { if (F.tid == 0) slot[0] = (int)__hip_atomic_fetch_add(qctr + 64, 1u, RLX_AGENT); __syncthreads(); ait = __builtin_amdgcn_readfirstlane(slot[0]); __syncthreads(); continue; } }
        ait = attn_unit(F, bh >> 3, bh & 7, qb, lam, qctr + 64, slot);
    }
    constexpr int NPLE = (T / 256) * 4, WDN_ITEMS = NE * 16 * 32, WDN_CHUNK = 32, NWDN = WDN_ITEMS / WDN_CHUNK;
    gu32* fctr = F.ctl + CW_QUEUE + 256 + 64 * pass;
    for (;;) {
        if (F.tid == 0) slot[0] = (int)__hip_atomic_fetch_add(fctr, 1u, RLX_AGENT);
        __syncthreads();
        const int it = __builtin_amdgcn_readfirstlane(slot[0]);
        __syncthreads();
        if (it >= NPLE + NWDN) break;
        if (it < NPLE) {
            ProbPleProj P{(const char*)(F.ws + WS_PH), (const char*)(F.ws + WS_WPP), (f16*)(F.ws + WS_PE)};
            pg8::OneOrder S; S.u.pm = it >> 2; S.u.pn = it & 3; S.u.e = 0; S.u.cnt = 0; pg8::gemm_phase(F.lds, P, S);
        } else {
            LAS float* scr = (LAS float*)(F.lds + F.wave * 16384);
#pragma unroll 1
            for (int j = 0; j < WDN_CHUNK / 8; ++j) { const int r = (it - NPLE) * WDN_CHUNK + j * 8 + F.wave; const int e = r / (16 * 32), ii = r % (16 * 32);
                tr_item(A.in[I_WDN] + (size_t)e * 1024 * 1024, 1024, 1024, (f16*)(F.ws + WS_WDN + (size_t)e * 1024 * 1024), ii, 4, nullptr, scr, F.lane); }
        }
        __syncthreads();
    }
}

__device__ __forceinline__ void p3_glu(Frame& F) {
    ProbGlu P{(const char*)(F.ws + WS_YH), (const char*)(F.ws + WS_WGLU), (f16*)(F.ws + WS_MIX)};
    pg8::DenseOrder S; S.init(T, 1024, F.G, (int)blockIdx.x); pg8::gemm_phase(F.lds, P, S);
}

__device__ __forceinline__ void p4_outproj(Frame& F) {
    ProbOut P{(const char*)(F.ws + WS_MIX), (const char*)(F.ws + WS_WOUT), (f16*)(F.ws + WS_MIXO)};
    pg8::DenseOrder S; S.init(T, DM, F.G, (int)blockIdx.x); pg8::gemm_phase(F.lds, P, S);
}

constexpr int RT_XROW = 2064;
constexpr int RT_XHI = 0, RT_XLO = 32 * RT_XROW;
constexpr int RT_PART = 0;
constexpr int RT_FIN = 2 * 32 * RT_XROW;
constexpr int RT_CNT = RT_FIN + 32 * 33 * 4;
__device__ __forceinline__ void p5_router(Frame& F, int pass) {
    const Args& A = *F.a; const int tid = F.tid, lane = F.lane, wave = F.wave, r32 = lane & 31, hi = lane >> 5;
    LAS unsigned char* lds = F.lds;
    LAS unsigned* lcnt = (LAS unsigned*)(lds + RT_CNT); LAS unsigned* lbase = lcnt + 32; LAS unsigned* asg = lcnt + 64;
    if (tid < 32) lcnt[tid] = 0u;
    const float* xin = A.in[I_X]; const f16* mixo = (const f16*)(F.ws + WS_MIXO); f16* x1h = (f16*)(F.ws + WS_X1H); unsigned char* x1q = (unsigned char*)(F.ws + WS_X1Q); float* gates = (float*)(F.ws + WS_GATES);
    h8 whi[8], wlo[8];
#pragma unroll
    for (int kk = 0; kk < 8; ++kk)
#pragma unroll
        for (int e = 0; e < 8; ++e) { const float w = A.in[I_WR][(128 * wave + 16 * kk + 8 * hi + e) * 32 + r32]; const f16 h = (f16)w; whi[kk][e] = h; wlo[kk][e] = (f16)(w - (float)h); }
    f32x4 gv[4], bv[4];
#pragma unroll
    for (int jx = 0; jx < 4; ++jx) { gv[jx] = *(const f32x4*)(A.in[I_LN1G] + 256 * jx + 4 * lane); bv[jx] = *(const f32x4*)(A.in[I_LN1B] + 256 * jx + 4 * lane); }
    const int rows_per_blk = T / F.G;
#pragma unroll 1
    for (int bt = 0; bt < rows_per_blk / 32; ++bt) {
        const int row0 = (bt * F.G + (int)blockIdx.x) * 32;
#pragma unroll 1
        for (int rr = 0; rr < 4; ++rr) {
            const int lr = wave * 4 + rr; const size_t ro = (size_t)(row0 + lr) * 1024;
            f32x4 v[4]; float s1 = 0.f, s2 = 0.f;
#pragma unroll
            for (int jx = 0; jx < 4; ++jx) { const f32x4 xv = *(const f32x4*)(xin + ro + 256 * jx + 4 * lane); const h4 mv = *(const h4*)(mixo + ro + 256 * jx + 4 * lane);
#pragma unroll
                for (int e = 0; e < 4; ++e) { const float t = ALPHA * xv[e] + (float)mv[e]; v[jx][e] = t; s1 += t; } }
            const float mean = wave_sum(s1) * (1.0f / 1024.0f);
#pragma unroll
            for (int jx = 0; jx < 4; ++jx) { v[jx] = v[jx] - mean; s2 += (v[jx][0] * v[jx][0] + v[jx][1] * v[jx][1]) + (v[jx][2] * v[jx][2] + v[jx][3] * v[jx][3]); }
            const float rstd = rsqrtf(wave_sum(s2) * (1.0f / 1024.0f) + LN_EPS);
#pragma unroll
            for (int jx = 0; jx < 4; ++jx) {
                const f32x4 y = v[jx] * rstd * gv[jx] + bv[jx];
                h4 yh_, yl_;
#pragma unroll
                for (int e = 0; e < 4; ++e) { const f16 h = (f16)y[e]; yh_[e] = h; yl_[e] = (f16)(y[e] - (float)h); }
                *(h4*)(x1h + ro + 256 * jx + 4 * lane) = yh_;
                *(int*)(x1q + ro + 256 * jx + 4 * lane) = pack_fp8x4(y[0], y[1], y[2], y[3]);
                *(LAS h4*)(lds + RT_XHI + lr * RT_XROW + (256 * jx + 4 * lane) * 2) = yh_;
                *(LAS h4*)(lds + RT_XLO + lr * RT_XROW + (256 * jx + 4 * lane) * 2) = yl_;
            }
        }
        __syncthreads();
        f32x16 acc = {};
#pragma unroll
        for (int kk = 0; kk < 8; ++kk) {
            const int ko = (128 * wave + 16 * kk + 8 * hi) * 2;
            const h8 xh_ = *(const LAS h8*)(lds + RT_XHI + r32 * RT_XROW + ko), xl_ = *(const LAS h8*)(lds + RT_XLO + r32 * RT_XROW + ko);
            acc = __builtin_amdgcn_mfma_f32_32x32x16_f16(whi[kk], xh_, acc, 0, 0, 0);
            acc = __builtin_amdgcn_mfma_f32_32x32x16_f16(wlo[kk], xh_, acc, 0, 0, 0);
            acc = __builtin_amdgcn_mfma_f32_32x32x16_f16(whi[kk], xl_, acc, 0, 0, 0);
        }
        __syncthreads();
#pragma unroll
        for (int g = 0; g < 4; ++g) { f32x4 o; o[0] = acc[4 * g]; o[1] = acc[4 * g + 1]; o[2] = acc[4 * g + 2]; o[3] = acc[4 * g + 3];
            *(LAS f32x4*)(lds + RT_PART + (((wave * 32 + r32) * 32) + 8 * g + 4 * hi) * 4) = o; }
        __syncthreads();
        { const int row = tid >> 4, e0 = 2 * (tid & 15); float a0 = A.in[I_BR][e0], a1 = A.in[I_BR][e0 + 1];
#pragma unroll
          for (int w = 0; w < 8; ++w) { a0 += *(const LAS float*)(lds + RT_PART + (((w * 32 + row) * 32) + e0) * 4); a1 += *(const LAS float*)(lds + RT_PART + (((w * 32 + row) * 32) + e0 + 1) * 4); }
          *(LAS float*)(lds + RT_FIN + (row * 33 + e0) * 4) = a0; *(LAS float*)(lds + RT_FIN + (row * 33 + e0 + 1) * 4) = a1; }
        __syncthreads();
        if (tid < 32) {
            const LAS float* lg = (const LAS float*)(lds + RT_FIN + tid * 33 * 4);
            float tv[4]; int te[4];
#pragma unroll
            for (int k = 0; k < 4; ++k) { tv[k] = -INFINITY; te[k] = 0; }
#pragma unroll 1
            for (int e = 0; e < 32; ++e) { const float x = lg[e];
                if (x > tv[3]) {
                    if (x > tv[0]) { tv[3] = tv[2]; te[3] = te[2]; tv[2] = tv[1]; te[2] = te[1]; tv[1] = tv[0]; te[1] = te[0]; tv[0] = x; te[0] = e; }
                    else if (x > tv[1]) { tv[3] = tv[2]; te[3] = te[2]; tv[2] = tv[1]; te[2] = te[1]; tv[1] = x; te[1] = e; }
                    else if (x > tv[2]) { tv[3] = tv[2]; te[3] = te[2]; tv[2] = x; te[2] = e; }
                    else { tv[3] = x; te[3] = e; } } }
            const float e1 = __expf(tv[1] - tv[0]), e2 = __expf(tv[2] - tv[0]), e3 = __expf(tv[3] - tv[0]); const float inv = 1.0f / (1.0f + e1 + e2 + e3);
            const int row = row0 + tid; f32x4 gk; gk[0] = inv; gk[1] = e1 * inv; gk[2] = e2 * inv; gk[3] = e3 * inv;
            *(f32x4*)(gates + (size_t)row * 4) = gk;
#pragma unroll
            for (int k = 0; k < 4; ++k) { const unsigned rk = atomicAdd((unsigned*)&lcnt[te[k]], 1u); asg[(bt * 32 + tid) * 4 + k] = (unsigned)te[k] | (rk << 8); }
        }
        __syncthreads();
    }
    if (F.tid < 32) lbase[F.tid] = __hip_atomic_fetch_add(F.ctl + CW_CNT + 2048 * pass + 64 * F.tid, lcnt[F.tid], RLX_AGENT);
    __syncthreads();
    int* list = (int*)(F.ws + WS_LIST + (size_t)pass * 4 * MiB);
    { const unsigned a = asg[F.tid]; const int e = a & 255, rk = a >> 8; const int row = ((F.tid >> 7) * F.G + (int)blockIdx.x) * 32 + ((F.tid >> 2) & 31);
      list[(size_t)e * ECAP + lbase[e] + rk] = row * 4 + (F.tid & 3); }
    __syncthreads();
}

template <int WHICH> __device__ __forceinline__ void p67_moe(Frame& F) {
    const Args& A = *F.a;
    LAS int* tab = (LAS int*)(F.lds + pg8::STAGE_BYTES + 2048);
    if (F.tid < 32) tab[F.tid] = (int)__hip_atomic_load(F.ctl + CW_CNT + 64 * F.tid, RLX_AGENT);
    __syncthreads();
    if (F.tid == 0) { int sacc = 0; for (int e = 0; e < 32; ++e) { tab[32 + e] = sacc; sacc += (tab[e] + 255) >> 8; } tab[64] = sacc; }
    __syncthreads();
    const int* list = (const int*)(F.ws + WS_LIST);
    if (WHICH == 0) {
        ProbMoeUp P{(const char*)(F.ws + WS_X1Q), (const char*)(F.ws + WS_WGU), list, A.in[I_BGU], (unsigned char*)(F.ws + WS_ACT)};
        pg8::MoeOrder S{tab, 8, F.G, F.vcu}; pg8::gemm_phase(F.lds, P, S);
    } else {
        ProbMoeDn P{(const char*)(F.ws + WS_ACT), (const char*)(F.ws + WS_WDN), list, A.in[I_BDN], (const float*)(F.ws + WS_GATES), (unsigned char*)(F.ws + WS_SLAB)};
        pg8::MoeOrder S{tab, 4, F.G, F.vcu}; pg8::gemm_phase(F.lds, P, S);
    }
    __syncthreads();
}

__device__ __forceinline__ void p8_combine(Frame& F) {
    const int lane = F.lane;
    typedef int i32x2 __attribute__((ext_vector_type(2))); typedef float f32x2 __attribute__((ext_vector_type(2)));
    const f16* x1h = (const f16*)(F.ws + WS_X1H); const unsigned char* slab = (const unsigned char*)(F.ws + WS_SLAB); f16* rh = (f16*)(F.ws + WS_RH); unsigned char* rq = (unsigned char*)(F.ws + WS_RQ);
    for (int row = F.gw; row < T; row += F.NGW) {
#pragma unroll
        for (int j = 0; j < 2; ++j) {
            const size_t o = (size_t)row * 1024 + 512 * j + 8 * lane;
            const h8 xv = *(const h8*)(x1h + o); float v[8], acc[8];
#pragma unroll
            for (int e = 0; e < 8; ++e) { v[e] = ALPHA * (float)xv[e]; acc[e] = 0.f; }
#pragma unroll
            for (int k = 0; k < 4; ++k) { const i32x2 sv = *(const i32x2*)(slab + ((size_t)row * 4 + k) * 1024 + 512 * j + 8 * lane);
#pragma unroll
                for (int q = 0; q < 2; ++q) { const f32x2 lo = __builtin_amdgcn_cvt_pk_f32_fp8(sv[q], false), hi = __builtin_amdgcn_cvt_pk_f32_fp8(sv[q], true);
                    acc[4 * q] += lo[0]; acc[4 * q + 1] += lo[1]; acc[4 * q + 2] += hi[0]; acc[4 * q + 3] += hi[1]; } }
            h8 hh;
#pragma unroll
            for (int e = 0; e < 8; ++e) { v[e] += acc[e] * (1.0f / SLAB_SCALE); hh[e] = (f16)v[e]; v[e] = fminf(fmaxf(v[e] * RQ_SCALE, -448.f), 448.f); }
            *(h8*)(rh + o) = hh;
            i32x2 qq = {pack_fp8x4(v[0], v[1], v[2], v[3]), pack_fp8x4(v[4], v[5], v[6], v[7])}; *(i32x2*)(rq + o) = qq;
        }
    }
}

__device__ __forceinline__ void p9_ple(Frame& F) {
    ProbPleGate P{(const char*)(F.ws + WS_RQ), (const char*)(F.ws + WS_WPG), (f16*)(F.ws + WS_GATEH)};
    pg8::DenseOrder S; S.init(T, DM, F.G, (int)blockIdx.x); pg8::gemm_phase(F.lds, P, S);
}

__device__ __forceinline__ void p10_ln2(Frame& F) {
    const Args& A = *F.a; const int lane = F.lane; float* out = A.out; const f16* rh = (const f16*)(F.ws + WS_RH); const f16* gateh = (const f16*)(F.ws + WS_GATEH); const f16* pe = (const f16*)(F.ws + WS_PE);
    f32x4 gv[4], bv[4];
#pragma unroll
    for (int j = 0; j < 2; ++j)
#pragma unroll
        for (int q = 0; q < 2; ++q) { gv[2 * j + q] = *(const f32x4*)(A.in[I_LN2G] + 512 * j + 8 * lane + 4 * q); bv[2 * j + q] = *(const f32x4*)(A.in[I_LN2B] + 512 * j + 8 * lane + 4 * q); }
    for (int row = F.gw; row < T; row += F.NGW) {
        f32x4 v[4]; float s = 0.f;
#pragma unroll
        for (int j = 0; j < 2; ++j) { const size_t o_ = (size_t)row * 1024 + 512 * j + 8 * lane; const h8 r8 = *(const h8*)(rh + o_), g8 = *(const h8*)(gateh + o_), p8 = *(const h8*)(pe + o_);
#pragma unroll
            for (int q = 0; q < 2; ++q) { f32x4 t;
#pragma unroll
                for (int e = 0; e < 4; ++e) t[e] = (float)r8[4 * q + e] + (float)g8[4 * q + e] * (float)p8[4 * q + e];
                v[2 * j + q] = t; s += (t[0] + t[1]) + (t[2] + t[3]); } }
        const float mean = wave_sum(s) * (1.0f / 1024.0f); float s2 = 0.f;
#pragma unroll
        for (int j = 0; j < 4; ++j) { v[j] = v[j] - mean; s2 += (v[j][0] * v[j][0] + v[j][1] * v[j][1]) + (v[j][2] * v[j][2] + v[j][3] * v[j][3]); }
        const float rstd = rsqrtf(wave_sum(s2) * (1.0f / 1024.0f) + LN_EPS);
#pragma unroll
        for (int j = 0; j < 2; ++j)
#pragma unroll
            for (int q = 0; q < 2; ++q) *(f32x4*)(out + (size_t)row * 1024 + 512 * j + 8 * lane + 4 * q) = v[2 * j + q] * rstd * gv[2 * j + q] + bv[2 * j + q];
    }
}

__global__ void __launch_bounds__(NTHREADS, 2) fwd_kernel(Args args) {
    extern __shared__ __attribute__((aligned(16))) unsigned char lds_raw[];
    Frame F;
    F.lds = (LAS unsigned char*)lds_raw; F.a = &args; F.ws = args.ws; F.ctl = (gu32*)(args.ws + WS_CTL);
    F.tid = threadIdx.x; F.lane = F.tid & 63; F.wave = __builtin_amdgcn_readfirstlane(F.tid >> 6);
    F.G = gridDim.x; F.gw = blockIdx.x * NWAVES + F.wave; F.NGW = F.G * NWAVES;
    { const int bx = blockIdx.x; F.vcu = (F.G % 8 == 0) ? (bx % 8) * (F.G / 8) + bx / 8 : bx; }
    volatile LAS unsigned* barst = (volatile LAS unsigned*)(F.lds + LDS_BARST);
    if (F.tid < 16) barst[F.tid] = 0u;
    __syncthreads();
    XcdBarrier bar; bar.bar = (unsigned*)(F.ctl + CW_BAR); bar.x = 0; bar.st = nullptr;
    if (MK_N_LAUNCHES == 1) bar = xcd_barrier_post((unsigned*)(F.ctl + CW_BAR), barst);
    const int lo = args.ph_lo, hi = args.ph_hi;
#define IN(k) (lo <= (k) && (k) < hi)
#define SEAM(k) do { if (IN(k) && IN((k) + 1)) xcd_barrier(bar); } while (0)
#define REP(k, body) do { if (IN(k)) { body; if ((PROBE_MASK >> (k)) & 1) { xcd_barrier(bar); body; } } } while (0)
    REP(0, p0_prologue(F)); SEAM(0);
    REP(1, p1_inproj(F)); SEAM(1);
    if (IN(2)) { p2_mixers(F, args.pass); if ((PROBE_MASK >> 2) & 1) { xcd_barrier(bar); p2_mixers(F, 1); } } SEAM(2);
    REP(3, p3_glu(F)); SEAM(3);
    REP(4, p4_outproj(F)); SEAM(4);
    if (IN(5)) { p5_router(F, args.pass); } SEAM(5);
    REP(6, p67_moe<0>(F)); SEAM(6);
    REP(7, p67_moe<1>(F)); SEAM(7);
    REP(8, p8_combine(F)); SEAM(8);
    REP(9, p9_ple(F)); SEAM(9);
    if (IN(10)) { p10_ln2(F); }
#undef REP
#undef IN
#undef SEAM
}
}

extern "C" void kernel_launch(void* const* d_in, const int* in_sizes, int n_in, void* d_out, int out_size, void* d_ws, size_t ws_size, hipStream_t stream) {
    static int grid = 0;
    if (grid == 0) {
        if (n_in != 31 || out_size != T * DM || ws_size < WS_END) { fprintf(stderr, "kernel_launch: unexpected problem (n_in %d, out %d, ws %zu)\n", n_in, out_size, ws_size); grid = -1; return; }
        int dev = 0, cus = 0;
        if (hipGetDevice(&dev) != hipSuccess || hipDeviceGetAttribute(&cus, hipDeviceAttributeMultiprocessorCount, dev) != hipSuccess) { grid = -1; return; }
        if (hipFuncSetAttribute((const void*)fwd_kernel, hipFuncAttributeMaxDynamicSharedMemorySize, LDS_BYTES) != hipSuccess) { fprintf(stderr, "kernel_launch: hipFuncSetAttribute failed\n"); grid = -1; return; }
        int per_cu = 0;
        if (hipOccupancyMaxActiveBlocksPerMultiprocessor(&per_cu, (const void*)fwd_kernel, NTHREADS, LDS_BYTES) != hipSuccess || per_cu < 1) { fprintf(stderr, "kernel_launch: occupancy query says %d\n", per_cu); }
        (void)hipGetLastError();
        grid = cus;
    }
    if (grid < 0) return;
    (void)hipMemsetAsync((char*)d_ws + WS_CTL, 0, CTL_ZERO_BYTES, stream);
    Args a{};
    for (int i = 0; i < 31; ++i) a.in[i] = (const float*)d_in[i];
    a.out = (float*)d_out; a.ws = (unsigned char*)d_ws;
    if (MK_N_LAUNCHES == 1) { a.ph_lo = 0; a.ph_hi = NPHASE; hipLaunchKernelGGL(fwd_kernel, dim3(grid), dim3(NTHREADS), LDS_BYTES, stream, a); }
    else { for (int p = 0; p < NPHASE; ++p) { a.ph_lo = p; a.ph_hi = p + 1; a.pass = 0; hipLaunchKernelGGL(fwd_kernel, dim3(grid), dim3(NTHREADS), LDS_BYTES, stream, a);
             if (p == PROBE_DUP) { a.pass = 1; hipLaunchKernelGGL(fwd_kernel, dim3(grid), dim3(NTHREADS), LDS_BYTES, stream, a); } } }
}
```

```cpp
#include <hip/hip_runtime.h>
#include <cstdio>
#include <cstdint>

#ifndef PROBE_MASK
#define PROBE_MASK 0
#endif
#ifndef PROBE_SEL
#define PROBE_SEL 0
#endif
#ifndef PROBE_DUP
#define PROBE_DUP -1
#endif
#ifndef MK_N_LAUNCHES
#define MK_N_LAUNCHES 1
#endif

namespace {
constexpr int BATCH = 4, SEQ = 8192, DM = 1024, T = BATCH * SEQ;
constexpr int NH = 8, NG = 32, NS = 64, DIN = 2048;
constexpr int NE = 32, PLE = 256;
constexpr int ECAP = T;
constexpr float LN_EPS = 1e-5f, RMS_EPS = 1e-5f;
constexpr float ALPHA = 1.189207115002721f;
constexpr float QSCALE = 0.17677669529663687f * 1.4426950408889634f;
constexpr float LOG2E = 1.4426950408889634f;
constexpr int NPHASE = 11;
constexpr int NWAVES = 8, NTHREADS = 512;

typedef _Float16 f16;
typedef f16 h8 __attribute__((ext_vector_type(8)));
typedef f16 h4 __attribute__((ext_vector_type(4)));
typedef f16 h2 __attribute__((ext_vector_type(2)));
typedef float f32x4 __attribute__((ext_vector_type(4)));
typedef float f32x16 __attribute__((ext_vector_type(16)));
typedef int i32x4 __attribute__((ext_vector_type(4)));
typedef int i32x8 __attribute__((ext_vector_type(8)));
#define LAS __attribute__((address_space(3)))
#define GAS __attribute__((address_space(1)))
typedef GAS unsigned gu32;
#define RLX_AGENT __ATOMIC_RELAXED, __HIP_MEMORY_SCOPE_AGENT

constexpr size_t MiB = 1u << 20;
constexpr size_t WS_CTL = 0, CTL_ZERO_BYTES = 1 * MiB;
constexpr size_t WS_YSS = 3 * MiB;
constexpr size_t WS_GATES = 5 * MiB;
constexpr size_t WS_LIST = 6 * MiB;
constexpr size_t WS_WIN = 16 * MiB;
constexpr size_t WS_WGLU = 20 * MiB;
constexpr size_t WS_WOUT = 21 * MiB;
constexpr size_t WS_WPG = 23 * MiB;
constexpr size_t WS_WPP = 25 * MiB;
constexpr size_t WS_WGU = 32 * MiB;
constexpr size_t WS_WDN = 160 * MiB;
constexpr size_t WS_PE = 224 * MiB;
constexpr size_t WS_V1 = 288 * MiB;
constexpr size_t WS_A = 416 * MiB;
constexpr size_t WS_XH = WS_A;
constexpr size_t WS_PH = WS_A + 64 * MiB;
constexpr size_t WS_QH = WS_A + 80 * MiB;
constexpr size_t WS_KT = WS_A + 112 * MiB;
constexpr size_t WS_VT = WS_A + 144 * MiB;
constexpr size_t WS_UG = WS_A + 176 * MiB;
constexpr size_t WS_ACT = WS_A;
constexpr size_t WS_X1Q = WS_A + 128 * MiB;
constexpr size_t WS_R = WS_A;
constexpr size_t WS_RH = WS_A + 128 * MiB;
constexpr size_t WS_RQ = WS_A + 192 * MiB;
constexpr size_t WS_B = 672 * MiB;
constexpr size_t WS_YH = WS_B;
constexpr size_t WS_MIX = WS_B + 32 * MiB;
constexpr size_t WS_X1H = 940 * MiB;
constexpr size_t WS_SLAB = WS_B;
constexpr size_t WS_SSMOP = 928 * MiB;
constexpr size_t WS_A16 = 936 * MiB;
constexpr size_t WS_GATEH = WS_V1;
constexpr size_t WS_MIXO = WS_XH;
constexpr size_t WS_END = 1004 * MiB;

constexpr int CW_BAR = 4096;
constexpr int CW_CNT = 8192;
constexpr int CW_QUEUE = 12288;
constexpr int CW_KMAX = 16384;

constexpr int LDS_BYTES = 147456;
constexpr int LDS_BARST = LDS_BYTES - 64;

__device__ __forceinline__ float wave_sum(float v) {
#pragma unroll
    for (int o = 1; o < 64; o <<= 1) v += __shfl_xor(v, o);
    return v;
}
__device__ __forceinline__ float sigmoidf_(float x) { return __builtin_amdgcn_rcpf(1.0f + __builtin_amdgcn_exp2f(-LOG2E * x)); }
__device__ __forceinline__ float gelu_tanh(float x) {
    const float z = 0.7978845608028654f * (x + 0.044715f * x * x * x);
    const float e = __builtin_amdgcn_exp2f(fminf(2.0f * LOG2E * z, 80.0f));
    const float t = 1.0f - 2.0f * __builtin_amdgcn_rcpf(e + 1.0f);
    return 0.5f * x * (1.0f + t);
}
__device__ __forceinline__ int crow(int r, int hi) { return (r & 3) + 8 * (r >> 2) + 4 * hi; }
__device__ __forceinline__ float swap_add(float v) { return v + __shfl_xor(v, 32); }
__device__ __forceinline__ float swap_max(float v) { return fmaxf(v, __shfl_xor(v, 32)); }

#define XB_TMO      128
#define XB_XCNT(j)  (256  + 64 * (j))
#define XB_XSUB(j)  (1280 + 64 * (j))
#define XB_XGEN(j)  (2304 + 64 * (j))
#define XB_TOP      3328
#define XB_TOPGEN   3392
#define XCD_BAR_WORDS 3456
#define XB_SPIN_CAP (1u << 20)
__device__ __forceinline__ unsigned xb_ld(unsigned* p)              { return __hip_atomic_load(p, __ATOMIC_RELAXED, __HIP_MEMORY_SCOPE_AGENT); }
__device__ __forceinline__ unsigned xb_add(unsigned* p, unsigned v) { return __hip_atomic_fetch_add(p, v, __ATOMIC_RELAXED, __HIP_MEMORY_SCOPE_AGENT); }
__device__ __forceinline__ unsigned xb_xcc_id() { return (unsigned)__builtin_amdgcn_s_getreg((3 << 11) | 20) & 0xFu; }
#define XB_SPIN(cond, bar) do { unsigned _sp = 0; while (cond) { __builtin_amdgcn_s_sleep(1); \
    if ((++_sp & 255u) == 0u) { if (xb_ld(&(bar)[XB_TMO])) break; if (_sp > XB_SPIN_CAP) { atomicAdd(&(bar)[XB_TMO], 1u); break; } } } } while (0)
struct XcdBarrier { unsigned* bar; unsigned x; volatile LAS unsigned* st; };
__device__ __forceinline__ XcdBarrier xcd_barrier_post(unsigned* bar, volatile LAS unsigned* st) {
    XcdBarrier b; b.bar = bar; b.x = xb_xcc_id(); b.st = st;
    if (threadIdx.x == 0) (void)xb_add(&bar[XB_XCNT(b.x)], 1u);
    return b;
}
__device__ __forceinline__ void xcd_barrier_complete(unsigned* bar, unsigned x, unsigned& nloc, unsigned& nx) {
    const unsigned G = gridDim.x * gridDim.y * gridDim.z;
    unsigned sum, cnt, mine, sp = 0u;
    for (;;) {
        sum = 0u; cnt = 0u; mine = 0u;
#pragma unroll
        for (unsigned j = 0; j < 16; ++j) { const unsigned c = xb_ld(&bar[XB_XCNT(j)]); sum += c; cnt += (c > 0u) ? 1u : 0u; mine = (j == x) ? c : mine; }
        if (sum == G) break;
        __builtin_amdgcn_s_sleep(1);
        if ((++sp & 255u) == 0u) { if (xb_ld(&bar[XB_TMO])) break; if (sp > XB_SPIN_CAP) { atomicAdd(&bar[XB_TMO], 1u); break; } }
    }
    nloc = mine > 0u ? mine : 1u; nx = cnt > 0u ? cnt : 1u;
}
__device__ __forceinline__ void xcd_barrier(const XcdBarrier& b) {
    asm volatile("s_waitcnt vmcnt(0)" ::: "memory");
    __syncthreads();
    if (threadIdx.x == 0) {
        unsigned* bar = b.bar;
        __builtin_amdgcn_s_waitcnt(0);
        unsigned nloc = b.st[0], nx = b.st[1];
        if (nloc == 0u) { xcd_barrier_complete(bar, b.x, nloc, nx); b.st[0] = nloc; b.st[1] = nx; }
        const unsigned old = xb_add(&bar[XB_XSUB(b.x)], 1u);
        const unsigned gen = old / nloc;
        if (old + 1u == (gen + 1u) * nloc) {
            __builtin_amdgcn_fence(__ATOMIC_RELEASE, "agent");
            asm volatile("s_waitcnt vmcnt(0)" ::: "memory");
            const unsigned og = xb_add(&bar[XB_TOP], 1u);
            const unsigned tg = og / nx;
            if (og + 1u == (tg + 1u) * nx) xb_add(&bar[XB_TOPGEN], 1u);
            else XB_SPIN(xb_ld(&bar[XB_TOPGEN]) == tg, bar);
            __builtin_amdgcn_fence(__ATOMIC_ACQUIRE, "agent");
            xb_add(&bar[XB_XGEN(b.x)], 1u);
            asm volatile("s_waitcnt vmcnt(0)" ::: "memory");
        } else {
            XB_SPIN(xb_ld(&bar[XB_XGEN(b.x)]) == gen, bar);
            __builtin_amdgcn_fence(__ATOMIC_ACQUIRE, "agent");
            asm volatile("s_waitcnt vmcnt(0)" ::: "memory");
        }
    }
    __syncthreads();
}

struct Args { const float* in[31]; float* out; unsigned char* ws; int ph_lo, ph_hi, pass, pad; };
enum { I_X = 0, I_P, I_WIN, I_LQ1, I_LK1, I_LQ2, I_LK2, I_SUBLN, I_ARE, I_AIM, I_LOGDT, I_BRE, I_BIM, I_CRE, I_CIM, I_SSMD, I_WGLU, I_SSMG, I_WOUT,
       I_LN1G, I_LN1B, I_WR, I_BR, I_WGU, I_BGU, I_WDN, I_BDN, I_WPG, I_WPP, I_LN2G, I_LN2B };

struct Frame {
    LAS unsigned char* lds;
    const Args* a;
    unsigned char* ws;
    gu32* ctl;
    int tid, lane, wave, gw, NGW, G, vcu;
};

namespace pg8 {
constexpr int BM = 256, BK = 64, HALF = 128, HTB = HALF * BK * 2, STAGE_BYTES = 8 * HTB, NXCD = 8, WGM = 8;
__device__ __forceinline__ int lds_byte(int r, int c) { const int st = (r >> 4) * 2 + (c >> 5), rr = r & 15, cc = c & 31, ob = rr * 64 + cc * 2; return st * 1024 + (ob ^ (((ob >> 9) & 1) << 5)); }
__device__ __forceinline__ void stage_rc(int b, int& R, int& C) { const int st = b / 1024, sb = b % 1024, swz = sb ^ (((sb >> 9) & 1) << 5); R = (st >> 1) * 16 + swz / 64; C = (st & 1) * 32 + (swz % 64) / 2; }
struct Unit { int pm, pn, e, cnt; };
struct DenseOrder {
    int nM, nN, nwg, G, c;
    __device__ __forceinline__ void init(int M, int N, int G_, int c_) { nM = M / BM; nN = N / BM; nwg = nM * nN; G = G_; c = c_; }
    __device__ __forceinline__ bool next(int i, Unit& u) const {
        const long L = (long)i * G + c; if (L >= nwg) return false;
        int wgid = (int)L; { const int q = nwg / NXCD, r = nwg % NXCD, xcd = wgid % NXCD, off = wgid / NXCD; wgid = (xcd < r ? xcd * (q + 1) : r * (q + 1) + (xcd - r) * q) + off; }
        const int nig = WGM * nN, gid = wgid / nig, fm = gid * WGM, gsz = (nM - fm) < WGM ? (nM - fm) : WGM;
        u.pm = fm + ((wgid % nig) % gsz); u.pn = (wgid % nig) / gsz; u.e = 0; u.cnt = 0; return true;
    }
};
struct OneOrder { Unit u; __device__ __forceinline__ bool next(int i, Unit& o) const { if (i != 0) return false; o = u; return true; } };
struct MoeOrder {
    const LAS int* tab; int ntn, G, c;
    __device__ __forceinline__ bool next(int i, Unit& u) const {
        const int L = i * G + c; if (L >= tab[64] * ntn) return false;
        int e = 0;
#pragma unroll 1
        for (int q = 1; q < 32; ++q) if (L >= tab[32 + q] * ntn) e = q;
        const int cnt = tab[e], lu = L - tab[32 + e] * ntn;
        u.e = e; u.cnt = cnt; u.pn = lu % ntn; u.pm = lu / ntn; return true;
    }
};

template <class P, class Sched>
__device__ __forceinline__ void gemm_phase(LAS unsigned char* lds, const P& p, const Sched& S) {
    const int tid = threadIdx.x, wid = __builtin_amdgcn_readfirstlane(tid >> 6), lane = tid & 63, wr = wid >> 2, wc = wid & 3, fr = lane & 15, fq = lane >> 4;
    constexpr int K = P::K, PB = P::FP8 ? K : 2 * K  , nt = PB / 128;
    int RA[2]; unsigned CB[2], voffB[2];
#pragma unroll
    for (int i = 0; i < 2; ++i) { int R, C; stage_rc(tid * 16 + i * 8192, R, C); RA[i] = R; CB[i] = (unsigned)C * 2u; voffB[i] = (unsigned)(R * PB + C * 2); }
    constexpr size_t kstep = 128, hstep = (size_t)HALF * PB, tstep = 2 * hstep;
    const unsigned ldsw = (unsigned)wid * 1024u;
    const int aoff = lds_byte(wr * 64 + fr, fq * 8), boff = lds_byte(wc * 32 + fr, fq * 8);
    LAS float* rsl = (LAS float*)(lds + STAGE_BYTES);
    const char* abase = p.abase();
#define PG8_SA(b, h) (((b) * 2 + (h)) * HTB)
#define PG8_SB(b, h) ((4 + (b) * 2 + (h)) * HTB)
#define PG8_STAGE(bufoff, gbase, voff) do { _Pragma("unroll") for (int _i = 0; _i < 2; ++_i) \
        __builtin_amdgcn_global_load_lds((const unsigned*)((const char*)(gbase) + (voff)[_i]), (LAS unsigned*)(lds + (bufoff) + ldsw + _i * 8192), 16, 0, 0); } while (0)
#define PG8_LDA(dst, b, h) do { _Pragma("unroll") for (int m = 0; m < 4; ++m) { \
        if constexpr (P::FP8) { const i32x4 lo_ = *(const LAS i32x4*)(lds + PG8_SA(b, h) + aoff + m * 2048), hi_ = *(const LAS i32x4*)(lds + PG8_SA(b, h) + aoff + m * 2048 + 1024); dst##8[m] = __builtin_shufflevector(lo_, hi_, 0, 1, 2, 3, 4, 5, 6, 7); } \
        else { _Pragma("unroll") for (int k = 0; k < 2; ++k) dst[m][k] = *(const LAS h8*)(lds + PG8_SA(b, h) + aoff + m * 2048 + k * 1024); } } } while (0)
#define PG8_LDB(dst, b, h) do { _Pragma("unroll") for (int n = 0; n < 2; ++n) { \
        if constexpr (P::FP8) { const i32x4 lo_ = *(const LAS i32x4*)(lds + PG8_SB(b, h) + boff + n * 2048), hi_ = *(const LAS i32x4*)(lds + PG8_SB(b, h) + boff + n * 2048 + 1024); dst##8[n] = __builtin_shufflevector(lo_, hi_, 0, 1, 2, 3, 4, 5, 6, 7); } \
        else { _Pragma("unroll") for (int k = 0; k < 2; ++k) dst[n][k] = *(const LAS h8*)(lds + PG8_SB(b, h) + boff + n * 2048 + k * 1024); } } } while (0)
#define PG8_MMA(ai, bj, At, Bt) do { __builtin_amdgcn_s_setprio(1); _Pragma("unroll") for (int m = 0; m < 4; ++m) _Pragma("unroll") for (int n = 0; n < 2; ++n) { \
        if constexpr (P::FP8) asm volatile("v_mfma_scale_f32_16x16x128_f8f6f4 %0, %1, %2, %0, %3, %3 op_sel_hi:[0,0,0]" : "+v"(acc[ai][bj][m][n]) : "v"(Bt##8[n]), "v"(At##8[m]), "v"(one_scale)); \
        else { _Pragma("unroll") for (int k = 0; k < 2; ++k) acc[ai][bj][m][n] = __builtin_amdgcn_mfma_f32_16x16x32_f16(Bt[n][k], At[m][k], acc[ai][bj][m][n], 0, 0, 0); } } \
        __builtin_amdgcn_s_setprio(0); } while (0)
#define PG8_WAIT_V(n) asm volatile("s_waitcnt vmcnt(" #n ")" ::: "memory")
#define PG8_WAIT_L(n) asm volatile("s_waitcnt lgkmcnt(" #n ")" ::: "memory")
#define PG8_BAR __builtin_amdgcn_s_barrier()
#define PG8_SCHED __builtin_amdgcn_sched_barrier(0)
    Unit cur, nxt; int ui = 0;
    if (!S.next(0, cur)) return;
    f32x4 acc[2][2][4][2];
#pragma unroll
    for (int a = 0; a < 2; ++a)
#pragma unroll
        for (int b = 0; b < 2; ++b)
#pragma unroll
            for (int m = 0; m < 4; ++m)
#pragma unroll
                for (int n = 0; n < 2; ++n) acc[a][b][m][n] = (f32x4){0.f, 0.f, 0.f, 0.f};
    h8 At[4][2], B0[2][2], B1[2][2]; i32x8 At8[4], B08[2], B18[2];
    int one_scale = 0x7f7f7f7f; asm volatile("" : "+v"(one_scale));
    LAS int* ginfo = (LAS int*)(lds + STAGE_BYTES + 4096);
    unsigned voffA[2];
    const char* cA = abase; const char* nA = abase;
#pragma unroll
    for (int i = 0; i < 2; ++i) voffA[i] = P::GATHER ? CB[i] : (unsigned)(RA[i] * PB) + CB[i];
    if constexpr (P::GATHER) {
        if (tid < 256) p.fill_rows(cur, ginfo, tid);
        asm volatile("s_waitcnt lgkmcnt(0)" ::: "memory"); PG8_BAR; asm volatile("" ::: "memory");
    } else cA = abase + (size_t)cur.pm * tstep;
    constexpr size_t hA = P::GATHER ? 0 : hstep;
#define PG8_STAGE_A(bufoff, gbase, par, half) do { if constexpr (P::GATHER) { _Pragma("unroll") for (int _i = 0; _i < 2; ++_i) { \
            const unsigned ro_ = p.rowbytes(ginfo[(par) * 512 + (half) * 128 + RA[_i]] & 0x7fffffff) + voffA[_i]; \
            __builtin_amdgcn_global_load_lds((const unsigned*)((const char*)(gbase) + ro_), (LAS unsigned*)(lds + (bufoff) + ldsw + _i * 8192), 16, 0, 0); } } \
        else PG8_STAGE(bufoff, (const char*)(gbase) + (half) * hA, voffA); } while (0)
    const char* cB = p.bptr(cur);
    if constexpr (P::MID) p.mid_prepare(cur, rsl, tid);
    PG8_STAGE(PG8_SB(0, 0), cB, voffB); PG8_STAGE(PG8_SB(0, 1), cB + hstep, voffB); PG8_STAGE_A(PG8_SA(0, 0), cA, 0, 0); PG8_STAGE_A(PG8_SA(0, 1), cA, 0, 1);
    if (wr == 1) PG8_BAR;
    PG8_WAIT_V(2); PG8_BAR;
    PG8_STAGE(PG8_SB(1, 0), cB + kstep, voffB); PG8_STAGE_A(PG8_SA(1, 0), cA + kstep, 0, 0); PG8_STAGE(PG8_SB(1, 1), cB + hstep + kstep, voffB);
    PG8_WAIT_V(6); PG8_BAR;
    for (;;) {
        const bool has_next = S.next(ui + 1, nxt);
        const char* nB = cB; nA = cA;
        const int cpar = ui & 1; int npar = cpar;
        if (has_next) {
            nB = p.bptr(nxt); npar = cpar ^ 1;
            if constexpr (P::GATHER) { if (tid < 256) p.fill_rows(nxt, ginfo + npar * 512, tid); }
            else nA = abase + (size_t)nxt.pm * tstep;
            if constexpr (P::MID) p.mid_prepare(nxt, rsl + 256 * ((ui + 1) & 1), tid);
        }
#pragma unroll 1
        for (int t = 0; t < nt; t += 2) {
            const bool last = (t == nt - 2);
            if constexpr (P::MID) {
                if (t == nt / 2) {
                    const LAS float* rs = rsl + 256 * (ui & 1);
#pragma unroll
                    for (int a = 0; a < 2; ++a)
#pragma unroll
                        for (int m = 0; m < 4; ++m) { const float sc = rs[a * 128 + wr * 64 + m * 16 + fr];
#pragma unroll
                            for (int b = 0; b < 2; ++b)
#pragma unroll
                                for (int n = 0; n < 2; ++n) acc[a][b][m][n] *= sc; }
                }
            }
            const char* a1 = cA + (size_t)(t + 1) * kstep;
            const char* a2 = last ? nA : cA + (size_t)(t + 2) * kstep; const char* b2 = last ? nB : cB + (size_t)(t + 2) * kstep;
            const char* a3 = a2 + kstep; const char* b3 = b2 + kstep;
            const int par2 = last ? npar : cpar;
            PG8_LDB(B0, 0, 0); PG8_LDB(B1, 0, 1); PG8_SCHED; PG8_LDA(At, 0, 0); PG8_STAGE_A(PG8_SA(1, 1), a1, cpar, 1);
            PG8_WAIT_V(8); PG8_WAIT_L(0); PG8_BAR; PG8_MMA(0, 0, At, B0); PG8_MMA(0, 1, At, B1); PG8_BAR; PG8_SCHED;
            PG8_LDA(At, 0, 1); PG8_STAGE(PG8_SB(0, 0), b2, voffB); PG8_STAGE(PG8_SB(0, 1), b2 + hstep, voffB); PG8_STAGE_A(PG8_SA(0, 0), a2, par2, 0);
            PG8_WAIT_V(8); PG8_WAIT_L(0); PG8_BAR; PG8_MMA(1, 0, At, B0); PG8_MMA(1, 1, At, B1); PG8_BAR; PG8_SCHED;
            PG8_LDB(B0, 1, 0); PG8_LDB(B1, 1, 1); PG8_SCHED; PG8_LDA(At, 1, 0); PG8_STAGE_A(PG8_SA(0, 1), a2, par2, 1);
            PG8_WAIT_V(8); PG8_WAIT_L(0); PG8_BAR; PG8_MMA(0, 0, At, B0); PG8_MMA(0, 1, At, B1); PG8_BAR; PG8_SCHED;
            PG8_LDA(At, 1, 1); PG8_STAGE(PG8_SB(1, 0), b3, voffB); PG8_STAGE(PG8_SB(1, 1), b3 + hstep, voffB); PG8_STAGE_A(PG8_SA(1, 0), a3, par2, 0);
            PG8_WAIT_V(8); PG8_WAIT_L(0); PG8_BAR; PG8_MMA(1, 0, At, B0); PG8_MMA(1, 1, At, B1); PG8_BAR; PG8_SCHED;
        }
        if (wr == 0) PG8_BAR;
        if constexpr (P::FP8) asm volatile("s_nop 15\n\ts_nop 7" ::: "memory");
        {
            const int cb = wc * 32 + fq * 8;
#define PG8_EPI_LOOP(RI, CALL) do { const auto pre = p.pre(cur, cb); (void)pre; \
                _Pragma("unroll") for (int a = 0; a < 2; ++a) { \
                    int lrow = a * 128 + wr * 64 + fr; decltype(RI) ris[4]; \
                    _Pragma("unroll") for (int m = 0; m < 4; ++m) { lrow = a * 128 + wr * 64 + m * 16 + fr; ris[m] = RI; } \
                    _Pragma("unroll") for (int m = 0; m < 4; ++m) { lrow = a * 128 + wr * 64 + m * 16 + fr; const auto ri = ris[m]; CALL; } } } while (0)
            if constexpr (P::KINDS) {
                const int kd = __builtin_amdgcn_readfirstlane(p.kind(cur));
                if (kd == 1) p.knorm(cur, acc, wc, lane);
                if (kd == 0) PG8_EPI_LOOP(p.template rowpart<0>(cur, lrow), p.template epik<0>(cur, ri, cb, acc[a][0][m][0], acc[a][0][m][1], acc[a][1][m][0], acc[a][1][m][1]));
                else if (kd == 1) PG8_EPI_LOOP(p.template rowpart<1>(cur, lrow), p.template epik<1>(cur, ri, cb, acc[a][0][m][0], acc[a][0][m][1], acc[a][1][m][0], acc[a][1][m][1]));
                else if (kd == 2) PG8_EPI_LOOP(p.template rowpart<2>(cur, lrow), p.template epik<2>(cur, ri, cb, acc[a][0][m][0], acc[a][0][m][1], acc[a][1][m][0], acc[a][1][m][1]));
                else PG8_EPI_LOOP(p.template rowpart<3>(cur, lrow), p.template epik<3>(cur, ri, cb, acc[a][0][m][0], acc[a][0][m][1], acc[a][1][m][0], acc[a][1][m][1]));
            } else {
                if constexpr (P::GATHER) {
                    const LAS int* gi_ = ginfo + (ui & 1) * 512; const auto pre = p.pre(cur, cb); const bool odd = (fq & 1) != 0; const int cbs = cb - (odd ? 8 : 0);
                    decltype(p.rowinfo_lds(gi_, 0)) rA[2][2], rB[2][2]; int rS[2][2];
#pragma unroll
                    for (int a = 0; a < 2; ++a)
#pragma unroll
                        for (int mp = 0; mp < 2; ++mp) { const int lr0 = a * 128 + wr * 64 + mp * 32 + fr; rA[a][mp] = p.rowinfo_lds(gi_, lr0); rB[a][mp] = p.rowinfo_lds(gi_, lr0 + 16); rS[a][mp] = p.rowidx(p.rowinfo_lds(gi_, lr0 + (odd ? 16 : 0))); }
                    asm volatile("s_waitcnt lgkmcnt(0)" ::: "memory");
#pragma unroll
                    for (int a = 0; a < 2; ++a) {
#pragma unroll
                        for (int mp = 0; mp < 2; ++mp) {
                            const auto ri0 = rA[a][mp], ri1 = rB[a][mp];
                            const i32x4 x0 = p.val(cur, pre, ri0, acc[a][0][2 * mp][0], acc[a][0][2 * mp][1], acc[a][1][2 * mp][0], acc[a][1][2 * mp][1]);
                            const i32x4 x1 = p.val(cur, pre, ri1, acc[a][0][2 * mp + 1][0], acc[a][0][2 * mp + 1][1], acc[a][1][2 * mp + 1][0], acc[a][1][2 * mp + 1][1]);
                            const int asel = rS[a][mp];
#pragma unroll
                            for (int q = 0; q < P::NW; ++q) {
                                const auto lo = __builtin_amdgcn_permlane16_swap((unsigned)x0[2 * q], (unsigned)x1[2 * q], false, false), hi = __builtin_amdgcn_permlane16_swap((unsigned)x0[2 * q + 1], (unsigned)x1[2 * q + 1], false, false);
                                i32x4 w; w[0] = (int)lo[0]; w[1] = (int)hi[0]; w[2] = (int)lo[1]; w[3] = (int)hi[1];
                                p.store16(cur, asel, cbs, q, w);
                            }
                        }
                    }
                }
                else PG8_EPI_LOOP(p.rowinfo(cur, lrow), p.epi(cur, pre, ri, lrow, cb, acc[a][0][m][0], acc[a][0][m][1], acc[a][1][m][0], acc[a][1][m][1]));
            }
#undef PG8_EPI_LOOP
        }
        if (!has_next) break;
#pragma unroll
        for (int a = 0; a < 2; ++a)
#pragma unroll
            for (int b = 0; b < 2; ++b)
#pragma unroll
                for (int m = 0; m < 4; ++m)
#pragma unroll
                    for (int n = 0; n < 2; ++n) acc[a][b][m][n] = (f32x4){0.f, 0.f, 0.f, 0.f};
        cur = nxt; cB = nB; cA = nA; ++ui;
        if (wr == 1) PG8_BAR;
    }
    PG8_WAIT_V(0);
    PG8_BAR;
#undef PG8_SA
#undef PG8_SB
#undef PG8_STAGE
#undef PG8_STAGE_A
#undef PG8_LDA
#undef PG8_LDB
#undef PG8_MMA
#undef PG8_WAIT_V
#undef PG8_WAIT_L
#undef PG8_BAR
#undef PG8_SCHED
}
}

struct NoPre {};
__device__ __forceinline__ int pack_fp8x4(float a, float b, float c, float d) { int w = 0; w = __builtin_amdgcn_cvt_pk_fp8_f32(a, b, w, false); w = __builtin_amdgcn_cvt_pk_fp8_f32(c, d, w, true); return w; }
constexpr float WGU_SCALE = 32.0f, WDN_SCALE = 64.0f, ACT_SCALE = 4.0f, SLAB_SCALE = 16.0f, RQ_SCALE = 8.0f;
__device__ __forceinline__ h8 pack8(f32x4 lo, f32x4 hi) { h8 o; o[0] = (f16)lo[0]; o[1] = (f16)lo[1]; o[2] = (f16)lo[2]; o[3] = (f16)lo[3]; o[4] = (f16)hi[0]; o[5] = (f16)hi[1]; o[6] = (f16)hi[2]; o[7] = (f16)hi[3]; return o; }
struct ProbInproj {
    static constexpr int K = 1024; static constexpr bool KINDS = true; static constexpr bool GATHER = false; static constexpr bool FP8 = false; static constexpr bool MID = false;
    const char* xh; const char* win; f16 *qh, *kt, *vt, *ug; gu32* kmax;
    __device__ __forceinline__ const char* abase() const { return xh; }
    __device__ __forceinline__ unsigned rowoff(const pg8::Unit& u, int r) const { return (unsigned)(u.pm * 256 + r) * (unsigned)(K * 2); }
    __device__ __forceinline__ const char* bptr(const pg8::Unit& u) const { return win + (size_t)u.pn * 256 * K * 2; }
    __device__ __forceinline__ NoPre pre(const pg8::Unit&, int) const { return NoPre{}; }
    __device__ __forceinline__ int kind(const pg8::Unit& u) const { return u.pn >> 1; }
    __device__ __forceinline__ void knorm(const pg8::Unit& u, const f32x4 (&acc)[2][2][4][2], int wc, int lane) const {
#pragma unroll
        for (int b = 0; b < 2; ++b) {
            float mx = 0.f;
#pragma unroll
            for (int a = 0; a < 2; ++a)
#pragma unroll
                for (int m = 0; m < 4; ++m) { const f32x4 x = acc[a][b][m][0], y = acc[a][b][m][1];
                    float q = (x[0] * x[0] + x[1] * x[1]) + (x[2] * x[2] + x[3] * x[3]) + (y[0] * y[0] + y[1] * y[1]) + (y[2] * y[2] + y[3] * y[3]);
                    q += __shfl_xor(q, 16); q += __shfl_xor(q, 32); mx = fmaxf(mx, q); }
            mx = fmaxf(mx, __shfl_xor(mx, 1)); mx = fmaxf(mx, __shfl_xor(mx, 2)); mx = fmaxf(mx, __shfl_xor(mx, 4)); mx = fmaxf(mx, __shfl_xor(mx, 8));
            if (lane == 0) { const int bt = (u.pm * 256) >> 13, hd = (u.pn & 1) * 4 + 2 * b + (wc >> 1), mp = wc & 1;
                __hip_atomic_fetch_max(kmax + (bt * 8 + hd) * 2 + mp, __float_as_uint(sqrtf(mx)), RLX_AGENT); }
        }
    }
    template <int KIND> __device__ __forceinline__ unsigned rowpart(const pg8::Unit& u, int lr) const {
        const int row = u.pm * 256 + lr, b = row >> 13, tt = row & 8191, tile = tt >> 6, key = tt & 63;
        if (KIND == 0) return (unsigned)row * 512u;
        if (KIND == 1) return (unsigned)((b * 8 * 128 + tile) * 4096 + key * 8);
        if (KIND == 2) { const int sx = key >> 4, w = key & 15, hh = (w >> 2) & 1, j = (w & 3) + 4 * (w >> 3); return (unsigned)((b * 8 * 128 + tile) * 4096 + (2 * sx + hh) * 512 + j); }
        return (unsigned)((b * 32 * 8192 + tt) * 16);
    }
    template <int KIND> __device__ __forceinline__ void epik(const pg8::Unit& u, unsigned rp, int cb, f32x4 v00, f32x4 v01, f32x4 v10, f32x4 v11) const {
#pragma unroll
        for (int b = 0; b < 2; ++b) {
            const int col = (u.pn & 1) * 256 + b * 128 + cb; const f32x4 lo = b ? v10 : v00, hi = b ? v11 : v01;
            if (KIND == 0) { *(h8*)(qh + rp + col) = pack8(lo * QSCALE, hi * QSCALE); }
            else if (KIND == 1) { const int hd = col >> 6, d = col & 63; *(h8*)(kt + rp + (unsigned)(hd * 128 * 4096 + (d >> 3) * 512)) = pack8(lo, hi); }
            else if (KIND == 2) { const int hd = col >> 6, dv = col & 63; f16* q = vt + rp + (unsigned)(hd * 128 * 4096 + dv * 8);
                q[0] = (f16)lo[0]; q[8] = (f16)lo[1]; q[16] = (f16)lo[2]; q[24] = (f16)lo[3]; q[32] = (f16)hi[0]; q[40] = (f16)hi[1]; q[48] = (f16)hi[2]; q[56] = (f16)hi[3]; }
            else { const int g = col >> 4, c0 = col & 15; *(h8*)(ug + rp + (unsigned)(g * 8192 * 16 + c0)) = pack8(lo, hi); }
        }
    }
};
struct ProbPleProj {
    static constexpr int K = 256; static constexpr bool KINDS = false; static constexpr bool GATHER = false; static constexpr bool FP8 = false; static constexpr bool MID = false;
    const char* ph; const char* wpp; f16* pe;
    __device__ __forceinline__ const char* abase() const { return ph; }
    __device__ __forceinline__ unsigned rowoff(const pg8::Unit& u, int r) const { return (unsigned)(u.pm * 256 + r) * (unsigned)(K * 2); }
    __device__ __forceinline__ const char* bptr(const pg8::Unit& u) const { return wpp + (size_t)u.pn * 256 * K * 2; }
    __device__ __forceinline__ NoPre pre(const pg8::Unit&, int) const { return NoPre{}; }
    __device__ __forceinline__ int rowinfo(const pg8::Unit&, int) const { return 0; }
    __device__ __forceinline__ void epi(const pg8::Unit& u, NoPre, int, int lr, int cb, f32x4 v00, f32x4 v01, f32x4 v10, f32x4 v11) const {
        f16* o = pe + (size_t)(u.pm * 256 + lr) * 1024 + u.pn * 256 + cb; *(h8*)o = pack8(v00, v01); *(h8*)(o + 128) = pack8(v10, v11); }
};
struct ProbGlu {
    static constexpr int K = 512; static constexpr bool KINDS = false; static constexpr bool GATHER = false; static constexpr bool FP8 = false; static constexpr bool MID = false;
    const char* yh; const char* wg; f16* mix; float* yss;
    __device__ __forceinline__ const char* abase() const { return yh; }
    __device__ __forceinline__ unsigned rowoff(const pg8::Unit& u, int r) const { return (unsigned)(u.pm * 256 + r) * (unsigned)(K * 2); }
    __device__ __forceinline__ const char* bptr(const pg8::Unit& u) const { return wg + (size_t)u.pn * 256 * K * 2; }
    __device__ __forceinline__ NoPre pre(const pg8::Unit&, int) const { return NoPre{}; }
    __device__ __forceinline__ int rowinfo(const pg8::Unit&, int) const { return 0; }
    __device__ __forceinline__ void epi(const pg8::Unit& u, NoPre, int, int lr, int cb, f32x4 v00, f32x4 v01, f32x4 v10, f32x4 v11) const {
        h8 o; float ss = 0.f;
#pragma unroll
        for (int e = 0; e < 4; ++e) { const float y0 = v00[e] * sigmoidf_(v10[e]), y1 = v01[e] * sigmoidf_(v11[e]); o[e] = (f16)y0; o[4 + e] = (f16)y1; ss += y0 * y0 + y1 * y1; }
        *(h8*)(mix + (size_t)(u.pm * 256 + lr) * 1024 + u.pn * 128 + cb) = o;
        ss += __shfl_xor(ss, 16); ss += __shfl_xor(ss, 32);
        if (((cb >> 3) & 3) == 0) yss[(size_t)(u.pm * 256 + lr) * 16 + u.pn * 4 + (cb >> 5)] = ss; }
};
struct ProbOut {
    static constexpr int K = 1024; static constexpr bool KINDS = false; static constexpr bool GATHER = false; static constexpr bool FP8 = false; static constexpr bool MID = true;
    const char* mixb; const char* wo; f16* mixo; const float* yss;
    __device__ __forceinline__ const char* abase() const { return mixb; }
    __device__ __forceinline__ unsigned rowoff(const pg8::Unit& u, int r) const { return (unsigned)(u.pm * 256 + r) * (unsigned)(K * 2); }
    __device__ __forceinline__ const char* bptr(const pg8::Unit& u) const { return wo + (size_t)u.pn * 256 * K * 2; }
    __device__ __forceinline__ NoPre pre(const pg8::Unit&, int) const { return NoPre{}; }
    __device__ __forceinline__ int rowinfo(const pg8::Unit&, int) const { return 0; }
    __device__ __forceinline__ void mid_prepare(const pg8::Unit& u, LAS float* slot, int tid) const {
        const int row = tid >> 1; const f32x4* q = (const f32x4*)(yss + (size_t)(u.pm * 256 + row) * 16 + (tid & 1) * 8);
        const f32x4 a = q[0], b = q[1]; float sacc = ((a[0] + a[1]) + (a[2] + a[3])) + ((b[0] + b[1]) + (b[2] + b[3]));
        sacc += __shfl_xor(sacc, 1);
        if (!(tid & 1)) slot[row] = rsqrtf(sacc * (1.0f / 512.0f) + RMS_EPS);
    }
    __device__ __forceinline__ void epi(const pg8::Unit& u, NoPre, int, int lr, int cb, f32x4 v00, f32x4 v01, f32x4 v10, f32x4 v11) const {
        f16* o = mixo + (size_t)(u.pm * 256 + lr) * 1024 + u.pn * 256 + cb; *(h8*)o = pack8(v00, v01); *(h8*)(o + 128) = pack8(v10, v11); }
};
struct Pre16 { f32x4 a, b, c, d; };
struct ProbMoeUp {
    static constexpr int K = 1024; static constexpr bool KINDS = false; static constexpr bool GATHER = true; static constexpr bool FP8 = true; static constexpr bool MID = false;
    const char* x1q; const char* wgu; const int* list; const float* bias; unsigned char* act;
    __device__ __forceinline__ const char* abase() const { return x1q; }
    __device__ __forceinline__ unsigned rowoff(const pg8::Unit&, int) const { return 0u; }
    __device__ __forceinline__ void fill_rows(const pg8::Unit& u, LAS int* tabp, int r) const { const int i = u.pm * 256 + r; const bool ok = i < u.cnt; const int a = list[(size_t)u.e * ECAP + (ok ? i : 0)]; tabp[r] = ok ? a : (a | (int)0x80000000); }
    __device__ __forceinline__ unsigned rowbytes(int a) const { return (unsigned)(a >> 2) * (unsigned)K; }
    __device__ __forceinline__ int rowinfo_lds(const LAS int* tabp, int lr) const { return tabp[lr]; }
    __device__ __forceinline__ const char* bptr(const pg8::Unit& u) const { return wgu + ((size_t)u.e * 2048 + (size_t)u.pn * 256) * K; }
    __device__ __forceinline__ Pre16 pre(const pg8::Unit& u, int cb) const {
        const float* bp = bias + u.e * 2048 + 2 * (u.pn * 128 + cb); Pre16 r; r.a = *(const f32x4*)bp; r.b = *(const f32x4*)(bp + 4); r.c = *(const f32x4*)(bp + 8); r.d = *(const f32x4*)(bp + 12); return r; }
    __device__ __forceinline__ int rowinfo(const pg8::Unit& u, int lr) const { const int i = u.pm * 256 + lr; return i < u.cnt ? list[(size_t)u.e * ECAP + i] : -1; }
    static constexpr int NW = 1;
    __device__ __forceinline__ int rowidx(int a) const { return a; }
    __device__ __forceinline__ i32x4 val(const pg8::Unit&, const Pre16& pb, int, f32x4 v00, f32x4 v01, f32x4 v10, f32x4 v11) const {
        const float bg[8] = {pb.a[0], pb.a[2], pb.b[0], pb.b[2], pb.c[0], pb.c[2], pb.d[0], pb.d[2]}, bl[8] = {pb.a[1], pb.a[3], pb.b[1], pb.b[3], pb.c[1], pb.c[3], pb.d[1], pb.d[3]};
        float o[8];
#pragma unroll
        for (int e = 0; e < 8; ++e) { const float g = fminf((e < 4 ? v00[e] : v01[e - 4]) * (1.0f / WGU_SCALE) + bg[e], 7.0f), l = fminf(fmaxf((e < 4 ? v10[e] : v11[e - 4]) * (1.0f / WGU_SCALE) + bl[e], -7.0f), 7.0f);
            o[e] = g * sigmoidf_(1.702f * g) * (l + 1.0f) * ACT_SCALE; }
        i32x4 w; w[0] = pack_fp8x4(o[0], o[1], o[2], o[3]); w[1] = pack_fp8x4(o[4], o[5], o[6], o[7]); w[2] = 0; w[3] = 0; return w; }
    __device__ __forceinline__ void store16(const pg8::Unit& u, int a, int cbs, int, i32x4 w) const { if (a < 0) return; *(i32x4*)(act + (size_t)a * 1024 + u.pn * 128 + cbs) = w; }
};
struct RowAG { int a; float g; };
struct ProbMoeDn {
    static constexpr int K = 1024; static constexpr bool KINDS = false; static constexpr bool GATHER = true; static constexpr bool FP8 = true; static constexpr bool MID = false;
    const char* actb; const char* wdn; const int* list; const float* bias; const float* gates; unsigned char* slab;
    __device__ __forceinline__ const char* abase() const { return actb; }
    __device__ __forceinline__ unsigned rowoff(const pg8::Unit&, int) const { return 0u; }
    __device__ __forceinline__ void fill_rows(const pg8::Unit& u, LAS int* tabp, int r) const { const int i = u.pm * 256 + r; const bool ok = i < u.cnt; const int a = list[(size_t)u.e * ECAP + (ok ? i : 0)];
        tabp[r] = ok ? a : (a | (int)0x80000000); tabp[256 + r] = __float_as_int(ok ? gates[a] : 0.f); }
    __device__ __forceinline__ unsigned rowbytes(int a) const { return (unsigned)a * (unsigned)K; }
    __device__ __forceinline__ RowAG rowinfo_lds(const LAS int* tabp, int lr) const { RowAG r; r.a = tabp[lr]; r.g = __int_as_float(tabp[256 + lr]); return r; }
    __device__ __forceinline__ const char* bptr(const pg8::Unit& u) const { return wdn + ((size_t)u.e * 1024 + (size_t)u.pn * 256) * K; }
    __device__ __forceinline__ Pre16 pre(const pg8::Unit& u, int cb) const {
        const float* bp = bias + u.e * 1024 + u.pn * 256 + cb; Pre16 r; r.a = *(const f32x4*)bp; r.b = *(const f32x4*)(bp + 4); r.c = *(const f32x4*)(bp + 128); r.d = *(const f32x4*)(bp + 132); return r; }
    __device__ __forceinline__ RowAG rowinfo(const pg8::Unit& u, int lr) const { const int i = u.pm * 256 + lr; RowAG r; r.a = i < u.cnt ? list[(size_t)u.e * ECAP + i] : -1; r.g = r.a >= 0 ? gates[r.a] : 0.f; return r; }
    static constexpr int NW = 2;
    __device__ __forceinline__ int rowidx(const RowAG& r) const { return r.a; }
    __device__ __forceinline__ i32x4 val(const pg8::Unit&, const Pre16& pb, const RowAG& ri, f32x4 v00, f32x4 v01, f32x4 v10, f32x4 v11) const {
        constexpr float S = 1.0f / (WDN_SCALE * ACT_SCALE);
        const float g = ri.g * SLAB_SCALE;
        f32x4 a = (v00 * S + pb.a) * g, b = (v01 * S + pb.b) * g, c = (v10 * S + pb.c) * g, d = (v11 * S + pb.d) * g;
#pragma unroll
        for (int e = 0; e < 4; ++e) { a[e] = fminf(fmaxf(a[e], -448.f), 448.f); b[e] = fminf(fmaxf(b[e], -448.f), 448.f); c[e] = fminf(fmaxf(c[e], -448.f), 448.f); d[e] = fminf(fmaxf(d[e], -448.f), 448.f); }
        i32x4 w; w[0] = pack_fp8x4(a[0], a[1], a[2], a[3]); w[1] = pack_fp8x4(b[0], b[1], b[2], b[3]); w[2] = pack_fp8x4(c[0], c[1], c[2], c[3]); w[3] = pack_fp8x4(d[0], d[1], d[2], d[3]); return w; }
    __device__ __forceinline__ void store16(const pg8::Unit& u, int a_, int cbs, int q, i32x4 w) const { if (a_ < 0) return; *(i32x4*)(slab + (size_t)a_ * 1024 + u.pn * 256 + q * 128 + cbs) = w; }
};
struct ProbPleGate {
    static constexpr int K = 1024; static constexpr bool KINDS = false; static constexpr bool GATHER = false; static constexpr bool FP8 = true; static constexpr bool MID = false;
    const char* rq; const char* wpg; f16* gateh;
    __device__ __forceinline__ const char* abase() const { return rq; }
    __device__ __forceinline__ unsigned rowoff(const pg8::Unit& u, int r) const { return (unsigned)(u.pm * 256 + r) * (unsigned)K; }
    __device__ __forceinline__ const char* bptr(const pg8::Unit& u) const { return wpg + (size_t)u.pn * 256 * K; }
    __device__ __forceinline__ NoPre pre(const pg8::Unit&, int) const { return NoPre{}; }
    __device__ __forceinline__ int rowinfo(const pg8::Unit&, int) const { return 0; }
    __device__ __forceinline__ void epi(const pg8::Unit& u, NoPre, int, int lr, int cb, f32x4 v00, f32x4 v01, f32x4 v10, f32x4 v11) const {
        f16* o = gateh + (size_t)(u.pm * 256 + lr) * 1024 + u.pn * 256 + cb;
        constexpr float S = 1.0f / (WDN_SCALE * RQ_SCALE);
        f32x4 a, b, c, d;
#pragma unroll
        for (int e = 0; e < 4; ++e) { a[e] = sigmoidf_(v00[e] * S); b[e] = sigmoidf_(v01[e] * S); c[e] = sigmoidf_(v10[e] * S); d[e] = sigmoidf_(v11[e] * S); }
        *(h8*)o = pack8(a, b); *(h8*)(o + 128) = pack8(c, d); }
};

__device__ __forceinline__ int invperm32(int c) { return 16 * ((c >> 2) & 1) + 4 * (c >> 3) + (c & 3); }
__device__ __forceinline__ void tr_item(const float* W, int K, int N, f16* WT, int item, int mode, const float* gsc, LAS float* scr, int lane) {
    const int nblk = N / 32, kb = item / nblk, nb = item % nblk, k0 = 64 * kb, n0 = 32 * nb;
#pragma unroll 8
    for (int i = 0; i < 32; ++i) {
        const int kk = 2 * i + (lane >> 5);
        float v = W[(size_t)(k0 + kk) * N + n0 + (lane & 31)];
        if (mode == 2 && k0 + kk >= 512) v *= gsc[k0 + kk - 512];
        scr[kk * 33 + (lane & 31)] = v;
    }
    asm volatile("s_waitcnt lgkmcnt(0)" ::: "memory");
    const int c = lane & 7;
#pragma unroll
    for (int j = 0; j < 4; ++j) {
        const int n = (lane >> 3) + 8 * j; const LAS float* s = scr + (8 * c) * 33 + n;
        const int ns = n0 + n; int nd;
        if (mode == 1 || mode == 3) { const int ja = mode == 1 ? (ns & 511) : (ns >> 1), bj = mode == 1 ? (ns >> 9) : (ns & 1), jl = ja & 127;
            nd = 256 * (ja >> 7) + 128 * bj + (jl & ~31) + invperm32(jl & 31); }
        else nd = (ns & ~31) + invperm32(ns & 31);
        int kd = k0 + 8 * c; if (mode == 2) kd = (kd + 512) & 1023;
        if (mode >= 3) {
            const float sc = mode == 3 ? WGU_SCALE : WDN_SCALE;
            typedef int i32x2 __attribute__((ext_vector_type(2)));
            i32x2 o; o[0] = pack_fp8x4(s[0] * sc, s[33] * sc, s[66] * sc, s[99] * sc); o[1] = pack_fp8x4(s[132] * sc, s[165] * sc, s[198] * sc, s[231] * sc);
            *(i32x2*)((unsigned char*)WT + (size_t)nd * K + kd) = o;
        } else {
            h8 o; o[0] = (f16)s[0]; o[1] = (f16)s[33]; o[2] = (f16)s[66]; o[3] = (f16)s[99]; o[4] = (f16)s[132]; o[5] = (f16)s[165]; o[6] = (f16)s[198]; o[7] = (f16)s[231];
            *(h8*)(WT + (size_t)nd * K + kd) = o;
        }
    }
    asm volatile("s_waitcnt lgkmcnt(0)" ::: "memory");
}

__device__ __forceinline__ void ssm_precompute(Frame& F, int g) {
    const Args& A = *F.a; const int tid = F.tid;
    LAS float* pwr = (LAS float*)F.lds;
    LAS float* pwi = pwr + 17 * 64;
    LAS float* Bbr = pwi + 17 * 64;
    LAS float* Bbi = Bbr + 1024;
    LAS float* Cr = Bbi + 1024;
    LAS float* Ci = Cr + 1024;
    LAS float* Kd = Ci + 1024;
    if (tid < 64) {
        const int p = tid;
        const float are = A.in[I_ARE][g * 64 + p], aim = A.in[I_AIM][g * 64 + p], dt = __expf(A.in[I_LOGDT][g]);
        for (int d = 0; d <= 16; ++d) { const float mag = __expf(are * dt * (float)d); float sn, cs; sincosf(aim * dt * (float)d, &sn, &cs); pwr[d * 64 + p] = mag * cs; pwi[d * 64 + p] = mag * sn; }
        const float abr = pwr[64 + p], abi = pwi[64 + p];
        const float nr = abr - 1.0f, ni = abi, den = 1.0f / (are * are + aim * aim);
        const float fr_ = (nr * are + ni * aim) * den, fi_ = (ni * are - nr * aim) * den;
        for (int c = 0; c < 16; ++c) { const float br = A.in[I_BRE][(g * 64 + p) * 16 + c], bi = A.in[I_BIM][(g * 64 + p) * 16 + c]; Bbr[p * 16 + c] = fr_ * br - fi_ * bi; Bbi[p * 16 + c] = fr_ * bi + fi_ * br; }
        float* a16 = (float*)(F.ws + WS_A16) + (g * 64 + p) * 2; a16[0] = pwr[16 * 64 + p]; a16[1] = pwi[16 * 64 + p];
    }
    for (int i = tid; i < 1024; i += NTHREADS) { Cr[i] = A.in[I_CRE][g * 1024 + i]; Ci[i] = A.in[I_CIM][g * 1024 + i]; }
    __syncthreads();
    for (int q = 0; q < 8; ++q) {
        const int idx = tid * 8 + q, d = idx >> 8, cp = (idx >> 4) & 15, c = idx & 15; float acc = 0.f;
        for (int p = 0; p < 64; ++p) { const float cr = Cr[cp * 64 + p], ci = Ci[cp * 64 + p], pr = pwr[d * 64 + p], pi = pwi[d * 64 + p];
            const float zr = cr * pr - ci * pi, zi = cr * pi + ci * pr; acc += zr * Bbr[p * 16 + c] - zi * Bbi[p * 16 + c]; }
        Kd[idx] = acc;
    }
    __syncthreads();
    f16* ops = (f16*)(F.ws + WS_SSMOP) + (size_t)g * 131072;
    f16* Top = ops; f16* We = ops + 65536; f16* Wc = ops + 65536 + 32768;
    for (int v = tid; v < 8192; v += NTHREADS) {
        const int row = v >> 5, kv = v & 31, j = kv >> 1, half = kv & 1, i = row >> 4, cp = row & 15; h8 o;
#pragma unroll
        for (int e = 0; e < 8; ++e) o[e] = (j <= i) ? (f16)Kd[((i - j) * 16 + cp) * 16 + 8 * half + e] : (f16)0.f;
        *(h8*)(Top + row * 256 + kv * 8) = o;
    }
    for (int v = tid; v < 4096; v += NTHREADS) {
        const int sx = v >> 5, kv = v & 31, j = kv >> 1, half = kv & 1, p = sx & 63; const float pr = pwr[(15 - j) * 64 + p], pi = pwi[(15 - j) * 64 + p]; h8 o;
#pragma unroll
        for (int e = 0; e < 8; ++e) { const float br = Bbr[p * 16 + 8 * half + e], bi = Bbi[p * 16 + 8 * half + e]; o[e] = (f16)(sx < 64 ? pr * br - pi * bi : pr * bi + pi * br); }
        *(h8*)(We + sx * 256 + kv * 8) = o;
    }
    for (int v = tid; v < 4096; v += NTHREADS) {
        const int row = v >> 4, kv = v & 15, i = row >> 4, cp = row & 15; h8 o;
#pragma unroll
        for (int e = 0; e < 8; ++e) { const int sx = 8 * kv + e, p = sx & 63; const float cr = Cr[cp * 64 + p], ci = Ci[cp * 64 + p], pr = pwr[(i + 1) * 64 + p], pi = pwi[(i + 1) * 64 + p];
            o[e] = (f16)(sx < 64 ? cr * pr - ci * pi : -(cr * pi + ci * pr)); }
        *(h8*)(Wc + row * 128 + kv * 8) = o;
    }
    __syncthreads();
}

__device__ __forceinline__ void p0_prologue(Frame& F) {
    const Args& A = *F.a;
    if (blockIdx.x < NG) ssm_precompute(F, (int)blockIdx.x);
    LAS float* scr = (LAS float*)(F.lds + F.wave * 16384);
    constexpr int I0 = 16 * 64, I1 = 8 * 32, I2 = 16 * 32, I3 = 16 * 32, I4 = 4 * 32, I5 = NE * 16 * 64, I6 = NE * 16 * 32;
    constexpr int NIT = I0 + I1 + I2 + I3 + I4 + I5;
    for (int it = F.gw; it < NIT; it += F.NGW) {
        int r = it;
        if (r < I0) { tr_item(A.in[I_WIN], 1024, 2048, (f16*)(F.ws + WS_WIN), r, 0, nullptr, scr, F.lane); continue; } r -= I0;
        if (r < I1) { tr_item(A.in[I_WGLU], 512, 1024, (f16*)(F.ws + WS_WGLU), r, 1, nullptr, scr, F.lane); continue; } r -= I1;
        if (r < I2) { tr_item(A.in[I_WOUT], 1024, 1024, (f16*)(F.ws + WS_WOUT), r, 2, A.in[I_SSMG], scr, F.lane); continue; } r -= I2;
        if (r < I3) { tr_item(A.in[I_WPG], 1024, 1024, (f16*)(F.ws + WS_WPG), r, 4, nullptr, scr, F.lane); continue; } r -= I3;
        if (r < I4) { tr_item(A.in[I_WPP], 256, 1024, (f16*)(F.ws + WS_WPP), r, 0, nullptr, scr, F.lane); continue; } r -= I4;
        if (r < I5) { const int e = r / (16 * 64), ii = r % (16 * 64);
            tr_item(A.in[I_WGU] + (size_t)e * 1024 * 2048, 1024, 2048, (f16*)(F.ws + WS_WGU + (size_t)e * 2048 * 1024), ii, 3, nullptr, scr, F.lane); continue; }
    }
    const size_t gt = (size_t)blockIdx.x * NTHREADS + F.tid, NT = (size_t)F.G * NTHREADS;
    { const f32x4* s = (const f32x4*)A.in[I_X]; h8* d = (h8*)(F.ws + WS_XH);
      for (size_t i = gt; i < (size_t)T * DM / 8; i += NT) { const f32x4 a = s[2 * i], b = s[2 * i + 1]; h8 o; o[0] = (f16)a[0]; o[1] = (f16)a[1]; o[2] = (f16)a[2]; o[3] = (f16)a[3]; o[4] = (f16)b[0]; o[5] = (f16)b[1]; o[6] = (f16)b[2]; o[7] = (f16)b[3]; d[i] = o; } }
    { const f32x4* s = (const f32x4*)A.in[I_P]; h8* d = (h8*)(F.ws + WS_PH);
      for (size_t i = gt; i < (size_t)T * PLE / 8; i += NT) { const f32x4 a = s[2 * i], b = s[2 * i + 1]; h8 o; o[0] = (f16)a[0]; o[1] = (f16)a[1]; o[2] = (f16)a[2]; o[3] = (f16)a[3]; o[4] = (f16)b[0]; o[5] = (f16)b[1]; o[6] = (f16)b[2]; o[7] = (f16)b[3]; d[i] = o; } }
}

__device__ __forceinline__ void p1_inproj(Frame& F) {
    { ProbInproj P{(const char*)(F.ws + WS_XH), (const char*)(F.ws + WS_WIN), (f16*)(F.ws + WS_QH), (f16*)(F.ws + WS_KT), (f16*)(F.ws + WS_VT), (f16*)(F.ws + WS_UG), F.ctl + CW_KMAX};
      pg8::DenseOrder S; S.init(T, DIN, F.G, (int)blockIdx.x); pg8::gemm_phase(F.lds, P, S); }
}

constexpr int ATT_SLOT = 32768, ATT_FLAGS = 3 * ATT_SLOT;
constexpr float ATT_SKIP = -40.0f;
constexpr int ATT_SG = 143360;
__device__ __forceinline__ int attn_unit(Frame& F, int b, int hd, int qb, float lam, gu32* qc, volatile LAS int* slot) {
    const int lane = F.lane, wave = F.wave, r32 = lane & 31, hi = lane >> 5;
    LAS unsigned char* lds = F.lds;
    const f16* qh = (const f16*)(F.ws + WS_QH);
    const f16* ktb = (const f16*)(F.ws + WS_KT) + (size_t)((b * 8 + hd) * 128) * 4096;
    const f16* vtb = (const f16*)(F.ws + WS_VT) + (size_t)((b * 8 + hd) * 128) * 4096;
    f16* mix = (f16*)(F.ws + WS_MIX);
    const int q0 = qb * 256, q0w = q0 + 32 * wave, NT = 4 * (qb + 1), NI = NT / 2; const size_t rowbase = (size_t)b * SEQ;
    volatile LAS int* flags = (volatile LAS int*)(lds + ATT_FLAGS);
#define ATT_ISSUE(ii) do { const int t0_ = NT - 1 - 2 * (ii); const unsigned so_ = (unsigned)(((ii) % 3) * ATT_SLOT + wave * 1024); \
        __builtin_amdgcn_global_load_lds((const unsigned*)(ktb + (size_t)t0_ * 4096 + wave * 512 + lane * 8), (LAS unsigned*)(lds + so_), 16, 0, 0); \
        __builtin_amdgcn_global_load_lds((const unsigned*)(vtb + (size_t)t0_ * 4096 + wave * 512 + lane * 8), (LAS unsigned*)(lds + so_ + 8192), 16, 0, 0); \
        __builtin_amdgcn_global_load_lds((const unsigned*)(ktb + (size_t)(t0_ - 1) * 4096 + wave * 512 + lane * 8), (LAS unsigned*)(lds + so_ + 16384), 16, 0, 0); \
        __builtin_amdgcn_global_load_lds((const unsigned*)(vtb + (size_t)(t0_ - 1) * 4096 + wave * 512 + lane * 8), (LAS unsigned*)(lds + so_ + 24576), 16, 0, 0); } while (0)
    ATT_ISSUE(0); ATT_ISSUE(1);
    if (lane == 0) { flags[wave] = 1; flags[8 + wave] = 1; }
    h8 qf[2][2];
#pragma unroll
    for (int mp = 0; mp < 2; ++mp)
#pragma unroll
        for (int kk = 0; kk < 2; ++kk) qf[mp][kk] = *(const h8*)(qh + (rowbase + q0w + r32) * 512 + hd * 64 + mp * 32 + kk * 16 + hi * 8);
    float sb1, sb2;
    { float n1 = 0.f, n2 = 0.f;
#pragma unroll
      for (int kk = 0; kk < 2; ++kk)
#pragma unroll
          for (int e = 0; e < 8; ++e) { const float a = (float)qf[0][kk][e], c = (float)qf[1][kk][e]; n1 += a * a; n2 += c * c; }
      n1 = swap_add(n1); n2 = swap_add(n2);
      const float k1 = __uint_as_float(__hip_atomic_load(F.ctl + CW_KMAX + (b * 8 + hd) * 2, RLX_AGENT)), k2 = __uint_as_float(__hip_atomic_load(F.ctl + CW_KMAX + (b * 8 + hd) * 2 + 1, RLX_AGENT));
      sb1 = sqrtf(n1) * k1 * 1.01f; sb2 = sqrtf(n2) * k2 * 1.01f; }
    const float slope2 = exp2f(-(float)(hd + 1)) * LOG2E;
    const int td = q0w >> 6, wo = q0w & 63;
    const f16 s_hi = (f16)slope2, s_lo = (f16)(slope2 - (float)s_hi);
    float mr1 = 0.f, mr2 = 0.f, l1 = 0.f, l2 = 0.f;
    h8 qx1, qx2;
    { h8 z; z[0] = (f16)(64.0f * (float)s_hi); z[1] = s_hi; z[2] = (f16)(64.0f * (float)s_lo); z[3] = s_lo; z[4] = (f16)0.f; z[5] = (f16)0.f; z[6] = (f16)0.f; z[7] = (f16)0.f;
      if (hi) { z[0] = (f16)0.f; z[1] = (f16)0.f; z[2] = (f16)0.f; z[3] = (f16)0.f; }
      qx1 = z; qx2 = z; }
    f32x16 o1[2], o2[2];
#pragma unroll
    for (int i = 0; i < 2; ++i) { o1[i] = (f32x16){}; o2[i] = (f32x16){}; }
    bool wdone = false, started = false;
    h2 ones; ones[0] = (f16)1.f; ones[1] = (f16)1.f;
#pragma unroll 1
    for (int ii = 0; ii < NI; ++ii) {
        if (ii + 1 < NI) asm volatile("s_waitcnt vmcnt(4) lgkmcnt(0)" ::: "memory"); else asm volatile("s_waitcnt vmcnt(0) lgkmcnt(0)" ::: "memory");
        __builtin_amdgcn_s_barrier();
        asm volatile("" ::: "memory");
        { const volatile LAS int* fl = flags + 8 * (ii & 1); const int any = fl[0] | fl[1] | fl[2] | fl[3] | fl[4] | fl[5] | fl[6] | fl[7];
          if (__builtin_amdgcn_readfirstlane(any) == 0) break; }
        if (ii + 2 < NI) ATT_ISSUE(ii + 2);
        bool need = !wdone;
        const int T0 = NT - 1 - 2 * ii, T1 = T0 - 1;
        if (T1 <= td && !wdone) {
            const bool first = !started; started = true;
            const LAS unsigned char* kp = lds + (ii % 3) * ATT_SLOT;
            const LAS unsigned char* kbase = kp + (hi * 512 + r32 * 8) * 2;
            const LAS unsigned char* vbase = kp + 8192 + (hi * 512 + r32 * 8) * 2;
            const float bmax = slope2 * (float)(64 * (T0 - td) + 63 - wo);
            const bool gen = first || T0 >= td || (__any(fmaxf(sb1 - mr1, sb2 - mr2) + bmax > 12.0f) != 0);
            const bool tlo = T0 > td;
            f32x16 s0[2], s1[2]; h8 kfr[4], vfr[6], pf[4], kxa, kxb; float ls;
#define ATT_SB __builtin_amdgcn_sched_barrier(0)
#define ATT_KX(tl) do { const f16 tr_ = (f16)(float)(T0 - (tl) - td); const f16 wa_ = (f16)(float)(r32 - wo), wb_ = (f16)(float)(32 + r32 - wo); h8 za, zb; \
                za[0] = tr_; za[1] = wa_; za[2] = tr_; za[3] = wa_; za[4] = (f16)1.f; za[5] = (f16)0.f; za[6] = (f16)0.f; za[7] = (f16)0.f; \
                zb[0] = tr_; zb[1] = wb_; zb[2] = tr_; zb[3] = wb_; zb[4] = (f16)1.f; zb[5] = (f16)0.f; zb[6] = (f16)0.f; zb[7] = (f16)0.f; \
                if (hi) { za[0] = (f16)0.f; za[1] = (f16)0.f; za[2] = (f16)0.f; za[3] = (f16)0.f; za[4] = (f16)0.f; zb[0] = (f16)0.f; zb[1] = (f16)0.f; zb[2] = (f16)0.f; zb[3] = (f16)0.f; zb[4] = (f16)0.f; } \
                kxa = za; kxb = zb; } while (0)
#define ATT_KLD(mp, tl) do { _Pragma("unroll") for (int kb = 0; kb < 2; ++kb) _Pragma("unroll") for (int j = 0; j < 2; ++j) \
                kfr[kb * 2 + j] = *(const LAS h8*)(kbase + (tl) * 16384 + ((mp) * 4 + j * 2) * 1024 + kb * 512); } while (0)
#define ATT_VLD(d, tl, sx, dh) vfr[d] = *(const LAS h8*)(vbase + (tl) * 16384 + (sx) * 2048 + (dh) * 512)
#define ATT_QKM(sn, mpn, qxn, j) do { if ((j) == 0) sn[0] = __builtin_amdgcn_mfma_f32_32x32x16_f16(kxa, qxn, (f32x16){}, 0, 0, 0); \
                else if ((j) == 1) sn[1] = __builtin_amdgcn_mfma_f32_32x32x16_f16(kxb, qxn, (f32x16){}, 0, 0, 0); \
                else if ((j) == 2) sn[0] = __builtin_amdgcn_mfma_f32_32x32x16_f16(kfr[0], qf[mpn][0], sn[0], 0, 0, 0); \
                else if ((j) == 3) sn[1] = __builtin_amdgcn_mfma_f32_32x32x16_f16(kfr[2], qf[mpn][0], sn[1], 0, 0, 0); \
                else if ((j) == 4) sn[0] = __builtin_amdgcn_mfma_f32_32x32x16_f16(kfr[1], qf[mpn][1], sn[0], 0, 0, 0); \
                else sn[1] = __builtin_amdgcn_mfma_f32_32x32x16_f16(kfr[3], qf[mpn][1], sn[1], 0, 0, 0); } while (0)
#define ATT_EXPH(sc, h) do { const float a0_ = __builtin_amdgcn_exp2f(sc[(h) >> 3][2 * ((h) & 7)]), a1_ = __builtin_amdgcn_exp2f(sc[(h) >> 3][2 * ((h) & 7) + 1]); \
                h2 p_; p_[0] = (f16)a0_; p_[1] = (f16)a1_; pf[(h) >> 2][2 * ((h) & 3)] = p_[0]; pf[(h) >> 2][2 * ((h) & 3) + 1] = p_[1]; \
                if (((h) & 1) == 0) hacc = p_; else { hacc = hacc + p_; asm volatile("v_dot2c_f32_f16 %0, %1, %2" : "+v"(ls) : "v"(hacc), "v"(ones)); } } while (0)
#define ATT_PLAINQK(sn, mpn, qxn) do { ATT_QKM(sn, mpn, qxn, 0); ATT_QKM(sn, mpn, qxn, 1); ATT_QKM(sn, mpn, qxn, 2); ATT_QKM(sn, mpn, qxn, 3); ATT_QKM(sn, mpn, qxn, 4); ATT_QKM(sn, mpn, qxn, 5); } while (0)
#define ATT_GENI(sc, mr, l, o, qx, tile, FIRST) do { \
                if ((tile) >= td) { _Pragma("unroll") for (int kb = 0; kb < 2; ++kb) _Pragma("unroll") for (int r = 0; r < 16; ++r) { const int kpos = 64 * (tile) + 32 * kb + crow(r, hi); if (kpos > q0w + r32) sc[kb][r] = -1e30f; } } \
                float rm = sc[0][0]; \
                _Pragma("unroll") for (int kb = 0; kb < 2; ++kb) _Pragma("unroll") for (int r = 0; r < 16; ++r) rm = fmaxf(rm, sc[kb][r]); \
                rm = swap_max(rm); \
                if ((FIRST) || __any(rm > 4.0f) != 0) { const float d = (FIRST) ? rm : fmaxf(rm, 0.f); const float f = __builtin_amdgcn_exp2f(-d); \
                    _Pragma("unroll") for (int kb = 0; kb < 2; ++kb) _Pragma("unroll") for (int r = 0; r < 16; ++r) sc[kb][r] -= d; \
                    mr += d; l *= f; o[0] *= f; o[1] *= f; if (!hi) qx[4] = (f16)(-mr); } } while (0)
#define ATT_BLOCK(sc, l, o, tlc, HASN, sn, mpn, qxn, NKLD) do { ls = 0.f; h2 hacc; \
                if (HASN) ATT_QKM(sn, mpn, qxn, 0); ATT_EXPH(sc, 0); ATT_SB; \
                if (HASN) ATT_QKM(sn, mpn, qxn, 1); ATT_EXPH(sc, 1); ATT_SB; \
                if (HASN) ATT_QKM(sn, mpn, qxn, 2); ATT_EXPH(sc, 2); ATT_VLD(0, tlc, 0, 0); ATT_VLD(1, tlc, 0, 1); ATT_SB; \
                if (HASN) ATT_QKM(sn, mpn, qxn, 3); ATT_EXPH(sc, 3); ATT_VLD(2, tlc, 1, 0); ATT_VLD(3, tlc, 1, 1); ATT_SB; \
                if (HASN) ATT_QKM(sn, mpn, qxn, 4); ATT_EXPH(sc, 4); ATT_VLD(4, tlc, 2, 0); ATT_VLD(5, tlc, 2, 1); ATT_SB; \
                if (HASN) ATT_QKM(sn, mpn, qxn, 5); ATT_EXPH(sc, 5); ATT_SB; \
                o[0] = __builtin_amdgcn_mfma_f32_32x32x16_f16(vfr[0], pf[0], o[0], 0, 0, 0); ATT_EXPH(sc, 6); ATT_EXPH(sc, 7); ATT_SB; \
                o[1] = __builtin_amdgcn_mfma_f32_32x32x16_f16(vfr[1], pf[0], o[1], 0, 0, 0); ATT_EXPH(sc, 8); NKLD; ATT_SB; \
                o[0] = __builtin_amdgcn_mfma_f32_32x32x16_f16(vfr[2], pf[1], o[0], 0, 0, 0); ATT_EXPH(sc, 9); ATT_EXPH(sc, 10); ATT_VLD(0, tlc, 3, 0); ATT_VLD(1, tlc, 3, 1); ATT_SB; \
                o[1] = __builtin_amdgcn_mfma_f32_32x32x16_f16(vfr[3], pf[1], o[1], 0, 0, 0); ATT_EXPH(sc, 11); ATT_SB; \
                o[0] = __builtin_amdgcn_mfma_f32_32x32x16_f16(vfr[4], pf[2], o[0], 0, 0, 0); ATT_EXPH(sc, 12); ATT_EXPH(sc, 13); ATT_SB; \
                o[1] = __builtin_amdgcn_mfma_f32_32x32x16_f16(vfr[5], pf[2], o[1], 0, 0, 0); ATT_EXPH(sc, 14); ATT_EXPH(sc, 15); ATT_SB; \
                o[0] = __builtin_amdgcn_mfma_f32_32x32x16_f16(vfr[0], pf[3], o[0], 0, 0, 0); ATT_SB; \
                o[1] = __builtin_amdgcn_mfma_f32_32x32x16_f16(vfr[1], pf[3], o[1], 0, 0, 0); ATT_SB; \
                l += ls; } while (0)
            if (!tlo) {
                ATT_KX(0); ATT_KLD(0, 0); ATT_PLAINQK(s0, 0, qx1); ATT_SB; ATT_KLD(1, 0); ATT_SB;
                if (gen) ATT_GENI(s0, mr1, l1, o1, qx1, T0, first);
                ATT_BLOCK(s0, l1, o1, 0, true, s1, 1, qx2, ATT_KLD(0, 1));
                ATT_KX(1);
                if (gen) ATT_GENI(s1, mr2, l2, o2, qx2, T0, first);
                ATT_BLOCK(s1, l2, o2, 0, true, s0, 0, qx1, ATT_KLD(1, 1));
            } else {
                ATT_KX(1); ATT_KLD(0, 1); ATT_PLAINQK(s0, 0, qx1); ATT_SB; ATT_KLD(1, 1); ATT_SB;
            }
            { const bool f2 = first && tlo;
              if (gen) ATT_GENI(s0, mr1, l1, o1, qx1, T1, f2);
              ATT_BLOCK(s0, l1, o1, 1, true, s1, 1, qx2, (void)0);
              if (gen) ATT_GENI(s1, mr2, l2, o2, qx2, T1, f2);
              ATT_BLOCK(s1, l2, o2, 1, false, s0, 0, qx1, (void)0); }
#undef ATT_SB
#undef ATT_KX
#undef ATT_KLD
#undef ATT_VLD
#undef ATT_QKM
#undef ATT_EXPH
#undef ATT_PLAINQK
#undef ATT_GENI
#undef ATT_BLOCK
            const float far = fmaxf(sb1 - mr1, sb2 - mr2) + slope2 * (float)(64 * T1 - 1 - q0w);
            need = (T1 >= 1) && (__any(far >= ATT_SKIP) != 0);
            if (!need) wdone = true;
        }
        if (lane == 0) flags[8 * ((ii + 1) & 1) + wave] = need ? 1 : 0;
    }
    asm volatile("s_waitcnt vmcnt(0) lgkmcnt(0)" ::: "memory");
    __builtin_amdgcn_s_barrier();
    asm volatile("" ::: "memory");
#undef ATT_ISSUE
    unsigned nxt = 0;
    if (F.tid == 0) nxt = __hip_atomic_fetch_add(qc, 1u, RLX_AGENT);
    l1 = swap_add(l1); l2 = swap_add(l2);
    const float i1 = 1.0f / l1, i2 = lam / l2;
    float ss = 0.f;
#pragma unroll
    for (int dh = 0; dh < 2; ++dh)
#pragma unroll
        for (int r = 0; r < 16; ++r) { const float v = o1[dh][r] * i1 - o2[dh][r] * i2; o1[dh][r] = v; ss += v * v; }
    ss = swap_add(ss);
    const float rs = rsqrtf(ss * (1.0f / 64.0f) + RMS_EPS) * 0.8f;
    const LAS float* sg = (const LAS float*)(lds + ATT_SG);
    f16* orow = mix + (rowbase + q0w + r32) * 1024 + 512 + hd * 64;
#pragma unroll
    for (int dh = 0; dh < 2; ++dh)
#pragma unroll
        for (int gp = 0; gp < 2; ++gp) {
            typedef unsigned u32x2 __attribute__((ext_vector_type(2))); typedef unsigned u32x4 __attribute__((ext_vector_type(4)));
            u32x2 pk[2];
#pragma unroll
            for (int j = 0; j < 2; ++j) { const int gq = 2 * gp + j; const int dv = 32 * dh + 8 * gq + 4 * hi; const f32x4 gg = *(const LAS f32x4*)(sg + dv);
                h4 o; o[0] = (f16)(o1[dh][4 * gq] * rs * gg[0]); o[1] = (f16)(o1[dh][4 * gq + 1] * rs * gg[1]); o[2] = (f16)(o1[dh][4 * gq + 2] * rs * gg[2]); o[3] = (f16)(o1[dh][4 * gq + 3] * rs * gg[3]);
                pk[j] = __builtin_bit_cast(u32x2, o); }
            const auto s0 = __builtin_amdgcn_permlane32_swap(pk[0][0], pk[1][0], false, false), s1 = __builtin_amdgcn_permlane32_swap(pk[0][1], pk[1][1], false, false);
            u32x4 w; w[0] = s0[0]; w[1] = s1[0]; w[2] = s0[1]; w[3] = s1[1];
            *(u32x4*)(orow + 32 * dh + 16 * gp + 8 * hi) = w;
        }
    if (F.tid == 0) slot[0] = (int)nxt;
    __syncthreads();
    const int nit = __builtin_amdgcn_readfirstlane(slot[0]);
    __syncthreads();
    return nit;
}

constexpr int SSM_UROW = 528, SSM_EROW = 528, SSM_XROW = 272;
constexpr int SSM_U0 = 0, SSM_U1 = 64 * SSM_UROW, SSM_E = 2 * 64 * SSM_UROW, SSM_XP = SSM_E + 64 * SSM_EROW;
typedef float f32x4_t __attribute__((ext_vector_type(4)));
__device__ __forceinline__ void ssm_unit(Frame& F, int b, int g) {
    const Args& A = *F.a; const int tid = F.tid, wave = F.wave, lane = F.lane, fr = lane & 15, fq = lane >> 4;
    const f16* ops = (const f16*)(F.ws + WS_SSMOP) + (size_t)g * 131072;
    const f16* Top = ops; const f16* We = ops + 65536; const f16* Wc = ops + 65536 + 32768;
    const char* ugb = (const char*)((const f16*)(F.ws + WS_UG) + (size_t)((b * 32 + g) * 8192) * 16);
    f16* yh = (f16*)(F.ws + WS_YH) + (size_t)b * SEQ * 512 + g * 16;
    LAS unsigned char* lds = F.lds;
    h8 BY[2][12];
#pragma unroll
    for (int n2 = 0; n2 < 2; ++n2) {
        const int nrow = 16 * (2 * wave + n2) + fr;
#pragma unroll
        for (int kk = 0; kk < 8; ++kk) BY[n2][kk] = *(const h8*)(Top + nrow * 256 + 32 * kk + 8 * fq);
#pragma unroll
        for (int kk = 0; kk < 4; ++kk) BY[n2][8 + kk] = *(const h8*)(Wc + nrow * 128 + 32 * kk + 8 * fq);
    }
    const float* a16 = (const float*)(F.ws + WS_A16) + (g * 64 + lane) * 2;
    const float a16r = a16[0], a16i = a16[1];
    const f32x4 dsk = *(const f32x4*)(A.in[I_SSMD] + g * 16 + 4 * fq);
    float xr = 0.f, xi = 0.f;
#pragma unroll
    for (int q = 0; q < 4; ++q) { const int o = (q * NTHREADS + tid) * 16; const h8 v = *(const h8*)(ugb + o); *(LAS h8*)(lds + SSM_U0 + (o >> 9) * SSM_UROW + (o & 511)) = v; }
    __syncthreads();
#pragma unroll 1
    for (int seg = 0; seg < 8; ++seg) {
        LAS unsigned char* Uc = lds + ((seg & 1) ? SSM_U1 : SSM_U0);
        LAS unsigned char* Un = lds + ((seg & 1) ? SSM_U0 : SSM_U1);
        {
            f32x4 ea[4]; h8 BE[8];
#pragma unroll
            for (int kk = 0; kk < 8; ++kk) BE[kk] = *(const h8*)(We + (16 * wave + fr) * 256 + 32 * kk + 8 * fq);
#pragma unroll
            for (int mt = 0; mt < 4; ++mt) ea[mt] = (f32x4){0.f, 0.f, 0.f, 0.f};
#pragma unroll
            for (int kk = 0; kk < 8; ++kk)
#pragma unroll
                for (int mt = 0; mt < 4; ++mt) { const h8 a = *(const LAS h8*)(Uc + (16 * mt + fr) * SSM_UROW + (32 * kk + 8 * fq) * 2); ea[mt] = __builtin_amdgcn_mfma_f32_16x16x32_f16(BE[kk], a, ea[mt], 0, 0, 0); }
#pragma unroll
            for (int mt = 0; mt < 4; ++mt) *(LAS f32x4*)(lds + SSM_E + (16 * mt + fr) * SSM_EROW + (16 * wave + 4 * fq) * 4) = ea[mt];
        }
        __syncthreads();
        if (wave == 0) {
#pragma unroll 8
            for (int n = 0; n < 64; ++n) {
                const float er = *(const LAS float*)(lds + SSM_E + n * SSM_EROW + lane * 4), ei = *(const LAS float*)(lds + SSM_E + n * SSM_EROW + (64 + lane) * 4);
                *(LAS f16*)(lds + SSM_XP + n * SSM_XROW + lane * 2) = (f16)xr; *(LAS f16*)(lds + SSM_XP + n * SSM_XROW + (64 + lane) * 2) = (f16)xi;
                const float nr = a16r * xr - a16i * xi + er, ni = a16r * xi + a16i * xr + ei; xr = nr; xi = ni;
            }
        } else if (seg < 7) {
            const char* src = ugb + (size_t)(seg + 1) * 32768;
            for (int v = tid - 64; v < 2048; v += NTHREADS - 64) { const int o = v * 16; const h8 x = *(const h8*)(src + o); *(LAS h8*)(Un + (o >> 9) * SSM_UROW + (o & 511)) = x; }
        }
        __syncthreads();
        {
            f32x4 ya[4][2];
#pragma unroll
            for (int mt = 0; mt < 4; ++mt) { ya[mt][0] = (f32x4){0.f, 0.f, 0.f, 0.f}; ya[mt][1] = (f32x4){0.f, 0.f, 0.f, 0.f}; }
#pragma unroll
            for (int kk = 0; kk < 12; ++kk)
#pragma unroll
                for (int mt = 0; mt < 4; ++mt) {
                    const h8 a = kk < 8 ? *(const LAS h8*)(Uc + (16 * mt + fr) * SSM_UROW + (32 * kk + 8 * fq) * 2) : *(const LAS h8*)(lds + SSM_XP + (16 * mt + fr) * SSM_XROW + (32 * (kk - 8) + 8 * fq) * 2);
                    ya[mt][0] = __builtin_amdgcn_mfma_f32_16x16x32_f16(BY[0][kk], a, ya[mt][0], 0, 0, 0);
                    ya[mt][1] = __builtin_amdgcn_mfma_f32_16x16x32_f16(BY[1][kk], a, ya[mt][1], 0, 0, 0);
                }
#pragma unroll
            for (int mt = 0; mt < 4; ++mt)
#pragma unroll
                for (int n2 = 0; n2 < 2; ++n2) {
                    const int ch = 16 * mt + fr, ti = 2 * wave + n2; const size_t tok = (size_t)(seg * 64 + ch) * 16 + ti;
                    const h4 u4 = *(const LAS h4*)(Uc + ch * SSM_UROW + (ti * 16 + 4 * fq) * 2);
                    h4 o;
#pragma unroll
                    for (int e = 0; e < 4; ++e) o[e] = (f16)gelu_tanh(ya[mt][n2][e] + dsk[e] * (float)u4[e]);
                    *(h4*)(yh + tok * 512 + 4 * fq) = o;
                }
        }
    }
    __syncthreads();
}

__device__ __forceinline__ void p2_mixers(Frame& F, int pass) {
    const Args& A = *F.a;
    gu32* qctr = F.ctl + CW_QUEUE + 128 * pass;
    constexpr int NSSM = BATCH * NG, NATT = BATCH * NH * 32;
    volatile LAS int* slot = (volatile LAS int*)(F.lds + LDS_BARST + 16);
    for (;;) {
        if (F.tid == 0) slot[0] = (int)__hip_atomic_fetch_add(qctr, 1u, RLX_AGENT);
        __syncthreads();
        const int it = __builtin_amdgcn_readfirstlane(slot[0]);
        __syncthreads();
        if (it >= NSSM) break;
        if (pass == 1 && PROBE_SEL != 0 && PROBE_SEL != 1) continue;
        ssm_unit(F, it / NG, it % NG);
    }
    asm volatile("" ::: "memory");
    float lam;
    { float d1 = 0.f, d2 = 0.f;
#pragma unroll 1
      for (int i = 0; i < 32; ++i) { d1 += A.in[I_LQ1][i] * A.in[I_LK1][i]; d2 += A.in[I_LQ2][i] * A.in[I_LK2][i]; }
      lam = __expf(d1) - __expf(d2) + 0.2f; }
    asm volatile("" : "+v"(lam));
    if (F.tid < 64) *(LAS float*)(F.lds + ATT_SG + F.tid * 4) = A.in[I_SUBLN][F.tid];
    int ait;
    { if (F.tid == 0) slot[0] = (int)__hip_atomic_fetch_add(qctr + 64, 1u, RLX_AGENT);
      __syncthreads();
      ait = __builtin_amdgcn_readfirstlane(slot[0]);
      __syncthreads(); }
    while (ait < NATT) {
        const int qb = 31 - ait / 32, bh = ait % 32;
        if (pass == 1 && PROBE_SEL != 0) { const int hd_ = bh & 7; const bool sel = PROBE_SEL == 2 ? hd_ >= 6 : PROBE_SEL == 3 ? hd_ <= 3 : PROBE_SEL == 4 ? (hd_ == 7 && qb == 31) : PROBE_SEL == 5 ? (hd_ == 4 || hd_ == 5) : false;
            if (!sel) { if (F.tid == 0) slot[0] = (int)__hip_atomic_fetch_add(qctr + 64, 1u, RLX_AGENT); __syncthreads(); ait = __builtin_amdgcn_readfirstlane(slot[0]); __syncthreads(); continue; } }
        ait = attn_unit(F, bh >> 3, bh & 7, qb, lam, qctr + 64, slot);
    }
    constexpr int NPLE = (T / 256) * 4, WDN_ITEMS = NE * 16 * 32, WDN_CHUNK = 32, NWDN = WDN_ITEMS / WDN_CHUNK;
    gu32* fctr = F.ctl + CW_QUEUE + 256 + 64 * pass;
    for (;;) {
        if (F.tid == 0) slot[0] = (int)__hip_atomic_fetch_add(fctr, 1u, RLX_AGENT);
        __syncthreads();
        const int it = __builtin_amdgcn_readfirstlane(slot[0]);
        __syncthreads();
        if (it >= NPLE + NWDN) break;
        if (it < NPLE) {
            ProbPleProj P{(const char*)(F.ws + WS_PH), (const char*)(F.ws + WS_WPP), (f16*)(F.ws + WS_PE)};
            pg8::OneOrder S; S.u.pm = it >> 2; S.u.pn = it & 3; S.u.e = 0; S.u.cnt = 0; pg8::gemm_phase(F.lds, P, S);
        } else {
            LAS float* scr = (LAS float*)(F.lds + F.wave * 16384);
#pragma unroll 1
            for (int j = 0; j < WDN_CHUNK / 8; ++j) { const int r = (it - NPLE) * WDN_CHUNK + j * 8 + F.wave; const int e = r / (16 * 32), ii = r % (16 * 32);
                tr_item(A.in[I_WDN] + (size_t)e * 1024 * 1024, 1024, 1024, (f16*)(F.ws + WS_WDN + (size_t)e * 1024 * 1024), ii, 4, nullptr, scr, F.lane); }
        }
        __syncthreads();
    }
}

__device__ __forceinline__ void p3_glu(Frame& F) {
    ProbGlu P{(const char*)(F.ws + WS_YH), (const char*)(F.ws + WS_WGLU), (f16*)(F.ws + WS_MIX), (float*)(F.ws + WS_YSS)};
    pg8::DenseOrder S; S.init(T, 1024, F.G, (int)blockIdx.x); pg8::gemm_phase(F.lds, P, S);
}

__device__ __forceinline__ void p4_outproj(Frame& F) {
    ProbOut P{(const char*)(F.ws + WS_MIX), (const char*)(F.ws + WS_WOUT), (f16*)(F.ws + WS_MIXO), (const float*)(F.ws + WS_YSS)};
    pg8::DenseOrder S; S.init(T, DM, F.G, (int)blockIdx.x); pg8::gemm_phase(F.lds, P, S);
}

constexpr int RT_XROW = 2064;
constexpr int RT_XHI = 0, RT_XLO = 32 * RT_XROW;
constexpr int RT_PART = 0;
constexpr int RT_FIN = 2 * 32 * RT_XROW;
constexpr int RT_CNT = RT_FIN + 32 * 33 * 4;
__device__ __forceinline__ void p5_router(Frame& F, int pass) {
    const Args& A = *F.a; const int tid = F.tid, lane = F.lane, wave = F.wave, r32 = lane & 31, hi = lane >> 5;
    LAS unsigned char* lds = F.lds;
    LAS unsigned* lcnt = (LAS unsigned*)(lds + RT_CNT); LAS unsigned* lbase = lcnt + 32; LAS unsigned* asg = lcnt + 64;
    if (tid < 32) lcnt[tid] = 0u;
    const float* xin = A.in[I_X]; const f16* mixo = (const f16*)(F.ws + WS_MIXO); f16* x1h = (f16*)(F.ws + WS_X1H); unsigned char* x1q = (unsigned char*)(F.ws + WS_X1Q); float* gates = (float*)(F.ws + WS_GATES);
    h8 whi[8], wlo[8];
#pragma unroll
    for (int kk = 0; kk < 8; ++kk)
#pragma unroll
        for (int e = 0; e < 8; ++e) { const float w = A.in[I_WR][(128 * wave + 16 * kk + 8 * hi + e) * 32 + r32]; const f16 h = (f16)w; whi[kk][e] = h; wlo[kk][e] = (f16)(w - (float)h); }
    f32x4 gv[4], bv[4];
#pragma unroll
    for (int jx = 0; jx < 4; ++jx) { gv[jx] = *(const f32x4*)(A.in[I_LN1G] + 256 * jx + 4 * lane); bv[jx] = *(const f32x4*)(A.in[I_LN1B] + 256 * jx + 4 * lane); }
    const int rows_per_blk = T / F.G;
#pragma unroll 1
    for (int bt = 0; bt < rows_per_blk / 32; ++bt) {
        const int row0 = (bt * F.G + (int)blockIdx.x) * 32;
#pragma unroll 1
        for (int rr = 0; rr < 4; ++rr) {
            const int lr = wave * 4 + rr; const size_t ro = (size_t)(row0 + lr) * 1024;
            f32x4 v[4]; float s1 = 0.f, s2 = 0.f;
#pragma unroll
            for (int jx = 0; jx < 4; ++jx) { const f32x4 xv = *(const f32x4*)(xin + ro + 256 * jx + 4 * lane); const h4 mv = *(const h4*)(mixo + ro + 256 * jx + 4 * lane);
#pragma unroll
                for (int e = 0; e < 4; ++e) { const float t = ALPHA * xv[e] + (float)mv[e]; v[jx][e] = t; s1 += t; } }
            const float mean = wave_sum(s1) * (1.0f / 1024.0f);
#pragma unroll
            for (int jx = 0; jx < 4; ++jx) { v[jx] = v[jx] - mean; s2 += (v[jx][0] * v[jx][0] + v[jx][1] * v[jx][1]) + (v[jx][2] * v[jx][2] + v[jx][3] * v[jx][3]); }
            const float rstd = rsqrtf(wave_sum(s2) * (1.0f / 1024.0f) + LN_EPS);
#pragma unroll
            for (int jx = 0; jx < 4; ++jx) {
                const f32x4 y = v[jx] * rstd * gv[jx] + bv[jx];
                h4 yh_, yl_;
#pragma unroll
                for (int e = 0; e < 4; ++e) { const f16 h = (f16)y[e]; yh_[e] = h; yl_[e] = (f16)(y[e] - (float)h); }
                *(h4*)(x1h + ro + 256 * jx + 4 * lane) = yh_;
                *(int*)(x1q + ro + 256 * jx + 4 * lane) = pack_fp8x4(y[0], y[1], y[2], y[3]);
                *(LAS h4*)(lds + RT_XHI + lr * RT_XROW + (256 * jx + 4 * lane) * 2) = yh_;
                *(LAS h4*)(lds + RT_XLO + lr * RT_XROW + (256 * jx + 4 * lane) * 2) = yl_;
            }
        }
        __syncthreads();
        f32x16 acc = {};
#pragma unroll
        for (int kk = 0; kk < 8; ++kk) {
            const int ko = (128 * wave + 16 * kk + 8 * hi) * 2;
            const h8 xh_ = *(const LAS h8*)(lds + RT_XHI + r32 * RT_XROW + ko), xl_ = *(const LAS h8*)(lds + RT_XLO + r32 * RT_XROW + ko);
            acc = __builtin_amdgcn_mfma_f32_32x32x16_f16(whi[kk], xh_, acc, 0, 0, 0);
            acc = __builtin_amdgcn_mfma_f32_32x32x16_f16(wlo[kk], xh_, acc, 0, 0, 0);
            acc = __builtin_amdgcn_mfma_f32_32x32x16_f16(whi[kk], xl_, acc, 0, 0, 0);
        }
        __syncthreads();
#pragma unroll
        for (int g = 0; g < 4; ++g) { f32x4 o; o[0] = acc[4 * g]; o[1] = acc[4 * g + 1]; o[2] = acc[4 * g + 2]; o[3] = acc[4 * g + 3];
            *(LAS f32x4*)(lds + RT_PART + (((wave * 32 + r32) * 32) + 8 * g + 4 * hi) * 4) = o; }
        __syncthreads();
        { const int row = tid >> 4, e0 = 2 * (tid & 15); float a0 = A.in[I_BR][e0], a1 = A.in[I_BR][e0 + 1];
#pragma unroll
          for (int w = 0; w < 8; ++w) { a0 += *(const LAS float*)(lds + RT_PART + (((w * 32 + row) * 32) + e0) * 4); a1 += *(const LAS float*)(lds + RT_PART + (((w * 32 + row) * 32) + e0 + 1) * 4); }
          *(LAS float*)(lds + RT_FIN + (row * 33 + e0) * 4) = a0; *(LAS float*)(lds + RT_FIN + (row * 33 + e0 + 1) * 4) = a1; }
        __syncthreads();
        if (tid < 32) {
            const LAS float* lg = (const LAS float*)(lds + RT_FIN + tid * 33 * 4);
            float tv[4]; int te[4];
#pragma unroll
            for (int k = 0; k < 4; ++k) { tv[k] = -INFINITY; te[k] = 0; }
#pragma unroll 1
            for (int e = 0; e < 32; ++e) { const float x = lg[e];
                if (x > tv[3]) {
                    if (x > tv[0]) { tv[3] = tv[2]; te[3] = te[2]; tv[2] = tv[1]; te[2] = te[1]; tv[1] = tv[0]; te[1] = te[0]; tv[0] = x; te[0] = e; }
                    else if (x > tv[1]) { tv[3] = tv[2]; te[3] = te[2]; tv[2] = tv[1]; te[2] = te[1]; tv[1] = x; te[1] = e; }
                    else if (x > tv[2]) { tv[3] = tv[2]; te[3] = te[2]; tv[2] = x; te[2] = e; }
                    else { tv[3] = x; te[3] = e; } } }
            const float e1 = __expf(tv[1] - tv[0]), e2 = __expf(tv[2] - tv[0]), e3 = __expf(tv[3] - tv[0]); const float inv = 1.0f / (1.0f + e1 + e2 + e3);
            const int row = row0 + tid; f32x4 gk; gk[0] = inv; gk[1] = e1 * inv; gk[2] = e2 * inv; gk[3] = e3 * inv;
            *(f32x4*)(gates + (size_t)row * 4) = gk;
#pragma unroll
            for (int k = 0; k < 4; ++k) { const unsigned rk = atomicAdd((unsigned*)&lcnt[te[k]], 1u); asg[(bt * 32 + tid) * 4 + k] = (unsigned)te[k] | (rk << 8); }
        }
        __syncthreads();
    }
    if (F.tid < 32) lbase[F.tid] = __hip_atomic_fetch_add(F.ctl + CW_CNT + 2048 * pass + 64 * F.tid, lcnt[F.tid], RLX_AGENT);
    __syncthreads();
    int* list = (int*)(F.ws + WS_LIST + (size_t)pass * 4 * MiB);
    { const unsigned a = asg[F.tid]; const int e = a & 255, rk = a >> 8; const int row = ((F.tid >> 7) * F.G + (int)blockIdx.x) * 32 + ((F.tid >> 2) & 31);
      list[(size_t)e * ECAP + lbase[e] + rk] = row * 4 + (F.tid & 3); }
    __syncthreads();
}

template <int WHICH> __device__ __forceinline__ void p67_moe(Frame& F) {
    const Args& A = *F.a;
    LAS int* tab = (LAS int*)(F.lds + pg8::STAGE_BYTES + 2048);
    if (F.tid < 32) tab[F.tid] = (int)__hip_atomic_load(F.ctl + CW_CNT + 64 * F.tid, RLX_AGENT);
    __syncthreads();
    if (F.tid == 0) { int sacc = 0; for (int e = 0; e < 32; ++e) { tab[32 + e] = sacc; sacc += (tab[e] + 255) >> 8; } tab[64] = sacc; }
    __syncthreads();
    const int* list = (const int*)(F.ws + WS_LIST);
    if (WHICH == 0) {
        ProbMoeUp P{(const char*)(F.ws + WS_X1Q), (const char*)(F.ws + WS_WGU), list, A.in[I_BGU], (unsigned char*)(F.ws + WS_ACT)};
        pg8::MoeOrder S{tab, 8, F.G, F.vcu}; pg8::gemm_phase(F.lds, P, S);
    } else {
        ProbMoeDn P{(const char*)(F.ws + WS_ACT), (const char*)(F.ws + WS_WDN), list, A.in[I_BDN], (const float*)(F.ws + WS_GATES), (unsigned char*)(F.ws + WS_SLAB)};
        pg8::MoeOrder S{tab, 4, F.G, F.vcu}; pg8::gemm_phase(F.lds, P, S);
    }
    __syncthreads();
}

__device__ __forceinline__ void p8_combine(Frame& F) {
    const int lane = F.lane;
    typedef int i32x2 __attribute__((ext_vector_type(2))); typedef float f32x2 __attribute__((ext_vector_type(2)));
    const f16* x1h = (const f16*)(F.ws + WS_X1H); const unsigned char* slab = (const unsigned char*)(F.ws + WS_SLAB); f16* rh = (f16*)(F.ws + WS_RH); unsigned char* rq = (unsigned char*)(F.ws + WS_RQ);
    for (int row = F.gw; row < T; row += F.NGW) {
#pragma unroll
        for (int j = 0; j < 2; ++j) {
            const size_t o = (size_t)row * 1024 + 512 * j + 8 * lane;
            const h8 xv = *(const h8*)(x1h + o); float v[8], acc[8];
#pragma unroll
            for (int e = 0; e < 8; ++e) { v[e] = ALPHA * (float)xv[e]; acc[e] = 0.f; }
#pragma unroll
            for (int k = 0; k < 4; ++k) { const i32x2 sv = *(const i32x2*)(slab + ((size_t)row * 4 + k) * 1024 + 512 * j + 8 * lane);
#pragma unroll
                for (int q = 0; q < 2; ++q) { const f32x2 lo = __builtin_amdgcn_cvt_pk_f32_fp8(sv[q], false), hi = __builtin_amdgcn_cvt_pk_f32_fp8(sv[q], true);
                    acc[4 * q] += lo[0]; acc[4 * q + 1] += lo[1]; acc[4 * q + 2] += hi[0]; acc[4 * q + 3] += hi[1]; } }
            h8 hh;
#pragma unroll
            for (int e = 0; e < 8; ++e) { v[e] += acc[e] * (1.0f / SLAB_SCALE); hh[e] = (f16)v[e]; v[e] = fminf(fmaxf(v[e] * RQ_SCALE, -448.f), 448.f); }
            *(h8*)(rh + o) = hh;
            i32x2 qq = {pack_fp8x4(v[0], v[1], v[2], v[3]), pack_fp8x4(v[4], v[5], v[6], v[7])}; *(i32x2*)(rq + o) = qq;
        }
    }
}

__device__ __forceinline__ void p9_ple(Frame& F) {
    ProbPleGate P{(const char*)(F.ws + WS_RQ), (const char*)(F.ws + WS_WPG), (f16*)(F.ws + WS_GATEH)};
    pg8::DenseOrder S; S.init(T, DM, F.G, (int)blockIdx.x); pg8::gemm_phase(F.lds, P, S);
}

__device__ __forceinline__ void p10_ln2(Frame& F) {
    const Args& A = *F.a; const int lane = F.lane; float* out = A.out; const f16* rh = (const f16*)(F.ws + WS_RH); const f16* gateh = (const f16*)(F.ws + WS_GATEH); const f16* pe = (const f16*)(F.ws + WS_PE);
    f32x4 gv[4], bv[4];
#pragma unroll
    for (int j = 0; j < 2; ++j)
#pragma unroll
        for (int q = 0; q < 2; ++q) { gv[2 * j + q] = *(const f32x4*)(A.in[I_LN2G] + 512 * j + 8 * lane + 4 * q); bv[2 * j + q] = *(const f32x4*)(A.in[I_LN2B] + 512 * j + 8 * lane + 4 * q); }
    for (int row = F.gw; row < T; row += F.NGW) {
        f32x4 v[4]; float s = 0.f;
#pragma unroll
        for (int j = 0; j < 2; ++j) { const size_t o_ = (size_t)row * 1024 + 512 * j + 8 * lane; const h8 r8 = *(const h8*)(rh + o_), g8 = *(const h8*)(gateh + o_), p8 = *(const h8*)(pe + o_);
#pragma unroll
            for (int q = 0; q < 2; ++q) { f32x4 t;
#pragma unroll
                for (int e = 0; e < 4; ++e) t[e] = (float)r8[4 * q + e] + (float)g8[4 * q + e] * (float)p8[4 * q + e];
                v[2 * j + q] = t; s += (t[0] + t[1]) + (t[2] + t[3]); } }
        const float mean = wave_sum(s) * (1.0f / 1024.0f); float s2 = 0.f;
#pragma unroll
        for (int j = 0; j < 4; ++j) { v[j] = v[j] - mean; s2 += (v[j][0] * v[j][0] + v[j][1] * v[j][1]) + (v[j][2] * v[j][2] + v[j][3] * v[j][3]); }
        const float rstd = rsqrtf(wave_sum(s2) * (1.0f / 1024.0f) + LN_EPS);
#pragma unroll
        for (int j = 0; j < 2; ++j)
#pragma unroll
            for (int q = 0; q < 2; ++q) *(f32x4*)(out + (size_t)row * 1024 + 512 * j + 8 * lane + 4 * q) = v[2 * j + q] * rstd * gv[2 * j + q] + bv[2 * j + q];
    }
}

__global__ void __launch_bounds__(NTHREADS, 2) fwd_kernel(Args args) {
    extern __shared__ __attribute__((aligned(16))) unsigned char lds_raw[];
    Frame F;
    F.lds = (LAS unsigned char*)lds_raw; F.a = &args; F.ws = args.ws; F.ctl = (gu32*)(args.ws + WS_CTL);
    F.tid = threadIdx.x; F.lane = F.tid & 63; F.wave = __builtin_amdgcn_readfirstlane(F.tid >> 6);
    F.G = gridDim.x; F.gw = blockIdx.x * NWAVES + F.wave; F.NGW = F.G * NWAVES;
    { const int bx = blockIdx.x; F.vcu = (F.G % 8 == 0) ? (bx % 8) * (F.G / 8) + bx / 8 : bx; }
    volatile LAS unsigned* barst = (volatile LAS unsigned*)(F.lds + LDS_BARST);
    if (F.tid < 16) barst[F.tid] = 0u;
    __syncthreads();
    XcdBarrier bar; bar.bar = (unsigned*)(F.ctl + CW_BAR); bar.x = 0; bar.st = nullptr;
    if (MK_N_LAUNCHES == 1) bar = xcd_barrier_post((unsigned*)(F.ctl + CW_BAR), barst);
    const int lo = args.ph_lo, hi = args.ph_hi;
#define IN(k) (lo <= (k) && (k) < hi)
#define SEAM(k) do { if (IN(k) && IN((k) + 1)) xcd_barrier(bar); } while (0)
#define REP(k, body) do { if (IN(k)) { body; if ((PROBE_MASK >> (k)) & 1) { xcd_barrier(bar); body; } } } while (0)
    REP(0, p0_prologue(F)); SEAM(0);
    REP(1, p1_inproj(F)); SEAM(1);
    if (IN(2)) { p2_mixers(F, args.pass); if ((PROBE_MASK >> 2) & 1) { xcd_barrier(bar); p2_mixers(F, 1); } } SEAM(2);
    REP(3, p3_glu(F)); SEAM(3);
    REP(4, p4_outproj(F)); SEAM(4);
    if (IN(5)) { p5_router(F, args.pass); } SEAM(5);
    REP(6, p67_moe<0>(F)); SEAM(6);
    REP(7, p67_moe<1>(F)); SEAM(7);
    REP(8, p8_combine(F)); SEAM(8);
    REP(9, p9_ple(F)); SEAM(9);
    if (IN(10)) { p10_ln2(F); }
#undef REP
#undef IN
#undef SEAM
}
}

extern "C" void kernel_launch(void* const* d_in, const int* in_sizes, int n_in, void* d_out, int out_size, void* d_ws, size_t ws_size, hipStream_t stream) {
    static int grid = 0;
    if (grid == 0) {
        if (n_in != 31 || out_size != T * DM || ws_size < WS_END) { fprintf(stderr, "kernel_launch: unexpected problem (n_in %d, out %d, ws %zu)\n", n_in, out_size, ws_size); grid = -1; return; }
        int dev = 0, cus = 0;
        if (hipGetDevice(&dev) != hipSuccess || hipDeviceGetAttribute(&cus, hipDeviceAttributeMultiprocessorCount, dev) != hipSuccess) { grid = -1; return; }
        if (hipFuncSetAttribute((const void*)fwd_kernel, hipFuncAttributeMaxDynamicSharedMemorySize, LDS_BYTES) != hipSuccess) { fprintf(stderr, "kernel_launch: hipFuncSetAttribute failed\n"); grid = -1; return; }
        int per_cu = 0;
        if (hipOccupancyMaxActiveBlocksPerMultiprocessor(&per_cu, (const void*)fwd_kernel, NTHREADS, LDS_BYTES) != hipSuccess || per_cu < 1) { fprintf(stderr, "kernel_launch: occupancy query says %d\n", per_cu); }
        (void)hipGetLastError();
        grid = cus;
    }
    if (grid < 0) return;
    (void)hipMemsetAsync((char*)d_ws + WS_CTL, 0, CTL_ZERO_BYTES, stream);
    Args a{};
    for (int i = 0; i < 31; ++i) a.in[i] = (const float*)d_in[i];
    a.out = (float*)d_out; a.ws = (unsigned char*)d_ws;
    if (MK_N_LAUNCHES == 1) { a.ph_lo = 0; a.ph_hi = NPHASE; hipLaunchKernelGGL(fwd_kernel, dim3(grid), dim3(NTHREADS), LDS_BYTES, stream, a); }
    else { for (int p = 0; p < NPHASE; ++p) { a.ph_lo = p; a.ph_hi = p + 1; a.pass = 0; hipLaunchKernelGGL(fwd_kernel, dim3(grid), dim3(NTHREADS), LDS_BYTES, stream, a);
             if (p == PROBE_DUP) { a.pass = 1; hipLaunchKernelGGL(fwd_kernel, dim3(grid), dim3(NTHREADS), LDS_BYTES, stream, a); } } }
}
```
